# Optimizing an MI355X kernel written in HIP

```python
import jax, jax.numpy as jnp
from jax import lax
import numpy as np

D_MODEL = 1024
BATCH = 4
SEQ = 8192
DEPTH = 1

D_RNN = 1024
RNN_BLOCKS = 8
RNN_BW = D_RNN // RNN_BLOCKS
CONV_W = 4
LRU_C = 8.0
N_HEADS = 8
HEAD_DIM = 128
D_ATTN = N_HEADS * HEAD_DIM
MOBA_BLOCK = 256
MOBA_TOPK = 3
Q_CHUNK = 32
N_BRANCH = 2
D_FF = 2816
FFN_CONV_W = 3

D_IN = 2 * D_RNN + 3 * D_ATTN + N_BRANCH * D_MODEL
EPS = 1e-6
NEG = -1e30

kernel_name = "hybrid_rglru_moba_convffn_block"


def rmsnorm(x, g):
    xf = x.astype(jnp.float32)
    y = xf * lax.rsqrt(jnp.mean(xf * xf, axis=-1, keepdims=True) + EPS)
    return (y * g.astype(jnp.float32)).astype(x.dtype)


def causal_dwconv(x, w, b):
    width = w.shape[0]
    s = x.shape[1]
    xp = jnp.pad(x, ((0, 0), (width - 1, 0), (0, 0)))
    y = b
    for k in range(width):
        y = y + xp[:, k:k + s] * w[k]
    return y


def rg_lru(x, w_r, b_r, w_i, b_i, lam):
    bsz, s, _ = x.shape
    xb = x.reshape(bsz, s, RNN_BLOCKS, RNN_BW)
    r = jax.nn.sigmoid(jnp.einsum('bsnc,ncd->bsnd', xb, w_r) + b_r).reshape(bsz, s, D_RNN)
    i = jax.nn.sigmoid(jnp.einsum('bsnc,ncd->bsnd', xb, w_i) + b_i).reshape(bsz, s, D_RNN)
    log_a = (-LRU_C * r.astype(jnp.float32)) * jax.nn.softplus(-lam.astype(jnp.float32))
    a = jnp.exp(log_a)
    mult = jnp.sqrt(-jnp.expm1(2.0 * log_a))
    bx = mult * (i * x).astype(jnp.float32)

    def combine(c1, c2):
        a1, b1 = c1
        a2, b2 = c2
        return a1 * a2, a2 * b1 + b2

    _, h = lax.associative_scan(combine, (a, bx), axis=1)
    return h.astype(x.dtype)


def moba_attention(q, k, v):
    bsz, nh, s, hd = q.shape
    nb = -(-s // MOBA_BLOCK)
    s_pad = nb * MOBA_BLOCK
    pad = ((0, 0), (0, 0), (0, s_pad - s), (0, 0))
    q = jnp.pad(q, pad)
    k = jnp.pad(k, pad)
    v = jnp.pad(v, pad)
    kb = k.reshape(bsz, nh, nb, MOBA_BLOCK, hd)
    vb = v.reshape(bsz, nh, nb, MOBA_BLOCK, hd)
    k_mean = jnp.mean(kb.astype(jnp.float32), axis=3)
    n_sel = min(MOBA_TOPK, nb)
    n_chunks = s_pad // Q_CHUNK
    scale = HEAD_DIM ** -0.5
    qc = q.reshape(bsz, nh, n_chunks, Q_CHUNK, hd).transpose(2, 0, 1, 3, 4)
    gather = jax.vmap(jax.vmap(lambda t, ix: t[ix]))

    def chunk_fn(args):
        ci, qi = args
        q_pos = ci * Q_CHUNK + jnp.arange(Q_CHUNK)
        own = (ci * Q_CHUNK) // MOBA_BLOCK
        gate = jnp.einsum('bhqd,bhnd->bhqn', qi.astype(jnp.float32), k_mean)
        gate = jnp.where(jnp.arange(nb) < own, gate, NEG)
        _, idx = lax.top_k(gate, n_sel)
        slot_ok = jnp.arange(n_sel) < own
        k_sel = gather(kb, idx)
        v_sel = gather(vb, idx)
        k_own = lax.dynamic_slice_in_dim(k, own * MOBA_BLOCK, MOBA_BLOCK, axis=2)
        v_own = lax.dynamic_slice_in_dim(v, own * MOBA_BLOCK, MOBA_BLOCK, axis=2)
        s_sel = jnp.einsum('bhqd,bhqnkd->bhqnk', qi, k_sel).astype(jnp.float32) * scale
        s_sel = jnp.where(slot_ok[:, None], s_sel, NEG).reshape(bsz, nh, Q_CHUNK, n_sel * MOBA_BLOCK)
        s_own = jnp.einsum('bhqd,bhkd->bhqk', qi, k_own).astype(jnp.float32) * scale
        k_pos = own * MOBA_BLOCK + jnp.arange(MOBA_BLOCK)
        s_own = jnp.where(k_pos[None, :] <= q_pos[:, None], s_own, NEG)
        p = jax.nn.softmax(jnp.concatenate([s_sel, s_own], axis=-1), axis=-1).astype(v.dtype)
        p_sel = p[..., :n_sel * MOBA_BLOCK].reshape(bsz, nh, Q_CHUNK, n_sel, MOBA_BLOCK)
        p_own = p[..., n_sel * MOBA_BLOCK:]
        return (jnp.einsum('bhqnk,bhqnkd->bhqd', p_sel, v_sel)
                + jnp.einsum('bhqk,bhkd->bhqd', p_own, v_own))

    o = lax.map(chunk_fn, (jnp.arange(n_chunks), qc))
    o = o.transpose(1, 2, 0, 3, 4).reshape(bsz, nh, s_pad, hd)[:, :, :s]
    return o


def setup_inputs(seed: int = 0) -> dict:
    key = jax.random.key(seed)
    ks = jax.random.split(key, 24)
    f32 = jnp.float32
    L = DEPTH

    def nrm(k, shape, scale):
        return jax.random.normal(k, shape, f32) * scale

    a0 = jax.random.uniform(ks[9], (L, D_RNN), f32, 0.9, 0.999)
    s0 = a0 ** (1.0 / LRU_C)
    lru_lambda = jnp.log(s0) - jnp.log1p(-s0)
    return {
        "x": jax.random.normal(ks[0], (BATCH, SEQ, D_MODEL), f32),
        "norm1_g": 1.0 + nrm(ks[1], (L, D_MODEL), 0.02),
        "w_in": nrm(ks[2], (L, D_MODEL, D_IN), D_MODEL ** -0.5),
        "conv_w": nrm(ks[3], (L, CONV_W, D_RNN), CONV_W ** -0.5),
        "conv_b": nrm(ks[4], (L, D_RNN), 0.01),
        "w_r": nrm(ks[5], (L, RNN_BLOCKS, RNN_BW, RNN_BW), RNN_BW ** -0.5),
        "b_r": nrm(ks[6], (L, RNN_BLOCKS, RNN_BW), 0.01),
        "w_i": nrm(ks[7], (L, RNN_BLOCKS, RNN_BW, RNN_BW), RNN_BW ** -0.5),
        "b_i": nrm(ks[8], (L, RNN_BLOCKS, RNN_BW), 0.01),
        "lru_lambda": lru_lambda,
        "q_norm_g": 1.0 + nrm(ks[10], (L, HEAD_DIM), 0.02),
        "k_norm_g": 1.0 + nrm(ks[11], (L, HEAD_DIM), 0.02),
        "w_proj_rnn": nrm(ks[12], (L, D_RNN, D_MODEL), D_RNN ** -0.5),
        "w_proj_attn": nrm(ks[13], (L, D_ATTN, D_MODEL), D_ATTN ** -0.5),
        "w_out": nrm(ks[14], (L, D_MODEL, D_MODEL), D_MODEL ** -0.5),
        "norm2_g": 1.0 + nrm(ks[15], (L, D_MODEL), 0.02),
        "w_up": nrm(ks[16], (L, D_MODEL, D_FF), D_MODEL ** -0.5),
        "w_gate": nrm(ks[17], (L, D_MODEL, D_FF), D_MODEL ** -0.5),
        "ffn_conv_w": nrm(ks[18], (L, FFN_CONV_W, D_FF), FFN_CONV_W ** -0.5),
        "ffn_conv_b": nrm(ks[19], (L, D_FF), 0.01),
        "w_down": nrm(ks[20], (L, D_FF, D_MODEL), D_FF ** -0.5),
    }


def reference(x, norm1_g, w_in, conv_w, conv_b, w_r, b_r, w_i, b_i, lru_lambda,
              q_norm_g, k_norm_g, w_proj_rnn, w_proj_attn, w_out, norm2_g,
              w_up, w_gate, ffn_conv_w, ffn_conv_b, w_down):
    bsz, s, _ = x.shape
    cuts = np.cumsum([D_RNN, D_RNN, D_ATTN, D_ATTN, D_ATTN])
    for l in range(DEPTH):
        h = rmsnorm(x, norm1_g[l])
        u = jnp.einsum('bsd,de->bse', h, w_in[l])
        x_rnn, g_rnn, q, k, v, g_br = jnp.split(u, list(cuts), axis=-1)
        xa = causal_dwconv(x_rnn, conv_w[l], conv_b[l])
        ya = rg_lru(xa, w_r[l], b_r[l], w_i[l], b_i[l], lru_lambda[l]) * jax.nn.gelu(g_rnn)
        q = rmsnorm(q.reshape(bsz, s, N_HEADS, HEAD_DIM), q_norm_g[l]).transpose(0, 2, 1, 3)
        k = rmsnorm(k.reshape(bsz, s, N_HEADS, HEAD_DIM), k_norm_g[l]).transpose(0, 2, 1, 3)
        v = v.reshape(bsz, s, N_HEADS, HEAD_DIM).transpose(0, 2, 1, 3)
        yb = moba_attention(q, k, v).transpose(0, 2, 1, 3).reshape(bsz, s, D_ATTN)
        gates = jax.nn.sigmoid(g_br).reshape(bsz, s, N_BRANCH, D_MODEL)
        merged = (gates[:, :, 0] * jnp.einsum('bsc,cd->bsd', ya, w_proj_rnn[l])
                  + gates[:, :, 1] * jnp.einsum('bsc,cd->bsd', yb, w_proj_attn[l]))
        x = x + jnp.einsum('bsd,de->bse', merged, w_out[l])
        h = rmsnorm(x, norm2_g[l])
        up = causal_dwconv(jnp.einsum('bsd,df->bsf', h, w_up[l]), ffn_conv_w[l], ffn_conv_b[l])
        act = jax.nn.gelu(up) * jnp.einsum('bsd,df->bsf', h, w_gate[l])
        x = x + jnp.einsum('bsf,fd->bsd', act, w_down[l])
    return x
```

```cpp
#include <hip/hip_runtime.h>
#include <cstdio>
#include <cstdint>
namespace pg8 {
#define PG8_LAS __attribute__((address_space(3)))
typedef unsigned short bf16_t;
typedef short bf16x8 __attribute__((ext_vector_type(8)));
typedef float f32x4 __attribute__((ext_vector_type(4)));
typedef unsigned u32x4 __attribute__((ext_vector_type(4)));
constexpr int BM = 256, BK = 64, HALF = 128, HTB = HALF * BK * 2  , STAGE_BYTES = 8 * HTB, NXCD = 8, WGM = 8;

__host__ __device__ __forceinline__ int lds_byte(int r, int c) { const int st = (r >> 4) * 2 + (c >> 5), rr = r & 15, cc = c & 31, ob = rr * 64 + cc * 2; return st * 1024 + (ob ^ (((ob >> 9) & 1) << 5)); }
__host__ __device__ __forceinline__ void stage_rc(int b, int& R, int& C) { const int st = b / 1024, sb = b % 1024, swz = sb ^ (((sb >> 9) & 1) << 5); R = (st >> 1) * 16 + swz / 64; C = (st & 1) * 32 + (swz % 64) / 2; }
__host__ __device__ __forceinline__ int perm32(int rho) { const int n = rho >> 4, i = rho & 15; return 8 * (i >> 2) + 4 * n + (i & 3); }

struct Unit { int pm, pn; };
struct Gemm { const bf16_t* A; const bf16_t* Bt; int M, N, K; };

struct StaticOrder {
    int nM, nN, nwg, G, c;
    __host__ __device__ void init(int M, int N, int G_, int c_) { nM = M / BM; nN = N / BM; nwg = nM * nN; G = G_; c = c_; }
    __host__ __device__ bool next(int i, Unit& u) const {
        const long L = (long)i * G + c; if (L >= nwg) return false;
        int wgid = (int)L; { const int q = nwg / NXCD, r = nwg % NXCD, xcd = wgid % NXCD, off = wgid / NXCD; wgid = (xcd < r ? xcd * (q + 1) : r * (q + 1) + (xcd - r) * q) + off; }
        const int nig = WGM * nN, gid = wgid / nig, fm = gid * WGM, gsz = (nM - fm) < WGM ? (nM - fm) : WGM;
        u.pm = fm + ((wgid % nig) % gsz); u.pn = (wgid % nig) / gsz; return true;
    }
    __device__ __forceinline__ void a_ready(const Unit&) const {}
    __device__ __forceinline__ void done(const Unit&) const {}
};

__device__ __forceinline__ unsigned cvt_pk_bf16(float lo, float hi) { unsigned r; asm volatile("v_cvt_pk_bf16_f32 %0, %1, %2" : "=v"(r) : "v"(lo), "v"(hi)); return r; }
typedef float f32x2 __attribute__((ext_vector_type(2)));
__device__ __forceinline__ float bf2f(unsigned short h) { return __builtin_bit_cast(float, (unsigned)h << 16); }
__device__ __forceinline__ float bflo(unsigned w) { return __builtin_bit_cast(float, w << 16); }
__device__ __forceinline__ float bfhi(unsigned w) { return __builtin_bit_cast(float, w & 0xffff0000u); }
__device__ __forceinline__ float fast_sigmoid(float x) { return __builtin_amdgcn_rcpf(1.0f + __builtin_amdgcn_exp2f(-1.4426950408889634f * x)); }
__device__ __forceinline__ float gelu_tanh(float x) { const float z = 0.7978845608028654f * (x + 0.044715f * x * x * x); return x * fast_sigmoid(2.0f * z); }

struct EpiG1 {
    static constexpr bool PERM = true, AFTER_DRAIN = false;
    bf16_t *o0, *o1, *o2, *o3, *o4, *o5, *o6;
    __device__ __forceinline__ void operator()(const f32x4 (&acc)[2][2][4][2], const Unit& u, int wr, int wc, int fr, int fq) const {
        const int seg = u.pn >> 2;
        bf16_t* base = seg == 0 ? o0 : seg == 1 ? o1 : seg == 2 ? o2 : seg == 3 ? o3 : seg == 4 ? o4 : seg == 5 ? o5 : o6;
        const int row0 = u.pm * BM + wr * 64 + fr, col0 = (u.pn & 3) * BM + wc * 32 + 8 * fq;
#pragma unroll
        for (int ai = 0; ai < 2; ++ai)
#pragma unroll
            for (int m = 0; m < 4; ++m) { bf16_t* rowp = base + (size_t)(row0 + ai * HALF + m * 16) * 1024 + col0;
#pragma unroll
                for (int bj = 0; bj < 2; ++bj) { f32x4 v0 = acc[ai][bj][m][0], v1 = acc[ai][bj][m][1];
                    if (seg == 1) {
#pragma unroll
                        for (int j = 0; j < 4; ++j) { v0[j] = gelu_tanh(v0[j]); v1[j] = gelu_tanh(v1[j]); }
                    } else if (seg >= 5) {
#pragma unroll
                        for (int j = 0; j < 4; ++j) { v0[j] = fast_sigmoid(v0[j]); v1[j] = fast_sigmoid(v1[j]); }
                    }
                    u32x4 w; w.x = cvt_pk_bf16(v0[0], v0[1]); w.y = cvt_pk_bf16(v0[2], v0[3]); w.z = cvt_pk_bf16(v1[0], v1[1]); w.w = cvt_pk_bf16(v1[2], v1[3]);
                    *(u32x4*)(rowp + bj * HALF) = w; } }
    }
};
template <bool ADD> struct EpiGate {
    static constexpr bool PERM = true, AFTER_DRAIN = false;
    const bf16_t* g; bf16_t* out;
    __device__ __forceinline__ void operator()(const f32x4 (&acc)[2][2][4][2], const Unit& u, int wr, int wc, int fr, int fq) const {
        const int row0 = u.pm * BM + wr * 64 + fr, col0 = u.pn * BM + wc * 32 + 8 * fq;
#pragma unroll
        for (int ai = 0; ai < 2; ++ai)
#pragma unroll
            for (int m = 0; m < 4; ++m) { const size_t off = (size_t)(row0 + ai * HALF + m * 16) * 1024 + col0;
#pragma unroll
                for (int bj = 0; bj < 2; ++bj) { const f32x4 v0 = acc[ai][bj][m][0], v1 = acc[ai][bj][m][1];
                    const u32x4 gw = *(const u32x4*)(g + off + bj * HALF);
                    float r[8] = { v0[0] * bflo(gw.x), v0[1] * bfhi(gw.x), v0[2] * bflo(gw.y), v0[3] * bfhi(gw.y), v1[0] * bflo(gw.z), v1[1] * bfhi(gw.z), v1[2] * bflo(gw.w), v1[3] * bfhi(gw.w) };
                    if (ADD) { const u32x4 t = *(const u32x4*)(out + off + bj * HALF);
                        r[0] += bflo(t.x); r[1] += bfhi(t.x); r[2] += bflo(t.y); r[3] += bfhi(t.y); r[4] += bflo(t.z); r[5] += bfhi(t.z); r[6] += bflo(t.w); r[7] += bfhi(t.w); }
                    u32x4 w; w.x = cvt_pk_bf16(r[0], r[1]); w.y = cvt_pk_bf16(r[2], r[3]); w.z = cvt_pk_bf16(r[4], r[5]); w.w = cvt_pk_bf16(r[6], r[7]);
                    *(u32x4*)(out + off + bj * HALF) = w; } }
    }
};
struct EpiRes {
    static constexpr bool PERM = false, AFTER_DRAIN = false;
    const float* base; float* out;
    __device__ __forceinline__ void operator()(const f32x4 (&acc)[2][2][4][2], const Unit& u, int wr, int wc, int fr, int fq) const {
        const int row0 = u.pm * BM + wr * 64 + fr, col0 = u.pn * BM + wc * 32 + 4 * fq;
#pragma unroll
        for (int ai = 0; ai < 2; ++ai)
#pragma unroll
            for (int m = 0; m < 4; ++m) { const size_t off = (size_t)(row0 + ai * HALF + m * 16) * 1024 + col0;
#pragma unroll
                for (int bj = 0; bj < 2; ++bj)
#pragma unroll
                    for (int n = 0; n < 2; ++n) { const f32x4 b = *(const f32x4*)(base + off + bj * HALF + n * 16); *(f32x4*)(out + off + bj * HALF + n * 16) = b + acc[ai][bj][m][n]; } }
    }
};
struct EpiUG {
    static constexpr bool PERM = true, AFTER_DRAIN = false;
    bf16_t* up; bf16_t* gt;
    __device__ __forceinline__ void operator()(const f32x4 (&acc)[2][2][4][2], const Unit& u, int wr, int wc, int fr, int fq) const {
        const int row0 = u.pm * BM + wr * 64 + fr, col0 = u.pn * HALF + wc * 32 + 8 * fq;
#pragma unroll
        for (int ai = 0; ai < 2; ++ai)
#pragma unroll
            for (int m = 0; m < 4; ++m) { const size_t off = (size_t)(row0 + ai * HALF + m * 16) * 2816 + col0;
#pragma unroll
                for (int bj = 0; bj < 2; ++bj) { const f32x4 v0 = acc[ai][bj][m][0], v1 = acc[ai][bj][m][1];
                    u32x4 w; w.x = cvt_pk_bf16(v0[0], v0[1]); w.y = cvt_pk_bf16(v0[2], v0[3]); w.z = cvt_pk_bf16(v1[0], v1[1]); w.w = cvt_pk_bf16(v1[2], v1[3]);
                    *(u32x4*)((bj ? gt : up) + off) = w; } }
    }
};
template <class Epi, class Sched, bool ALIGN_EPI = false, bool SP2 = false>
__device__ __forceinline__ void gemm_phase(PG8_LAS unsigned char* lds, const Gemm g, const Sched& S, const Epi& E) {
    const int tid = threadIdx.x, wid = __builtin_amdgcn_readfirstlane(tid >> 6), lane = tid & 63, wr = wid >> 2, wc = wid & 3, fr = lane & 15, fq = lane >> 4;
    const int K = g.K, nt = K / BK;
    unsigned voffA[2], voffB[2];
#pragma unroll
    for (int i = 0; i < 2; ++i) { int R, C; stage_rc(tid * 16 + i * 8192, R, C); const int Rb = Epi::PERM ? ((R & ~31) + perm32(R & 31)) : R;
        voffA[i] = (unsigned)(R * K + C) * 2u; voffB[i] = (unsigned)(Rb * K + C) * 2u; }
    const size_t kstep = (size_t)(BK * 2);
    const size_t hstep = (size_t)HALF * K * 2;
    const size_t tstep = 2 * hstep;
    const unsigned ldsw = (unsigned)wid * 1024u;
    const int aoff = lds_byte(wr * 64 + fr, fq * 8), boff = lds_byte(wc * 32 + fr, fq * 8);
#define PG8_SA(b, h) (((b) * 2 + (h)) * HTB)
#define PG8_SB(b, h) ((4 + (b) * 2 + (h)) * HTB)
#define PG8_STAGE(bufoff, gbase, voff) do { _Pragma("unroll") for (int _i = 0; _i < 2; ++_i) \
        __builtin_amdgcn_global_load_lds((const unsigned*)((const char*)(gbase) + (voff)[_i]), (PG8_LAS unsigned*)(lds + (bufoff) + ldsw + _i * 8192), 16, 0, 0); } while (0)
#define PG8_LDA(dst, b, h) do { _Pragma("unroll") for (int m = 0; m < 4; ++m) _Pragma("unroll") for (int k = 0; k < 2; ++k) dst[m][k] = *(const PG8_LAS bf16x8*)(lds + PG8_SA(b, h) + aoff + m * 2048 + k * 1024); } while (0)
#define PG8_LDB(dst, b, h) do { _Pragma("unroll") for (int n = 0; n < 2; ++n) _Pragma("unroll") for (int k = 0; k < 2; ++k) dst[n][k] = *(const PG8_LAS bf16x8*)(lds + PG8_SB(b, h) + boff + n * 2048 + k * 1024); } while (0)
#define PG8_MMA(ai, bj, At, Bt) do { __builtin_amdgcn_s_setprio(1); _Pragma("unroll") for (int m = 0; m < 4; ++m) _Pragma("unroll") for (int n = 0; n < 2; ++n) _Pragma("unroll") for (int k = 0; k < 2; ++k) \
        acc[ai][bj][m][n] = __builtin_amdgcn_mfma_f32_16x16x32_bf16(Bt[n][k], At[m][k], acc[ai][bj][m][n], 0, 0, 0); __builtin_amdgcn_s_setprio(0); } while (0)
#define PG8_WAIT_V(n) asm volatile("s_waitcnt vmcnt(" #n ")" ::: "memory")
#define PG8_WAIT_L(n) asm volatile("s_waitcnt lgkmcnt(" #n ")" ::: "memory")
#define PG8_BAR __builtin_amdgcn_s_barrier()
#define PG8_SCHED __builtin_amdgcn_sched_barrier(0)
    Unit cur, nxt; int ui = 0;
    if (!S.next(0, cur)) return;
    f32x4 acc[2][2][4][2];
#pragma unroll
    for (int a = 0; a < 2; ++a)
#pragma unroll
        for (int b = 0; b < 2; ++b)
#pragma unroll
            for (int m = 0; m < 4; ++m)
#pragma unroll
                for (int n = 0; n < 2; ++n) acc[a][b][m][n] = (f32x4){0.f, 0.f, 0.f, 0.f};
    bf16x8 At[4][2], B0[2][2], B1[2][2];
    const char* cA = (const char*)g.A + (size_t)cur.pm * tstep; const char* cB = (const char*)g.Bt + (size_t)cur.pn * tstep;
    S.a_ready(cur);
    if constexpr (SP2) {
        PG8_STAGE(PG8_SB(0, 0), cB, voffB); PG8_STAGE(PG8_SB(0, 1), cB + hstep, voffB); PG8_STAGE(PG8_SA(0, 0), cA, voffA); PG8_STAGE(PG8_SA(0, 1), cA + hstep, voffA);
        if (wr == 1) PG8_BAR;
        PG8_WAIT_V(2); PG8_BAR;
        PG8_STAGE(PG8_SB(1, 0), cB + kstep, voffB); PG8_STAGE(PG8_SA(1, 0), cA + kstep, voffA); PG8_STAGE(PG8_SB(1, 1), cB + hstep + kstep, voffB);
        PG8_WAIT_V(6); PG8_BAR;
    } else {
        PG8_STAGE(PG8_SB(0, 0), cB, voffB); PG8_STAGE(PG8_SA(0, 0), cA, voffA); PG8_STAGE(PG8_SB(0, 1), cB + hstep, voffB); PG8_STAGE(PG8_SA(0, 1), cA + hstep, voffA);
        if (wr == 1) PG8_BAR;
        PG8_WAIT_V(4); PG8_BAR;
        PG8_STAGE(PG8_SB(1, 0), cB + kstep, voffB); PG8_STAGE(PG8_SA(1, 0), cA + kstep, voffA); PG8_STAGE(PG8_SB(1, 1), cB + hstep + kstep, voffB);
        PG8_WAIT_V(6); PG8_BAR;
    }
    for (;;) {
        const bool has_next = S.next(ui + 1, nxt);
        const char* nA = has_next ? (const char*)g.A + (size_t)nxt.pm * tstep : cA; const char* nB = has_next ? (const char*)g.Bt + (size_t)nxt.pn * tstep : cB;
        for (int t = 0; t < nt; t += 2) {
            const bool last = (t == nt - 2);
            const char* a1 = cA + (size_t)(t + 1) * kstep;
            const char* a2 = last ? nA : cA + (size_t)(t + 2) * kstep; const char* b2 = last ? nB : cB + (size_t)(t + 2) * kstep;
            const char* a3 = a2 + kstep; const char* b3 = b2 + kstep;
            if (last && has_next) S.a_ready(nxt);
            if constexpr (SP2) {
            PG8_LDB(B0, 0, 0); PG8_LDB(B1, 0, 1); PG8_SCHED; PG8_LDA(At, 0, 0); PG8_STAGE(PG8_SA(1, 1), a1 + hstep, voffA);
            PG8_WAIT_V(8); PG8_WAIT_L(0); PG8_BAR; PG8_MMA(0, 0, At, B0); PG8_MMA(0, 1, At, B1); PG8_BAR; PG8_SCHED;
            PG8_LDA(At, 0, 1); PG8_STAGE(PG8_SB(0, 0), b2, voffB); PG8_STAGE(PG8_SB(0, 1), b2 + hstep, voffB); PG8_STAGE(PG8_SA(0, 0), a2, voffA);
            PG8_WAIT_V(8); PG8_WAIT_L(0); PG8_BAR; PG8_MMA(1, 0, At, B0); PG8_MMA(1, 1, At, B1); PG8_BAR; PG8_SCHED;
            PG8_LDB(B0, 1, 0); PG8_LDB(B1, 1, 1); PG8_SCHED; PG8_LDA(At, 1, 0); PG8_STAGE(PG8_SA(0, 1), a2 + hstep, voffA);
            PG8_WAIT_V(8); PG8_WAIT_L(0); PG8_BAR; PG8_MMA(0, 0, At, B0); PG8_MMA(0, 1, At, B1); PG8_BAR; PG8_SCHED;
            PG8_LDA(At, 1, 1); PG8_STAGE(PG8_SB(1, 0), b3, voffB); PG8_STAGE(PG8_SB(1, 1), b3 + hstep, voffB); PG8_STAGE(PG8_SA(1, 0), a3, voffA);
            PG8_WAIT_V(8); PG8_WAIT_L(0); PG8_BAR; PG8_MMA(1, 0, At, B0); PG8_MMA(1, 1, At, B1); PG8_BAR; PG8_SCHED;
            } else {
            PG8_LDB(B0, 0, 0); PG8_SCHED; PG8_LDA(At, 0, 0); PG8_STAGE(PG8_SA(1, 1), a1 + hstep, voffA);
            PG8_WAIT_L(8); PG8_BAR; PG8_WAIT_L(0); PG8_MMA(0, 0, At, B0); PG8_BAR; PG8_SCHED;
            PG8_LDB(B1, 0, 1); PG8_STAGE(PG8_SB(0, 0), b2, voffB);
            PG8_BAR; PG8_WAIT_L(0); PG8_MMA(0, 1, At, B1); PG8_BAR;
            PG8_LDA(At, 0, 1); PG8_STAGE(PG8_SA(0, 0), a2, voffA);
            PG8_BAR; PG8_WAIT_L(0); PG8_MMA(1, 0, At, B0); PG8_BAR; PG8_SCHED;
            PG8_STAGE(PG8_SB(0, 1), b2 + hstep, voffB);
            PG8_WAIT_V(6); PG8_BAR; PG8_MMA(1, 1, At, B1); PG8_BAR;
            PG8_LDB(B0, 1, 0); PG8_SCHED; PG8_LDA(At, 1, 0); PG8_STAGE(PG8_SA(0, 1), a2 + hstep, voffA);
            PG8_WAIT_L(8); PG8_BAR; PG8_WAIT_L(0); PG8_MMA(0, 0, At, B0); PG8_BAR; PG8_SCHED;
            PG8_LDB(B1, 1, 1); PG8_STAGE(PG8_SB(1, 0), b3, voffB);
            PG8_BAR; PG8_WAIT_L(0); PG8_MMA(0, 1, At, B1); PG8_BAR;
            PG8_LDA(At, 1, 1); PG8_STAGE(PG8_SA(1, 0), a3, voffA);
            PG8_BAR; PG8_WAIT_L(0); PG8_MMA(1, 0, At, B0); PG8_BAR; PG8_SCHED;
            PG8_STAGE(PG8_SB(1, 1), b3 + hstep, voffB);
            PG8_WAIT_V(6); PG8_BAR; PG8_MMA(1, 1, At, B1); PG8_BAR;
            }
        }
        if constexpr (ALIGN_EPI) { if (wr == 0) PG8_BAR; }
        if constexpr (!Epi::AFTER_DRAIN) { E(acc, cur, wr, wc, fr, fq); S.done(cur); }
        if (!has_next) break;
#pragma unroll
        for (int a = 0; a < 2; ++a)
#pragma unroll
            for (int b = 0; b < 2; ++b)
#pragma unroll
                for (int m = 0; m < 4; ++m)
#pragma unroll
                    for (int n = 0; n < 2; ++n) acc[a][b][m][n] = (f32x4){0.f, 0.f, 0.f, 0.f};
        cur = nxt; cA = nA; cB = nB; ++ui;
        if constexpr (ALIGN_EPI) { if (wr == 1) PG8_BAR; }
    }
    PG8_WAIT_V(0);
    if constexpr (!ALIGN_EPI) { if (wr == 0) PG8_BAR; }
    PG8_BAR;
    if constexpr (Epi::AFTER_DRAIN) { E.fused(acc, cur, wr, wc, fr, fq, lds, wid, lane); S.done(cur); }
#undef PG8_SA
#undef PG8_SB
#undef PG8_STAGE
#undef PG8_LDA
#undef PG8_LDB
#undef PG8_MMA
#undef PG8_WAIT_V
#undef PG8_WAIT_L
#undef PG8_BAR
#undef PG8_SCHED
}
}
#define GAS __attribute__((address_space(1)))
#define LAS __attribute__((address_space(3)))
typedef unsigned short bf16;
typedef unsigned v4u __attribute__((ext_vector_type(4)));
typedef float f32x4 __attribute__((ext_vector_type(4)));
typedef short bf16x8 __attribute__((ext_vector_type(8)));
typedef GAS unsigned gu32;
typedef GAS unsigned long long gu64;
#define RLX_AGENT __ATOMIC_RELAXED, __HIP_MEMORY_SCOPE_AGENT
#define LDS_WAIT() asm volatile("s_waitcnt lgkmcnt(0)" ::: "memory")
#define VM_WAIT() asm volatile("s_waitcnt vmcnt(0)" ::: "memory")
__device__ __forceinline__ unsigned long long rt() { return __builtin_amdgcn_s_memrealtime(); }
__device__ __forceinline__ unsigned f2bf(float f) { unsigned u = __builtin_bit_cast(unsigned, f); return (u + 0x7fffu + ((u >> 16) & 1u)) >> 16; }
__device__ __forceinline__ unsigned pk2(float lo, float hi) { return f2bf(lo) | (f2bf(hi) << 16); }

#define XB_TMO      128
#define XB_XCNT(j)  (256  + 64 * (j))
#define XB_XSUB(j)  (1280 + 64 * (j))
#define XB_XGEN(j)  (2304 + 64 * (j))
#define XB_TOP      3328
#define XB_TOPGEN   3392
#define XCD_BAR_WORDS 3456
#define XB_SPIN_CAP (1u << 18)

__device__ __forceinline__ unsigned xb_ld(unsigned* p)              { return __hip_atomic_load(p, __ATOMIC_RELAXED, __HIP_MEMORY_SCOPE_AGENT); }
__device__ __forceinline__ unsigned xb_add(unsigned* p, unsigned v) { return __hip_atomic_fetch_add(p, v, __ATOMIC_RELAXED, __HIP_MEMORY_SCOPE_AGENT); }
__device__ __forceinline__ unsigned xb_xcc_id() { return (unsigned)__builtin_amdgcn_s_getreg((3 << 11) | 20) & 0xFu; }
#define XB_SPIN(cond, bar) do { unsigned _sp = 0; while (cond) { __builtin_amdgcn_s_sleep(1); \
    if ((++_sp & 255u) == 0u) { if (xb_ld(&(bar)[XB_TMO])) break; if (_sp > XB_SPIN_CAP) { atomicAdd(&(bar)[XB_TMO], 1u); break; } } } } while (0)

struct XcdBarrier {
    unsigned* bar; unsigned x;
    volatile LAS unsigned* st;
};

__device__ __forceinline__ XcdBarrier xcd_barrier_post(unsigned* bar, volatile LAS unsigned* st) {
    XcdBarrier b; b.bar = bar; b.x = xb_xcc_id(); b.st = st;
    if (threadIdx.x == 0) (void)xb_add(&bar[XB_XCNT(b.x)], 1u);
    return b;
}
__device__ __forceinline__ void xcd_barrier_complete(unsigned* bar, unsigned x, unsigned& nloc, unsigned& nx) {
    const unsigned G = gridDim.x * gridDim.y * gridDim.z;
    unsigned sum, cnt, mine, sp = 0u;
    for (;;) {
        sum = 0u; cnt = 0u; mine = 0u;
#pragma unroll
        for (unsigned j = 0; j < 16; ++j) { const unsigned c = xb_ld(&bar[XB_XCNT(j)]); sum += c; cnt += (c > 0u) ? 1u : 0u; mine = (j == x) ? c : mine; }
        if (sum == G) break;
        __builtin_amdgcn_s_sleep(1);
        if ((++sp & 255u) == 0u) { if (xb_ld(&bar[XB_TMO])) break; if (sp > XB_SPIN_CAP) { atomicAdd(&bar[XB_TMO], 1u); break; } }
    }
    nloc = mine > 0u ? mine : 1u; nx = cnt > 0u ? cnt : 1u;
}

__device__ __forceinline__ void xcd_barrier(const XcdBarrier& b) {
    asm volatile("s_waitcnt vmcnt(0)" ::: "memory");
    __syncthreads();
    if (threadIdx.x == 0) {
        unsigned* bar = b.bar;
        __builtin_amdgcn_s_waitcnt(0);
        unsigned nloc = b.st[0], nx = b.st[1];
        if (nloc == 0u) { xcd_barrier_complete(bar, b.x, nloc, nx); b.st[0] = nloc; b.st[1] = nx; }
        const unsigned old = xb_add(&bar[XB_XSUB(b.x)], 1u);
        const unsigned gen = old / nloc;
        if (old + 1u == (gen + 1u) * nloc) {
            __builtin_amdgcn_fence(__ATOMIC_RELEASE, "agent");
            asm volatile("s_waitcnt vmcnt(0)" ::: "memory");
            const unsigned og = xb_add(&bar[XB_TOP], 1u);
            const unsigned tg = og / nx;
            if (og + 1u == (tg + 1u) * nx) xb_add(&bar[XB_TOPGEN], 1u);
            else XB_SPIN(xb_ld(&bar[XB_TOPGEN]) == tg, bar);
            __builtin_amdgcn_fence(__ATOMIC_ACQUIRE, "agent");
            xb_add(&bar[XB_XGEN(b.x)], 1u);
            asm volatile("s_waitcnt vmcnt(0)" ::: "memory");
        } else {
            XB_SPIN(xb_ld(&bar[XB_XGEN(b.x)]) == gen, bar);
            __builtin_amdgcn_fence(__ATOMIC_ACQUIRE, "agent");
            asm volatile("s_waitcnt vmcnt(0)" ::: "memory");
        }
    }
    __syncthreads();
}

constexpr int NWAVES = 8;
constexpr int NB = 4, SEQ = 8192, DM = 1024, M = NB * SEQ, DIN = 7168, DFF = 2816, NH = 8, HD = 128, NBLK = SEQ / 256;
constexpr float EPS = 1e-6f;
constexpr float QSCALE = 0.08838834764831845f * 1.4426950408889634f;
#ifndef MK_ONE_LAUNCH
#define MK_ONE_LAUNCH 1
#endif
constexpr int NPHASE = 13;

constexpr size_t MiB = 1u << 20;
constexpr size_t WS_CTL = 0, CTL_ZERO_BYTES = 1 * MiB;
constexpr size_t WS_WIN = 2 * MiB, WS_PA = 16 * MiB, WS_PB = 18 * MiB, WS_WOUT = 20 * MiB, WS_WUG = 22 * MiB, WS_WDN = 33 * MiB, WS_WR = 39 * MiB, WS_WI = 39 * MiB + 256 * 1024;
constexpr size_t WS_KM = 40 * MiB, WS_AG = 41 * MiB;
constexpr size_t WS_XN = 48 * MiB;
constexpr size_t WS_XR = 112 * MiB;
constexpr size_t WS_GR = 176 * MiB;
constexpr size_t WS_Q = 240 * MiB, WS_K = 304 * MiB, WS_V = 368 * MiB;
constexpr size_t WS_UP = 112 * MiB, WS_GT = 288 * MiB;
constexpr size_t WS_END = 464 * MiB;
constexpr int CW_BAR = 4096;

constexpr int LDS_BYTES = 147456;
constexpr int MISC_OFF = 131072 + 320;

__device__ __forceinline__ float wave_sum(float v) {
#pragma unroll
    for (int o = 1; o < 64; o <<= 1) v += __shfl_xor(v, o);
    return v;
}
__device__ __forceinline__ void p0_transpose_item(const float* W, int N, bf16* WT, int ldwt, int drow0, const float* gain, LAS float* scr, int kb, int nb, int lane) {
    const int k0 = 64 * kb, n0 = 32 * nb;
#pragma unroll 8
    for (int i = 0; i < 32; ++i) { const int kk = 2 * i + (lane >> 5); float v = W[(size_t)(k0 + kk) * N + n0 + (lane & 31)]; if (gain) v *= gain[k0 + kk]; scr[kk * 33 + (lane & 31)] = v; }
    LDS_WAIT(); asm volatile("" ::: "memory");
    const int c = lane & 7;
#pragma unroll
    for (int j = 0; j < 4; ++j) { const int n = (lane >> 3) + 8 * j; const LAS float* s = scr + (8 * c) * 33 + n;
        v4u o; o.x = pk2(s[0 * 33], s[1 * 33]); o.y = pk2(s[2 * 33], s[3 * 33]); o.z = pk2(s[4 * 33], s[5 * 33]); o.w = pk2(s[6 * 33], s[7 * 33]);
        *(GAS v4u*)(WT + (size_t)(drow0 + n) * ldwt + k0 + 8 * c) = o; }
    LDS_WAIT(); asm volatile("" ::: "memory");
}
__device__ __forceinline__ void rms_row_to_bf16(const float* xrow, bf16* orow, int lane) {
    const GAS f32x4* xr = (const GAS f32x4*)xrow + lane;
    f32x4 v[4]; float s = 0.f;
#pragma unroll
    for (int j = 0; j < 4; ++j) { v[j] = xr[64 * j]; s += (v[j].x * v[j].x + v[j].y * v[j].y) + (v[j].z * v[j].z + v[j].w * v[j].w); }
    const float rstd = 1.0f / sqrtf(wave_sum(s) * (1.f / DM) + EPS);
    GAS unsigned long long* o8 = (GAS unsigned long long*)orow + lane;
#pragma unroll
    for (int j = 0; j < 4; ++j) o8[64 * j] = (unsigned long long)pk2(v[j].x * rstd, v[j].y * rstd) | ((unsigned long long)pk2(v[j].z * rstd, v[j].w * rstd) << 32);
}

struct Args { const float* in[21]; float* out; unsigned char* ws; int ph_lo, ph_hi, li, pad; };
enum { I_X = 0, I_N1G, I_WIN, I_CONVW, I_CONVB, I_WR, I_BR, I_WI, I_BI, I_LAM, I_QNG, I_KNG, I_PA, I_PB, I_WOUT, I_N2G, I_WUP, I_WGATE, I_FCW, I_FCB, I_WDN };

__device__ __forceinline__ void p0_prologue(const Args& a, LAS unsigned char* lds, int gw, int NGW, int wave, int lane) {
    LAS float* scr = (LAS float*)(lds + wave * 16384);
    unsigned char* ws = a.ws;
    constexpr int I_IN = 16 * 224, I_SQ = 16 * 32, I_UP = 16 * 88, I_DN = 44 * 32, I_RG = 64;
    constexpr int NITEMS = I_IN + 3 * I_SQ + 2 * I_UP + I_DN + 2 * I_RG;
    for (int it = gw; it < NITEMS; it += NGW) {
        int r = it;
        if (r < I_IN) { p0_transpose_item(a.in[I_WIN], DIN, (bf16*)(ws + WS_WIN), DM, 32 * (r % 224), a.in[I_N1G], scr, r / 224, r % 224, lane); continue; } r -= I_IN;
        if (r < I_SQ) { p0_transpose_item(a.in[I_PA], DM, (bf16*)(ws + WS_PA), DM, 32 * (r % 32), nullptr, scr, r / 32, r % 32, lane); continue; } r -= I_SQ;
        if (r < I_SQ) { p0_transpose_item(a.in[I_PB], DM, (bf16*)(ws + WS_PB), DM, 32 * (r % 32), nullptr, scr, r / 32, r % 32, lane); continue; } r -= I_SQ;
        if (r < I_SQ) { p0_transpose_item(a.in[I_WOUT], DM, (bf16*)(ws + WS_WOUT), DM, 32 * (r % 32), nullptr, scr, r / 32, r % 32, lane); continue; } r -= I_SQ;
        if (r < I_UP) { const int nb = r % 88, n0 = 32 * nb; p0_transpose_item(a.in[I_WUP], DFF, (bf16*)(ws + WS_WUG), DM, 256 * (n0 / 128) + (n0 % 128), a.in[I_N2G], scr, r / 88, nb, lane); continue; } r -= I_UP;
        if (r < I_UP) { const int nb = r % 88, n0 = 32 * nb; p0_transpose_item(a.in[I_WGATE], DFF, (bf16*)(ws + WS_WUG), DM, 256 * (n0 / 128) + 128 + (n0 % 128), a.in[I_N2G], scr, r / 88, nb, lane); continue; } r -= I_UP;
        if (r < I_DN) { p0_transpose_item(a.in[I_WDN], DM, (bf16*)(ws + WS_WDN), DFF, 32 * (r % 32), nullptr, scr, r / 32, r % 32, lane); continue; } r -= I_DN;
        if (r < I_RG) { const int blk = r >> 3, q = r & 7; p0_transpose_item(a.in[I_WR] + blk * 16384, 128, (bf16*)(ws + WS_WR) + blk * 16384, 128, 32 * (q & 3), nullptr, scr, q >> 2, q & 3, lane); continue; } r -= I_RG;
        { const int blk = r >> 3, q = r & 7; p0_transpose_item(a.in[I_WI] + blk * 16384, 128, (bf16*)(ws + WS_WI) + blk * 16384, 128, 32 * (q & 3), nullptr, scr, q >> 2, q & 3, lane); }
    }
    for (int m = gw; m < M; m += NGW) rms_row_to_bf16(a.in[I_X] + (size_t)m * DM, (bf16*)(ws + WS_XN) + (size_t)m * DM, lane);
}

__device__ __forceinline__ void p1b_qknorm(const Args& a, LAS unsigned char* lds, int G, int wave, int lane, int tid) {
    LAS float* red = (LAS float*)lds;
    for (int item = blockIdx.x; item < 256; item += G) {
        const int rb = item >> 1, which = item & 1;
        bf16* buf = (bf16*)(a.ws + (which ? WS_K : WS_Q));
        const float* g = a.in[which ? I_KNG : I_QNG];
        const int c0 = lane * 16, d0 = c0 & 127;
        float gain[16], colsum[16];
#pragma unroll
        for (int j = 0; j < 16; ++j) { gain[j] = g[d0 + j] * (which ? 1.0f : QSCALE); colsum[j] = 0.f; }
        for (int i = 0; i < 32; ++i) {
            bf16* p = buf + (size_t)(rb * 256 + wave * 32 + i) * DM + c0;
            const v4u w0 = *(const GAS v4u*)p, w1 = *(const GAS v4u*)(p + 8);
            float v[16] = { pg8::bflo(w0.x), pg8::bfhi(w0.x), pg8::bflo(w0.y), pg8::bfhi(w0.y), pg8::bflo(w0.z), pg8::bfhi(w0.z), pg8::bflo(w0.w), pg8::bfhi(w0.w),
                            pg8::bflo(w1.x), pg8::bfhi(w1.x), pg8::bflo(w1.y), pg8::bfhi(w1.y), pg8::bflo(w1.z), pg8::bfhi(w1.z), pg8::bflo(w1.w), pg8::bfhi(w1.w) };
            float ss = 0.f;
#pragma unroll
            for (int j = 0; j < 16; ++j) ss += v[j] * v[j];
            ss += __shfl_xor(ss, 1); ss += __shfl_xor(ss, 2); ss += __shfl_xor(ss, 4);
            const float rstd = 1.0f / sqrtf(ss * (1.f / HD) + EPS);
#pragma unroll
            for (int j = 0; j < 16; ++j) { v[j] = v[j] * rstd * gain[j]; colsum[j] += v[j]; }
            v4u o0, o1; o0.x = pk2(v[0], v[1]); o0.y = pk2(v[2], v[3]); o0.z = pk2(v[4], v[5]); o0.w = pk2(v[6], v[7]);
            o1.x = pk2(v[8], v[9]); o1.y = pk2(v[10], v[11]); o1.z = pk2(v[12], v[13]); o1.w = pk2(v[14], v[15]);
            *(GAS v4u*)p = o0; *(GAS v4u*)(p + 8) = o1;
        }
        if (which) {
#pragma unroll
            for (int j = 0; j < 16; ++j) red[wave * 1024 + c0 + j] = colsum[j];
            __syncthreads();
            float* KM = (float*)(a.ws + WS_KM);
            for (int c = tid; c < 1024; c += 512) { float s = 0.f;
#pragma unroll
                for (int w = 0; w < 8; ++w) s += red[w * 1024 + c];
                KM[(size_t)rb * 1024 + c] = s * (1.0f / 256.0f); }
            __syncthreads();
        }
    }
}

template <bool FINAL> __device__ __forceinline__ void rnn_phase(const Args& a, LAS unsigned char* lds, int G, int wave, int lane, int tid) {
    LAS bf16* XAb = (LAS bf16*)lds;
    LAS float* XA32 = (LAS float*)(lds + 17408);
    LAS float* LA = (LAS float*)(lds + 17408 + 32768);
    const bf16* XR = (const bf16*)(a.ws + WS_XR); const bf16* GR = (const bf16*)(a.ws + WS_GR); bf16* YA = (bf16*)(a.ws + WS_XN);
    float* AG = (float*)(a.ws + WS_AG);
    const int kq = lane >> 4, fr = lane & 15;
    for (int tile = blockIdx.x; tile < 1024; tile += G) {
        const int n = tile & 7, rb = tile >> 3, chunk = rb & 31, bb = rb >> 5;
        const int dcol = 16 * wave + fr, ch = n * 128 + dcol;
        bf16x8 wrf[4], wif[4];
#pragma unroll
        for (int ks = 0; ks < 4; ++ks) { wrf[ks] = *(const GAS bf16x8*)((const bf16*)(a.ws + WS_WR) + (size_t)ch * 128 + 32 * ks + 8 * kq);
                                         wif[ks] = *(const GAS bf16x8*)((const bf16*)(a.ws + WS_WI) + (size_t)ch * 128 + 32 * ks + 8 * kq); }
        const float br = a.in[I_BR][ch], bi = a.in[I_BI][ch];
        const float lam = a.in[I_LAM][ch]; const float sp = log1pf(expf(-lam));
        const int cg = tid & 15, cc = n * 128 + 8 * cg;
        float cw[4][8], cb[8];
#pragma unroll
        for (int j = 0; j < 8; ++j) { cb[j] = a.in[I_CONVB][cc + j];
#pragma unroll
            for (int k = 0; k < 4; ++k) cw[k][j] = a.in[I_CONVW][k * 1024 + cc + j]; }
        float h = 0.f, Pa = 1.f;
        if (FINAL && tid < 128) {
            for (int c2 = 0; c2 < chunk; ++c2) { const float2 ah = *(const float2*)(AG + ((size_t)(bb * 32 + c2) * 1024 + n * 128 + tid) * 2); h = ah.x * h + ah.y; }
        }
        for (int s = 0; s < 4; ++s) {
            const int r0 = rb * 256 + 64 * s;
#pragma unroll
            for (int pp = 0; pp < 2; ++pp) {
                const int tok = (tid >> 4) + 32 * pp;
                float acc[8];
#pragma unroll
                for (int j = 0; j < 8; ++j) acc[j] = cb[j];
#pragma unroll
                for (int k = 0; k < 4; ++k) {
                    const int tseq = chunk * 256 + 64 * s + tok - 3 + k;
                    if (tseq >= 0) { const v4u w = *(const GAS v4u*)(XR + (size_t)(r0 + tok - 3 + k) * DM + cc);
                        acc[0] += cw[k][0] * pg8::bflo(w.x); acc[1] += cw[k][1] * pg8::bfhi(w.x); acc[2] += cw[k][2] * pg8::bflo(w.y); acc[3] += cw[k][3] * pg8::bfhi(w.y);
                        acc[4] += cw[k][4] * pg8::bflo(w.z); acc[5] += cw[k][5] * pg8::bfhi(w.z); acc[6] += cw[k][6] * pg8::bflo(w.w); acc[7] += cw[k][7] * pg8::bfhi(w.w); }
                }
                v4u o; o.x = pk2(acc[0], acc[1]); o.y = pk2(acc[2], acc[3]); o.z = pk2(acc[4], acc[5]); o.w = pk2(acc[6], acc[7]);
                *(LAS v4u*)(XAb + tok * 136 + 8 * cg) = o;
                *(LAS f32x4*)(XA32 + tok * 128 + 8 * cg) = (f32x4){acc[0], acc[1], acc[2], acc[3]};
                *(LAS f32x4*)(XA32 + tok * 128 + 8 * cg + 4) = (f32x4){acc[4], acc[5], acc[6], acc[7]};
            }
            __syncthreads();
#pragma unroll
            for (int rt = 0; rt < 4; ++rt) {
                f32x4 aR = {0.f, 0.f, 0.f, 0.f}, aI = {0.f, 0.f, 0.f, 0.f};
#pragma unroll
                for (int ks = 0; ks < 4; ++ks) { const bf16x8 af = *(const LAS bf16x8*)(XAb + (16 * rt + fr) * 136 + 32 * ks + 8 * kq);
                    aR = __builtin_amdgcn_mfma_f32_16x16x32_bf16(af, wrf[ks], aR, 0, 0, 0); aI = __builtin_amdgcn_mfma_f32_16x16x32_bf16(af, wif[ks], aI, 0, 0, 0); }
#pragma unroll
                for (int rg = 0; rg < 4; ++rg) { const int tok = 16 * rt + 4 * kq + rg;
                    const float r = 1.0f / (1.0f + expf(-(aR[rg] + br))), ig = 1.0f / (1.0f + expf(-(aI[rg] + bi)));
                    const float la = -8.0f * r * sp; const float av = expf(la); const float mult = sqrtf(-expm1f(2.0f * la));
                    const float xa = XA32[tok * 128 + dcol];
                    LA[tok * 128 + dcol] = av; XA32[tok * 128 + dcol] = mult * ig * xa; }
            }
            __syncthreads();
            if (tid < 128) {
                for (int t = 0; t < 64; ++t) { const float av = LA[t * 128 + tid], bx = XA32[t * 128 + tid]; h = av * h + bx; Pa *= av; if (FINAL) XA32[t * 128 + tid] = h; }
            }
            __syncthreads();
            if (FINAL) {
#pragma unroll
                for (int pp = 0; pp < 2; ++pp) {
                    const int tok = (tid >> 4) + 32 * pp;
                    const f32x4 h0 = *(const LAS f32x4*)(XA32 + tok * 128 + 8 * cg), h1 = *(const LAS f32x4*)(XA32 + tok * 128 + 8 * cg + 4);
                    const v4u gw = *(const GAS v4u*)(GR + (size_t)(r0 + tok) * DM + cc);
                    v4u o; o.x = pk2(h0[0] * pg8::bflo(gw.x), h0[1] * pg8::bfhi(gw.x)); o.y = pk2(h0[2] * pg8::bflo(gw.y), h0[3] * pg8::bfhi(gw.y));
                    o.z = pk2(h1[0] * pg8::bflo(gw.z), h1[1] * pg8::bfhi(gw.z)); o.w = pk2(h1[2] * pg8::bflo(gw.w), h1[3] * pg8::bfhi(gw.w));
                    *(GAS v4u*)(YA + (size_t)(r0 + tok) * DM + cc) = o;
                }
                __syncthreads();
            }
        }
        if (!FINAL && tid < 128) { *(float2*)(AG + ((size_t)rb * 1024 + n * 128 + tid) * 2) = make_float2(Pa, h); }
    }
}

__device__ __forceinline__ void attn_phase_v1(const Args& a, LAS unsigned char* lds, int vcu, int wave, int lane, int tid) {
    LAS float* KMl = (LAS float*)lds;
    LAS unsigned* SEL = (LAS unsigned*)(lds + 16384);
    LAS bf16* Kt = (LAS bf16*)(lds + 17408);
    LAS bf16* Vt = (LAS bf16*)(lds + 34816);
    LAS bf16* Pw = (LAS bf16*)(lds + 53248) + wave * (32 * 72);
    const bf16* Qg = (const bf16*)(a.ws + WS_Q); const bf16* Kg = (const bf16*)(a.ws + WS_K); const bf16* Vg = (const bf16*)(a.ws + WS_V); bf16* YB = (bf16*)(a.ws + WS_XR);
    const float* KM = (const float*)(a.ws + WS_KM);
    const int kq = lane >> 4, fr = lane & 15;
    const int bh = vcu >> 3, sidx = vcu & 7, bb = bh >> 3, hh = bh & 7;
    const size_t rowbase = (size_t)bb * SEQ;
#pragma unroll 1
    for (int ui = 0; ui < 4; ++ui) {
        const int qb = (ui == 0) ? sidx : (ui == 1) ? 15 - sidx : (ui == 2) ? 16 + sidx : 31 - sidx;
        const int q0 = qb * 256;
        int tl = tid; asm volatile("" : "+v"(tl));
#pragma unroll 2
        for (int e = tl; e < 32 * 128; e += 512) { const int nn = e >> 7, d = e & 127; KMl[e] = KM[((size_t)(bb * 32 + nn) * 8 + hh) * 128 + d]; }
        __syncthreads();
        {
            const int qi = tl >> 1, half = tl & 1;
            const bf16* qp = Qg + (rowbase + q0 + qi) * DM + hh * HD;
            float sc[16];
#pragma unroll
            for (int nn = 0; nn < 16; ++nn) sc[nn] = 0.f;
#pragma unroll 1
            for (int dc = 0; dc < 16; ++dc) {
                const v4u w = *(const GAS v4u*)(qp + 8 * dc);
                const float qv[8] = { pg8::bflo(w.x), pg8::bfhi(w.x), pg8::bflo(w.y), pg8::bfhi(w.y), pg8::bflo(w.z), pg8::bfhi(w.z), pg8::bflo(w.w), pg8::bfhi(w.w) };
#pragma unroll
                for (int nn = 0; nn < 16; ++nn) { const LAS float* kp = KMl + (16 * half + nn) * 128 + 8 * dc; const f32x4 k0 = *(const LAS f32x4*)kp, k1 = *(const LAS f32x4*)(kp + 4);
                    sc[nn] += (qv[0] * k0[0] + qv[1] * k0[1]) + (qv[2] * k0[2] + qv[3] * k0[3]) + (qv[4] * k1[0] + qv[5] * k1[1]) + (qv[6] * k1[2] + qv[7] * k1[3]);
                    asm volatile("" ::: "memory"); }
            }
            unsigned mask = 0u;
#pragma unroll
            for (int r = 0; r < 3; ++r) {
                if (r < qb) { float best = -3.0e38f; int bi = 64;
#pragma unroll
                    for (int nn = 0; nn < 16; ++nn) { const int gn = 16 * half + nn; const bool ok = (gn < qb) && !((mask >> gn) & 1u) && (sc[nn] > best); best = ok ? sc[nn] : best; bi = ok ? gn : bi; }
                    const float ob = __shfl_xor(best, 1); const int oi = __shfl_xor(bi, 1);
                    const bool take = (ob > best) || (ob == best && oi < bi);
                    bi = take ? oi : bi;
                    mask |= 1u << (bi & 31); }
            }
            if (half == 0) SEL[qi] = mask;
        }
        __syncthreads();
        const int wq0 = q0 + 32 * wave;
        bf16x8 qf[2][4]; unsigned selm[2][4];
#pragma unroll
        for (int rt = 0; rt < 2; ++rt) {
#pragma unroll
            for (int ks = 0; ks < 4; ++ks) qf[rt][ks] = *(const GAS bf16x8*)(Qg + (rowbase + wq0 + 16 * rt + fr) * DM + hh * HD + 32 * ks + 8 * kq);
#pragma unroll
            for (int rg = 0; rg < 4; ++rg) selm[rt][rg] = SEL[32 * wave + 16 * rt + 4 * kq + rg];
        }
        f32x4 O[2][8]; float lp[2][4];
#pragma unroll
        for (int rt = 0; rt < 2; ++rt) {
#pragma unroll
            for (int dt = 0; dt < 8; ++dt) O[rt][dt] = (f32x4){0.f, 0.f, 0.f, 0.f};
#pragma unroll
            for (int rg = 0; rg < 4; ++rg) lp[rt][rg] = 0.f; }
        const unsigned allsel = selm[0][0] | selm[0][1] | selm[0][2] | selm[0][3] | selm[1][0] | selm[1][1] | selm[1][2] | selm[1][3];
#pragma unroll 1
        for (int nn = 0; nn <= qb; ++nn) {
            const bool own = (nn == qb);
            const bool wave_any = own || (__any((int)((allsel >> nn) & 1u)) != 0);
#pragma unroll 1
            for (int kt = 0; kt < 4; ++kt) {
                const int key0 = nn * 256 + 64 * kt;
                __syncthreads();
#pragma unroll
                for (int pp = 0; pp < 2; ++pp) { const int p = tid + 512 * pp;
                    { const int row = p >> 4, c16 = p & 15; const v4u v = *(const GAS v4u*)(Kg + (rowbase + key0 + row) * DM + hh * HD + 8 * c16); *(LAS v4u*)(Kt + row * 136 + 8 * c16) = v; }
                    { const int key = p & 63, d8 = p >> 6; const v4u v = *(const GAS v4u*)(Vg + (rowbase + key0 + key) * DM + hh * HD + 8 * d8);
                      Vt[(8 * d8 + 0) * 72 + key] = (bf16)(v.x & 0xffffu); Vt[(8 * d8 + 1) * 72 + key] = (bf16)(v.x >> 16); Vt[(8 * d8 + 2) * 72 + key] = (bf16)(v.y & 0xffffu); Vt[(8 * d8 + 3) * 72 + key] = (bf16)(v.y >> 16);
                      Vt[(8 * d8 + 4) * 72 + key] = (bf16)(v.z & 0xffffu); Vt[(8 * d8 + 5) * 72 + key] = (bf16)(v.z >> 16); Vt[(8 * d8 + 6) * 72 + key] = (bf16)(v.w & 0xffffu); Vt[(8 * d8 + 7) * 72 + key] = (bf16)(v.w >> 16); }
                }
                __syncthreads();
                const bool live = wave_any && !(own && (64 * kt > 32 * wave + 31));
                if (live) {
#pragma unroll
                    for (int rt = 0; rt < 2; ++rt) {
#pragma unroll
                        for (int nt = 0; nt < 4; ++nt) {
                            f32x4 s = {0.f, 0.f, 0.f, 0.f};
#pragma unroll
                            for (int ks = 0; ks < 4; ++ks) { const bf16x8 kf = *(const LAS bf16x8*)(Kt + (16 * nt + fr) * 136 + 32 * ks + 8 * kq); s = __builtin_amdgcn_mfma_f32_16x16x32_bf16(qf[rt][ks], kf, s, 0, 0, 0); }
#pragma unroll
                            for (int rg = 0; rg < 4; ++rg) {
                                const bool ok = own ? (64 * kt + 16 * nt + fr <= 32 * wave + 16 * rt + 4 * kq + rg) : (((selm[rt][rg] >> nn) & 1u) != 0u);
                                const float p = ok ? __builtin_amdgcn_exp2f(s[rg]) : 0.f;
                                lp[rt][rg] += p;
                                Pw[(16 * rt + 4 * kq + rg) * 72 + 16 * nt + fr] = (bf16)f2bf(p);
                            }
                        }
                    }
                    LDS_WAIT(); asm volatile("" ::: "memory");
                    bf16x8 pa[2][2];
#pragma unroll
                    for (int rt = 0; rt < 2; ++rt)
#pragma unroll
                        for (int k2 = 0; k2 < 2; ++k2) pa[rt][k2] = *(const LAS bf16x8*)(Pw + (16 * rt + fr) * 72 + 32 * k2 + 8 * kq);
#pragma unroll
                    for (int dt = 0; dt < 8; ++dt) {
#pragma unroll
                        for (int k2 = 0; k2 < 2; ++k2) { const bf16x8 vb = *(const LAS bf16x8*)(Vt + (16 * dt + fr) * 72 + 32 * k2 + 8 * kq);
                            O[0][dt] = __builtin_amdgcn_mfma_f32_16x16x32_bf16(pa[0][k2], vb, O[0][dt], 0, 0, 0); O[1][dt] = __builtin_amdgcn_mfma_f32_16x16x32_bf16(pa[1][k2], vb, O[1][dt], 0, 0, 0); }
                    }
                    LDS_WAIT(); asm volatile("" ::: "memory");
                }
            }
        }
#pragma unroll
        for (int rt = 0; rt < 2; ++rt) {
#pragma unroll
            for (int rg = 0; rg < 4; ++rg) { float l = lp[rt][rg]; l += __shfl_xor(l, 1); l += __shfl_xor(l, 2); l += __shfl_xor(l, 4); l += __shfl_xor(l, 8); const float inv = 1.0f / l;
                bf16* op = YB + (rowbase + wq0 + 16 * rt + 4 * kq + rg) * DM + hh * HD + fr;
#pragma unroll
                for (int dt = 0; dt < 8; ++dt) op[16 * dt] = (bf16)f2bf(O[rt][dt][rg] * inv); }
        }
        __syncthreads();
    }
}

__device__ __forceinline__ void p5b_act(const Args& a, int gtid, int NT) {
    const bf16* UP = (const bf16*)(a.ws + WS_UP); bf16* GT = (bf16*)(a.ws + WS_GT);
    const float* cw = a.in[I_FCW]; const float* cb = a.in[I_FCB];
    constexpr int CPR = DFF / 8;
    for (long e = gtid; e < (long)M * CPR; e += NT) {
        const int row = (int)(e / CPR), c8 = (int)(e % CPR) * 8, tseq = row & (SEQ - 1);
        float acc[8];
#pragma unroll
        for (int j = 0; j < 8; ++j) acc[j] = cb[c8 + j];
#pragma unroll
        for (int k = 0; k < 3; ++k) {
            if (tseq - 2 + k >= 0) { const v4u w = *(const GAS v4u*)(UP + (size_t)(row - 2 + k) * DFF + c8); const float* wk = cw + k * DFF + c8;
                acc[0] += wk[0] * pg8::bflo(w.x); acc[1] += wk[1] * pg8::bfhi(w.x); acc[2] += wk[2] * pg8::bflo(w.y); acc[3] += wk[3] * pg8::bfhi(w.y);
                acc[4] += wk[4] * pg8::bflo(w.z); acc[5] += wk[5] * pg8::bfhi(w.z); acc[6] += wk[6] * pg8::bflo(w.w); acc[7] += wk[7] * pg8::bfhi(w.w); }
        }
        const v4u gw = *(const GAS v4u*)(GT + (size_t)row * DFF + c8);
        v4u o; o.x = pk2(pg8::gelu_tanh(acc[0]) * pg8::bflo(gw.x), pg8::gelu_tanh(acc[1]) * pg8::bfhi(gw.x)); o.y = pk2(pg8::gelu_tanh(acc[2]) * pg8::bflo(gw.y), pg8::gelu_tanh(acc[3]) * pg8::bfhi(gw.y));
        o.z = pk2(pg8::gelu_tanh(acc[4]) * pg8::bflo(gw.z), pg8::gelu_tanh(acc[5]) * pg8::bfhi(gw.z)); o.w = pk2(pg8::gelu_tanh(acc[6]) * pg8::bflo(gw.w), pg8::gelu_tanh(acc[7]) * pg8::bfhi(gw.w));
        *(GAS v4u*)(GT + (size_t)row * DFF + c8) = o;
    }
}

__global__ void __launch_bounds__(NWAVES * 64, 2) mk_fwd(Args args) {
    extern __shared__ __attribute__((aligned(16))) unsigned char lds_raw[];
    LAS unsigned char* lds = (LAS unsigned char*)lds_raw;
    volatile LAS unsigned* MISC = (volatile LAS unsigned*)(lds + MISC_OFF);
    const int tid = threadIdx.x, lane = tid & 63, wave = __builtin_amdgcn_readfirstlane(tid >> 6);
    const int G = gridDim.x; const int bx = blockIdx.x; const int vcu = (G % 8 == 0) ? (bx % 8) * (G / 8) + bx / 8 : bx;
    unsigned char* ws = args.ws;
    gu32* ctl = (gu32*)(ws + WS_CTL);
    for (int u = tid; u < (LDS_BYTES - 131072) / 4; u += NWAVES * 64) ((LAS unsigned*)(lds + 131072))[u] = 0u;
    __syncthreads();
    XcdBarrier bar; bar.bar = (unsigned*)(ctl + CW_BAR); bar.x = 0; bar.st = nullptr;
    if (MK_ONE_LAUNCH) bar = xcd_barrier_post((unsigned*)(ctl + CW_BAR), MISC + 8);
    const int lo = args.ph_lo, hi = args.ph_hi;
    const int tid0 = tid;
#define LAUNDER() int tid = tid0; asm volatile("" : "+v"(tid)); const int lane = tid & 63; (void)lane
#ifndef PH_MASK
#define PH_MASK 0xffff
#endif
#define IN(k) (((PH_MASK >> (k)) & 1) && lo <= (k) && (k) < hi)
#define SEAM(k) do { if (IN(k) && IN((k) + 1)) xcd_barrier(bar); } while (0)
    const int gw = vcu * NWAVES + wave, NGW = G * NWAVES;
    bf16* XN = (bf16*)(ws + WS_XN); bf16* XR = (bf16*)(ws + WS_XR); bf16* GR = (bf16*)(ws + WS_GR);
    bf16* Qb = (bf16*)(ws + WS_Q); bf16* Kb = (bf16*)(ws + WS_K); bf16* Vb = (bf16*)(ws + WS_V);
    bf16* GA = (bf16*)args.out; bf16* GB = (bf16*)args.out + (size_t)M * DM;

    if (IN(0)) { LAUNDER(); p0_prologue(args, lds, gw, NGW, wave, lane); } SEAM(0);
    if (IN(1)) { LAUNDER(); pg8::Gemm g{XN, (const bf16*)(ws + WS_WIN), M, DIN, DM}; pg8::StaticOrder S; S.init(M, DIN, G, bx);
        pg8::EpiG1 E{XR, GR, Qb, Kb, Vb, GA, GB};
        pg8::gemm_phase<pg8::EpiG1, pg8::StaticOrder, true, true>(lds, g, S, E); } SEAM(1);
    if (IN(2)) { LAUNDER(); p1b_qknorm(args, lds, G, wave, lane, tid); } SEAM(2);
    if (IN(3)) { LAUNDER(); rnn_phase<false>(args, lds, G, wave, lane, tid); } SEAM(3);
    if (IN(4)) { LAUNDER(); rnn_phase<true>(args, lds, G, wave, lane, tid); } SEAM(4);
    if (IN(5)) { LAUNDER(); attn_phase_v1(args, lds, vcu, wave, lane, tid); } SEAM(5);
    if (IN(6)) { LAUNDER(); pg8::Gemm g{XN  , (const bf16*)(ws + WS_PA), M, DM, DM}; pg8::StaticOrder S; S.init(M, DM, G, bx);
        pg8::EpiGate<false> E{GA, GR  };
        pg8::gemm_phase<pg8::EpiGate<false>, pg8::StaticOrder, true, true>(lds, g, S, E); } SEAM(6);
    if (IN(7)) { LAUNDER(); pg8::Gemm g{XR  , (const bf16*)(ws + WS_PB), M, DM, DM}; pg8::StaticOrder S; S.init(M, DM, G, bx);
        pg8::EpiGate<true> E{GB, GR  };
        pg8::gemm_phase<pg8::EpiGate<true>, pg8::StaticOrder, true, true>(lds, g, S, E); } SEAM(7);
    if (IN(8)) { LAUNDER(); pg8::Gemm g{GR  , (const bf16*)(ws + WS_WOUT), M, DM, DM}; pg8::StaticOrder S; S.init(M, DM, G, bx);
        pg8::EpiRes E{args.in[I_X], args.out};
        pg8::gemm_phase<pg8::EpiRes, pg8::StaticOrder, true, true>(lds, g, S, E); } SEAM(8);
    if (IN(9)) { LAUNDER(); for (int m = gw; m < M; m += NGW) rms_row_to_bf16(args.out + (size_t)m * DM, XN + (size_t)m * DM, lane); } SEAM(9);
    if (IN(10)) { LAUNDER(); pg8::Gemm g{XN  , (const bf16*)(ws + WS_WUG), M, 2 * DFF, DM}; pg8::StaticOrder S; S.init(M, 2 * DFF, G, bx);
        pg8::EpiUG E{(bf16*)(ws + WS_UP), (bf16*)(ws + WS_GT)};
        pg8::gemm_phase<pg8::EpiUG, pg8::StaticOrder, true, true>(lds, g, S, E); } SEAM(10);
    if (IN(11)) { LAUNDER(); p5b_act(args, vcu * 512 + tid, G * 512); } SEAM(11);
    if (IN(12)) { LAUNDER(); pg8::Gemm g{(const bf16*)(ws + WS_GT)  , (const bf16*)(ws + WS_WDN), M, DM, DFF}; pg8::StaticOrder S; S.init(M, DM, G, bx);
        pg8::EpiRes E{args.out, args.out};
        pg8::gemm_phase<pg8::EpiRes, pg8::StaticOrder, true, true>(lds, g, S, E); }
#undef IN
#undef SEAM
}

extern "C" void kernel_launch(void* const* d_in, const int* in_sizes, int n_in, void* d_out, int out_size, void* d_ws, size_t ws_size, hipStream_t stream) {
    static int grid = 0;
    if (grid == 0) {
        if (n_in != 21 || out_size != M * DM || ws_size < WS_END) { fprintf(stderr, "kernel_launch: unexpected shapes: n_in %d out %d ws %zu\n", n_in, out_size, ws_size); grid = -1; return; }
        int dev = 0, cus = 0;
        if (hipGetDevice(&dev) != hipSuccess || hipDeviceGetAttribute(&cus, hipDeviceAttributeMultiprocessorCount, dev) != hipSuccess) { grid = -1; return; }
        if (hipFuncSetAttribute((const void*)mk_fwd, hipFuncAttributeMaxDynamicSharedMemorySize, LDS_BYTES) != hipSuccess) { fprintf(stderr, "kernel_launch: hipFuncSetAttribute failed\n"); grid = -1; return; }
        int per_cu = 0;
        if (hipOccupancyMaxActiveBlocksPerMultiprocessor(&per_cu, (const void*)mk_fwd, NWAVES * 64, LDS_BYTES) != hipSuccess || per_cu < 1) fprintf(stderr, "kernel_launch: occupancy query says %d\n", per_cu);
        (void)hipGetLastError();
        grid = cus;
    }
    if (grid < 0) return;
    (void)hipMemsetAsync((char*)d_ws + WS_CTL, 0, CTL_ZERO_BYTES, stream);
    Args a{};
    for (int i = 0; i < 21; ++i) a.in[i] = (const float*)d_in[i];
    a.out = (float*)d_out; a.ws = (unsigned char*)d_ws;
#if MK_ONE_LAUNCH
    a.ph_lo = 0; a.ph_hi = NPHASE; a.li = 0;
    hipLaunchKernelGGL(mk_fwd, dim3(grid), dim3(NWAVES * 64), LDS_BYTES, stream, a);
#else
    for (int p = 0; p < NPHASE; ++p) { a.ph_lo = p; a.ph_hi = p + 1; a.li = p; hipLaunchKernelGGL(mk_fwd, dim3(grid), dim3(NWAVES * 64), LDS_BYTES, stream, a); }
#endif
}
```

```cpp
#include <hip/hip_runtime.h>
#include <cstdio>
#include <cstdint>
namespace pg8 {
#define PG8_LAS __attribute__((address_space(3)))
typedef unsigned short bf16_t;
typedef short bf16x8 __attribute__((ext_vector_type(8)));
typedef float f32x4 __attribute__((ext_vector_type(4)));
typedef unsigned u32x4 __attribute__((ext_vector_type(4)));
constexpr int BM = 256, BK = 64, HALF = 128, HTB = HALF * BK * 2  , STAGE_BYTES = 8 * HTB, NXCD = 8, WGM = 8;

__host__ __device__ __forceinline__ int lds_byte(int r, int c) { const int st = (r >> 4) * 2 + (c >> 5), rr = r & 15, cc = c & 31, ob = rr * 64 + cc * 2; return st * 1024 + (ob ^ (((ob >> 9) & 1) << 5)); }
__host__ __device__ __forceinline__ void stage_rc(int b, int& R, int& C) { const int st = b / 1024, sb = b % 1024, swz = sb ^ (((sb >> 9) & 1) << 5); R = (st >> 1) * 16 + swz / 64; C = (st & 1) * 32 + (swz % 64) / 2; }
__host__ __device__ __forceinline__ int perm32(int rho) { const int n = rho >> 4, i = rho & 15; return 8 * (i >> 2) + 4 * n + (i & 3); }

struct Unit { int pm, pn; };
struct Gemm { const bf16_t* A; const bf16_t* Bt; int M, N, K; };

struct StaticOrder {
    int nM, nN, nwg, G, c;
    __host__ __device__ void init(int M, int N, int G_, int c_) { nM = M / BM; nN = N / BM; nwg = nM * nN; G = G_; c = c_; }
    __host__ __device__ bool next(int i, Unit& u) const {
        const long L = (long)i * G + c; if (L >= nwg) return false;
        int wgid = (int)L; { const int q = nwg / NXCD, r = nwg % NXCD, xcd = wgid % NXCD, off = wgid / NXCD; wgid = (xcd < r ? xcd * (q + 1) : r * (q + 1) + (xcd - r) * q) + off; }
        const int nig = WGM * nN, gid = wgid / nig, fm = gid * WGM, gsz = (nM - fm) < WGM ? (nM - fm) : WGM;
        u.pm = fm + ((wgid % nig) % gsz); u.pn = (wgid % nig) / gsz; return true;
    }
    __device__ __forceinline__ void a_ready(const Unit&) const {}
    __device__ __forceinline__ void done(const Unit&) const {}
};

__device__ __forceinline__ unsigned cvt_pk_bf16(float lo, float hi) { unsigned r; asm volatile("v_cvt_pk_bf16_f32 %0, %1, %2" : "=v"(r) : "v"(lo), "v"(hi)); return r; }
typedef float f32x2 __attribute__((ext_vector_type(2)));
__device__ __forceinline__ float bf2f(unsigned short h) { return __builtin_bit_cast(float, (unsigned)h << 16); }
__device__ __forceinline__ float bflo(unsigned w) { return __builtin_bit_cast(float, w << 16); }
__device__ __forceinline__ float bfhi(unsigned w) { return __builtin_bit_cast(float, w & 0xffff0000u); }
__device__ __forceinline__ float fast_sigmoid(float x) { return __builtin_amdgcn_rcpf(1.0f + __builtin_amdgcn_exp2f(-1.4426950408889634f * x)); }
__device__ __forceinline__ float gelu_tanh(float x) { const float z = 0.7978845608028654f * (x + 0.044715f * x * x * x); return x * fast_sigmoid(2.0f * z); }

struct EpiG1 {
    static constexpr bool PERM = true, AFTER_DRAIN = false;
    bf16_t *o0, *o1, *o2, *o3, *o4, *o5, *o6;
    __device__ __forceinline__ void operator()(const f32x4 (&acc)[2][2][4][2], const Unit& u, int wr, int wc, int fr, int fq) const {
        const int seg = u.pn >> 2;
        bf16_t* base = seg == 0 ? o0 : seg == 1 ? o1 : seg == 2 ? o2 : seg == 3 ? o3 : seg == 4 ? o4 : seg == 5 ? o5 : o6;
        const int row0 = u.pm * BM + wr * 64 + fr, col0 = (u.pn & 3) * BM + wc * 32 + 8 * fq;
#pragma unroll
        for (int ai = 0; ai < 2; ++ai)
#pragma unroll
            for (int m = 0; m < 4; ++m) { bf16_t* rowp = base + (size_t)(row0 + ai * HALF + m * 16) * 1024 + col0;
#pragma unroll
                for (int bj = 0; bj < 2; ++bj) { f32x4 v0 = acc[ai][bj][m][0], v1 = acc[ai][bj][m][1];
                    if (seg == 1) {
#pragma unroll
                        for (int j = 0; j < 4; ++j) { v0[j] = gelu_tanh(v0[j]); v1[j] = gelu_tanh(v1[j]); }
                    } else if (seg >= 5) {
#pragma unroll
                        for (int j = 0; j < 4; ++j) { v0[j] = fast_sigmoid(v0[j]); v1[j] = fast_sigmoid(v1[j]); }
                    }
                    u32x4 w; w.x = cvt_pk_bf16(v0[0], v0[1]); w.y = cvt_pk_bf16(v0[2], v0[3]); w.z = cvt_pk_bf16(v1[0], v1[1]); w.w = cvt_pk_bf16(v1[2], v1[3]);
                    *(u32x4*)(rowp + bj * HALF) = w; } }
    }
};
template <bool ADD> struct EpiGate {
    static constexpr bool PERM = true, AFTER_DRAIN = false;
    const bf16_t* g; bf16_t* out;
    __device__ __forceinline__ void operator()(const f32x4 (&acc)[2][2][4][2], const Unit& u, int wr, int wc, int fr, int fq) const {
        const int row0 = u.pm * BM + wr * 64 + fr, col0 = u.pn * BM + wc * 32 + 8 * fq;
#pragma unroll
        for (int ai = 0; ai < 2; ++ai)
#pragma unroll
            for (int m = 0; m < 4; ++m) { const size_t off = (size_t)(row0 + ai * HALF + m * 16) * 1024 + col0;
#pragma unroll
                for (int bj = 0; bj < 2; ++bj) { const f32x4 v0 = acc[ai][bj][m][0], v1 = acc[ai][bj][m][1];
                    const u32x4 gw = *(const u32x4*)(g + off + bj * HALF);
                    float r[8] = { v0[0] * bflo(gw.x), v0[1] * bfhi(gw.x), v0[2] * bflo(gw.y), v0[3] * bfhi(gw.y), v1[0] * bflo(gw.z), v1[1] * bfhi(gw.z), v1[2] * bflo(gw.w), v1[3] * bfhi(gw.w) };
                    if (ADD) { const u32x4 t = *(const u32x4*)(out + off + bj * HALF);
                        r[0] += bflo(t.x); r[1] += bfhi(t.x); r[2] += bflo(t.y); r[3] += bfhi(t.y); r[4] += bflo(t.z); r[5] += bfhi(t.z); r[6] += bflo(t.w); r[7] += bfhi(t.w); }
                    u32x4 w; w.x = cvt_pk_bf16(r[0], r[1]); w.y = cvt_pk_bf16(r[2], r[3]); w.z = cvt_pk_bf16(r[4], r[5]); w.w = cvt_pk_bf16(r[6], r[7]);
                    *(u32x4*)(out + off + bj * HALF) = w; } }
    }
};
struct EpiRes {
    static constexpr bool PERM = false, AFTER_DRAIN = false;
    const float* base; float* out;
    __device__ __forceinline__ void operator()(const f32x4 (&acc)[2][2][4][2], const Unit& u, int wr, int wc, int fr, int fq) const {
        const int row0 = u.pm * BM + wr * 64 + fr, col0 = u.pn * BM + wc * 32 + 4 * fq;
#pragma unroll
        for (int ai = 0; ai < 2; ++ai)
#pragma unroll
            for (int m = 0; m < 4; ++m) { const size_t off = (size_t)(row0 + ai * HALF + m * 16) * 1024 + col0;
#pragma unroll
                for (int bj = 0; bj < 2; ++bj)
#pragma unroll
                    for (int n = 0; n < 2; ++n) { const f32x4 b = *(const f32x4*)(base + off + bj * HALF + n * 16); *(f32x4*)(out + off + bj * HALF + n * 16) = b + acc[ai][bj][m][n]; } }
    }
};
struct EpiUG {
    static constexpr bool PERM = true, AFTER_DRAIN = false;
    bf16_t* up; bf16_t* gt;
    __device__ __forceinline__ void operator()(const f32x4 (&acc)[2][2][4][2], const Unit& u, int wr, int wc, int fr, int fq) const {
        const int row0 = u.pm * BM + wr * 64 + fr, col0 = u.pn * HALF + wc * 32 + 8 * fq;
#pragma unroll
        for (int ai = 0; ai < 2; ++ai)
#pragma unroll
            for (int m = 0; m < 4; ++m) { const size_t off = (size_t)(row0 + ai * HALF + m * 16) * 2816 + col0;
#pragma unroll
                for (int bj = 0; bj < 2; ++bj) { const f32x4 v0 = acc[ai][bj][m][0], v1 = acc[ai][bj][m][1];
                    u32x4 w; w.x = cvt_pk_bf16(v0[0], v0[1]); w.y = cvt_pk_bf16(v0[2], v0[3]); w.z = cvt_pk_bf16(v1[0], v1[1]); w.w = cvt_pk_bf16(v1[2], v1[3]);
                    *(u32x4*)((bj ? gt : up) + off) = w; } }
    }
};
template <int CTRL> __device__ __forceinline__ float dpp_mov(float old, float src) { return __builtin_bit_cast(float, __builtin_amdgcn_update_dpp(__builtin_bit_cast(int, old), __builtin_bit_cast(int, src), CTRL, 0xf, 0xf, false)); }
struct EpiUGF {
    static constexpr bool PERM = true, AFTER_DRAIN = false;
    bf16_t* act; const float* cw; const float* cb; float* sb_last; float* su0; float* sg0; PG8_LAS float* halo;
    __device__ __forceinline__ void operator()(const f32x4 (&acc)[2][2][4][2], const Unit& u, int wr, int wc, int fr, int fq) const {
        const int colh = wc * 32 + 8 * fq, gcol = u.pn * HALF + colh;
        if (fr >= 14) {
#pragma unroll
            for (int ai = 0; ai < 2; ++ai)
#pragma unroll
                for (int n = 0; n < 2; ++n) *(PG8_LAS f32x4*)(halo + ((2 * ai + wr) * 2 + (fr - 14)) * 128 + colh + 4 * n) = acc[ai][0][3][n];
            if (wr == 1) {
#pragma unroll
                for (int n = 0; n < 2; ++n) *(f32x4*)(sb_last + ((size_t)u.pm * 2 + (fr - 14)) * 2816 + gcol + 4 * n) = acc[1][0][3][n];
            }
        }
        asm volatile("s_waitcnt lgkmcnt(0)" ::: "memory"); __builtin_amdgcn_s_barrier(); asm volatile("" ::: "memory");
        f32x4 w0[2], w1[2], w2[2], bb[2];
#pragma unroll
        for (int n = 0; n < 2; ++n) { w0[n] = *(const f32x4*)(cw + gcol + 4 * n); w1[n] = *(const f32x4*)(cw + 2816 + gcol + 4 * n); w2[n] = *(const f32x4*)(cw + 2 * 2816 + gcol + 4 * n); bb[n] = *(const f32x4*)(cb + gcol + 4 * n); }
#pragma unroll
        for (int ai = 0; ai < 2; ++ai) {
            const int seg = 2 * ai + wr;
            f32x4 prev[2];
#pragma unroll
            for (int n = 0; n < 2; ++n) prev[n] = *(const PG8_LAS f32x4*)(halo + (((seg > 0 ? seg - 1 : 0)) * 2 + (fr & 1)) * 128 + colh + 4 * n);
#pragma unroll
            for (int m = 0; m < 4; ++m) {
                float r[8];
#pragma unroll
                for (int n = 0; n < 2; ++n) { const f32x4 cur = acc[ai][0][m][n], gt = acc[ai][1][m][n];
#pragma unroll
                    for (int j = 0; j < 4; ++j) {
                        const float t1 = dpp_mov<0x121>(prev[n][j], prev[n][j]), v1 = dpp_mov<0x111>(t1, cur[j]);
                        const float t2 = dpp_mov<0x122>(prev[n][j], prev[n][j]), v2 = dpp_mov<0x112>(t2, cur[j]);
                        const float c = bb[n][j] + w2[n][j] * cur[j] + w1[n][j] * v1 + w0[n][j] * v2;
                        r[4 * n + j] = gelu_tanh(c) * gt[j]; }
                    prev[n] = cur; }
                const size_t row = (size_t)u.pm * BM + ai * HALF + wr * 64 + m * 16 + fr;
                const bool head = (seg == 0) && (m == 0) && (fr < 2);
                if (!head) { u32x4 w; w.x = cvt_pk_bf16(r[0], r[1]); w.y = cvt_pk_bf16(r[2], r[3]); w.z = cvt_pk_bf16(r[4], r[5]); w.w = cvt_pk_bf16(r[6], r[7]);
                    *(u32x4*)(act + row * 2816 + gcol) = w; }
                else {
#pragma unroll
                    for (int n = 0; n < 2; ++n) { *(f32x4*)(su0 + ((size_t)u.pm * 2 + fr) * 2816 + gcol + 4 * n) = acc[0][0][0][n]; *(f32x4*)(sg0 + ((size_t)u.pm * 2 + fr) * 2816 + gcol + 4 * n) = acc[0][1][0][n]; }
                }
            }
        }
    }
};
template <class Epi, class Sched, bool ALIGN_EPI = false, bool SP2 = false>
__device__ __forceinline__ void gemm_phase(PG8_LAS unsigned char* lds, const Gemm g, const Sched& S, const Epi& E) {
    const int tid = threadIdx.x, wid = __builtin_amdgcn_readfirstlane(tid >> 6), lane = tid & 63, wr = wid >> 2, wc = wid & 3, fr = lane & 15, fq = lane >> 4;
    const int K = g.K, nt = K / BK;
    unsigned voffA[2], voffB[2];
#pragma unroll
    for (int i = 0; i < 2; ++i) { int R, C; stage_rc(tid * 16 + i * 8192, R, C); const int Rb = Epi::PERM ? ((R & ~31) + perm32(R & 31)) : R;
        voffA[i] = (unsigned)(R * K + C) * 2u; voffB[i] = (unsigned)(Rb * K + C) * 2u; }
    const size_t kstep = (size_t)(BK * 2);
    const size_t hstep = (size_t)HALF * K * 2;
    const size_t tstep = 2 * hstep;
    const unsigned ldsw = (unsigned)wid * 1024u;
    const int aoff = lds_byte(wr * 64 + fr, fq * 8), boff = lds_byte(wc * 32 + fr, fq * 8);
#define PG8_SA(b, h) (((b) * 2 + (h)) * HTB)
#define PG8_SB(b, h) ((4 + (b) * 2 + (h)) * HTB)
#define PG8_STAGE(bufoff, gbase, voff) do { _Pragma("unroll") for (int _i = 0; _i < 2; ++_i) \
        __builtin_amdgcn_global_load_lds((const unsigned*)((const char*)(gbase) + (voff)[_i]), (PG8_LAS unsigned*)(lds + (bufoff) + ldsw + _i * 8192), 16, 0, 0); } while (0)
#define PG8_LDA(dst, b, h) do { _Pragma("unroll") for (int m = 0; m < 4; ++m) _Pragma("unroll") for (int k = 0; k < 2; ++k) dst[m][k] = *(const PG8_LAS bf16x8*)(lds + PG8_SA(b, h) + aoff + m * 2048 + k * 1024); } while (0)
#define PG8_LDB(dst, b, h) do { _Pragma("unroll") for (int n = 0; n < 2; ++n) _Pragma("unroll") for (int k = 0; k < 2; ++k) dst[n][k] = *(const PG8_LAS bf16x8*)(lds + PG8_SB(b, h) + boff + n * 2048 + k * 1024); } while (0)
#define PG8_MMA(ai, bj, At, Bt) do { __builtin_amdgcn_s_setprio(1); _Pragma("unroll") for (int m = 0; m < 4; ++m) _Pragma("unroll") for (int n = 0; n < 2; ++n) _Pragma("unroll") for (int k = 0; k < 2; ++k) \
        acc[ai][bj][m][n] = __builtin_amdgcn_mfma_f32_16x16x32_bf16(Bt[n][k], At[m][k], acc[ai][bj][m][n], 0, 0, 0); __builtin_amdgcn_s_setprio(0); } while (0)
#define PG8_WAIT_V(n) asm volatile("s_waitcnt vmcnt(" #n ")" ::: "memory")
#define PG8_WAIT_L(n) asm volatile("s_waitcnt lgkmcnt(" #n ")" ::: "memory")
#define PG8_BAR __builtin_amdgcn_s_barrier()
#define PG8_SCHED __builtin_amdgcn_sched_barrier(0)
    Unit cur, nxt; int ui = 0;
    if (!S.next(0, cur)) return;
    f32x4 acc[2][2][4][2];
#pragma unroll
    for (int a = 0; a < 2; ++a)
#pragma unroll
        for (int b = 0; b < 2; ++b)
#pragma unroll
            for (int m = 0; m < 4; ++m)
#pragma unroll
                for (int n = 0; n < 2; ++n) acc[a][b][m][n] = (f32x4){0.f, 0.f, 0.f, 0.f};
    bf16x8 At[4][2], B0[2][2], B1[2][2];
    const char* cA = (const char*)g.A + (size_t)cur.pm * tstep; const char* cB = (const char*)g.Bt + (size_t)cur.pn * tstep;
    S.a_ready(cur);
    if constexpr (SP2) {
        PG8_STAGE(PG8_SB(0, 0), cB, voffB); PG8_STAGE(PG8_SB(0, 1), cB + hstep, voffB); PG8_STAGE(PG8_SA(0, 0), cA, voffA); PG8_STAGE(PG8_SA(0, 1), cA + hstep, voffA);
        if (wr == 1) PG8_BAR;
        PG8_WAIT_V(2); PG8_BAR;
        PG8_STAGE(PG8_SB(1, 0), cB + kstep, voffB); PG8_STAGE(PG8_SA(1, 0), cA + kstep, voffA); PG8_STAGE(PG8_SB(1, 1), cB + hstep + kstep, voffB);
        PG8_WAIT_V(6); PG8_BAR;
    } else {
        PG8_STAGE(PG8_SB(0, 0), cB, voffB); PG8_STAGE(PG8_SA(0, 0), cA, voffA); PG8_STAGE(PG8_SB(0, 1), cB + hstep, voffB); PG8_STAGE(PG8_SA(0, 1), cA + hstep, voffA);
        if (wr == 1) PG8_BAR;
        PG8_WAIT_V(4); PG8_BAR;
        PG8_STAGE(PG8_SB(1, 0), cB + kstep, voffB); PG8_STAGE(PG8_SA(1, 0), cA + kstep, voffA); PG8_STAGE(PG8_SB(1, 1), cB + hstep + kstep, voffB);
        PG8_WAIT_V(6); PG8_BAR;
    }
    for (;;) {
        const bool has_next = S.next(ui + 1, nxt);
        const char* nA = has_next ? (const char*)g.A + (size_t)nxt.pm * tstep : cA; const char* nB = has_next ? (const char*)g.Bt + (size_t)nxt.pn * tstep : cB;
        for (int t = 0; t < nt; t += 2) {
            const bool last = (t == nt - 2);
            const char* a1 = cA + (size_t)(t + 1) * kstep;
            const char* a2 = last ? nA : cA + (size_t)(t + 2) * kstep; const char* b2 = last ? nB : cB + (size_t)(t + 2) * kstep;
            const char* a3 = a2 + kstep; const char* b3 = b2 + kstep;
            if (last && has_next) S.a_ready(nxt);
            if constexpr (SP2) {
            PG8_LDB(B0, 0, 0); PG8_LDB(B1, 0, 1); PG8_SCHED; PG8_LDA(At, 0, 0); PG8_STAGE(PG8_SA(1, 1), a1 + hstep, voffA);
            PG8_WAIT_V(8); PG8_WAIT_L(0); PG8_BAR; PG8_MMA(0, 0, At, B0); PG8_MMA(0, 1, At, B1); PG8_BAR; PG8_SCHED;
            PG8_LDA(At, 0, 1); PG8_STAGE(PG8_SB(0, 0), b2, voffB); PG8_STAGE(PG8_SB(0, 1), b2 + hstep, voffB); PG8_STAGE(PG8_SA(0, 0), a2, voffA);
            PG8_WAIT_V(8); PG8_WAIT_L(0); PG8_BAR; PG8_MMA(1, 0, At, B0); PG8_MMA(1, 1, At, B1); PG8_BAR; PG8_SCHED;
            PG8_LDB(B0, 1, 0); PG8_LDB(B1, 1, 1); PG8_SCHED; PG8_LDA(At, 1, 0); PG8_STAGE(PG8_SA(0, 1), a2 + hstep, voffA);
            PG8_WAIT_V(8); PG8_WAIT_L(0); PG8_BAR; PG8_MMA(0, 0, At, B0); PG8_MMA(0, 1, At, B1); PG8_BAR; PG8_SCHED;
            PG8_LDA(At, 1, 1); PG8_STAGE(PG8_SB(1, 0), b3, voffB); PG8_STAGE(PG8_SB(1, 1), b3 + hstep, voffB); PG8_STAGE(PG8_SA(1, 0), a3, voffA);
            PG8_WAIT_V(8); PG8_WAIT_L(0); PG8_BAR; PG8_MMA(1, 0, At, B0); PG8_MMA(1, 1, At, B1); PG8_BAR; PG8_SCHED;
            } else {
            PG8_LDB(B0, 0, 0); PG8_SCHED; PG8_LDA(At, 0, 0); PG8_STAGE(PG8_SA(1, 1), a1 + hstep, voffA);
            PG8_WAIT_L(8); PG8_BAR; PG8_WAIT_L(0); PG8_MMA(0, 0, At, B0); PG8_BAR; PG8_SCHED;
            PG8_LDB(B1, 0, 1); PG8_STAGE(PG8_SB(0, 0), b2, voffB);
            PG8_BAR; PG8_WAIT_L(0); PG8_MMA(0, 1, At, B1); PG8_BAR;
            PG8_LDA(At, 0, 1); PG8_STAGE(PG8_SA(0, 0), a2, voffA);
            PG8_BAR; PG8_WAIT_L(0); PG8_MMA(1, 0, At, B0); PG8_BAR; PG8_SCHED;
            PG8_STAGE(PG8_SB(0, 1), b2 + hstep, voffB);
            PG8_WAIT_V(6); PG8_BAR; PG8_MMA(1, 1, At, B1); PG8_BAR;
            PG8_LDB(B0, 1, 0); PG8_SCHED; PG8_LDA(At, 1, 0); PG8_STAGE(PG8_SA(0, 1), a2 + hstep, voffA);
            PG8_WAIT_L(8); PG8_BAR; PG8_WAIT_L(0); PG8_MMA(0, 0, At, B0); PG8_BAR; PG8_SCHED;
            PG8_LDB(B1, 1, 1); PG8_STAGE(PG8_SB(1, 0), b3, voffB);
            PG8_BAR; PG8_WAIT_L(0); PG8_MMA(0, 1, At, B1); PG8_BAR;
            PG8_LDA(At, 1, 1); PG8_STAGE(PG8_SA(1, 0), a3, voffA);
            PG8_BAR; PG8_WAIT_L(0); PG8_MMA(1, 0, At, B0); PG8_BAR; PG8_SCHED;
            PG8_STAGE(PG8_SB(1, 1), b3 + hstep, voffB);
            PG8_WAIT_V(6); PG8_BAR; PG8_MMA(1, 1, At, B1); PG8_BAR;
            }
        }
        if constexpr (ALIGN_EPI) { if (wr == 0) PG8_BAR; }
        if constexpr (!Epi::AFTER_DRAIN) { E(acc, cur, wr, wc, fr, fq); S.done(cur); }
        if (!has_next) break;
#pragma unroll
        for (int a = 0; a < 2; ++a)
#pragma unroll
            for (int b = 0; b < 2; ++b)
#pragma unroll
                for (int m = 0; m < 4; ++m)
#pragma unroll
                    for (int n = 0; n < 2; ++n) acc[a][b][m][n] = (f32x4){0.f, 0.f, 0.f, 0.f};
        cur = nxt; cA = nA; cB = nB; ++ui;
        if constexpr (ALIGN_EPI) { if (wr == 1) PG8_BAR; }
    }
    PG8_WAIT_V(0);
    if constexpr (!ALIGN_EPI) { if (wr == 0) PG8_BAR; }
    PG8_BAR;
    if constexpr (Epi::AFTER_DRAIN) { E.fused(acc, cur, wr, wc, fr, fq, lds, wid, lane); S.done(cur); }
#undef PG8_SA
#undef PG8_SB
#undef PG8_STAGE
#undef PG8_LDA
#undef PG8_LDB
#undef PG8_MMA
#undef PG8_WAIT_V
#undef PG8_WAIT_L
#undef PG8_BAR
#undef PG8_SCHED
}
}
#define GAS __attribute__((address_space(1)))
#define LAS __attribute__((address_space(3)))
typedef unsigned short bf16;
typedef unsigned v4u __attribute__((ext_vector_type(4)));
typedef float f32x4 __attribute__((ext_vector_type(4)));
typedef short bf16x8 __attribute__((ext_vector_type(8)));
typedef GAS unsigned gu32;
typedef GAS unsigned long long gu64;
#define RLX_AGENT __ATOMIC_RELAXED, __HIP_MEMORY_SCOPE_AGENT
#define LDS_WAIT() asm volatile("s_waitcnt lgkmcnt(0)" ::: "memory")
#define VM_WAIT() asm volatile("s_waitcnt vmcnt(0)" ::: "memory")
__device__ __forceinline__ unsigned long long rt() { return __builtin_amdgcn_s_memrealtime(); }
__device__ __forceinline__ unsigned f2bf(float f) { unsigned u = __builtin_bit_cast(unsigned, f); return (u + 0x7fffu + ((u >> 16) & 1u)) >> 16; }
__device__ __forceinline__ unsigned pk2(float lo, float hi) { return f2bf(lo) | (f2bf(hi) << 16); }

#define XB_TMO      128
#define XB_XCNT(j)  (256  + 64 * (j))
#define XB_XSUB(j)  (1280 + 64 * (j))
#define XB_XGEN(j)  (2304 + 64 * (j))
#define XB_TOP      3328
#define XB_TOPGEN   3392
#define XCD_BAR_WORDS 3456
#define XB_SPIN_CAP (1u << 18)

__device__ __forceinline__ unsigned xb_ld(unsigned* p)              { return __hip_atomic_load(p, __ATOMIC_RELAXED, __HIP_MEMORY_SCOPE_AGENT); }
__device__ __forceinline__ unsigned xb_add(unsigned* p, unsigned v) { return __hip_atomic_fetch_add(p, v, __ATOMIC_RELAXED, __HIP_MEMORY_SCOPE_AGENT); }
__device__ __forceinline__ unsigned xb_xcc_id() { return (unsigned)__builtin_amdgcn_s_getreg((3 << 11) | 20) & 0xFu; }
#define XB_SPIN(cond, bar) do { unsigned _sp = 0; while (cond) { __builtin_amdgcn_s_sleep(1); \
    if ((++_sp & 255u) == 0u) { if (xb_ld(&(bar)[XB_TMO])) break; if (_sp > XB_SPIN_CAP) { atomicAdd(&(bar)[XB_TMO], 1u); break; } } } } while (0)

struct XcdBarrier {
    unsigned* bar; unsigned x;
    volatile LAS unsigned* st;
};

__device__ __forceinline__ XcdBarrier xcd_barrier_post(unsigned* bar, volatile LAS unsigned* st) {
    XcdBarrier b; b.bar = bar; b.x = xb_xcc_id(); b.st = st;
    if (threadIdx.x == 0) (void)xb_add(&bar[XB_XCNT(b.x)], 1u);
    return b;
}
__device__ __forceinline__ void xcd_barrier_complete(unsigned* bar, unsigned x, unsigned& nloc, unsigned& nx) {
    const unsigned G = gridDim.x * gridDim.y * gridDim.z;
    unsigned sum, cnt, mine, sp = 0u;
    for (;;) {
        sum = 0u; cnt = 0u; mine = 0u;
#pragma unroll
        for (unsigned j = 0; j < 16; ++j) { const unsigned c = xb_ld(&bar[XB_XCNT(j)]); sum += c; cnt += (c > 0u) ? 1u : 0u; mine = (j == x) ? c : mine; }
        if (sum == G) break;
        __builtin_amdgcn_s_sleep(1);
        if ((++sp & 255u) == 0u) { if (xb_ld(&bar[XB_TMO])) break; if (sp > XB_SPIN_CAP) { atomicAdd(&bar[XB_TMO], 1u); break; } }
    }
    nloc = mine > 0u ? mine : 1u; nx = cnt > 0u ? cnt : 1u;
}

__device__ __forceinline__ void xcd_barrier(const XcdBarrier& b) {
    asm volatile("s_waitcnt vmcnt(0)" ::: "memory");
    __syncthreads();
    if (threadIdx.x == 0) {
        unsigned* bar = b.bar;
        __builtin_amdgcn_s_waitcnt(0);
        unsigned nloc = b.st[0], nx = b.st[1];
        if (nloc == 0u) { xcd_barrier_complete(bar, b.x, nloc, nx); b.st[0] = nloc; b.st[1] = nx; }
        const unsigned old = xb_add(&bar[XB_XSUB(b.x)], 1u);
        const unsigned gen = old / nloc;
        if (old + 1u == (gen + 1u) * nloc) {
            __builtin_amdgcn_fence(__ATOMIC_RELEASE, "agent");
            asm volatile("s_waitcnt vmcnt(0)" ::: "memory");
            const unsigned og = xb_add(&bar[XB_TOP], 1u);
            const unsigned tg = og / nx;
            if (og + 1u == (tg + 1u) * nx) xb_add(&bar[XB_TOPGEN], 1u);
            else XB_SPIN(xb_ld(&bar[XB_TOPGEN]) == tg, bar);
            __builtin_amdgcn_fence(__ATOMIC_ACQUIRE, "agent");
            xb_add(&bar[XB_XGEN(b.x)], 1u);
            asm volatile("s_waitcnt vmcnt(0)" ::: "memory");
        } else {
            XB_SPIN(xb_ld(&bar[XB_XGEN(b.x)]) == gen, bar);
            __builtin_amdgcn_fence(__ATOMIC_ACQUIRE, "agent");
            asm volatile("s_waitcnt vmcnt(0)" ::: "memory");
        }
    }
    __syncthreads();
}

constexpr int NWAVES = 8;
constexpr int NB = 4, SEQ = 8192, DM = 1024, M = NB * SEQ, DIN = 7168, DFF = 2816, NH = 8, HD = 128, NBLK = SEQ / 256;
constexpr float EPS = 1e-6f;
constexpr float QSCALE = 0.08838834764831845f * 1.4426950408889634f;
#ifndef MK_ONE_LAUNCH
#define MK_ONE_LAUNCH 1
#endif
constexpr int NPHASE = 15;

constexpr size_t MiB = 1u << 20;
constexpr size_t WS_CTL = 0, CTL_ZERO_BYTES = 1 * MiB;
constexpr size_t WS_WIN = 2 * MiB, WS_PA = 16 * MiB, WS_PB = 18 * MiB, WS_WOUT = 20 * MiB, WS_WUG = 22 * MiB, WS_WDN = 33 * MiB, WS_WR = 39 * MiB, WS_WI = 39 * MiB + 256 * 1024;
constexpr size_t WS_KM = 40 * MiB, WS_AG = 41 * MiB;
constexpr size_t WS_XN = 48 * MiB;
constexpr size_t WS_Q = 112 * MiB;
constexpr size_t WS_K = 176 * MiB;
constexpr size_t WS_V = 240 * MiB;
constexpr size_t WS_XR = 304 * MiB, WS_GR = 368 * MiB;
constexpr size_t WS_ACT = 112 * MiB;
constexpr size_t WS_SB = 448 * MiB, WS_SU0 = 451 * MiB, WS_SG0 = 454 * MiB;
constexpr size_t WS_END = 512 * MiB;
constexpr int CW_BAR = 4096;

constexpr int LDS_BYTES = 147456;
constexpr int MISC_OFF = 131072 + 320;

__device__ __forceinline__ float wave_sum(float v) {
#pragma unroll
    for (int o = 1; o < 64; o <<= 1) v += __shfl_xor(v, o);
    return v;
}
__device__ __forceinline__ void p0_transpose_item(const float* W, int N, bf16* WT, int ldwt, int drow0, const float* gain, LAS float* scr, int kb, int nb, int lane) {
    const int k0 = 64 * kb, n0 = 32 * nb;
#pragma unroll 8
    for (int i = 0; i < 32; ++i) { const int kk = 2 * i + (lane >> 5); float v = W[(size_t)(k0 + kk) * N + n0 + (lane & 31)]; if (gain) v *= gain[k0 + kk]; scr[kk * 33 + (lane & 31)] = v; }
    LDS_WAIT(); asm volatile("" ::: "memory");
    const int c = lane & 7;
#pragma unroll
    for (int j = 0; j < 4; ++j) { const int n = (lane >> 3) + 8 * j; const LAS float* s = scr + (8 * c) * 33 + n;
        v4u o; o.x = pk2(s[0 * 33], s[1 * 33]); o.y = pk2(s[2 * 33], s[3 * 33]); o.z = pk2(s[4 * 33], s[5 * 33]); o.w = pk2(s[6 * 33], s[7 * 33]);
        *(GAS v4u*)(WT + (size_t)(drow0 + n) * ldwt + k0 + 8 * c) = o; }
    LDS_WAIT(); asm volatile("" ::: "memory");
}
__device__ __forceinline__ void rms_row_to_bf16(const float* xrow, bf16* orow, int lane) {
    const GAS f32x4* xr = (const GAS f32x4*)xrow + lane;
    f32x4 v[4]; float s = 0.f;
#pragma unroll
    for (int j = 0; j < 4; ++j) { v[j] = xr[64 * j]; s += (v[j].x * v[j].x + v[j].y * v[j].y) + (v[j].z * v[j].z + v[j].w * v[j].w); }
    const float rstd = 1.0f / sqrtf(wave_sum(s) * (1.f / DM) + EPS);
    GAS unsigned long long* o8 = (GAS unsigned long long*)orow + lane;
#pragma unroll
    for (int j = 0; j < 4; ++j) o8[64 * j] = (unsigned long long)pk2(v[j].x * rstd, v[j].y * rstd) | ((unsigned long long)pk2(v[j].z * rstd, v[j].w * rstd) << 32);
}

struct Args { const float* in[21]; float* out; unsigned char* ws; int ph_lo, ph_hi, li, pad; };
enum { I_X = 0, I_N1G, I_WIN, I_CONVW, I_CONVB, I_WR, I_BR, I_WI, I_BI, I_LAM, I_QNG, I_KNG, I_PA, I_PB, I_WOUT, I_N2G, I_WUP, I_WGATE, I_FCW, I_FCB, I_WDN };

__device__ __forceinline__ void p0_prologue(const Args& a, LAS unsigned char* lds, int gw, int NGW, int wave, int lane) {
    LAS float* scr = (LAS float*)(lds + wave * 16384);
    unsigned char* ws = a.ws;
    constexpr int I_IN = 16 * 224, I_SQ = 16 * 32, I_UP = 16 * 88, I_DN = 44 * 32, I_RG = 64;
    constexpr int NITEMS = I_IN + 3 * I_SQ + 2 * I_UP + I_DN + 2 * I_RG;
    for (int it = gw; it < NITEMS; it += NGW) {
        int r = it;
        if (r < I_IN) { p0_transpose_item(a.in[I_WIN], DIN, (bf16*)(ws + WS_WIN), DM, 32 * (r % 224), a.in[I_N1G], scr, r / 224, r % 224, lane); continue; } r -= I_IN;
        if (r < I_SQ) { p0_transpose_item(a.in[I_PA], DM, (bf16*)(ws + WS_PA), DM, 32 * (r % 32), nullptr, scr, r / 32, r % 32, lane); continue; } r -= I_SQ;
        if (r < I_SQ) { p0_transpose_item(a.in[I_PB], DM, (bf16*)(ws + WS_PB), DM, 32 * (r % 32), nullptr, scr, r / 32, r % 32, lane); continue; } r -= I_SQ;
        if (r < I_SQ) { p0_transpose_item(a.in[I_WOUT], DM, (bf16*)(ws + WS_WOUT), DM, 32 * (r % 32), nullptr, scr, r / 32, r % 32, lane); continue; } r -= I_SQ;
        if (r < I_UP) { const int nb = r % 88, n0 = 32 * nb; p0_transpose_item(a.in[I_WUP], DFF, (bf16*)(ws + WS_WUG), DM, 256 * (n0 / 128) + (n0 % 128), a.in[I_N2G], scr, r / 88, nb, lane); continue; } r -= I_UP;
        if (r < I_UP) { const int nb = r % 88, n0 = 32 * nb; p0_transpose_item(a.in[I_WGATE], DFF, (bf16*)(ws + WS_WUG), DM, 256 * (n0 / 128) + 128 + (n0 % 128), a.in[I_N2G], scr, r / 88, nb, lane); continue; } r -= I_UP;
        if (r < I_DN) { p0_transpose_item(a.in[I_WDN], DM, (bf16*)(ws + WS_WDN), DFF, 32 * (r % 32), nullptr, scr, r / 32, r % 32, lane); continue; } r -= I_DN;
        if (r < I_RG) { const int blk = r >> 3, q = r & 7; p0_transpose_item(a.in[I_WR] + blk * 16384, 128, (bf16*)(ws + WS_WR) + blk * 16384, 128, 32 * (q & 3), nullptr, scr, q >> 2, q & 3, lane); continue; } r -= I_RG;
        { const int blk = r >> 3, q = r & 7; p0_transpose_item(a.in[I_WI] + blk * 16384, 128, (bf16*)(ws + WS_WI) + blk * 16384, 128, 32 * (q & 3), nullptr, scr, q >> 2, q & 3, lane); }
    }
    for (int m = gw; m < M; m += NGW) rms_row_to_bf16(a.in[I_X] + (size_t)m * DM, (bf16*)(ws + WS_XN) + (size_t)m * DM, lane);
}

__device__ __forceinline__ void p1b_qknorm(const Args& a, LAS unsigned char* lds, int G, int wave, int lane, int tid) {
    LAS float* red = (LAS float*)lds;
    for (int item = blockIdx.x; item < 256; item += G) {
        const int rb = item >> 1, which = item & 1;
        bf16* buf = (bf16*)(a.ws + (which ? WS_K : WS_Q));
        const float* g = a.in[which ? I_KNG : I_QNG];
        const int c0 = lane * 16, d0 = c0 & 127;
        float gain[16], colsum[16];
#pragma unroll
        for (int j = 0; j < 16; ++j) { gain[j] = g[d0 + j] * (which ? 1.0f : QSCALE); colsum[j] = 0.f; }
        for (int i = 0; i < 32; ++i) {
            bf16* p = buf + (size_t)(rb * 256 + wave * 32 + i) * DM + c0;
            const v4u w0 = *(const GAS v4u*)p, w1 = *(const GAS v4u*)(p + 8);
            float v[16] = { pg8::bflo(w0.x), pg8::bfhi(w0.x), pg8::bflo(w0.y), pg8::bfhi(w0.y), pg8::bflo(w0.z), pg8::bfhi(w0.z), pg8::bflo(w0.w), pg8::bfhi(w0.w),
                            pg8::bflo(w1.x), pg8::bfhi(w1.x), pg8::bflo(w1.y), pg8::bfhi(w1.y), pg8::bflo(w1.z), pg8::bfhi(w1.z), pg8::bflo(w1.w), pg8::bfhi(w1.w) };
            float ss = 0.f;
#pragma unroll
            for (int j = 0; j < 16; ++j) ss += v[j] * v[j];
            ss += __shfl_xor(ss, 1); ss += __shfl_xor(ss, 2); ss += __shfl_xor(ss, 4);
            const float rstd = 1.0f / sqrtf(ss * (1.f / HD) + EPS);
#pragma unroll
            for (int j = 0; j < 16; ++j) { v[j] = v[j] * rstd * gain[j]; colsum[j] += v[j]; }
            v4u o0, o1; o0.x = pk2(v[0], v[1]); o0.y = pk2(v[2], v[3]); o0.z = pk2(v[4], v[5]); o0.w = pk2(v[6], v[7]);
            o1.x = pk2(v[8], v[9]); o1.y = pk2(v[10], v[11]); o1.z = pk2(v[12], v[13]); o1.w = pk2(v[14], v[15]);
            *(GAS v4u*)p = o0; *(GAS v4u*)(p + 8) = o1;
        }
        if (which) {
#pragma unroll
            for (int j = 0; j < 16; ++j) red[wave * 1024 + c0 + j] = colsum[j];
            __syncthreads();
            float* KM = (float*)(a.ws + WS_KM);
            for (int c = tid; c < 1024; c += 512) { float s = 0.f;
#pragma unroll
                for (int w = 0; w < 8; ++w) s += red[w * 1024 + c];
                KM[(size_t)rb * 1024 + c] = s * (1.0f / 256.0f); }
            __syncthreads();
        }
    }
}

template <bool FINAL> __device__ __forceinline__ void rnn_phase(const Args& a, LAS unsigned char* lds, int G, int wave, int lane, int tid) {
    LAS bf16* XRs = (LAS bf16*)lds;
    LAS bf16* XAb = (LAS bf16*)(lds + 18432);
    LAS bf16* HB = (LAS bf16*)(lds + 18432 + 17408);
    const bf16* XR = (const bf16*)(a.ws + WS_XR); const bf16* GR = (const bf16*)(a.ws + WS_GR); bf16* YA = (bf16*)(a.ws + WS_XN);
    float* AG = (float*)(a.ws + WS_AG);
    const int kq = lane >> 4, fr = lane & 15;
#pragma unroll 1
    for (int tile = blockIdx.x; tile < 1024; tile += G) {
        const int n = tile & 7, rb = tile >> 3, chunk = rb & 31, bb = rb >> 5;
        const int dcol = 16 * wave + fr, ch = n * 128 + dcol;
        bf16x8 wrf[4], wif[4];
#pragma unroll
        for (int ks = 0; ks < 4; ++ks) { wrf[ks] = *(const GAS bf16x8*)((const bf16*)(a.ws + WS_WR) + (size_t)ch * 128 + 32 * ks + 8 * kq);
                                         wif[ks] = *(const GAS bf16x8*)((const bf16*)(a.ws + WS_WI) + (size_t)ch * 128 + 32 * ks + 8 * kq); }
        const float nbr = -1.4426950408889634f * a.in[I_BR][ch], nbi = -1.4426950408889634f * a.in[I_BI][ch];
        const float sp = log1pf(expf(-a.in[I_LAM][ch]));
        const float c1 = -16.0f * sp, c2 = -8.0f * sp * 1.4426950408889634f;
        const int cg = tid & 15, cc = n * 128 + 8 * cg;
        float cw[4][8], cb[8];
#pragma unroll
        for (int j = 0; j < 8; ++j) { cb[j] = a.in[I_CONVB][cc + j];
#pragma unroll
            for (int k = 0; k < 4; ++k) cw[k][j] = a.in[I_CONVW][k * 1024 + cc + j]; }
        float hc = 0.f, Pa = 1.f;
        if (FINAL) {
#pragma unroll 1
            for (int c0 = 0; c0 < chunk; c0 += 8) { float2 ah[8];
#pragma unroll
                for (int j = 0; j < 8; ++j) { const int ci = (c0 + j < chunk) ? c0 + j : chunk - 1; ah[j] = *(const float2*)(AG + ((size_t)(bb * 32 + ci) * 1024 + ch) * 2); }
#pragma unroll
                for (int j = 0; j < 8; ++j) if (c0 + j < chunk) hc = ah[j].x * hc + ah[j].y; }
        }
        v4u pre[3];
        {
            const bool seqstart = (chunk == 0);
#pragma unroll
            for (int pp = 0; pp < 3; ++pp) { const int p = tid + 512 * pp;
                if (p < 67 * 16) { const int row = p >> 4, c = p & 15; const bool z = seqstart && row < 3; const int srow = z ? rb * 256 : rb * 256 - 3 + row;
                    v4u v = *(const GAS v4u*)(XR + (size_t)srow * DM + n * 128 + 8 * c); if (z) v = (v4u){0u, 0u, 0u, 0u}; pre[pp] = v; } }
        }
#pragma unroll 1
        for (int s = 0; s < 4; ++s) {
            const int r0 = rb * 256 + 64 * s;
#pragma unroll
            for (int pp = 0; pp < 3; ++pp) { const int p = tid + 512 * pp; if (p < 67 * 16) *(LAS v4u*)(XRs + (p >> 4) * 136 + 8 * (p & 15)) = pre[pp]; }
            __syncthreads();
            if (s < 3) {
#pragma unroll
                for (int pp = 0; pp < 3; ++pp) { const int p = tid + 512 * pp; if (p < 67 * 16) pre[pp] = *(const GAS v4u*)(XR + (size_t)(r0 + 64 - 3 + (p >> 4)) * DM + n * 128 + 8 * (p & 15)); }
            }
            v4u gpre[2];
            if (FINAL) {
#pragma unroll
                for (int pp = 0; pp < 2; ++pp) gpre[pp] = *(const GAS v4u*)(GR + (size_t)(r0 + (tid >> 4) + 32 * pp) * DM + cc);
            }
#pragma unroll
            for (int pp = 0; pp < 2; ++pp) {
                const int tok = (tid >> 4) + 32 * pp;
                float acc[8];
#pragma unroll
                for (int j = 0; j < 8; ++j) acc[j] = cb[j];
#pragma unroll
                for (int k = 0; k < 4; ++k) { const v4u w = *(const LAS v4u*)(XRs + (tok + k) * 136 + 8 * cg);
                    acc[0] += cw[k][0] * pg8::bflo(w.x); acc[1] += cw[k][1] * pg8::bfhi(w.x); acc[2] += cw[k][2] * pg8::bflo(w.y); acc[3] += cw[k][3] * pg8::bfhi(w.y);
                    acc[4] += cw[k][4] * pg8::bflo(w.z); acc[5] += cw[k][5] * pg8::bfhi(w.z); acc[6] += cw[k][6] * pg8::bflo(w.w); acc[7] += cw[k][7] * pg8::bfhi(w.w); }
                v4u o; o.x = pk2(acc[0], acc[1]); o.y = pk2(acc[2], acc[3]); o.z = pk2(acc[4], acc[5]); o.w = pk2(acc[6], acc[7]);
                *(LAS v4u*)(XAb + tok * 136 + 8 * cg) = o;
            }
            __syncthreads();
            float av[4][4], bx[4][4];
#pragma unroll
            for (int rt = 0; rt < 4; ++rt) {
                f32x4 aR = {0.f, 0.f, 0.f, 0.f}, aI = {0.f, 0.f, 0.f, 0.f};
#pragma unroll
                for (int ks = 0; ks < 4; ++ks) { const bf16x8 af = *(const LAS bf16x8*)(XAb + (16 * rt + fr) * 136 + 32 * ks + 8 * kq);
                    aR = __builtin_amdgcn_mfma_f32_16x16x32_bf16(af, wrf[ks], aR, 0, 0, 0); aI = __builtin_amdgcn_mfma_f32_16x16x32_bf16(af, wif[ks], aI, 0, 0, 0); }
#pragma unroll
                for (int rg = 0; rg < 4; ++rg) { const int tok = 16 * rt + 4 * kq + rg;
                    const float r = __builtin_amdgcn_rcpf(1.0f + __builtin_amdgcn_exp2f(-1.4426950408889634f * aR[rg] + nbr));
                    const float ig = __builtin_amdgcn_rcpf(1.0f + __builtin_amdgcn_exp2f(-1.4426950408889634f * aI[rg] + nbi));
                    const float aa = __builtin_amdgcn_exp2f(r * c2);
                    const float x = r * c1;
                    const float poly = -x * (1.0f + x * 0.5f * (1.0f + x * (1.0f / 3.0f) * (1.0f + x * 0.25f * (1.0f + x * 0.2f))));
                    const float em1 = (x > -0.25f) ? poly : (1.0f - aa * aa);
                    const float xa = pg8::bf2f(XAb[tok * 136 + dcol]);
                    av[rt][rg] = aa; bx[rt][rg] = __builtin_amdgcn_sqrtf(em1) * ig * xa; }
            }
#pragma unroll
            for (int rt = 0; rt < 4; ++rt) {
                float A = 1.f, H = 0.f;
#pragma unroll
                for (int rg = 0; rg < 4; ++rg) { H = av[rt][rg] * H + bx[rt][rg]; A *= av[rt][rg]; }
                { const float A1 = __shfl_up(A, 16), H1 = __shfl_up(H, 16); if (kq >= 1) { H = A * H1 + H; A = A1 * A; } }
                { const float A2 = __shfl_up(A, 32), H2 = __shfl_up(H, 32); if (kq >= 2) { H = A * H2 + H; A = A2 * A; } }
                const float At = __shfl(A, 48 + fr), Ht = __shfl(H, 48 + fr);
                if (FINAL) {
                    float Ae = __shfl_up(A, 16), He = __shfl_up(H, 16); if (kq == 0) { Ae = 1.f; He = 0.f; }
                    float h = Ae * hc + He;
#pragma unroll
                    for (int rg = 0; rg < 4; ++rg) { h = av[rt][rg] * h + bx[rt][rg]; HB[(16 * rt + 4 * kq + rg) * 136 + dcol] = (bf16)f2bf(h); }
                }
                hc = At * hc + Ht; Pa *= At;
            }
            if (FINAL) {
                __syncthreads();
#pragma unroll
                for (int pp = 0; pp < 2; ++pp) {
                    const int tok = (tid >> 4) + 32 * pp;
                    const v4u hw = *(const LAS v4u*)(HB + tok * 136 + 8 * cg);
                    const v4u gw = gpre[pp];
                    v4u o; o.x = pk2(pg8::bflo(hw.x) * pg8::bflo(gw.x), pg8::bfhi(hw.x) * pg8::bfhi(gw.x)); o.y = pk2(pg8::bflo(hw.y) * pg8::bflo(gw.y), pg8::bfhi(hw.y) * pg8::bfhi(gw.y));
                    o.z = pk2(pg8::bflo(hw.z) * pg8::bflo(gw.z), pg8::bfhi(hw.z) * pg8::bfhi(gw.z)); o.w = pk2(pg8::bflo(hw.w) * pg8::bflo(gw.w), pg8::bfhi(hw.w) * pg8::bfhi(gw.w));
                    *(GAS v4u*)(YA + (size_t)(r0 + tok) * DM + cc) = o;
                }
            }
        }
        if (!FINAL && kq == 0) { *(float2*)(AG + ((size_t)rb * 1024 + ch) * 2) = make_float2(Pa, hc); }
        __syncthreads();
    }
}
typedef short s16x4 __attribute__((ext_vector_type(4)));
typedef float f32x16 __attribute__((ext_vector_type(16)));
typedef short v4i16_t __attribute__((ext_vector_type(4)));
constexpr size_t WS_PART = 304 * MiB, WS_LIST = 496 * MiB, WS_LP = 42 * MiB;
constexpr int CW_CNT = 16384;
constexpr int LIST_PER_BH = 256 * 496;
__device__ __forceinline__ int list_off(int n) { return 256 * (31 * n - (n * (n - 1)) / 2); }
__device__ __forceinline__ unsigned cvtpk(float lo, float hi) { unsigned r; asm volatile("v_cvt_pk_bf16_f32 %0, %1, %2" : "=v"(r) : "v"(lo), "v"(hi)); return r; }
__device__ __forceinline__ s16x4 vtr(const LAS unsigned char* p) { return __builtin_bit_cast(s16x4, __builtin_amdgcn_ds_read_tr16_b64_v4i16((LAS v4i16_t*)p)); }

__device__ __forceinline__ void load_kv_block(LAS unsigned char* lds, const bf16* Kg, const bf16* Vg, size_t row0, int hh, int wave, int lane) {
#pragma unroll
    for (int i = 0; i < 8; ++i) {
        const int I = wave * 8 + i;
        { const int r = 4 * I + (lane >> 4), cp = lane & 15, c = cp ^ (r & 15);
          __builtin_amdgcn_global_load_lds((const unsigned*)(Kg + (row0 + r) * DM + hh * HD + 8 * c), (LAS unsigned*)(lds + I * 1024), 16, 0, 0); }
        { const int dt = lane >> 4, q = (lane >> 2) & 3, c8 = lane & 3;
          __builtin_amdgcn_global_load_lds((const unsigned*)(Vg + (row0 + 4 * I + q) * DM + hh * HD + 32 * dt + 8 * c8), (LAS unsigned*)(lds + 65536 + I * 1024), 16, 0, 0); }
    }
}

__device__ __forceinline__ void attn_wave(const LAS unsigned char* lds, const bf16x8 (&qf)[8], f32x16 (&O)[4], float& lsum, int kt_hi, int diag, int lane) {
    const int h2 = lane >> 5, kr = lane & 31;
    unsigned kaddr[8];
#pragma unroll
    for (int s = 0; s < 8; ++s) kaddr[s] = (unsigned)(kr * 256 + (((2 * s + h2) ^ (lane & 15)) * 16));
    const LAS unsigned char* vb = lds + 65536 + h2 * 1024 + ((lane >> 2) & 3) * 64 + ((lane >> 4) & 1) * 32 + (lane & 3) * 8;
#pragma unroll 1
    for (int kt = 0; kt < kt_hi; ++kt) {
        f32x16 S;
#pragma unroll
        for (int r = 0; r < 16; ++r) S[r] = 0.f;
#pragma unroll
        for (int s = 0; s < 8; ++s) { const bf16x8 kf = *(const LAS bf16x8*)(lds + kt * 8192 + kaddr[s]); S = __builtin_amdgcn_mfma_f32_32x32x16_bf16(kf, qf[s], S, 0, 0, 0); }
        float P[16];
#pragma unroll
        for (int r = 0; r < 16; ++r) P[r] = __builtin_amdgcn_exp2f(S[r]);
        if (kt == diag) {
#pragma unroll
            for (int r = 0; r < 16; ++r) { const int kl = (r & 3) + 8 * (r >> 2) + 4 * h2; P[r] = (kl <= kr) ? P[r] : 0.f; }
        }
        float ls = 0.f;
#pragma unroll
        for (int r = 0; r < 16; ++r) ls += P[r];
        lsum += ls;
        v4u pw0, pw1;
        pw0.x = cvtpk(P[0], P[1]); pw0.y = cvtpk(P[2], P[3]); pw0.z = cvtpk(P[4], P[5]); pw0.w = cvtpk(P[6], P[7]);
        pw1.x = cvtpk(P[8], P[9]); pw1.y = cvtpk(P[10], P[11]); pw1.z = cvtpk(P[12], P[13]); pw1.w = cvtpk(P[14], P[15]);
        const bf16x8 pb0 = __builtin_bit_cast(bf16x8, pw0), pb1 = __builtin_bit_cast(bf16x8, pw1);
        const LAS unsigned char* vk = vb + kt * 8192;
#pragma unroll
        for (int dt = 0; dt < 4; ++dt) {
            { const s16x4 lo = vtr(vk + dt * 256), hi = vtr(vk + dt * 256 + 2048);
              const bf16x8 vf = (bf16x8){lo[0], lo[1], lo[2], lo[3], hi[0], hi[1], hi[2], hi[3]};
              O[dt] = __builtin_amdgcn_mfma_f32_32x32x16_bf16(vf, pb0, O[dt], 0, 0, 0); }
            { const s16x4 lo = vtr(vk + 4096 + dt * 256), hi = vtr(vk + 4096 + dt * 256 + 2048);
              const bf16x8 vf = (bf16x8){lo[0], lo[1], lo[2], lo[3], hi[0], hi[1], hi[2], hi[3]};
              O[dt] = __builtin_amdgcn_mfma_f32_32x32x16_bf16(vf, pb1, O[dt], 0, 0, 0); }
        }
    }
}

__device__ __forceinline__ void gate_phase(const Args& a, LAS unsigned char* lds, int vcu, int wave, int lane, int tid) {
    LAS unsigned* lcnt = (LAS unsigned*)lds; LAS unsigned* gbase = lcnt + 32;
    const bf16* Qg = (const bf16*)(a.ws + WS_Q); const float* KM = (const float*)(a.ws + WS_KM);
    unsigned* CNT = (unsigned*)(a.ws + WS_CTL) + CW_CNT; unsigned* LIST = (unsigned*)(a.ws + WS_LIST);
    const int h2 = lane >> 5, kr = lane & 31;
#pragma unroll 1
    for (int ui = 0; ui < 4; ++ui) {
        const int unit = vcu * 4 + ui, bh = unit >> 5, qb = unit & 31, bb = bh >> 3, hh = bh & 7;
        const size_t rowbase = (size_t)bb * SEQ; const int tq = qb * 256 + 32 * wave + kr;
        if (tid < 32) lcnt[tid] = 0u;
        __syncthreads();
        const float* kmp = KM + ((size_t)(bb * 32 + kr) * 8 + hh) * 128 + 8 * h2;
        const bf16* qp = Qg + (rowbase + tq) * DM + hh * HD + 8 * h2;
        f32x16 acc;
#pragma unroll
        for (int r = 0; r < 16; ++r) acc[r] = 0.f;
#pragma unroll
        for (int s = 0; s < 8; ++s) {
            const f32x4 k0 = *(const GAS f32x4*)(kmp + 16 * s), k1 = *(const GAS f32x4*)(kmp + 16 * s + 4);
            const float kv[8] = {k0[0], k0[1], k0[2], k0[3], k1[0], k1[1], k1[2], k1[3]};
            unsigned hi[4], lo[4];
#pragma unroll
            for (int j = 0; j < 4; ++j) { const unsigned h0 = f2bf(kv[2 * j]), h1 = f2bf(kv[2 * j + 1]); hi[j] = h0 | (h1 << 16);
                lo[j] = pk2(kv[2 * j] - __builtin_bit_cast(float, h0 << 16), kv[2 * j + 1] - __builtin_bit_cast(float, h1 << 16)); }
            const bf16x8 ahi = __builtin_bit_cast(bf16x8, (v4u){hi[0], hi[1], hi[2], hi[3]}), alo = __builtin_bit_cast(bf16x8, (v4u){lo[0], lo[1], lo[2], lo[3]});
            const bf16x8 bq = *(const GAS bf16x8*)(qp + 16 * s);
            acc = __builtin_amdgcn_mfma_f32_32x32x16_bf16(ahi, bq, acc, 0, 0, 0); acc = __builtin_amdgcn_mfma_f32_32x32x16_bf16(alo, bq, acc, 0, 0, 0);
        }
        unsigned mask = 0u; int seln[3] = {0, 0, 0}; unsigned pos[3] = {0u, 0u, 0u};
#pragma unroll
        for (int r3 = 0; r3 < 3; ++r3) {
            if (r3 < qb) { float best = -3.0e38f; int bi = 64;
#pragma unroll
                for (int r = 0; r < 16; ++r) { const int blk = (r & 3) + 8 * (r >> 2) + 4 * h2; const bool ok = (blk < qb) && !((mask >> blk) & 1u) && (acc[r] > best); best = ok ? acc[r] : best; bi = ok ? blk : bi; }
                const float ob = __shfl_xor(best, 32); const int oi = __shfl_xor(bi, 32);
                const bool take = (ob > best) || (ob == best && oi < bi);
                bi = take ? oi : bi; bi &= 31;
                mask |= 1u << bi; seln[r3] = bi;
                if (h2 == 0) pos[r3] = __hip_atomic_fetch_add(lcnt + bi, 1u, __ATOMIC_RELAXED, __HIP_MEMORY_SCOPE_WORKGROUP); }
        }
        __syncthreads();
        if (tid < 32) { const unsigned c = lcnt[tid]; gbase[tid] = c ? atomicAdd(CNT + bh * 32 + tid, c) : 0u; }
        __syncthreads();
        if (h2 == 0) {
#pragma unroll
            for (int r3 = 0; r3 < 3; ++r3) if (r3 < qb) LIST[(size_t)bh * LIST_PER_BH + list_off(seln[r3]) + gbase[seln[r3]] + pos[r3]] = ((unsigned)tq << 2) | (unsigned)r3;
        }
        __syncthreads();
    }
}

__device__ __forceinline__ void sparse_phase(const Args& a, LAS unsigned char* lds, int G, int wave, int lane, int tid) {
    LAS unsigned* cntl = (LAS unsigned*)(lds + 131072 + 1024);
    LAS unsigned* pre = cntl + 1024;
    const bf16* Qg = (const bf16*)(a.ws + WS_Q); const bf16* Kg = (const bf16*)(a.ws + WS_K); const bf16* Vg = (const bf16*)(a.ws + WS_V);
    const unsigned* CNT = (const unsigned*)(a.ws + WS_CTL) + CW_CNT; const unsigned* LIST = (const unsigned*)(a.ws + WS_LIST);
    bf16* PART = (bf16*)(a.ws + WS_PART); float* LP = (float*)(a.ws + WS_LP);
    const int h2 = lane >> 5, kr = lane & 31;
    for (int i = tid; i < 1024; i += 512) cntl[i] = __hip_atomic_load(CNT + i, __ATOMIC_RELAXED, __HIP_MEMORY_SCOPE_AGENT);
    __syncthreads();
    if (wave == 0) {
        unsigned loc[16]; unsigned s = 0u;
#pragma unroll
        for (int j = 0; j < 16; ++j) { loc[j] = s; s += (cntl[16 * lane + j] + 255u) >> 8; }
        unsigned inc = s;
#pragma unroll
        for (int o = 1; o < 64; o <<= 1) { const unsigned t = __shfl_up(inc, o); if (lane >= o) inc += t; }
        const unsigned exc = inc - s;
#pragma unroll
        for (int j = 0; j < 16; ++j) pre[16 * lane + j] = exc + loc[j];
        if (lane == 63) pre[1024] = inc;
    }
    __syncthreads();
    const unsigned T = pre[1024];
    const unsigned lo = (unsigned)(((unsigned long long)blockIdx.x * T) / (unsigned)G), hi = (unsigned)(((unsigned long long)(blockIdx.x + 1) * T) / (unsigned)G);
    int li = 0;
    { int a0 = 0, b0 = 1024; while (b0 - a0 > 1) { const int m = (a0 + b0) >> 1; if (pre[m] <= lo) a0 = m; else b0 = m; } li = a0; }
    int cur = -1;
#pragma unroll 1
    for (unsigned tile = lo; tile < hi; ++tile) {
        while (tile >= pre[li + 1]) ++li;
        const int k = (int)(tile - pre[li]); const int cnt = (int)cntl[li];
        const int bh = li >> 5, nn = li & 31, bb = bh >> 3, hh = bh & 7; const size_t rowbase = (size_t)bb * SEQ;
        if (li != cur) {
            __syncthreads();
            load_kv_block(lds, Kg, Vg, rowbase + (size_t)nn * 256, hh, wave, lane);
            asm volatile("s_waitcnt vmcnt(0)" ::: "memory");
            __syncthreads();
            cur = li;
        }
        const int idx0 = 256 * k + 32 * wave;
        if (idx0 < cnt) {
            const bool valid = (idx0 + kr) < cnt;
            const unsigned e = valid ? LIST[(size_t)bh * LIST_PER_BH + list_off(nn) + idx0 + kr] : 0u;
            const int t = (int)(e >> 2), j = (int)(e & 3u);
            const bf16* qp = Qg + (rowbase + t) * DM + hh * HD + 8 * h2;
            bf16x8 qf[8];
#pragma unroll
            for (int s = 0; s < 8; ++s) qf[s] = *(const GAS bf16x8*)(qp + 16 * s);
            f32x16 O[4];
#pragma unroll
            for (int dt = 0; dt < 4; ++dt)
#pragma unroll
                for (int r = 0; r < 16; ++r) O[dt][r] = 0.f;
            float lsum = 0.f;
            attn_wave(lds, qf, O, lsum, 8, -1, lane);
            lsum += __shfl_xor(lsum, 32);
            if (valid) {
                const size_t ps = ((size_t)bh * SEQ + t) * 3 + j;
                bf16* pp = PART + ps * 128 + 4 * h2;
#pragma unroll
                for (int dt = 0; dt < 4; ++dt)
#pragma unroll
                    for (int rq = 0; rq < 4; ++rq) { unsigned long long w = (unsigned long long)cvtpk(O[dt][4 * rq], O[dt][4 * rq + 1]) | ((unsigned long long)cvtpk(O[dt][4 * rq + 2], O[dt][4 * rq + 3]) << 32);
                        *(GAS unsigned long long*)(pp + 32 * dt + 8 * rq) = w; }
                if (h2 == 0) LP[ps] = lsum;
            }
        }
    }
}

__device__ __forceinline__ void own_phase(const Args& a, LAS unsigned char* lds, int vcu, int wave, int lane, int tid) {
    bf16* Qg = (bf16*)(a.ws + WS_Q); const bf16* Kg = (const bf16*)(a.ws + WS_K); const bf16* Vg = (const bf16*)(a.ws + WS_V);
    const bf16* PART = (const bf16*)(a.ws + WS_PART); const float* LP = (const float*)(a.ws + WS_LP);
    const int h2 = lane >> 5, kr = lane & 31;
#pragma unroll 1
    for (int ui = 0; ui < 4; ++ui) {
        const int unit = vcu * 4 + ui, bh = unit >> 5, qb = unit & 31, bb = bh >> 3, hh = bh & 7;
        const size_t rowbase = (size_t)bb * SEQ; const int t = qb * 256 + 32 * wave + kr;
        __syncthreads();
        load_kv_block(lds, Kg, Vg, rowbase + (size_t)qb * 256, hh, wave, lane);
        bf16* qp = Qg + (rowbase + t) * DM + hh * HD;
        bf16x8 qf[8];
#pragma unroll
        for (int s = 0; s < 8; ++s) qf[s] = *(const GAS bf16x8*)(qp + 8 * h2 + 16 * s);
        asm volatile("s_waitcnt vmcnt(0)" ::: "memory");
        __syncthreads();
        f32x16 O[4];
#pragma unroll
        for (int dt = 0; dt < 4; ++dt)
#pragma unroll
            for (int r = 0; r < 16; ++r) O[dt][r] = 0.f;
        float lsum = 0.f;
        attn_wave(lds, qf, O, lsum, wave + 1, wave, lane);
        lsum += __shfl_xor(lsum, 32);
        const int nsel = qb < 3 ? qb : 3;
#pragma unroll 1
        for (int j = 0; j < nsel; ++j) {
            const size_t ps = ((size_t)bh * SEQ + t) * 3 + j;
            const bf16* pp = PART + ps * 128 + 4 * h2;
            lsum += LP[ps];
#pragma unroll
            for (int dt = 0; dt < 4; ++dt)
#pragma unroll
                for (int rq = 0; rq < 4; ++rq) { const unsigned long long w = *(const GAS unsigned long long*)(pp + 32 * dt + 8 * rq); const unsigned w0 = (unsigned)w, w1 = (unsigned)(w >> 32);
                    O[dt][4 * rq] += pg8::bflo(w0); O[dt][4 * rq + 1] += pg8::bfhi(w0); O[dt][4 * rq + 2] += pg8::bflo(w1); O[dt][4 * rq + 3] += pg8::bfhi(w1); }
        }
        const float inv = 1.0f / lsum;
#pragma unroll
        for (int dt = 0; dt < 4; ++dt)
#pragma unroll
            for (int rq = 0; rq < 4; ++rq) { unsigned long long w = (unsigned long long)cvtpk(O[dt][4 * rq] * inv, O[dt][4 * rq + 1] * inv) | ((unsigned long long)cvtpk(O[dt][4 * rq + 2] * inv, O[dt][4 * rq + 3] * inv) << 32);
                *(GAS unsigned long long*)(qp + 4 * h2 + 32 * dt + 8 * rq) = w; }
    }
}
__device__ __forceinline__ void fix_phase(const Args& a, int gtid, int NT) {
    const float* SB = (const float*)(a.ws + WS_SB); const float* SU0 = (const float*)(a.ws + WS_SU0); const float* SG0 = (const float*)(a.ws + WS_SG0);
    bf16* ACT = (bf16*)(a.ws + WS_ACT); const float* cw = a.in[I_FCW]; const float* cb = a.in[I_FCB];
    for (int e = gtid; e < 128 * 2 * DFF; e += NT) {
        const int col = e % DFF, r = (e / DFF) & 1, pm = e / (2 * DFF);
        const bool first = (pm & 31) == 0;
        const float up0 = SU0[((size_t)pm * 2 + r) * DFF + col], gt = SG0[((size_t)pm * 2 + r) * DFF + col];
        const float pl1 = first ? 0.f : SB[((size_t)(pm - (first ? 0 : 1)) * 2 + 1) * DFF + col], pl0 = first ? 0.f : SB[((size_t)(pm - (first ? 0 : 1)) * 2 + 0) * DFF + col];
        const float x1 = (r == 0) ? pl1 : SU0[((size_t)pm * 2 + 0) * DFF + col];
        const float x2 = (r == 0) ? pl0 : pl1;
        const float c = cb[col] + cw[2 * DFF + col] * up0 + cw[DFF + col] * x1 + cw[col] * x2;
        ACT[((size_t)pm * 256 + r) * DFF + col] = (bf16)f2bf(pg8::gelu_tanh(c) * gt);
    }
}

__global__ void __launch_bounds__(NWAVES * 64, 2) mk_fwd(Args args) {
    extern __shared__ __attribute__((aligned(16))) unsigned char lds_raw[];
    LAS unsigned char* lds = (LAS unsigned char*)lds_raw;
    volatile LAS unsigned* MISC = (volatile LAS unsigned*)(lds + MISC_OFF);
    const int tid = threadIdx.x, lane = tid & 63, wave = __builtin_amdgcn_readfirstlane(tid >> 6);
    const int G = gridDim.x; const int bx = blockIdx.x; const int vcu = (G % 8 == 0) ? (bx % 8) * (G / 8) + bx / 8 : bx;
    unsigned char* ws = args.ws;
    gu32* ctl = (gu32*)(ws + WS_CTL);
    for (int u = tid; u < (LDS_BYTES - 131072) / 4; u += NWAVES * 64) ((LAS unsigned*)(lds + 131072))[u] = 0u;
    __syncthreads();
    XcdBarrier bar; bar.bar = (unsigned*)(ctl + CW_BAR); bar.x = 0; bar.st = nullptr;
    if (MK_ONE_LAUNCH) bar = xcd_barrier_post((unsigned*)(ctl + CW_BAR), MISC + 8);
    const int lo = args.ph_lo, hi = args.ph_hi;
    const int tid0 = tid;
#ifndef PROBE_DUP
#define PROBE_DUP 0
#endif
#define LAUNDER() int tid = tid0; asm volatile("" : "+v"(tid)); const int lane = tid & 63; (void)lane
#ifndef PH_MASK
#define PH_MASK 0xffff
#endif
#define IN(k) (((PH_MASK >> (k)) & 1) && lo <= (k) && (k) < hi)
#define SEAM(k) do { if (IN(k) && IN((k) + 1)) xcd_barrier(bar); } while (0)
    const int gw = vcu * NWAVES + wave, NGW = G * NWAVES;
    bf16* XN = (bf16*)(ws + WS_XN); bf16* XR = (bf16*)(ws + WS_XR); bf16* GR = (bf16*)(ws + WS_GR);
    bf16* Qb = (bf16*)(ws + WS_Q); bf16* Kb = (bf16*)(ws + WS_K); bf16* Vb = (bf16*)(ws + WS_V);
    bf16* GA = (bf16*)args.out; bf16* GB = (bf16*)args.out + (size_t)M * DM;

    if (IN(0)) { LAUNDER(); p0_prologue(args, lds, gw, NGW, wave, lane); } SEAM(0);
    if (IN(1)) { LAUNDER(); pg8::Gemm g{XN, (const bf16*)(ws + WS_WIN), M, DIN, DM}; pg8::StaticOrder S; S.init(M, DIN, G, bx);
        pg8::EpiG1 E{XR, GR, Qb, Kb, Vb, GA, GB};
        pg8::gemm_phase<pg8::EpiG1, pg8::StaticOrder, true, true>(lds, g, S, E); } SEAM(1);
    if (IN(2)) { LAUNDER(); p1b_qknorm(args, lds, G, wave, lane, tid); } SEAM(2);
    if (IN(3)) { LAUNDER(); rnn_phase<false>(args, lds, G, wave, lane, tid); } SEAM(3);
    if (IN(4)) { LAUNDER(); rnn_phase<true>(args, lds, G, wave, lane, tid); } SEAM(4);
    if (IN(5)) { LAUNDER(); gate_phase(args, lds, vcu, wave, lane, tid); } SEAM(5);
    if (IN(6)) { LAUNDER(); sparse_phase(args, lds, G, wave, lane, tid); } SEAM(6);
    if (IN(7)) { LAUNDER(); own_phase(args, lds, vcu, wave, lane, tid); } SEAM(7);
    if (IN(8)) { LAUNDER(); pg8::Gemm g{XN  , (const bf16*)(ws + WS_PA), M, DM, DM}; pg8::StaticOrder S; S.init(M, DM, G, bx);
        pg8::EpiGate<false> E{GA, Kb  };
        pg8::gemm_phase<pg8::EpiGate<false>, pg8::StaticOrder, true, true>(lds, g, S, E); } SEAM(8);
    if (IN(9)) { LAUNDER(); pg8::Gemm g{Qb  , (const bf16*)(ws + WS_PB), M, DM, DM}; pg8::StaticOrder S; S.init(M, DM, G, bx);
        pg8::EpiGate<true> E{GB, Kb  };
        pg8::gemm_phase<pg8::EpiGate<true>, pg8::StaticOrder, true, true>(lds, g, S, E); } SEAM(9);
    if (IN(10)) { LAUNDER(); pg8::Gemm g{Kb  , (const bf16*)(ws + WS_WOUT), M, DM, DM}; pg8::StaticOrder S; S.init(M, DM, G, bx);
        pg8::EpiRes E{args.in[I_X], args.out};
        pg8::gemm_phase<pg8::EpiRes, pg8::StaticOrder, true, true>(lds, g, S, E); } SEAM(10);
    if (IN(11)) { LAUNDER(); for (int m = gw; m < M; m += NGW) rms_row_to_bf16(args.out + (size_t)m * DM, XN + (size_t)m * DM, lane); } SEAM(11);
    if (IN(12)) { LAUNDER(); pg8::Gemm g{XN  , (const bf16*)(ws + WS_WUG), M, 2 * DFF, DM}; pg8::StaticOrder S; S.init(M, 2 * DFF, G, bx);
        pg8::EpiUGF E{(bf16*)(ws + WS_ACT), args.in[I_FCW], args.in[I_FCB], (float*)(ws + WS_SB), (float*)(ws + WS_SU0), (float*)(ws + WS_SG0), (LAS float*)(lds + 131072 + 1024)};
        pg8::gemm_phase<pg8::EpiUGF, pg8::StaticOrder, true, true>(lds, g, S, E); } SEAM(12);
    if (IN(13)) { LAUNDER(); fix_phase(args, vcu * 512 + tid, G * 512); } SEAM(13);
    if (IN(14)) { LAUNDER(); pg8::Gemm g{(const bf16*)(ws + WS_ACT), (const bf16*)(ws + WS_WDN), M, DM, DFF}; pg8::StaticOrder S; S.init(M, DM, G, bx);
        pg8::EpiRes E{args.out, args.out};
        pg8::gemm_phase<pg8::EpiRes, pg8::StaticOrder, true, true>(lds, g, S, E); }
#undef IN
#undef SEAM
}

extern "C" void kernel_launch(void* const* d_in, const int* in_sizes, int n_in, void* d_out, int out_size, void* d_ws, size_t ws_size, hipStream_t stream) {
    static int grid = 0;
    if (grid == 0) {
        if (n_in != 21 || out_size != M * DM || ws_size < WS_END) { fprintf(stderr, "kernel_launch: unexpected shapes: n_in %d out %d ws %zu\n", n_in, out_size, ws_size); grid = -1; return; }
        int dev = 0, cus = 0;
        if (hipGetDevice(&dev) != hipSuccess || hipDeviceGetAttribute(&cus, hipDeviceAttributeMultiprocessorCount, dev) != hipSuccess) { grid = -1; return; }
        if (hipFuncSetAttribute((const void*)mk_fwd, hipFuncAttributeMaxDynamicSharedMemorySize, LDS_BYTES) != hipSuccess) { fprintf(stderr, "kernel_launch: hipFuncSetAttribute failed\n"); grid = -1; return; }
        int per_cu = 0;
        if (hipOccupancyMaxActiveBlocksPerMultiprocessor(&per_cu, (const void*)mk_fwd, NWAVES * 64, LDS_BYTES) != hipSuccess || per_cu < 1) fprintf(stderr, "kernel_launch: occupancy query says %d\n", per_cu);
        (void)hipGetLastError();
        grid = cus;
    }
    if (grid < 0) return;
    (void)hipMemsetAsync((char*)d_ws + WS_CTL, 0, CTL_ZERO_BYTES, stream);
    Args a{};
    for (int i = 0; i < 21; ++i) a.in[i] = (const float*)d_in[i];
    a.out = (float*)d_out; a.ws = (unsigned char*)d_ws;
#if MK_ONE_LAUNCH
    a.ph_lo = 0; a.ph_hi = NPHASE; a.li = 0;
    hipLaunchKernelGGL(mk_fwd, dim3(grid), dim3(NWAVES * 64), LDS_BYTES, stream, a);
#else
    for (int p = 0; p < NPHASE; ++p) { a.ph_lo = p; a.ph_hi = p + 1; a.li = p; const int reps = ((PROBE_DUP >> p) & 1) ? 2 : 1;
        for (int r = 0; r < reps; ++r) hipLaunchKernelGGL(mk_fwd, dim3(grid), dim3(NWAVES * 64), LDS_BYTES, stream, a); }
#endif
}
```

```cpp
#include <hip/hip_runtime.h>
#include <cstdio>
#include <cstdint>
namespace pg8 {
#define PG8_LAS __attribute__((address_space(3)))
typedef unsigned short bf16_t;
typedef short bf16x8 __attribute__((ext_vector_type(8)));
typedef float f32x4 __attribute__((ext_vector_type(4)));
typedef unsigned u32x4 __attribute__((ext_vector_type(4)));
constexpr int BM = 256, BK = 64, HALF = 128, HTB = HALF * BK * 2  , STAGE_BYTES = 8 * HTB, NXCD = 8, WGM = 8;

__host__ __device__ __forceinline__ int lds_byte(int r, int c) { const int st = (r >> 4) * 2 + (c >> 5), rr = r & 15, cc = c & 31, ob = rr * 64 + cc * 2; return st * 1024 + (ob ^ (((ob >> 9) & 1) << 5)); }
__host__ __device__ __forceinline__ void stage_rc(int b, int& R, int& C) { const int st = b / 1024, sb = b % 1024, swz = sb ^ (((sb >> 9) & 1) << 5); R = (st >> 1) * 16 + swz / 64; C = (st & 1) * 32 + (swz % 64) / 2; }
__host__ __device__ __forceinline__ int perm32(int rho) { const int n = rho >> 4, i = rho & 15; return 8 * (i >> 2) + 4 * n + (i & 3); }

struct Unit { int pm, pn, half; };
struct Gemm { const bf16_t* A; const bf16_t* Bt; int M, N, K; const bf16_t* A2; const bf16_t* Bt2; };

struct StaticOrder {
    int nM, nN, nwg, G, c;
    __host__ __device__ void init(int M, int N, int G_, int c_) { nM = M / BM; nN = N / BM; nwg = nM * nN; G = G_; c = c_; }
    __host__ __device__ bool next(int i, Unit& u) const {
        const long L = (long)i * G + c; if (L >= nwg) return false;
        int wgid = (int)L; { const int q = nwg / NXCD, r = nwg % NXCD, xcd = wgid % NXCD, off = wgid / NXCD; wgid = (xcd < r ? xcd * (q + 1) : r * (q + 1) + (xcd - r) * q) + off; }
        const int nig = WGM * nN, gid = wgid / nig, fm = gid * WGM, gsz = (nM - fm) < WGM ? (nM - fm) : WGM;
        u.pm = fm + ((wgid % nig) % gsz); u.pn = (wgid % nig) / gsz; u.half = 0; return true;
    }
    __device__ __forceinline__ void a_ready(const Unit&) const {}
    __device__ __forceinline__ void done(const Unit&) const {}
};
struct DualOrder {
    StaticOrder so; int G, c;
    __host__ __device__ void init(int M, int N, int G_, int c_) { so.init(M, N, 1, 0); G = G_; c = c_; }
    __host__ __device__ bool next(int i, Unit& u) const { StaticOrder t = so; t.G = G; t.c = c; if (!t.next(i >> 1, u)) return false; u.half = i & 1; return true; }
    __device__ __forceinline__ void a_ready(const Unit&) const {}
    __device__ __forceinline__ void done(const Unit&) const {}
};
__device__ __forceinline__ unsigned cvt_pk_bf16(float lo, float hi) { unsigned r; asm volatile("v_cvt_pk_bf16_f32 %0, %1, %2" : "=v"(r) : "v"(lo), "v"(hi)); return r; }
typedef float f32x2 __attribute__((ext_vector_type(2)));
__device__ __forceinline__ float bf2f(unsigned short h) { return __builtin_bit_cast(float, (unsigned)h << 16); }
__device__ __forceinline__ float bflo(unsigned w) { return __builtin_bit_cast(float, w << 16); }
__device__ __forceinline__ float bfhi(unsigned w) { return __builtin_bit_cast(float, w & 0xffff0000u); }
__device__ __forceinline__ float fast_sigmoid(float x) { return __builtin_amdgcn_rcpf(1.0f + __builtin_amdgcn_exp2f(-1.4426950408889634f * x)); }
__device__ __forceinline__ float gelu_tanh(float x) { const float z = 0.7978845608028654f * (x + 0.044715f * x * x * x); return x * fast_sigmoid(2.0f * z); }

struct EpiG1 {
    static constexpr bool PERM = true, AFTER_DRAIN = false, DUAL = false;
    bf16_t *o0, *o1, *o2, *o3, *o4, *o5, *o6; const float* qg; const float* kg; float* km; PG8_LAS float* px; float qscale;
    __device__ __forceinline__ void operator()(f32x4 (&acc)[2][2][4][2], const Unit& u, int wr, int wc, int fr, int fq) const {
        const int seg = u.pn >> 2;
        bf16_t* base = seg == 0 ? o0 : seg == 1 ? o1 : seg == 2 ? o2 : seg == 3 ? o3 : seg == 4 ? o4 : seg == 5 ? o5 : o6;
        const int row0 = u.pm * BM + wr * 64 + fr, col0 = (u.pn & 3) * BM + wc * 32 + 8 * fq;
        if (seg == 2 || seg == 3) {
            float rs[2][4][2];
#pragma unroll
            for (int ai = 0; ai < 2; ++ai)
#pragma unroll
                for (int m = 0; m < 4; ++m)
#pragma unroll
                    for (int bj = 0; bj < 2; ++bj) { const f32x4 a0 = acc[ai][bj][m][0], a1 = acc[ai][bj][m][1];
                        float ss = (a0[0] * a0[0] + a0[1] * a0[1]) + (a0[2] * a0[2] + a0[3] * a0[3]) + (a1[0] * a1[0] + a1[1] * a1[1]) + (a1[2] * a1[2] + a1[3] * a1[3]);
                        ss += __shfl_xor(ss, 16); ss += __shfl_xor(ss, 32);
                        if (fq == 0) px[(ai * HALF + wr * 64 + m * 16 + fr) * 8 + bj * 4 + wc] = ss; }
            asm volatile("s_waitcnt lgkmcnt(0)" ::: "memory"); __builtin_amdgcn_s_barrier(); asm volatile("" ::: "memory");
#pragma unroll
            for (int ai = 0; ai < 2; ++ai)
#pragma unroll
                for (int m = 0; m < 4; ++m)
#pragma unroll
                    for (int bj = 0; bj < 2; ++bj) { const f32x4 p = *(const PG8_LAS f32x4*)(px + (ai * HALF + wr * 64 + m * 16 + fr) * 8 + bj * 4);
                        rs[ai][m][bj] = 1.0f / sqrtf(((p[0] + p[1]) + (p[2] + p[3])) * (1.0f / 128.0f) + 1e-6f); }
            const float* gp = (seg == 2 ? qg : kg) + wc * 32 + 8 * fq; const float gs = (seg == 2) ? qscale : 1.0f;
            const f32x4 g0 = *(const f32x4*)gp * gs, g1 = *(const f32x4*)(gp + 4) * gs;
            f32x4 cs[2][2];
#pragma unroll
            for (int bj = 0; bj < 2; ++bj) { cs[bj][0] = (f32x4){0.f, 0.f, 0.f, 0.f}; cs[bj][1] = (f32x4){0.f, 0.f, 0.f, 0.f}; }
#pragma unroll
            for (int ai = 0; ai < 2; ++ai)
#pragma unroll
                for (int m = 0; m < 4; ++m) { bf16_t* rowp = base + (size_t)(row0 + ai * HALF + m * 16) * 1024 + col0;
#pragma unroll
                    for (int bj = 0; bj < 2; ++bj) { const f32x4 v0 = acc[ai][bj][m][0] * rs[ai][m][bj] * g0, v1 = acc[ai][bj][m][1] * rs[ai][m][bj] * g1;
                        cs[bj][0] += v0; cs[bj][1] += v1;
                        u32x4 w; w.x = cvt_pk_bf16(v0[0], v0[1]); w.y = cvt_pk_bf16(v0[2], v0[3]); w.z = cvt_pk_bf16(v1[0], v1[1]); w.w = cvt_pk_bf16(v1[2], v1[3]);
                        *(u32x4*)(rowp + bj * HALF) = w; } }
            if (seg == 3) {
#pragma unroll
                for (int bj = 0; bj < 2; ++bj)
#pragma unroll
                    for (int n = 0; n < 2; ++n)
#pragma unroll
                        for (int j = 0; j < 4; ++j) { float c = cs[bj][n][j]; c += __shfl_xor(c, 1); c += __shfl_xor(c, 2); c += __shfl_xor(c, 4); c += __shfl_xor(c, 8);
                            if (fr == 0) atomicAdd(km + ((size_t)u.pm * 8 + 2 * (u.pn & 3) + bj) * 128 + wc * 32 + 8 * fq + 4 * n + j, c * (1.0f / 256.0f)); }
            }
            return;
        }
#pragma unroll
        for (int ai = 0; ai < 2; ++ai)
#pragma unroll
            for (int m = 0; m < 4; ++m) { bf16_t* rowp = base + (size_t)(row0 + ai * HALF + m * 16) * 1024 + col0;
#pragma unroll
                for (int bj = 0; bj < 2; ++bj) { f32x4 v0 = acc[ai][bj][m][0], v1 = acc[ai][bj][m][1];
                    if (seg == 1) {
#pragma unroll
                        for (int j = 0; j < 4; ++j) { v0[j] = gelu_tanh(v0[j]); v1[j] = gelu_tanh(v1[j]); }
                    } else if (seg >= 5) {
#pragma unroll
                        for (int j = 0; j < 4; ++j) { v0[j] = fast_sigmoid(v0[j]); v1[j] = fast_sigmoid(v1[j]); }
                    }
                    u32x4 w; w.x = cvt_pk_bf16(v0[0], v0[1]); w.y = cvt_pk_bf16(v0[2], v0[3]); w.z = cvt_pk_bf16(v1[0], v1[1]); w.w = cvt_pk_bf16(v1[2], v1[3]);
                    *(u32x4*)(rowp + bj * HALF) = w; } }
    }
};
struct EpiG3 {
    static constexpr bool PERM = true, AFTER_DRAIN = false, DUAL = true;
    const bf16_t* ga; const bf16_t* gb; bf16_t* out;
    __device__ __forceinline__ void mid(f32x4 (&acc)[2][2][4][2], const Unit& u, int wr, int wc, int fr, int fq) const {
        const int row0 = u.pm * BM + wr * 64 + fr, col0 = u.pn * BM + wc * 32 + 8 * fq;
#pragma unroll
        for (int ai = 0; ai < 2; ++ai) {
            u32x4 wa[4][2], wb[4][2];
#pragma unroll
            for (int m = 0; m < 4; ++m)
#pragma unroll
                for (int bj = 0; bj < 2; ++bj) { const size_t off = (size_t)(row0 + ai * HALF + m * 16) * 1024 + col0 + bj * HALF; wa[m][bj] = *(const u32x4*)(ga + off); wb[m][bj] = *(const u32x4*)(gb + off); }
#pragma unroll
            for (int m = 0; m < 4; ++m)
#pragma unroll
                for (int bj = 0; bj < 2; ++bj) { const u32x4 a = wa[m][bj], b = wb[m][bj];
                    acc[ai][bj][m][0] *= (f32x4){bflo(a.x) * __builtin_amdgcn_rcpf(bflo(b.x)), bfhi(a.x) * __builtin_amdgcn_rcpf(bfhi(b.x)), bflo(a.y) * __builtin_amdgcn_rcpf(bflo(b.y)), bfhi(a.y) * __builtin_amdgcn_rcpf(bfhi(b.y))};
                    acc[ai][bj][m][1] *= (f32x4){bflo(a.z) * __builtin_amdgcn_rcpf(bflo(b.z)), bfhi(a.z) * __builtin_amdgcn_rcpf(bfhi(b.z)), bflo(a.w) * __builtin_amdgcn_rcpf(bflo(b.w)), bfhi(a.w) * __builtin_amdgcn_rcpf(bfhi(b.w))}; }
        }
    }
    __device__ __forceinline__ void operator()(f32x4 (&acc)[2][2][4][2], const Unit& u, int wr, int wc, int fr, int fq) const {
        const int row0 = u.pm * BM + wr * 64 + fr, col0 = u.pn * BM + wc * 32 + 8 * fq;
        u32x4 wb[2][4][2];
#pragma unroll
        for (int ai = 0; ai < 2; ++ai)
#pragma unroll
            for (int m = 0; m < 4; ++m)
#pragma unroll
                for (int bj = 0; bj < 2; ++bj) wb[ai][m][bj] = *(const u32x4*)(gb + (size_t)(row0 + ai * HALF + m * 16) * 1024 + col0 + bj * HALF);
        asm volatile("" ::: "memory");
#pragma unroll
        for (int ai = 0; ai < 2; ++ai)
#pragma unroll
            for (int m = 0; m < 4; ++m)
#pragma unroll
                for (int bj = 0; bj < 2; ++bj) { const u32x4 b = wb[ai][m][bj]; const f32x4 v0 = acc[ai][bj][m][0], v1 = acc[ai][bj][m][1];
                    u32x4 w; w.x = cvt_pk_bf16(v0[0] * bflo(b.x), v0[1] * bfhi(b.x)); w.y = cvt_pk_bf16(v0[2] * bflo(b.y), v0[3] * bfhi(b.y)); w.z = cvt_pk_bf16(v1[0] * bflo(b.z), v1[1] * bfhi(b.z)); w.w = cvt_pk_bf16(v1[2] * bflo(b.w), v1[3] * bfhi(b.w));
                    *(u32x4*)(out + (size_t)(row0 + ai * HALF + m * 16) * 1024 + col0 + bj * HALF) = w; }
    }
};
template <class T> __device__ __forceinline__ T* at_byte(T* base, unsigned byteoff) { return (T*)((char*)base + byteoff); }
template <bool STATS> struct EpiRes {
    static constexpr bool PERM = true, AFTER_DRAIN = false, DUAL = false;
    const float* base; float* out; bf16_t* xb; float* rsp; PG8_LAS float* px;
    __device__ __forceinline__ void operator()(f32x4 (&acc)[2][2][4][2], const Unit& u, int wr, int wc, int fr, int fq) const {
        const unsigned e0 = (unsigned)(u.pm * BM + wr * 64 + fr) * 1024u + (unsigned)(u.pn * BM + wc * 32 + 8 * fq);
#pragma unroll
        for (int ai = 0; ai < 2; ++ai) {
#pragma unroll
            for (int mh = 0; mh < 2; ++mh) {
                f32x4 b[2][2][2];
#pragma unroll
                for (int m2 = 0; m2 < 2; ++m2)
#pragma unroll
                    for (int bj = 0; bj < 2; ++bj) { const float* p = at_byte(base, (e0 + (unsigned)((ai * HALF + (2 * mh + m2) * 16) * 1024 + bj * HALF)) * 4u); b[m2][bj][0] = *(const f32x4*)p; b[m2][bj][1] = *(const f32x4*)(p + 4); }
#pragma unroll
                for (int m2 = 0; m2 < 2; ++m2)
#pragma unroll
                    for (int bj = 0; bj < 2; ++bj) { acc[ai][bj][2 * mh + m2][0] += b[m2][bj][0]; acc[ai][bj][2 * mh + m2][1] += b[m2][bj][1]; }
                asm volatile("" ::: "memory");
            }
            if (STATS) {
#pragma unroll
                for (int m = 0; m < 4; ++m) { float ss = 0.f;
#pragma unroll
                    for (int bj = 0; bj < 2; ++bj)
#pragma unroll
                        for (int n = 0; n < 2; ++n) { const f32x4 v = acc[ai][bj][m][n]; ss += (v[0] * v[0] + v[1] * v[1]) + (v[2] * v[2] + v[3] * v[3]); }
                    ss += __shfl_xor(ss, 16); ss += __shfl_xor(ss, 32);
                    if (fq == 0) px[(ai * HALF + wr * 64 + m * 16 + fr) * 4 + wc] = ss; }
            }
#pragma unroll
            for (int m = 0; m < 4; ++m)
#pragma unroll
                for (int bj = 0; bj < 2; ++bj) { const unsigned eo = e0 + (unsigned)((ai * HALF + m * 16) * 1024 + bj * HALF); const f32x4 v0 = acc[ai][bj][m][0], v1 = acc[ai][bj][m][1];
                    float* po = at_byte(out, eo * 4u); *(f32x4*)po = v0; *(f32x4*)(po + 4) = v1;
                    if (STATS) { u32x4 w; w.x = cvt_pk_bf16(v0[0], v0[1]); w.y = cvt_pk_bf16(v0[2], v0[3]); w.z = cvt_pk_bf16(v1[0], v1[1]); w.w = cvt_pk_bf16(v1[2], v1[3]); *(u32x4*)at_byte(xb, eo * 2u) = w; } }
            asm volatile("" ::: "memory");
        }
        if (STATS) {
            asm volatile("s_waitcnt lgkmcnt(0)" ::: "memory"); __builtin_amdgcn_s_barrier(); asm volatile("" ::: "memory");
            const int t = (int)threadIdx.x;
            if (t < 256) { const f32x4 p = *(const PG8_LAS f32x4*)(px + t * 4); rsp[((size_t)u.pm * BM + t) * 4 + u.pn] = (p[0] + p[1]) + (p[2] + p[3]); }
        }
    }
};
template <int CTRL> __device__ __forceinline__ float dpp_mov(float old, float src) { return __builtin_bit_cast(float, __builtin_amdgcn_update_dpp(__builtin_bit_cast(int, old), __builtin_bit_cast(int, src), CTRL, 0xf, 0xf, false)); }
struct EpiUGF {
    static constexpr bool PERM = true, AFTER_DRAIN = false, DUAL = false;
    bf16_t* act; const float* cw; const float* cb; float* sb_last; float* su0; float* sg0; PG8_LAS float* halo; const float* rsp; int variant;
    __device__ __forceinline__ void operator()(f32x4 (&acc)[2][2][4][2], const Unit& u, int wr, int wc, int fr, int fq) const {
        const int colh = wc * 32 + 8 * fq, gcol = u.pn * HALF + colh;
        if (variant == 1) {
#pragma unroll
            for (int ai = 0; ai < 2; ++ai)
#pragma unroll
                for (int bj = 0; bj < 2; ++bj)
#pragma unroll
                    for (int m = 0; m < 4; ++m)
#pragma unroll
                        for (int n = 0; n < 2; ++n) asm volatile("" :: "v"(acc[ai][bj][m][n]));
            return; }
        {
            f32x4 rp[2][4];
#pragma unroll
            for (int ai = 0; ai < 2; ++ai)
#pragma unroll
                for (int m = 0; m < 4; ++m) rp[ai][m] = *(const f32x4*)at_byte(rsp, (unsigned)(u.pm * BM + ai * HALF + wr * 64 + m * 16 + fr) * 16u);
            { const int t = (int)threadIdx.x, r4 = t >> 7, c = t & 127;
              halo[1024 + t] = (r4 < 3) ? cw[r4 * 2816 + u.pn * HALF + c] : cb[u.pn * HALF + c]; }
#pragma unroll
            for (int ai = 0; ai < 2; ++ai)
#pragma unroll
                for (int m = 0; m < 4; ++m) { const f32x4 p = rp[ai][m]; const float rstd = 1.0f / sqrtf(((p[0] + p[1]) + (p[2] + p[3])) * (1.0f / 1024.0f) + 1e-6f);
#pragma unroll
                    for (int bj = 0; bj < 2; ++bj) { acc[ai][bj][m][0] *= rstd; acc[ai][bj][m][1] *= rstd; } }
        }
        asm volatile("" ::: "memory");
        if (fr >= 14) {
#pragma unroll
            for (int ai = 0; ai < 2; ++ai)
#pragma unroll
                for (int n = 0; n < 2; ++n) *(PG8_LAS f32x4*)(halo + ((2 * ai + wr) * 2 + (fr - 14)) * 128 + colh + 4 * n) = acc[ai][0][3][n];
            if (wr == 1) {
#pragma unroll
                for (int n = 0; n < 2; ++n) *(f32x4*)(sb_last + ((size_t)u.pm * 2 + (fr - 14)) * 2816 + gcol + 4 * n) = acc[1][0][3][n];
            }
        }
        asm volatile("s_waitcnt lgkmcnt(0)" ::: "memory"); __builtin_amdgcn_s_barrier(); asm volatile("" ::: "memory");
#pragma unroll
        for (int ai = 0; ai < 2; ++ai) {
            const int seg = 2 * ai + wr;
            f32x4 prev[2];
#pragma unroll
            for (int n = 0; n < 2; ++n) prev[n] = *(const PG8_LAS f32x4*)(halo + (((seg > 0 ? seg - 1 : 0)) * 2 + (fr & 1)) * 128 + colh + 4 * n);
#pragma unroll
            for (int m = 0; m < 4; ++m) {
                float r[8];
#pragma unroll
                for (int n = 0; n < 2; ++n) { const f32x4 cur = acc[ai][0][m][n], gt = acc[ai][1][m][n];
                    const f32x4 w0 = *(const PG8_LAS f32x4*)(halo + 1024 + colh + 4 * n), w1 = *(const PG8_LAS f32x4*)(halo + 1024 + 128 + colh + 4 * n), w2 = *(const PG8_LAS f32x4*)(halo + 1024 + 256 + colh + 4 * n), bb = *(const PG8_LAS f32x4*)(halo + 1024 + 384 + colh + 4 * n);
#pragma unroll
                    for (int j = 0; j < 4; ++j) {
                        const float t1 = dpp_mov<0x121>(prev[n][j], prev[n][j]), v1 = dpp_mov<0x111>(t1, cur[j]);
                        const float t2 = dpp_mov<0x122>(prev[n][j], prev[n][j]), v2 = dpp_mov<0x112>(t2, cur[j]);
                        const float c = bb[j] + w2[j] * cur[j] + w1[j] * v1 + w0[j] * v2;
                        r[4 * n + j] = gelu_tanh(c) * gt[j]; }
                    prev[n] = cur; }
                const unsigned row = (unsigned)(u.pm * BM + ai * HALF + wr * 64 + m * 16 + fr);
                const bool head = (seg == 0) && (m == 0) && (fr < 2);
                if (!head) { u32x4 w; w.x = cvt_pk_bf16(r[0], r[1]); w.y = cvt_pk_bf16(r[2], r[3]); w.z = cvt_pk_bf16(r[4], r[5]); w.w = cvt_pk_bf16(r[6], r[7]);
                    if (variant == 2) asm volatile("" :: "v"(w)); else *(u32x4*)at_byte(act, (row * 2816u + (unsigned)gcol) * 2u) = w; }
                else {
#pragma unroll
                    for (int n = 0; n < 2; ++n) { *(f32x4*)(su0 + ((size_t)u.pm * 2 + fr) * 2816 + gcol + 4 * n) = acc[0][0][0][n]; *(f32x4*)(sg0 + ((size_t)u.pm * 2 + fr) * 2816 + gcol + 4 * n) = acc[0][1][0][n]; }
                }
            }
        }
    }
};
template <class Epi, class Sched, bool ALIGN_EPI = false, bool SP2 = false>
__device__ __forceinline__ void gemm_phase(PG8_LAS unsigned char* lds, const Gemm g, const Sched& S, const Epi& E) {
    const int tid = threadIdx.x, wid = __builtin_amdgcn_readfirstlane(tid >> 6), lane = tid & 63, wr = wid >> 2, wc = wid & 3, fr = lane & 15, fq = lane >> 4;
    const int K = g.K, nt = K / BK;
    unsigned voffA[2], voffB[2];
#pragma unroll
    for (int i = 0; i < 2; ++i) { int R, C; stage_rc(tid * 16 + i * 8192, R, C); const int Rb = Epi::PERM ? ((R & ~31) + perm32(R & 31)) : R;
        voffA[i] = (unsigned)(R * K + C) * 2u; voffB[i] = (unsigned)(Rb * K + C) * 2u; }
    const size_t kstep = (size_t)(BK * 2);
    const size_t hstep = (size_t)HALF * K * 2;
    const size_t tstep = 2 * hstep;
    const unsigned ldsw = (unsigned)wid * 1024u;
    const int aoff = lds_byte(wr * 64 + fr, fq * 8), boff = lds_byte(wc * 32 + fr, fq * 8);
#define PG8_SA(b, h) (((b) * 2 + (h)) * HTB)
#define PG8_SB(b, h) ((4 + (b) * 2 + (h)) * HTB)
#define PG8_STAGE(bufoff, gbase, voff) do { _Pragma("unroll") for (int _i = 0; _i < 2; ++_i) \
        __builtin_amdgcn_global_load_lds((const unsigned*)((const char*)(gbase) + (voff)[_i]), (PG8_LAS unsigned*)(lds + (bufoff) + ldsw + _i * 8192), 16, 0, 0); } while (0)
#define PG8_LDA(dst, b, h) do { _Pragma("unroll") for (int m = 0; m < 4; ++m) _Pragma("unroll") for (int k = 0; k < 2; ++k) dst[m][k] = *(const PG8_LAS bf16x8*)(lds + PG8_SA(b, h) + aoff + m * 2048 + k * 1024); } while (0)
#define PG8_LDB(dst, b, h) do { _Pragma("unroll") for (int n = 0; n < 2; ++n) _Pragma("unroll") for (int k = 0; k < 2; ++k) dst[n][k] = *(const PG8_LAS bf16x8*)(lds + PG8_SB(b, h) + boff + n * 2048 + k * 1024); } while (0)
#define PG8_MMA(ai, bj, At, Bt) do { __builtin_amdgcn_s_setprio(1); _Pragma("unroll") for (int m = 0; m < 4; ++m) _Pragma("unroll") for (int n = 0; n < 2; ++n) _Pragma("unroll") for (int k = 0; k < 2; ++k) \
        acc[ai][bj][m][n] = __builtin_amdgcn_mfma_f32_16x16x32_bf16(Bt[n][k], At[m][k], acc[ai][bj][m][n], 0, 0, 0); __builtin_amdgcn_s_setprio(0); } while (0)
#define PG8_WAIT_V(n) asm volatile("s_waitcnt vmcnt(" #n ")" ::: "memory")
#define PG8_WAIT_L(n) asm volatile("s_waitcnt lgkmcnt(" #n ")" ::: "memory")
#define PG8_BAR __builtin_amdgcn_s_barrier()
#define PG8_SCHED __builtin_amdgcn_sched_barrier(0)
    Unit cur, nxt; int ui = 0;
    if (!S.next(0, cur)) return;
    f32x4 acc[2][2][4][2];
#pragma unroll
    for (int a = 0; a < 2; ++a)
#pragma unroll
        for (int b = 0; b < 2; ++b)
#pragma unroll
            for (int m = 0; m < 4; ++m)
#pragma unroll
                for (int n = 0; n < 2; ++n) acc[a][b][m][n] = (f32x4){0.f, 0.f, 0.f, 0.f};
    bf16x8 At[4][2], B0[2][2], B1[2][2];
    const char* cA = (const char*)(cur.half ? g.A2 : g.A) + (size_t)cur.pm * tstep; const char* cB = (const char*)(cur.half ? g.Bt2 : g.Bt) + (size_t)cur.pn * tstep;
    S.a_ready(cur);
    if constexpr (SP2) {
        PG8_STAGE(PG8_SB(0, 0), cB, voffB); PG8_STAGE(PG8_SB(0, 1), cB + hstep, voffB); PG8_STAGE(PG8_SA(0, 0), cA, voffA); PG8_STAGE(PG8_SA(0, 1), cA + hstep, voffA);
        if (wr == 1) PG8_BAR;
        PG8_WAIT_V(2); PG8_BAR;
        PG8_STAGE(PG8_SB(1, 0), cB + kstep, voffB); PG8_STAGE(PG8_SA(1, 0), cA + kstep, voffA); PG8_STAGE(PG8_SB(1, 1), cB + hstep + kstep, voffB);
        PG8_WAIT_V(6); PG8_BAR;
    } else {
        PG8_STAGE(PG8_SB(0, 0), cB, voffB); PG8_STAGE(PG8_SA(0, 0), cA, voffA); PG8_STAGE(PG8_SB(0, 1), cB + hstep, voffB); PG8_STAGE(PG8_SA(0, 1), cA + hstep, voffA);
        if (wr == 1) PG8_BAR;
        PG8_WAIT_V(4); PG8_BAR;
        PG8_STAGE(PG8_SB(1, 0), cB + kstep, voffB); PG8_STAGE(PG8_SA(1, 0), cA + kstep, voffA); PG8_STAGE(PG8_SB(1, 1), cB + hstep + kstep, voffB);
        PG8_WAIT_V(6); PG8_BAR;
    }
    for (;;) {
        const bool has_next = S.next(ui + 1, nxt);
        const char* nA = has_next ? (const char*)(nxt.half ? g.A2 : g.A) + (size_t)nxt.pm * tstep : cA; const char* nB = has_next ? (const char*)(nxt.half ? g.Bt2 : g.Bt) + (size_t)nxt.pn * tstep : cB;
        for (int t = 0; t < nt; t += 2) {
            const bool last = (t == nt - 2);
            const char* a1 = cA + (size_t)(t + 1) * kstep;
            const char* a2 = last ? nA : cA + (size_t)(t + 2) * kstep; const char* b2 = last ? nB : cB + (size_t)(t + 2) * kstep;
            const char* a3 = a2 + kstep; const char* b3 = b2 + kstep;
            if (last && has_next) S.a_ready(nxt);
            if constexpr (SP2) {
            PG8_LDB(B0, 0, 0); PG8_LDB(B1, 0, 1); PG8_SCHED; PG8_LDA(At, 0, 0); PG8_STAGE(PG8_SA(1, 1), a1 + hstep, voffA);
            PG8_WAIT_V(8); PG8_WAIT_L(0); PG8_BAR; PG8_MMA(0, 0, At, B0); PG8_MMA(0, 1, At, B1); PG8_BAR; PG8_SCHED;
            PG8_LDA(At, 0, 1); PG8_STAGE(PG8_SB(0, 0), b2, voffB); PG8_STAGE(PG8_SB(0, 1), b2 + hstep, voffB); PG8_STAGE(PG8_SA(0, 0), a2, voffA);
            PG8_WAIT_V(8); PG8_WAIT_L(0); PG8_BAR; PG8_MMA(1, 0, At, B0); PG8_MMA(1, 1, At, B1); PG8_BAR; PG8_SCHED;
            PG8_LDB(B0, 1, 0); PG8_LDB(B1, 1, 1); PG8_SCHED; PG8_LDA(At, 1, 0); PG8_STAGE(PG8_SA(0, 1), a2 + hstep, voffA);
            PG8_WAIT_V(8); PG8_WAIT_L(0); PG8_BAR; PG8_MMA(0, 0, At, B0); PG8_MMA(0, 1, At, B1); PG8_BAR; PG8_SCHED;
            PG8_LDA(At, 1, 1); PG8_STAGE(PG8_SB(1, 0), b3, voffB); PG8_STAGE(PG8_SB(1, 1), b3 + hstep, voffB); PG8_STAGE(PG8_SA(1, 0), a3, voffA);
            PG8_WAIT_V(8); PG8_WAIT_L(0); PG8_BAR; PG8_MMA(1, 0, At, B0); PG8_MMA(1, 1, At, B1); PG8_BAR; PG8_SCHED;
            } else {
            PG8_LDB(B0, 0, 0); PG8_SCHED; PG8_LDA(At, 0, 0); PG8_STAGE(PG8_SA(1, 1), a1 + hstep, voffA);
            PG8_WAIT_L(8); PG8_BAR; PG8_WAIT_L(0); PG8_MMA(0, 0, At, B0); PG8_BAR; PG8_SCHED;
            PG8_LDB(B1, 0, 1); PG8_STAGE(PG8_SB(0, 0), b2, voffB);
            PG8_BAR; PG8_WAIT_L(0); PG8_MMA(0, 1, At, B1); PG8_BAR;
            PG8_LDA(At, 0, 1); PG8_STAGE(PG8_SA(0, 0), a2, voffA);
            PG8_BAR; PG8_WAIT_L(0); PG8_MMA(1, 0, At, B0); PG8_BAR; PG8_SCHED;
            PG8_STAGE(PG8_SB(0, 1), b2 + hstep, voffB);
            PG8_WAIT_V(6); PG8_BAR; PG8_MMA(1, 1, At, B1); PG8_BAR;
            PG8_LDB(B0, 1, 0); PG8_SCHED; PG8_LDA(At, 1, 0); PG8_STAGE(PG8_SA(0, 1), a2 + hstep, voffA);
            PG8_WAIT_L(8); PG8_BAR; PG8_WAIT_L(0); PG8_MMA(0, 0, At, B0); PG8_BAR; PG8_SCHED;
            PG8_LDB(B1, 1, 1); PG8_STAGE(PG8_SB(1, 0), b3, voffB);
            PG8_BAR; PG8_WAIT_L(0); PG8_MMA(0, 1, At, B1); PG8_BAR;
            PG8_LDA(At, 1, 1); PG8_STAGE(PG8_SA(1, 0), a3, voffA);
            PG8_BAR; PG8_WAIT_L(0); PG8_MMA(1, 0, At, B0); PG8_BAR; PG8_SCHED;
            PG8_STAGE(PG8_SB(1, 1), b3 + hstep, voffB);
            PG8_WAIT_V(6); PG8_BAR; PG8_MMA(1, 1, At, B1); PG8_BAR;
            }
        }
        if constexpr (ALIGN_EPI) { if (wr == 0) PG8_BAR; }
        bool keep_acc = false;
        if constexpr (Epi::DUAL) { if (cur.half == 0) { E.mid(acc, cur, wr, wc, fr, fq); keep_acc = true; } }
        if constexpr (!Epi::AFTER_DRAIN) { if (!keep_acc) { E(acc, cur, wr, wc, fr, fq); S.done(cur); } }
        if (!has_next) break;
        if (!keep_acc) {
#pragma unroll
        for (int a = 0; a < 2; ++a)
#pragma unroll
            for (int b = 0; b < 2; ++b)
#pragma unroll
                for (int m = 0; m < 4; ++m)
#pragma unroll
                    for (int n = 0; n < 2; ++n) acc[a][b][m][n] = (f32x4){0.f, 0.f, 0.f, 0.f};
        }
        cur = nxt; cA = nA; cB = nB; ++ui;
        if constexpr (ALIGN_EPI) { if (wr == 1) PG8_BAR; }
    }
    PG8_WAIT_V(0);
    if constexpr (!ALIGN_EPI) { if (wr == 0) PG8_BAR; }
    PG8_BAR;
    if constexpr (Epi::AFTER_DRAIN) { E.fused(acc, cur, wr, wc, fr, fq, lds, wid, lane); S.done(cur); }
#undef PG8_SA
#undef PG8_SB
#undef PG8_STAGE
#undef PG8_LDA
#undef PG8_LDB
#undef PG8_MMA
#undef PG8_WAIT_V
#undef PG8_WAIT_L
#undef PG8_BAR
#undef PG8_SCHED
}
}
#define GAS __attribute__((address_space(1)))
#define LAS __attribute__((address_space(3)))
typedef unsigned short bf16;
typedef unsigned v4u __attribute__((ext_vector_type(4)));
typedef float f32x4 __attribute__((ext_vector_type(4)));
typedef short bf16x8 __attribute__((ext_vector_type(8)));
typedef GAS unsigned gu32;
typedef GAS unsigned long long gu64;
#define RLX_AGENT __ATOMIC_RELAXED, __HIP_MEMORY_SCOPE_AGENT
#define LDS_WAIT() asm volatile("s_waitcnt lgkmcnt(0)" ::: "memory")
#define VM_WAIT() asm volatile("s_waitcnt vmcnt(0)" ::: "memory")
__device__ __forceinline__ unsigned long long rt() { return __builtin_amdgcn_s_memrealtime(); }
__device__ __forceinline__ unsigned f2bf(float f) { unsigned u = __builtin_bit_cast(unsigned, f); return (u + 0x7fffu + ((u >> 16) & 1u)) >> 16; }
__device__ __forceinline__ unsigned pk2(float lo, float hi) { return f2bf(lo) | (f2bf(hi) << 16); }

#define XB_TMO      128
#define XB_XCNT(j)  (256  + 64 * (j))
#define XB_XSUB(j)  (1280 + 64 * (j))
#define XB_XGEN(j)  (2304 + 64 * (j))
#define XB_TOP      3328
#define XB_TOPGEN   3392
#define XCD_BAR_WORDS 3456
#define XB_SPIN_CAP (1u << 18)

__device__ __forceinline__ unsigned xb_ld(unsigned* p)              { return __hip_atomic_load(p, __ATOMIC_RELAXED, __HIP_MEMORY_SCOPE_AGENT); }
__device__ __forceinline__ unsigned xb_add(unsigned* p, unsigned v) { return __hip_atomic_fetch_add(p, v, __ATOMIC_RELAXED, __HIP_MEMORY_SCOPE_AGENT); }
__device__ __forceinline__ unsigned xb_xcc_id() { return (unsigned)__builtin_amdgcn_s_getreg((3 << 11) | 20) & 0xFu; }
#define XB_SPIN(cond, bar) do { unsigned _sp = 0; while (cond) { __builtin_amdgcn_s_sleep(1); \
    if ((++_sp & 255u) == 0u) { if (xb_ld(&(bar)[XB_TMO])) break; if (_sp > XB_SPIN_CAP) { atomicAdd(&(bar)[XB_TMO], 1u); break; } } } } while (0)

struct XcdBarrier {
    unsigned* bar; unsigned x;
    volatile LAS unsigned* st;
};

__device__ __forceinline__ XcdBarrier xcd_barrier_post(unsigned* bar, volatile LAS unsigned* st) {
    XcdBarrier b; b.bar = bar; b.x = xb_xcc_id(); b.st = st;
    if (threadIdx.x == 0) (void)xb_add(&bar[XB_XCNT(b.x)], 1u);
    return b;
}
__device__ __forceinline__ void xcd_barrier_complete(unsigned* bar, unsigned x, unsigned& nloc, unsigned& nx) {
    const unsigned G = gridDim.x * gridDim.y * gridDim.z;
    unsigned sum, cnt, mine, sp = 0u;
    for (;;) {
        sum = 0u; cnt = 0u; mine = 0u;
#pragma unroll
        for (unsigned j = 0; j < 16; ++j) { const unsigned c = xb_ld(&bar[XB_XCNT(j)]); sum += c; cnt += (c > 0u) ? 1u : 0u; mine = (j == x) ? c : mine; }
        if (sum == G) break;
        __builtin_amdgcn_s_sleep(1);
        if ((++sp & 255u) == 0u) { if (xb_ld(&bar[XB_TMO])) break; if (sp > XB_SPIN_CAP) { atomicAdd(&bar[XB_TMO], 1u); break; } }
    }
    nloc = mine > 0u ? mine : 1u; nx = cnt > 0u ? cnt : 1u;
}

__device__ __forceinline__ void xcd_barrier(const XcdBarrier& b) {
    asm volatile("s_waitcnt vmcnt(0)" ::: "memory");
    __syncthreads();
    if (threadIdx.x == 0) {
        unsigned* bar = b.bar;
        __builtin_amdgcn_s_waitcnt(0);
        unsigned nloc = b.st[0], nx = b.st[1];
        if (nloc == 0u) { xcd_barrier_complete(bar, b.x, nloc, nx); b.st[0] = nloc; b.st[1] = nx; }
        const unsigned old = xb_add(&bar[XB_XSUB(b.x)], 1u);
        const unsigned gen = old / nloc;
        if (old + 1u == (gen + 1u) * nloc) {
            __builtin_amdgcn_fence(__ATOMIC_RELEASE, "agent");
            asm volatile("s_waitcnt vmcnt(0)" ::: "memory");
            const unsigned og = xb_add(&bar[XB_TOP], 1u);
            const unsigned tg = og / nx;
            if (og + 1u == (tg + 1u) * nx) xb_add(&bar[XB_TOPGEN], 1u);
            else XB_SPIN(xb_ld(&bar[XB_TOPGEN]) == tg, bar);
            __builtin_amdgcn_fence(__ATOMIC_ACQUIRE, "agent");
            xb_add(&bar[XB_XGEN(b.x)], 1u);
            asm volatile("s_waitcnt vmcnt(0)" ::: "memory");
        } else {
            XB_SPIN(xb_ld(&bar[XB_XGEN(b.x)]) == gen, bar);
            __builtin_amdgcn_fence(__ATOMIC_ACQUIRE, "agent");
            asm volatile("s_waitcnt vmcnt(0)" ::: "memory");
        }
    }
    __syncthreads();
}

constexpr int NWAVES = 8;
constexpr int NB = 4, SEQ = 8192, DM = 1024, M = NB * SEQ, DIN = 7168, DFF = 2816, NH = 8, HD = 128, NBLK = SEQ / 256;
constexpr float EPS = 1e-6f;
constexpr float QSCALE = 0.08838834764831845f * 1.4426950408889634f;
#ifndef MK_ONE_LAUNCH
#define MK_ONE_LAUNCH 1
#endif
constexpr int NPHASE = 15;

constexpr size_t MiB = 1u << 20;
constexpr size_t WS_CTL = 0, CTL_ZERO_BYTES = 1 * MiB;
constexpr size_t WS_WIN = 2 * MiB, WS_PA = 16 * MiB, WS_PB = 18 * MiB, WS_WOUT = 20 * MiB, WS_WUG = 22 * MiB, WS_WDN = 33 * MiB, WS_WR = 39 * MiB, WS_WI = 39 * MiB + 256 * 1024;
constexpr size_t WS_KM = 40 * MiB, WS_AG = 41 * MiB, WS_RSP = 45 * MiB;
constexpr size_t WS_XN = 48 * MiB;
constexpr size_t WS_Q = 112 * MiB;
constexpr size_t WS_K = 176 * MiB;
constexpr size_t WS_V = 240 * MiB;
constexpr size_t WS_XR = 304 * MiB, WS_GR = 368 * MiB;
constexpr size_t WS_ACT = 112 * MiB;
constexpr size_t WS_SB = 448 * MiB, WS_SU0 = 451 * MiB, WS_SG0 = 454 * MiB;
constexpr size_t WS_END = 512 * MiB;
constexpr int CW_BAR = 4096;

constexpr int LDS_BYTES = 163840;
constexpr int MISC_OFF = LDS_BYTES - 512;

__device__ __forceinline__ float wave_sum(float v) {
#pragma unroll
    for (int o = 1; o < 64; o <<= 1) v += __shfl_xor(v, o);
    return v;
}
__device__ __forceinline__ unsigned cvtpk_bf16(float lo, float hi) { unsigned r; asm volatile("v_cvt_pk_bf16_f32 %0, %1, %2" : "=v"(r) : "v"(lo), "v"(hi)); return r; }
__device__ __forceinline__ void p0_transpose_item(const float* W, int N, bf16* WT, int ldwt, int drow0, const float* gain, LAS float* scr, int kb, int nb, int lane) {
    const int k0 = 64 * kb, n0 = 64 * nb, lr = lane >> 4, lc = (lane & 15) * 4;
    f32x4 v[16];
#pragma unroll
    for (int i = 0; i < 16; ++i) v[i] = *(const GAS f32x4*)(W + (size_t)(k0 + 4 * i + lr) * N + n0 + lc);
#pragma unroll
    for (int i = 0; i < 16; ++i) { const int kk = 4 * i + lr; const float g = gain ? gain[k0 + kk] : 1.0f; LAS float* d = scr + kk * 65 + lc; d[0] = v[i][0] * g; d[1] = v[i][1] * g; d[2] = v[i][2] * g; d[3] = v[i][3] * g; }
    LDS_WAIT(); asm volatile("" ::: "memory");
    const int c = lane & 7;
#pragma unroll
    for (int j = 0; j < 8; ++j) { const int n = (lane >> 3) + 8 * j; const LAS float* s = scr + (8 * c) * 65 + n;
        v4u o; o.x = cvtpk_bf16(s[0 * 65], s[1 * 65]); o.y = cvtpk_bf16(s[2 * 65], s[3 * 65]); o.z = cvtpk_bf16(s[4 * 65], s[5 * 65]); o.w = cvtpk_bf16(s[6 * 65], s[7 * 65]);
        *(GAS v4u*)(WT + (size_t)(drow0 + n) * ldwt + k0 + 8 * c) = o; }
    LDS_WAIT(); asm volatile("" ::: "memory");
}
__device__ __forceinline__ void rms_rows_to_bf16(const float* x, bf16* o, int m0, int mstep, int lane) {
    f32x4 v[4], w[4];
    if (m0 < M) {
#pragma unroll
        for (int j = 0; j < 4; ++j) v[j] = ((const GAS f32x4*)(x + (size_t)m0 * DM) + lane)[64 * j]; }
#pragma unroll 1
    for (int m = m0; m < M; m += mstep) {
        const int mn = m + mstep;
        if (mn < M) {
#pragma unroll
            for (int j = 0; j < 4; ++j) w[j] = ((const GAS f32x4*)(x + (size_t)mn * DM) + lane)[64 * j]; }
        float s = 0.f;
#pragma unroll
        for (int j = 0; j < 4; ++j) s += (v[j].x * v[j].x + v[j].y * v[j].y) + (v[j].z * v[j].z + v[j].w * v[j].w);
        const float rstd = 1.0f / sqrtf(wave_sum(s) * (1.f / DM) + EPS);
        GAS unsigned long long* o8 = (GAS unsigned long long*)(o + (size_t)m * DM) + lane;
#pragma unroll
        for (int j = 0; j < 4; ++j) o8[64 * j] = (unsigned long long)cvtpk_bf16(v[j].x * rstd, v[j].y * rstd) | ((unsigned long long)cvtpk_bf16(v[j].z * rstd, v[j].w * rstd) << 32);
#pragma unroll
        for (int j = 0; j < 4; ++j) v[j] = w[j];
    }
}

struct Args { const float* in[21]; float* out; unsigned char* ws; int ph_lo, ph_hi, li, pad; };
enum { I_X = 0, I_N1G, I_WIN, I_CONVW, I_CONVB, I_WR, I_BR, I_WI, I_BI, I_LAM, I_QNG, I_KNG, I_PA, I_PB, I_WOUT, I_N2G, I_WUP, I_WGATE, I_FCW, I_FCB, I_WDN };

__device__ __forceinline__ void p0_prologue(const Args& a, LAS unsigned char* lds, int gw, int NGW, int wave, int lane) {
    LAS float* scr = (LAS float*)(lds + wave * 16896);
    unsigned char* ws = a.ws;
    constexpr int I_IN = 16 * 112, I_SQ = 16 * 16, I_UP = 16 * 44, I_DN = 44 * 16, I_RG = 32;
    constexpr int NITEMS = I_IN + 3 * I_SQ + 2 * I_UP + I_DN + 2 * I_RG;
    for (int it = gw; it < NITEMS; it += NGW) {
        int r = it;
        if (r < I_IN) { p0_transpose_item(a.in[I_WIN], DIN, (bf16*)(ws + WS_WIN), DM, 64 * (r % 112), a.in[I_N1G], scr, r / 112, r % 112, lane); continue; } r -= I_IN;
        if (r < I_SQ) { p0_transpose_item(a.in[I_PA], DM, (bf16*)(ws + WS_PA), DM, 64 * (r % 16), nullptr, scr, r / 16, r % 16, lane); continue; } r -= I_SQ;
        if (r < I_SQ) { p0_transpose_item(a.in[I_PB], DM, (bf16*)(ws + WS_PB), DM, 64 * (r % 16), nullptr, scr, r / 16, r % 16, lane); continue; } r -= I_SQ;
        if (r < I_SQ) { p0_transpose_item(a.in[I_WOUT], DM, (bf16*)(ws + WS_WOUT), DM, 64 * (r % 16), nullptr, scr, r / 16, r % 16, lane); continue; } r -= I_SQ;
        if (r < I_UP) { const int nb = r % 44, n0 = 64 * nb; p0_transpose_item(a.in[I_WUP], DFF, (bf16*)(ws + WS_WUG), DM, 256 * (n0 / 128) + (n0 % 128), a.in[I_N2G], scr, r / 44, nb, lane); continue; } r -= I_UP;
        if (r < I_UP) { const int nb = r % 44, n0 = 64 * nb; p0_transpose_item(a.in[I_WGATE], DFF, (bf16*)(ws + WS_WUG), DM, 256 * (n0 / 128) + 128 + (n0 % 128), a.in[I_N2G], scr, r / 44, nb, lane); continue; } r -= I_UP;
        if (r < I_DN) { p0_transpose_item(a.in[I_WDN], DM, (bf16*)(ws + WS_WDN), DFF, 64 * (r % 16), nullptr, scr, r / 16, r % 16, lane); continue; } r -= I_DN;
        if (r < I_RG) { const int blk = r >> 2, q = r & 3; p0_transpose_item(a.in[I_WR] + blk * 16384, 128, (bf16*)(ws + WS_WR) + blk * 16384, 128, 64 * (q & 1), nullptr, scr, q >> 1, q & 1, lane); continue; } r -= I_RG;
        { const int blk = r >> 2, q = r & 3; p0_transpose_item(a.in[I_WI] + blk * 16384, 128, (bf16*)(ws + WS_WI) + blk * 16384, 128, 64 * (q & 1), nullptr, scr, q >> 1, q & 1, lane); }
    }
    rms_rows_to_bf16(a.in[I_X], (bf16*)(ws + WS_XN), gw, NGW, lane);
    for (int e = gw * 64 + lane; e < 128 * 1024; e += NGW * 64) ((float*)(ws + WS_KM))[e] = 0.f;
}

constexpr int CW_RFLAG = 20480;
__device__ __forceinline__ void rnn_phase(const Args& a, LAS unsigned char* lds, int G, int wave, int lane, int tid) {
    LAS bf16* XRs = (LAS bf16*)lds;
    LAS bf16* XAb = (LAS bf16*)(lds + 18432);
    LAS bf16* HB = (LAS bf16*)(lds + 18432 + 17408);
    LAS float* CWl = (LAS float*)(lds + 18432 + 2 * 17408);
    const bf16* XR = (const bf16*)(a.ws + WS_XR); const bf16* GR = (const bf16*)(a.ws + WS_GR); bf16* YA = (bf16*)(a.ws + WS_XN);
    gu64* AG = (gu64*)(a.ws + WS_AG); gu32* RFLAG = (gu32*)(a.ws + WS_CTL) + CW_RFLAG;
    const int kq = lane >> 4, fr = lane & 15;
#pragma unroll 1
    for (int it = 0; it * G + (int)blockIdx.x < 1024; ++it) {
        const int w = blockIdx.x, chunk = (w >> 3) & 31, seqi = (it * (G >> 5) + (w >> 8) * 8 + (w & 7)) & 31, bb = seqi >> 3, n = seqi & 7, rb = bb * 32 + chunk;
        const int dcol = 16 * wave + fr, ch = n * 128 + dcol;
        bf16x8 wrf[4], wif[4];
#pragma unroll
        for (int ks = 0; ks < 4; ++ks) { wrf[ks] = *(const GAS bf16x8*)((const bf16*)(a.ws + WS_WR) + (size_t)ch * 128 + 32 * ks + 8 * kq);
                                         wif[ks] = *(const GAS bf16x8*)((const bf16*)(a.ws + WS_WI) + (size_t)ch * 128 + 32 * ks + 8 * kq); }
        const float nbr = -1.4426950408889634f * a.in[I_BR][ch], nbi = -1.4426950408889634f * a.in[I_BI][ch];
        const float sp = log1pf(expf(-a.in[I_LAM][ch]));
        const float c1 = -16.0f * sp, c2 = -8.0f * sp * 1.4426950408889634f;
        const int cg = tid & 15, cc = n * 128 + 8 * cg;
        float av[4][4][4]; unsigned bxp[4][4][2];
        float hl = 0.f, Pa = 1.f;
        {
        for (int e = tid; e < 640; e += 512) CWl[e] = (e < 512) ? a.in[I_CONVW][(e >> 7) * 1024 + n * 128 + (e & 127)] : a.in[I_CONVB][n * 128 + (e & 127)];
        v4u pre[3];
        {
            const bool seqstart = (chunk == 0);
#pragma unroll
            for (int pp = 0; pp < 3; ++pp) { const int p = tid + 512 * pp;
                if (p < 67 * 16) { const int row = p >> 4, c = p & 15; const bool z = seqstart && row < 3; const int srow = z ? rb * 256 : rb * 256 - 3 + row;
                    v4u v = *(const GAS v4u*)(XR + (size_t)srow * DM + n * 128 + 8 * c); if (z) v = (v4u){0u, 0u, 0u, 0u}; pre[pp] = v; } }
        }
#pragma unroll
        for (int s = 0; s < 4; ++s) {
            const int r0 = rb * 256 + 64 * s;
#pragma unroll
            for (int pp = 0; pp < 3; ++pp) { const int p = tid + 512 * pp; if (p < 67 * 16) *(LAS v4u*)(XRs + (p >> 4) * 136 + 8 * (p & 15)) = pre[pp]; }
            __syncthreads();
            if (s < 3) {
#pragma unroll
                for (int pp = 0; pp < 3; ++pp) { const int p = tid + 512 * pp; if (p < 67 * 16) pre[pp] = *(const GAS v4u*)(XR + (size_t)(r0 + 64 - 3 + (p >> 4)) * DM + n * 128 + 8 * (p & 15)); }
            }
#pragma unroll
            for (int pp = 0; pp < 2; ++pp) {
                const int tok = (tid >> 4) + 32 * pp;
                f32x4 a0 = *(const LAS f32x4*)(CWl + 512 + 8 * cg), a1 = *(const LAS f32x4*)(CWl + 512 + 8 * cg + 4);
#pragma unroll
                for (int k = 0; k < 4; ++k) { const v4u wv = *(const LAS v4u*)(XRs + (tok + k) * 136 + 8 * cg);
                    const f32x4 c0 = *(const LAS f32x4*)(CWl + k * 128 + 8 * cg), c1v = *(const LAS f32x4*)(CWl + k * 128 + 8 * cg + 4);
                    a0 += c0 * (f32x4){pg8::bflo(wv.x), pg8::bfhi(wv.x), pg8::bflo(wv.y), pg8::bfhi(wv.y)}; a1 += c1v * (f32x4){pg8::bflo(wv.z), pg8::bfhi(wv.z), pg8::bflo(wv.w), pg8::bfhi(wv.w)}; }
                const float acc[8] = {a0[0], a0[1], a0[2], a0[3], a1[0], a1[1], a1[2], a1[3]};
                v4u o; o.x = cvtpk_bf16(acc[0], acc[1]); o.y = cvtpk_bf16(acc[2], acc[3]); o.z = cvtpk_bf16(acc[4], acc[5]); o.w = cvtpk_bf16(acc[6], acc[7]);
                *(LAS v4u*)(XAb + tok * 136 + 8 * cg) = o;
            }
            __syncthreads();
#pragma unroll
            for (int rt = 0; rt < 4; ++rt) {
                f32x4 aR = {0.f, 0.f, 0.f, 0.f}, aI = {0.f, 0.f, 0.f, 0.f};
#pragma unroll
                for (int ks = 0; ks < 4; ++ks) { const bf16x8 af = *(const LAS bf16x8*)(XAb + (16 * rt + fr) * 136 + 32 * ks + 8 * kq);
                    aR = __builtin_amdgcn_mfma_f32_16x16x32_bf16(af, wrf[ks], aR, 0, 0, 0); aI = __builtin_amdgcn_mfma_f32_16x16x32_bf16(af, wif[ks], aI, 0, 0, 0); }
                float A = 1.f, H = 0.f; float bxt[4];
#pragma unroll
                for (int rg = 0; rg < 4; ++rg) { const int tok = 16 * rt + 4 * kq + rg;
                    const float r = __builtin_amdgcn_rcpf(1.0f + __builtin_amdgcn_exp2f(-1.4426950408889634f * aR[rg] + nbr));
                    const float ig = __builtin_amdgcn_rcpf(1.0f + __builtin_amdgcn_exp2f(-1.4426950408889634f * aI[rg] + nbi));
                    const float aa = __builtin_amdgcn_exp2f(r * c2);
                    const float x = r * c1;
                    const float poly = -x * (1.0f + x * 0.5f * (1.0f + x * (1.0f / 3.0f) * (1.0f + x * 0.25f * (1.0f + x * 0.2f))));
                    const float em1 = (x > -0.25f) ? poly : (1.0f - aa * aa);
                    const float xa = pg8::bf2f(XAb[tok * 136 + dcol]);
                    const float bv = __builtin_amdgcn_sqrtf(em1) * ig * xa;
                    av[s][rt][rg] = aa; bxt[rg] = bv; H = aa * H + bv; A *= aa; }
                bxp[s][rt][0] = cvtpk_bf16(bxt[0], bxt[1]); bxp[s][rt][1] = cvtpk_bf16(bxt[2], bxt[3]);
                { const float A1 = __shfl_up(A, 16), H1 = __shfl_up(H, 16); if (kq >= 1) { H = A * H1 + H; A = A1 * A; } }
                { const float A2 = __shfl_up(A, 32), H2 = __shfl_up(H, 32); if (kq >= 2) { H = A * H2 + H; A = A2 * A; } }
                const float At = __shfl(A, 48 + fr), Ht = __shfl(H, 48 + fr);
                hl = At * hl + Ht; Pa *= At;
            }
        }
        }
        if (kq == 0) __hip_atomic_store(AG + (size_t)rb * 1024 + ch, ((unsigned long long)__float_as_uint(hl) << 32) | __float_as_uint(Pa), RLX_AGENT);
        asm volatile("s_waitcnt vmcnt(0)" ::: "memory");
        __syncthreads();
        if (tid == 0) __hip_atomic_store(RFLAG + rb * 8 + n, 1u, RLX_AGENT);
        if (wave == 0) {
            unsigned spins = 0;
            for (;;) {
                const unsigned f = (lane < chunk) ? __hip_atomic_load(RFLAG + (bb * 32 + lane) * 8 + n, RLX_AGENT) : 1u;
                if (__all(f != 0u)) break;
                __builtin_amdgcn_s_sleep(2);
                if (++spins > (1u << 22)) break;
            }
        }
        __syncthreads();
        float hc = 0.f;
#pragma unroll 1
        for (int c0 = 0; c0 < chunk; c0 += 8) { unsigned long long ah[8];
#pragma unroll
            for (int j = 0; j < 8; ++j) { const int ci = (c0 + j < chunk) ? c0 + j : chunk - 1; ah[j] = __hip_atomic_load(AG + (size_t)(bb * 32 + ci) * 1024 + ch, RLX_AGENT); }
#pragma unroll
            for (int j = 0; j < 8; ++j) if (c0 + j < chunk) hc = __uint_as_float((unsigned)ah[j]) * hc + __uint_as_float((unsigned)(ah[j] >> 32)); }
#pragma unroll
        for (int s = 0; s < 4; ++s) {
            const int r0 = rb * 256 + 64 * s;
            v4u gpre[2];
#pragma unroll
            for (int pp = 0; pp < 2; ++pp) gpre[pp] = *(const GAS v4u*)(GR + (size_t)(r0 + (tid >> 4) + 32 * pp) * DM + cc);
#pragma unroll
            for (int rt = 0; rt < 4; ++rt) {
                float A = 1.f, H = 0.f;
                const float bxv[4] = { pg8::bflo(bxp[s][rt][0]), pg8::bfhi(bxp[s][rt][0]), pg8::bflo(bxp[s][rt][1]), pg8::bfhi(bxp[s][rt][1]) };
#pragma unroll
                for (int rg = 0; rg < 4; ++rg) { H = av[s][rt][rg] * H + bxv[rg]; A *= av[s][rt][rg]; }
                { const float A1 = __shfl_up(A, 16), H1 = __shfl_up(H, 16); if (kq >= 1) { H = A * H1 + H; A = A1 * A; } }
                { const float A2 = __shfl_up(A, 32), H2 = __shfl_up(H, 32); if (kq >= 2) { H = A * H2 + H; A = A2 * A; } }
                const float At = __shfl(A, 48 + fr), Ht = __shfl(H, 48 + fr);
                float Ae = __shfl_up(A, 16), He = __shfl_up(H, 16); if (kq == 0) { Ae = 1.f; He = 0.f; }
                float h = Ae * hc + He;
#pragma unroll
                for (int rg = 0; rg < 4; ++rg) { h = av[s][rt][rg] * h + bxv[rg]; HB[(16 * rt + 4 * kq + rg) * 136 + dcol] = (bf16)cvtpk_bf16(h, h); }
                hc = At * hc + Ht;
            }
            __syncthreads();
#pragma unroll
            for (int pp = 0; pp < 2; ++pp) {
                const int tok = (tid >> 4) + 32 * pp;
                const v4u hw = *(const LAS v4u*)(HB + tok * 136 + 8 * cg);
                const v4u gw = gpre[pp];
                v4u o; o.x = cvtpk_bf16(pg8::bflo(hw.x) * pg8::bflo(gw.x), pg8::bfhi(hw.x) * pg8::bfhi(gw.x)); o.y = cvtpk_bf16(pg8::bflo(hw.y) * pg8::bflo(gw.y), pg8::bfhi(hw.y) * pg8::bfhi(gw.y));
                o.z = cvtpk_bf16(pg8::bflo(hw.z) * pg8::bflo(gw.z), pg8::bfhi(hw.z) * pg8::bfhi(gw.z)); o.w = cvtpk_bf16(pg8::bflo(hw.w) * pg8::bflo(gw.w), pg8::bfhi(hw.w) * pg8::bfhi(gw.w));
                *(GAS v4u*)(YA + (size_t)(r0 + tok) * DM + cc) = o;
            }
            __syncthreads();
        }
    }
}
typedef short s16x4 __attribute__((ext_vector_type(4)));
typedef float f32x16 __attribute__((ext_vector_type(16)));
typedef short v4i16_t __attribute__((ext_vector_type(4)));
constexpr size_t WS_PART = 304 * MiB, WS_LIST = 496 * MiB, WS_LP = 42 * MiB;
constexpr int CW_CNT = 16384;
constexpr int LIST_PER_BH = 256 * 496;
__device__ __forceinline__ int list_off(int n) { return 256 * (31 * n - (n * (n - 1)) / 2); }
__device__ __forceinline__ unsigned cvtpk(float lo, float hi) { unsigned r; asm volatile("v_cvt_pk_bf16_f32 %0, %1, %2" : "=v"(r) : "v"(lo), "v"(hi)); return r; }
__device__ __forceinline__ s16x4 vtr(const LAS unsigned char* p) { return __builtin_bit_cast(s16x4, __builtin_amdgcn_ds_read_tr16_b64_v4i16((LAS v4i16_t*)p)); }

__device__ __forceinline__ void load_kv_block(LAS unsigned char* lds, const bf16* Kg, const bf16* Vg, size_t row0, int hh, int wave, int lane) {
#pragma unroll
    for (int i = 0; i < 8; ++i) {
        const int I = wave * 8 + i;
        { const int r = 4 * I + (lane >> 4), cp = lane & 15, c = cp ^ (r & 15);
          __builtin_amdgcn_global_load_lds((const unsigned*)(Kg + (row0 + r) * DM + hh * HD + 8 * c), (LAS unsigned*)(lds + I * 1024), 16, 0, 0); }
        { const int dt = lane >> 4, q = (lane >> 2) & 3, c8 = lane & 3;
          __builtin_amdgcn_global_load_lds((const unsigned*)(Vg + (row0 + 4 * I + q) * DM + hh * HD + 32 * dt + 8 * c8), (LAS unsigned*)(lds + 65536 + I * 1024), 16, 0, 0); }
    }
}

__device__ __forceinline__ void attn_wave(const LAS unsigned char* lds, const bf16x8 (&qf)[8], f32x16 (&O)[4], float& lsum, int kt_hi, int diag, int lane) {
    const int h2 = lane >> 5, kr = lane & 31;
    unsigned kaddr[8];
#pragma unroll
    for (int s = 0; s < 8; ++s) kaddr[s] = (unsigned)(kr * 256 + (((2 * s + h2) ^ (lane & 15)) * 16));
    const LAS unsigned char* vb = lds + 65536 + h2 * 1024 + ((lane >> 2) & 3) * 64 + ((lane >> 4) & 1) * 32 + (lane & 3) * 8;
#pragma unroll 1
    for (int kt = 0; kt < kt_hi; ++kt) {
        f32x16 S;
#pragma unroll
        for (int r = 0; r < 16; ++r) S[r] = 0.f;
#pragma unroll
        for (int s = 0; s < 8; ++s) { const bf16x8 kf = *(const LAS bf16x8*)(lds + kt * 8192 + kaddr[s]); S = __builtin_amdgcn_mfma_f32_32x32x16_bf16(kf, qf[s], S, 0, 0, 0); }
        float P[16];
#pragma unroll
        for (int r = 0; r < 16; ++r) P[r] = __builtin_amdgcn_exp2f(S[r]);
        if (kt == diag) {
#pragma unroll
            for (int r = 0; r < 16; ++r) { const int kl = (r & 3) + 8 * (r >> 2) + 4 * h2; P[r] = (kl <= kr) ? P[r] : 0.f; }
        }
        float ls = 0.f;
#pragma unroll
        for (int r = 0; r < 16; ++r) ls += P[r];
        lsum += ls;
        v4u pw0, pw1;
        pw0.x = cvtpk(P[0], P[1]); pw0.y = cvtpk(P[2], P[3]); pw0.z = cvtpk(P[4], P[5]); pw0.w = cvtpk(P[6], P[7]);
        pw1.x = cvtpk(P[8], P[9]); pw1.y = cvtpk(P[10], P[11]); pw1.z = cvtpk(P[12], P[13]); pw1.w = cvtpk(P[14], P[15]);
        const bf16x8 pb0 = __builtin_bit_cast(bf16x8, pw0), pb1 = __builtin_bit_cast(bf16x8, pw1);
        const LAS unsigned char* vk = vb + kt * 8192;
#pragma unroll
        for (int dt = 0; dt < 4; ++dt) {
            { const s16x4 lo = vtr(vk + dt * 256), hi = vtr(vk + dt * 256 + 2048);
              const bf16x8 vf = (bf16x8){lo[0], lo[1], lo[2], lo[3], hi[0], hi[1], hi[2], hi[3]};
              O[dt] = __builtin_amdgcn_mfma_f32_32x32x16_bf16(vf, pb0, O[dt], 0, 0, 0); }
            { const s16x4 lo = vtr(vk + 4096 + dt * 256), hi = vtr(vk + 4096 + dt * 256 + 2048);
              const bf16x8 vf = (bf16x8){lo[0], lo[1], lo[2], lo[3], hi[0], hi[1], hi[2], hi[3]};
              O[dt] = __builtin_amdgcn_mfma_f32_32x32x16_bf16(vf, pb1, O[dt], 0, 0, 0); }
        }
    }
}

__device__ __forceinline__ void gate_phase(const Args& a, LAS unsigned char* lds, int vcu, int wave, int lane, int tid, int variant = 0) {
    LAS unsigned* lcnt = (LAS unsigned*)lds; LAS unsigned* gbase = lcnt + 32;
    const bf16* Qg = (const bf16*)(a.ws + WS_Q); const float* KM = (const float*)(a.ws + WS_KM);
    unsigned* CNT = (unsigned*)(a.ws + WS_CTL) + CW_CNT; unsigned* LIST = (unsigned*)(a.ws + WS_LIST);
    const int h2 = lane >> 5, kr = lane & 31;
#pragma unroll 1
    for (int ui = 0; ui < 4; ++ui) {
        const int unit = vcu * 4 + ui, bh = unit >> 5, qb = unit & 31, bb = bh >> 3, hh = bh & 7;
        const size_t rowbase = (size_t)bb * SEQ; const int tq = qb * 256 + 32 * wave + kr;
        if (tid < 32) lcnt[tid] = 0u;
        __syncthreads();
        const float* kmp = KM + ((size_t)(bb * 32 + kr) * 8 + hh) * 128 + 8 * h2;
        const bf16* qp = Qg + (rowbase + tq) * DM + hh * HD + 8 * h2;
        f32x16 acc;
#pragma unroll
        for (int r = 0; r < 16; ++r) acc[r] = 0.f;
#pragma unroll
        for (int s = 0; s < 8; ++s) {
            const f32x4 k0 = *(const GAS f32x4*)(kmp + 16 * s), k1 = *(const GAS f32x4*)(kmp + 16 * s + 4);
            const float kv[8] = {k0[0], k0[1], k0[2], k0[3], k1[0], k1[1], k1[2], k1[3]};
            unsigned hi[4], lo[4];
#pragma unroll
            for (int j = 0; j < 4; ++j) { const unsigned h0 = f2bf(kv[2 * j]), h1 = f2bf(kv[2 * j + 1]); hi[j] = h0 | (h1 << 16);
                lo[j] = pk2(kv[2 * j] - __builtin_bit_cast(float, h0 << 16), kv[2 * j + 1] - __builtin_bit_cast(float, h1 << 16)); }
            const bf16x8 ahi = __builtin_bit_cast(bf16x8, (v4u){hi[0], hi[1], hi[2], hi[3]}), alo = __builtin_bit_cast(bf16x8, (v4u){lo[0], lo[1], lo[2], lo[3]});
            const bf16x8 bq = *(const GAS bf16x8*)(qp + 16 * s);
            acc = __builtin_amdgcn_mfma_f32_32x32x16_bf16(ahi, bq, acc, 0, 0, 0); acc = __builtin_amdgcn_mfma_f32_32x32x16_bf16(alo, bq, acc, 0, 0, 0);
        }
        unsigned mask = 0u; int seln[3] = {0, 0, 0}; unsigned pos[3] = {0u, 0u, 0u};
#pragma unroll
        for (int r3 = 0; r3 < 3; ++r3) {
            if (r3 < qb) { float best = -3.0e38f; int bi = 64;
#pragma unroll
                for (int r = 0; r < 16; ++r) { const int blk = (r & 3) + 8 * (r >> 2) + 4 * h2; const bool ok = (blk < qb) && !((mask >> blk) & 1u) && (acc[r] > best); best = ok ? acc[r] : best; bi = ok ? blk : bi; }
                const float ob = __shfl_xor(best, 32); const int oi = __shfl_xor(bi, 32);
                const bool take = (ob > best) || (ob == best && oi < bi);
                bi = take ? oi : bi; bi &= 31;
                mask |= 1u << bi; seln[r3] = bi;
                if (h2 == 0) pos[r3] = __hip_atomic_fetch_add(lcnt + bi, 1u, __ATOMIC_RELAXED, __HIP_MEMORY_SCOPE_WORKGROUP); }
        }
        __syncthreads();
        if (tid < 32) { const unsigned c = lcnt[tid]; gbase[tid] = (c && !variant) ? atomicAdd(CNT + bh * 32 + tid, c) : 0u; }
        __syncthreads();
        if (h2 == 0 && !variant) {
#pragma unroll
            for (int r3 = 0; r3 < 3; ++r3) if (r3 < qb) LIST[(size_t)bh * LIST_PER_BH + list_off(seln[r3]) + gbase[seln[r3]] + pos[r3]] = ((unsigned)tq << 2) | (unsigned)r3;
        }
        __syncthreads();
    }
}

__device__ __forceinline__ void sparse_phase(const Args& a, LAS unsigned char* lds, int G, int wave, int lane, int tid, int variant = 0) {
    LAS unsigned* cntl = (LAS unsigned*)(lds + 131072 + 1024);
    LAS unsigned* pre = cntl + 1024;
    const bf16* Qg = (const bf16*)(a.ws + WS_Q); const bf16* Kg = (const bf16*)(a.ws + WS_K); const bf16* Vg = (const bf16*)(a.ws + WS_V);
    const unsigned* CNT = (const unsigned*)(a.ws + WS_CTL) + CW_CNT; const unsigned* LIST = (const unsigned*)(a.ws + WS_LIST);
    bf16* PART = (bf16*)(a.ws + WS_PART); float* LP = (float*)(a.ws + WS_LP);
    const int h2 = lane >> 5, kr = lane & 31;
    for (int i = tid; i < 1024; i += 512) cntl[i] = __hip_atomic_load(CNT + i, __ATOMIC_RELAXED, __HIP_MEMORY_SCOPE_AGENT);
    __syncthreads();
    if (wave == 0) {
        unsigned loc[16]; unsigned s = 0u;
#pragma unroll
        for (int j = 0; j < 16; ++j) { loc[j] = s; s += (cntl[16 * lane + j] + 255u) >> 8; }
        unsigned inc = s;
#pragma unroll
        for (int o = 1; o < 64; o <<= 1) { const unsigned t = __shfl_up(inc, o); if (lane >= o) inc += t; }
        const unsigned exc = inc - s;
#pragma unroll
        for (int j = 0; j < 16; ++j) pre[16 * lane + j] = exc + loc[j];
        if (lane == 63) pre[1024] = inc;
    }
    __syncthreads();
    const unsigned T = pre[1024];
    const unsigned lo = (unsigned)(((unsigned long long)blockIdx.x * T) / (unsigned)G), hi = (unsigned)(((unsigned long long)(blockIdx.x + 1) * T) / (unsigned)G);
    if (lo >= hi) return;
    int li = 0;
    { int a0 = 0, b0 = 1024; while (b0 - a0 > 1) { const int m = (a0 + b0) >> 1; if (pre[m] <= lo) a0 = m; else b0 = m; } li = a0; }
#define SP_ENTRY(LI, K2) ({ const int bh_ = (LI) >> 5, nn_ = (LI) & 31; const int idx_ = 256 * (K2) + 32 * wave + kr; (idx_ < (int)cntl[LI]) ? LIST[(size_t)bh_ * LIST_PER_BH + list_off(nn_) + idx_] : 0xffffffffu; })
#define SP_QROW(LI, E) (Qg + ((size_t)((LI) >> 8) * SEQ + (((E) == 0xffffffffu) ? 0u : ((E) >> 2))) * DM + (((LI) >> 5) & 7) * HD + 8 * h2)
    int l1 = li, l2, l3;
    unsigned t1 = lo;
    while (t1 >= pre[l1 + 1]) ++l1;
    l2 = l1; if (lo + 1 < hi) { while (lo + 1 >= pre[l2 + 1]) ++l2; }
    unsigned e1 = SP_ENTRY(l1, (int)(lo - pre[l1]));
    unsigned e2 = (lo + 1 < hi) ? SP_ENTRY(l2, (int)(lo + 1 - pre[l2])) : 0xffffffffu;
    bf16x8 qf[8];
    { const bf16* qp = SP_QROW(l1, e1);
#pragma unroll
      for (int s = 0; s < 8; ++s) qf[s] = *(const GAS bf16x8*)(qp + 16 * s); }
    int cur = -1;
#pragma unroll 1
    for (unsigned tile = lo; tile < hi; ++tile) {
        const int k = (int)(tile - pre[l1]); const int cnt = (int)cntl[l1];
        const int bh = l1 >> 5, nn = l1 & 31, bb = bh >> 3, hh = bh & 7; const size_t rowbase = (size_t)bb * SEQ;
        if (l1 != cur) {
            __syncthreads();
            load_kv_block(lds, Kg, Vg, rowbase + (size_t)nn * 256, hh, wave, lane);
            asm volatile("s_waitcnt vmcnt(0)" ::: "memory");
            __syncthreads();
            cur = l1;
        }
        bf16x8 qn[8]; unsigned e3 = 0xffffffffu; l3 = l2;
        if (tile + 1 < hi) { const bf16* qp = SP_QROW(l2, e2);
#pragma unroll
            for (int s = 0; s < 8; ++s) qn[s] = *(const GAS bf16x8*)(qp + 16 * s); }
        if (tile + 2 < hi) { while (tile + 2 >= pre[l3 + 1]) ++l3; e3 = SP_ENTRY(l3, (int)(tile + 2 - pre[l3])); }
        const int idx0 = 256 * k + 32 * wave;
        if (idx0 < cnt) {
            const bool valid = (e1 != 0xffffffffu);
            const int t = (int)(e1 >> 2), j = (int)(e1 & 3u);
            f32x16 O[4];
#pragma unroll
            for (int dt = 0; dt < 4; ++dt)
#pragma unroll
                for (int r = 0; r < 16; ++r) O[dt][r] = 0.f;
            float lsum = 0.f;
            if (variant != 1) attn_wave(lds, qf, O, lsum, variant == 2 ? 4 : 8, -1, lane);
            lsum += __shfl_xor(lsum, 32);
            if (variant) {
#pragma unroll
                for (int dt = 0; dt < 4; ++dt)
#pragma unroll
                    for (int r = 0; r < 16; ++r) asm volatile("" :: "v"(O[dt][r]));
                asm volatile("" :: "v"(lsum));
            }
            if (variant == 0 || variant == 3) {
                const int psl = valid ? (int)(((unsigned)bh * SEQ + (unsigned)t) * 3u + (unsigned)j) : -1;
                if (valid && h2 == 0) LP[psl] = lsum;
                LAS unsigned char* stg = lds + 131072 + 10240 + wave * 2560;
                const int ra = lane >> 2, rb2 = ra + 16, part = lane & 3;
                const int psa = __shfl(psl, ra), psb = __shfl(psl, rb2);
#pragma unroll
                for (int dt = 0; dt < 4; ++dt) {
#pragma unroll
                    for (int rq = 0; rq < 4; ++rq) { const unsigned long long w = (unsigned long long)cvtpk(O[dt][4 * rq], O[dt][4 * rq + 1]) | ((unsigned long long)cvtpk(O[dt][4 * rq + 2], O[dt][4 * rq + 3]) << 32);
                        *(LAS unsigned long long*)(stg + kr * 80 + rq * 16 + h2 * 8) = w; }
                    asm volatile("s_waitcnt lgkmcnt(0)" ::: "memory");
                    const v4u ca = *(const LAS v4u*)(stg + ra * 80 + part * 16), cb2 = *(const LAS v4u*)(stg + rb2 * 80 + part * 16);
                    if (psa >= 0) *(GAS v4u*)(PART + (size_t)psa * 128 + dt * 32 + part * 8) = ca;
                    if (psb >= 0) *(GAS v4u*)(PART + (size_t)psb * 128 + dt * 32 + part * 8) = cb2;
                    asm volatile("s_waitcnt lgkmcnt(0)" ::: "memory");
                }
            }
        }
        if (tile + 1 < hi) {
#pragma unroll
            for (int s = 0; s < 8; ++s) qf[s] = qn[s];
        }
        e1 = e2; e2 = e3; l1 = l2; l2 = l3;
    }
#undef SP_ENTRY
#undef SP_QROW
}

__device__ __forceinline__ void own_phase(const Args& a, LAS unsigned char* lds, int vcu, int wave, int lane, int tid, int variant = 0) {
    bf16* Qg = (bf16*)(a.ws + WS_Q); const bf16* Kg = (const bf16*)(a.ws + WS_K); const bf16* Vg = (const bf16*)(a.ws + WS_V);
    const bf16* PART = (const bf16*)(a.ws + WS_PART); const float* LP = (const float*)(a.ws + WS_LP);
    const int h2 = lane >> 5, kr = lane & 31;
    LAS unsigned char* stg = lds + 131072 + 10240 + wave * 2560;
    const int ra = lane >> 2, rb2 = ra + 16, part = lane & 3;
#pragma unroll 1
    for (int ui = 0; ui < 4; ++ui) {
        const int unit = vcu * 4 + ui, bh = unit >> 5, qb = unit & 31, bb = bh >> 3, hh = bh & 7;
        const size_t rowbase = (size_t)bb * SEQ; const int t0 = qb * 256 + 32 * wave, t = t0 + kr;
        __syncthreads();
        load_kv_block(lds, Kg, Vg, rowbase + (size_t)qb * 256, hh, wave, lane);
        bf16* qp = Qg + (rowbase + t) * DM + hh * HD;
        bf16x8 qf[8];
#pragma unroll
        for (int s = 0; s < 8; ++s) qf[s] = *(const GAS bf16x8*)(qp + 8 * h2 + 16 * s);
        const int nsel = qb < 3 ? qb : 3;
        const size_t psa = ((size_t)bh * SEQ + t0 + ra) * 3, psb = ((size_t)bh * SEQ + t0 + rb2) * 3;
        float lp[3] = {0.f, 0.f, 0.f};
#pragma unroll
        for (int j = 0; j < 3; ++j) if (j < nsel) lp[j] = LP[((size_t)bh * SEQ + t) * 3 + j];
        asm volatile("s_waitcnt vmcnt(0)" ::: "memory");
        __syncthreads();
        f32x16 O[4];
#pragma unroll
        for (int dt = 0; dt < 4; ++dt)
#pragma unroll
            for (int r = 0; r < 16; ++r) O[dt][r] = 0.f;
        float lsum = 0.f;
        attn_wave(lds, qf, O, lsum, wave + 1, wave, lane);
        lsum += __shfl_xor(lsum, 32);
        lsum += (lp[0] + lp[1]) + lp[2];
#pragma unroll 1
        for (int j = 0; j < nsel; ++j) {
            v4u pa[8];
#pragma unroll
            for (int dt = 0; dt < 4; ++dt) { pa[2 * dt] = *(const GAS v4u*)(PART + (psa + j) * 128 + dt * 32 + part * 8); pa[2 * dt + 1] = *(const GAS v4u*)(PART + (psb + j) * 128 + dt * 32 + part * 8); }
#pragma unroll
            for (int dt = 0; dt < 4; ++dt) {
                *(LAS v4u*)(stg + ra * 80 + part * 16) = pa[2 * dt]; *(LAS v4u*)(stg + rb2 * 80 + part * 16) = pa[2 * dt + 1];
                asm volatile("s_waitcnt lgkmcnt(0)" ::: "memory");
#pragma unroll
                for (int rq = 0; rq < 4; ++rq) { const unsigned long long w = *(const LAS unsigned long long*)(stg + kr * 80 + rq * 16 + h2 * 8); const unsigned w0 = (unsigned)w, w1 = (unsigned)(w >> 32);
                    O[dt][4 * rq] += pg8::bflo(w0); O[dt][4 * rq + 1] += pg8::bfhi(w0); O[dt][4 * rq + 2] += pg8::bflo(w1); O[dt][4 * rq + 3] += pg8::bfhi(w1); }
                asm volatile("s_waitcnt lgkmcnt(0)" ::: "memory");
            }
        }
        const float inv = 1.0f / lsum;
        bf16* ya = Qg + (rowbase + t0 + ra) * DM + hh * HD; bf16* yb = Qg + (rowbase + t0 + rb2) * DM + hh * HD;
#pragma unroll
        for (int dt = 0; dt < 4; ++dt) {
#pragma unroll
            for (int rq = 0; rq < 4; ++rq) { const unsigned long long w = (unsigned long long)cvtpk(O[dt][4 * rq] * inv, O[dt][4 * rq + 1] * inv) | ((unsigned long long)cvtpk(O[dt][4 * rq + 2] * inv, O[dt][4 * rq + 3] * inv) << 32);
                *(LAS unsigned long long*)(stg + kr * 80 + rq * 16 + h2 * 8) = w; }
            asm volatile("s_waitcnt lgkmcnt(0)" ::: "memory");
            const v4u ca = *(const LAS v4u*)(stg + ra * 80 + part * 16), cb2 = *(const LAS v4u*)(stg + rb2 * 80 + part * 16);
            if (variant) { asm volatile("" :: "v"(ca), "v"(cb2)); } else { *(GAS v4u*)(ya + dt * 32 + part * 8) = ca; *(GAS v4u*)(yb + dt * 32 + part * 8) = cb2; }
            asm volatile("s_waitcnt lgkmcnt(0)" ::: "memory");
        }
    }
}
__device__ __forceinline__ void fix_phase(const Args& a, int gtid, int NT) {
    const float* SB = (const float*)(a.ws + WS_SB); const float* SU0 = (const float*)(a.ws + WS_SU0); const float* SG0 = (const float*)(a.ws + WS_SG0);
    bf16* ACT = (bf16*)(a.ws + WS_ACT); const float* cw = a.in[I_FCW]; const float* cb = a.in[I_FCB];
    for (int e = gtid; e < 128 * 2 * DFF; e += NT) {
        const int col = e % DFF, r = (e / DFF) & 1, pm = e / (2 * DFF);
        const bool first = (pm & 31) == 0;
        const float up0 = SU0[((size_t)pm * 2 + r) * DFF + col], gt = SG0[((size_t)pm * 2 + r) * DFF + col];
        const float pl1 = first ? 0.f : SB[((size_t)(pm - (first ? 0 : 1)) * 2 + 1) * DFF + col], pl0 = first ? 0.f : SB[((size_t)(pm - (first ? 0 : 1)) * 2 + 0) * DFF + col];
        const float x1 = (r == 0) ? pl1 : SU0[((size_t)pm * 2 + 0) * DFF + col];
        const float x2 = (r == 0) ? pl0 : pl1;
        const float c = cb[col] + cw[2 * DFF + col] * up0 + cw[DFF + col] * x1 + cw[col] * x2;
        ACT[((size_t)pm * 256 + r) * DFF + col] = (bf16)f2bf(pg8::gelu_tanh(c) * gt);
    }
}

template <int PV> __global__ void __launch_bounds__(NWAVES * 64, 2) mk_fwd(Args args) {
    extern __shared__ __attribute__((aligned(16))) unsigned char lds_raw[];
    LAS unsigned char* lds = (LAS unsigned char*)lds_raw;
    volatile LAS unsigned* MISC = (volatile LAS unsigned*)(lds + MISC_OFF);
    const int tid = threadIdx.x, lane = tid & 63, wave = __builtin_amdgcn_readfirstlane(tid >> 6);
    const int G = gridDim.x; const int bx = blockIdx.x; const int vcu = (G % 8 == 0) ? (bx % 8) * (G / 8) + bx / 8 : bx;
    unsigned char* ws = args.ws;
    gu32* ctl = (gu32*)(ws + WS_CTL);
    for (int u = tid; u < (LDS_BYTES - 131072) / 4; u += NWAVES * 64) ((LAS unsigned*)(lds + 131072))[u] = 0u;
    __syncthreads();
    XcdBarrier bar; bar.bar = (unsigned*)(ctl + CW_BAR); bar.x = 0; bar.st = nullptr;
    if (MK_ONE_LAUNCH) bar = xcd_barrier_post((unsigned*)(ctl + CW_BAR), MISC + 8);
    const int lo = args.ph_lo, hi = args.ph_hi;
    const int tid0 = tid;
#ifndef PROBE_DUP
#define PROBE_DUP 0
#endif
#ifndef PROBE_VARIANT
#define PROBE_VARIANT 0
#endif
#define LAUNDER() int tid = tid0; asm volatile("" : "+v"(tid)); const int lane = tid & 63; (void)lane
#ifndef PH_MASK
#define PH_MASK 0xffff
#endif
#define IN(k) (((PH_MASK >> (k)) & 1) && lo <= (k) && (k) < hi)
#define SEAM(k) do { if (IN(k) && IN((k) + 1)) xcd_barrier(bar); } while (0)
    const int gw = vcu * NWAVES + wave, NGW = G * NWAVES;
    bf16* XN = (bf16*)(ws + WS_XN); bf16* XR = (bf16*)(ws + WS_XR); bf16* GR = (bf16*)(ws + WS_GR);
    bf16* Qb = (bf16*)(ws + WS_Q); bf16* Kb = (bf16*)(ws + WS_K); bf16* Vb = (bf16*)(ws + WS_V);
    bf16* GA = (bf16*)args.out; bf16* GB = (bf16*)args.out + (size_t)M * DM;

    if (IN(0)) { LAUNDER(); p0_prologue(args, lds, gw, NGW, wave, lane); } SEAM(0);
    if (IN(1)) { LAUNDER(); pg8::Gemm g{XN, (const bf16*)(ws + WS_WIN), M, DIN, DM, nullptr, nullptr}; pg8::StaticOrder S; S.init(M, DIN, G, bx);
        pg8::EpiG1 E{XR, GR, Qb, Kb, Vb, GA, GB, args.in[I_QNG], args.in[I_KNG], (float*)(ws + WS_KM), (LAS float*)(lds + 131072 + 1024), QSCALE};
        pg8::gemm_phase<pg8::EpiG1, pg8::StaticOrder, true, true>(lds, g, S, E); } SEAM(1);
    if (IN(3)) { LAUNDER(); rnn_phase(args, lds, G, wave, lane, tid); } SEAM(3);
    if (IN(5)) { LAUNDER(); gate_phase(args, lds, vcu, wave, lane, tid, PV); } SEAM(5);
    if (IN(6)) { LAUNDER(); sparse_phase(args, lds, G, wave, lane, tid, PV); } SEAM(6);
    if (IN(7)) { LAUNDER(); own_phase(args, lds, vcu, wave, lane, tid, PV); } SEAM(7);
    if (IN(8)) { LAUNDER(); pg8::Gemm g{XN  , (const bf16*)(ws + WS_PA), M, DM, DM, Qb  , (const bf16*)(ws + WS_PB)}; pg8::DualOrder S; S.init(M, DM, G, bx);
        pg8::EpiG3 E{GA, GB, Kb  };
        pg8::gemm_phase<pg8::EpiG3, pg8::DualOrder, true, true>(lds, g, S, E); } SEAM(8);
    if (IN(10)) { LAUNDER(); pg8::Gemm g{Kb  , (const bf16*)(ws + WS_WOUT), M, DM, DM, nullptr, nullptr}; pg8::StaticOrder S; S.init(M, DM, G, bx);
        pg8::EpiRes<true> E{args.in[I_X], args.out, XN  , (float*)(ws + WS_RSP), (LAS float*)(lds + 131072 + 1024)};
        pg8::gemm_phase<pg8::EpiRes<true>, pg8::StaticOrder, true, true>(lds, g, S, E); } SEAM(10);
    if (IN(12)) { LAUNDER(); pg8::Gemm g{XN  , (const bf16*)(ws + WS_WUG), M, 2 * DFF, DM, nullptr, nullptr}; pg8::StaticOrder S; S.init(M, 2 * DFF, G, bx);
        pg8::EpiUGF E{(bf16*)(ws + WS_ACT), args.in[I_FCW], args.in[I_FCB], (float*)(ws + WS_SB), (float*)(ws + WS_SU0), (float*)(ws + WS_SG0), (LAS float*)(lds + 131072 + 1024), (const float*)(ws + WS_RSP), PV};
        pg8::gemm_phase<pg8::EpiUGF, pg8::StaticOrder, true, true>(lds, g, S, E); } SEAM(12);
    if (IN(13)) { LAUNDER(); fix_phase(args, vcu * 512 + tid, G * 512); } SEAM(13);
    if (IN(14)) { LAUNDER(); pg8::Gemm g{(const bf16*)(ws + WS_ACT), (const bf16*)(ws + WS_WDN), M, DM, DFF, nullptr, nullptr}; pg8::StaticOrder S; S.init(M, DM, G, bx);
        pg8::EpiRes<false> E{args.out, args.out, nullptr, nullptr, nullptr};
        pg8::gemm_phase<pg8::EpiRes<false>, pg8::StaticOrder, true, true>(lds, g, S, E); }
#undef IN
#undef SEAM
}

extern "C" void kernel_launch(void* const* d_in, const int* in_sizes, int n_in, void* d_out, int out_size, void* d_ws, size_t ws_size, hipStream_t stream) {
    static int grid = 0;
    if (grid == 0) {
        if (n_in != 21 || out_size != M * DM || ws_size < WS_END) { fprintf(stderr, "kernel_launch: unexpected shapes: n_in %d out %d ws %zu\n", n_in, out_size, ws_size); grid = -1; return; }
        int dev = 0, cus = 0;
        if (hipGetDevice(&dev) != hipSuccess || hipDeviceGetAttribute(&cus, hipDeviceAttributeMultiprocessorCount, dev) != hipSuccess) { grid = -1; return; }
        if (hipFuncSetAttribute((const void*)mk_fwd<0>, hipFuncAttributeMaxDynamicSharedMemorySize, LDS_BYTES) != hipSuccess || (PROBE_VARIANT && hipFuncSetAttribute((const void*)mk_fwd<PROBE_VARIANT>, hipFuncAttributeMaxDynamicSharedMemorySize, LDS_BYTES) != hipSuccess)) { fprintf(stderr, "kernel_launch: hipFuncSetAttribute failed\n"); grid = -1; return; }
        int per_cu = 0;
        if (hipOccupancyMaxActiveBlocksPerMultiprocessor(&per_cu, (const void*)mk_fwd<0>, NWAVES * 64, LDS_BYTES) != hipSuccess || per_cu < 1) fprintf(stderr, "kernel_launch: occupancy query says %d\n", per_cu);
        (void)hipGetLastError();
        grid = cus;
    }
    if (grid < 0) return;
    (void)hipMemsetAsync((char*)d_ws + WS_CTL, 0, CTL_ZERO_BYTES, stream);
    Args a{};
    for (int i = 0; i < 21; ++i) a.in[i] = (const float*)d_in[i];
    a.out = (float*)d_out; a.ws = (unsigned char*)d_ws;
#if MK_ONE_LAUNCH
    a.ph_lo = 0; a.ph_hi = NPHASE; a.li = 0;
    hipLaunchKernelGGL(mk_fwd<0>, dim3(grid), dim3(NWAVES * 64), LDS_BYTES, stream, a);
#else
    for (int p = 0; p < NPHASE; ++p) { a.ph_lo = p; a.ph_hi = p + 1; a.li = p; const int reps = ((PROBE_DUP >> p) & 1) ? 2 : 1;
        for (int r = 0; r < reps; ++r) { if (r && PROBE_VARIANT) hipLaunchKernelGGL(mk_fwd<PROBE_VARIANT>, dim3(grid), dim3(NWAVES * 64), LDS_BYTES, stream, a); else hipLaunchKernelGGL(mk_fwd<0>, dim3(grid), dim3(NWAVES * 64), LDS_BYTES, stream, a); } }
#endif
}
```

```cpp
#include <hip/hip_runtime.h>
#include <cstdio>
#include <cstdint>
namespace pg8 {
#define PG8_LAS __attribute__((address_space(3)))
typedef unsigned short bf16_t;
typedef short bf16x8 __attribute__((ext_vector_type(8)));
typedef float f32x4 __attribute__((ext_vector_type(4)));
typedef unsigned u32x4 __attribute__((ext_vector_type(4)));
constexpr int BM = 256, BK = 64, HALF = 128, HTB = HALF * BK * 2  , STAGE_BYTES = 8 * HTB, NXCD = 8, WGM = 4;

__host__ __device__ __forceinline__ int lds_byte(int r, int c) { const int st = (r >> 4) * 2 + (c >> 5), rr = r & 15, cc = c & 31, ob = rr * 64 + cc * 2; return st * 1024 + (ob ^ (((ob >> 9) & 1) << 5)); }
__host__ __device__ __forceinline__ void stage_rc(int b, int& R, int& C) { const int st = b / 1024, sb = b % 1024, swz = sb ^ (((sb >> 9) & 1) << 5); R = (st >> 1) * 16 + swz / 64; C = (st & 1) * 32 + (swz % 64) / 2; }
__host__ __device__ __forceinline__ int perm32(int rho) { const int n = rho >> 4, i = rho & 15; return 8 * (i >> 2) + 4 * n + (i & 3); }

struct Unit { int pm, pn, half; };
struct Gemm { const bf16_t* A; const bf16_t* Bt; int M, N, K; const bf16_t* A2; const bf16_t* Bt2; };

struct StaticOrder {
    int nM, nN, nwg, G, c, wgm;
    __host__ __device__ void init(int M, int N, int G_, int c_, int wgm_ = WGM) { nM = M / BM; nN = N / BM; nwg = nM * nN; G = G_; c = c_; wgm = wgm_; }
    __host__ __device__ bool next(int i, Unit& u) const {
        const long L = (long)i * G + c; if (L >= nwg) return false;
        int wgid = (int)L; { const int q = nwg / NXCD, r = nwg % NXCD, xcd = wgid % NXCD, off = wgid / NXCD; wgid = (xcd < r ? xcd * (q + 1) : r * (q + 1) + (xcd - r) * q) + off; }
        const int nig = wgm * nN, gid = wgid / nig, fm = gid * wgm, gsz = (nM - fm) < wgm ? (nM - fm) : wgm;
        u.pm = fm + ((wgid % nig) % gsz); u.pn = (wgid % nig) / gsz; u.half = 0; return true;
    }
    __device__ __forceinline__ void a_ready(const Unit&) const {}
    __device__ __forceinline__ void done(const Unit&) const {}
};
struct DualOrder {
    StaticOrder so; int G, c;
    __host__ __device__ void init(int M, int N, int G_, int c_, int wgm_ = WGM) { so.init(M, N, 1, 0, wgm_); G = G_; c = c_; }
    __host__ __device__ bool next(int i, Unit& u) const { StaticOrder t = so; t.G = G; t.c = c; if (!t.next(i >> 1, u)) return false; u.half = i & 1; return true; }
    __device__ __forceinline__ void a_ready(const Unit&) const {}
    __device__ __forceinline__ void done(const Unit&) const {}
};
__device__ __forceinline__ unsigned cvt_pk_bf16(float lo, float hi) { unsigned r; asm volatile("v_cvt_pk_bf16_f32 %0, %1, %2" : "=v"(r) : "v"(lo), "v"(hi)); return r; }
typedef float f32x2 __attribute__((ext_vector_type(2)));
__device__ __forceinline__ float bf2f(unsigned short h) { return __builtin_bit_cast(float, (unsigned)h << 16); }
__device__ __forceinline__ float bflo(unsigned w) { return __builtin_bit_cast(float, w << 16); }
__device__ __forceinline__ float bfhi(unsigned w) { return __builtin_bit_cast(float, w & 0xffff0000u); }
__device__ __forceinline__ float fast_sigmoid(float x) { return __builtin_amdgcn_rcpf(1.0f + __builtin_amdgcn_exp2f(-1.4426950408889634f * x)); }
__device__ __forceinline__ float gelu_tanh(float x) { const float z = 0.7978845608028654f * (x + 0.044715f * x * x * x); return x * fast_sigmoid(2.0f * z); }

__device__ __forceinline__ f32x4 sigmoid4(f32x4 x) { f32x4 e = x * (-1.4426950408889634f);
#pragma unroll
    for (int j = 0; j < 4; ++j) e[j] = __builtin_amdgcn_exp2f(e[j]);
    e = e + 1.0f;
#pragma unroll
    for (int j = 0; j < 4; ++j) e[j] = __builtin_amdgcn_rcpf(e[j]);
    return e; }
__device__ __forceinline__ f32x4 gelu_tanh4(f32x4 c) { f32x4 e = (c * c * 0.044715f + 1.0f) * c * (-2.0f * 1.4426950408889634f * 0.7978845608028654f);
#pragma unroll
    for (int j = 0; j < 4; ++j) e[j] = __builtin_amdgcn_exp2f(e[j]);
    e = e + 1.0f;
#pragma unroll
    for (int j = 0; j < 4; ++j) e[j] = __builtin_amdgcn_rcpf(e[j]);
    return c * e; }
struct EpiG1 {
    static constexpr bool PERM = true, AFTER_DRAIN = false, DUAL = false;
    bf16_t *o0, *o1, *o2, *o3, *o4, *o5, *o6; const float* qg; const float* kg; float* km; PG8_LAS float* px; float qscale; int variant;
    __device__ __forceinline__ void operator()(f32x4 (&acc)[2][2][4][2], const Unit& u, int wr, int wc, int fr, int fq) const {
        const int seg = u.pn >> 2;
        if (variant == 1) {
#pragma unroll
            for (int ai = 0; ai < 2; ++ai)
#pragma unroll
                for (int bj = 0; bj < 2; ++bj)
#pragma unroll
                    for (int m = 0; m < 4; ++m)
#pragma unroll
                        for (int n = 0; n < 2; ++n) asm volatile("" :: "v"(acc[ai][bj][m][n]));
            return; }
        if (variant == 7 || variant == 8) {
            bf16_t* dummy = o0 + (size_t)64 * 1024 * 1024;
            const int r8 = (variant == 8) ? (fr & 7) : fr, cx = (variant == 8) ? ((fr >> 3) * 32) : 0;
#pragma unroll
            for (int ai = 0; ai < 2; ++ai)
#pragma unroll
                for (int m = 0; m < 4; ++m)
#pragma unroll
                    for (int bj = 0; bj < 2; ++bj) { const f32x4 v0 = acc[ai][bj][m][0], v1 = acc[ai][bj][m][1];
                        u32x4 w; w.x = cvt_pk_bf16(v0[0], v0[1]); w.y = cvt_pk_bf16(v0[2], v0[3]); w.z = cvt_pk_bf16(v1[0], v1[1]); w.w = cvt_pk_bf16(v1[2], v1[3]);
                        const int rr = (variant == 8) ? (u.pm * BM + wr * 64 + ai * HALF + m * 16 + r8 + 8 * bj) : (u.pm * BM + wr * 64 + ai * HALF + m * 16 + fr);
                        const int cc = (variant == 8) ? ((u.pn & 3) * BM + wc * 64 + cx + 8 * fq) : ((u.pn & 3) * BM + wc * 32 + 8 * fq + bj * HALF);
                        *(u32x4*)(dummy + (size_t)rr * 1024 + cc) = w; }
            return; }
        bf16_t* base = seg == 0 ? o0 : seg == 1 ? o1 : seg == 2 ? o2 : seg == 3 ? o3 : seg == 4 ? o4 : seg == 5 ? o5 : o6;
        const int row0 = u.pm * BM + wr * 64 + fr, col0 = (u.pn & 3) * BM + wc * 32 + 8 * fq;
        if (seg == 2 || seg == 3) {
            float rs[2][4][2];
#pragma unroll
            for (int ai = 0; ai < 2; ++ai)
#pragma unroll
                for (int m = 0; m < 4; ++m)
#pragma unroll
                    for (int bj = 0; bj < 2; ++bj) { const f32x4 a0 = acc[ai][bj][m][0], a1 = acc[ai][bj][m][1];
                        float ss = (a0[0] * a0[0] + a0[1] * a0[1]) + (a0[2] * a0[2] + a0[3] * a0[3]) + (a1[0] * a1[0] + a1[1] * a1[1]) + (a1[2] * a1[2] + a1[3] * a1[3]);
                        ss += __shfl_xor(ss, 16); ss += __shfl_xor(ss, 32);
                        if (fq == 0) px[(ai * HALF + wr * 64 + m * 16 + fr) * 8 + bj * 4 + wc] = ss; }
            asm volatile("s_waitcnt lgkmcnt(0)" ::: "memory"); __builtin_amdgcn_s_barrier(); asm volatile("" ::: "memory");
#pragma unroll
            for (int ai = 0; ai < 2; ++ai)
#pragma unroll
                for (int m = 0; m < 4; ++m)
#pragma unroll
                    for (int bj = 0; bj < 2; ++bj) { const f32x4 p = *(const PG8_LAS f32x4*)(px + (ai * HALF + wr * 64 + m * 16 + fr) * 8 + bj * 4);
                        rs[ai][m][bj] = 1.0f / sqrtf(((p[0] + p[1]) + (p[2] + p[3])) * (1.0f / 128.0f) + 1e-6f); }
            const float* gp = (seg == 2 ? qg : kg) + wc * 32 + 8 * fq; const float gs = (seg == 2) ? qscale : 1.0f;
            const f32x4 g0 = *(const f32x4*)gp * gs, g1 = *(const f32x4*)(gp + 4) * gs;
            f32x4 cs[2][2];
#pragma unroll
            for (int bj = 0; bj < 2; ++bj) { cs[bj][0] = (f32x4){0.f, 0.f, 0.f, 0.f}; cs[bj][1] = (f32x4){0.f, 0.f, 0.f, 0.f}; }
#pragma unroll
            for (int ai = 0; ai < 2; ++ai)
#pragma unroll
                for (int m = 0; m < 4; ++m) { bf16_t* rowp = base + (size_t)(row0 + ai * HALF + m * 16) * 1024 + col0;
#pragma unroll
                    for (int bj = 0; bj < 2; ++bj) { const f32x4 v0 = acc[ai][bj][m][0] * rs[ai][m][bj] * g0, v1 = acc[ai][bj][m][1] * rs[ai][m][bj] * g1;
                        cs[bj][0] += v0; cs[bj][1] += v1;
                        u32x4 w; w.x = cvt_pk_bf16(v0[0], v0[1]); w.y = cvt_pk_bf16(v0[2], v0[3]); w.z = cvt_pk_bf16(v1[0], v1[1]); w.w = cvt_pk_bf16(v1[2], v1[3]);
                        if (variant) asm volatile("" :: "v"(w)); else *(u32x4*)(rowp + bj * HALF) = w; } }
            if (seg == 3 && !variant) {
#pragma unroll
                for (int bj = 0; bj < 2; ++bj)
#pragma unroll
                    for (int n = 0; n < 2; ++n)
#pragma unroll
                        for (int j = 0; j < 4; ++j) { float c = cs[bj][n][j]; c += __shfl_xor(c, 1); c += __shfl_xor(c, 2); c += __shfl_xor(c, 4); c += __shfl_xor(c, 8);
                            if (fr == 0) atomicAdd(km + ((size_t)u.pm * 8 + 2 * (u.pn & 3) + bj) * 128 + wc * 32 + 8 * fq + 4 * n + j, c * (1.0f / 256.0f)); }
            }
            return;
        }
#pragma unroll
        for (int ai = 0; ai < 2; ++ai)
#pragma unroll
            for (int m = 0; m < 4; ++m) { bf16_t* rowp = base + (size_t)(row0 + ai * HALF + m * 16) * 1024 + col0;
#pragma unroll
                for (int bj = 0; bj < 2; ++bj) { f32x4 v0 = acc[ai][bj][m][0], v1 = acc[ai][bj][m][1];
                    if (seg == 1) { v0 = gelu_tanh4(v0); v1 = gelu_tanh4(v1); }
                    else if (seg >= 5) { v0 = sigmoid4(v0); v1 = sigmoid4(v1); }
                    u32x4 w; w.x = cvt_pk_bf16(v0[0], v0[1]); w.y = cvt_pk_bf16(v0[2], v0[3]); w.z = cvt_pk_bf16(v1[0], v1[1]); w.w = cvt_pk_bf16(v1[2], v1[3]);
                    if (variant) asm volatile("" :: "v"(w)); else *(u32x4*)(rowp + bj * HALF) = w; } }
    }
};
struct EpiG3 {
    static constexpr bool PERM = true, AFTER_DRAIN = false, DUAL = true;
    const bf16_t* ga; const bf16_t* gb; bf16_t* out;
    __device__ __forceinline__ void mid(f32x4 (&acc)[2][2][4][2], const Unit& u, int wr, int wc, int fr, int fq) const {
        const int row0 = u.pm * BM + wr * 64 + fr, col0 = u.pn * BM + wc * 32 + 8 * fq;
#pragma unroll
        for (int ai = 0; ai < 2; ++ai) {
            u32x4 wa[4][2], wb[4][2];
#pragma unroll
            for (int m = 0; m < 4; ++m)
#pragma unroll
                for (int bj = 0; bj < 2; ++bj) { const size_t off = (size_t)(row0 + ai * HALF + m * 16) * 1024 + col0 + bj * HALF; wa[m][bj] = *(const u32x4*)(ga + off); wb[m][bj] = *(const u32x4*)(gb + off); }
#pragma unroll
            for (int m = 0; m < 4; ++m)
#pragma unroll
                for (int bj = 0; bj < 2; ++bj) { const u32x4 a = wa[m][bj], b = wb[m][bj];
                    acc[ai][bj][m][0] *= (f32x4){bflo(a.x) * __builtin_amdgcn_rcpf(bflo(b.x)), bfhi(a.x) * __builtin_amdgcn_rcpf(bfhi(b.x)), bflo(a.y) * __builtin_amdgcn_rcpf(bflo(b.y)), bfhi(a.y) * __builtin_amdgcn_rcpf(bfhi(b.y))};
                    acc[ai][bj][m][1] *= (f32x4){bflo(a.z) * __builtin_amdgcn_rcpf(bflo(b.z)), bfhi(a.z) * __builtin_amdgcn_rcpf(bfhi(b.z)), bflo(a.w) * __builtin_amdgcn_rcpf(bflo(b.w)), bfhi(a.w) * __builtin_amdgcn_rcpf(bfhi(b.w))}; }
        }
    }
    __device__ __forceinline__ void operator()(f32x4 (&acc)[2][2][4][2], const Unit& u, int wr, int wc, int fr, int fq) const {
        const int row0 = u.pm * BM + wr * 64 + fr, col0 = u.pn * BM + wc * 32 + 8 * fq;
        u32x4 wb[2][4][2];
#pragma unroll
        for (int ai = 0; ai < 2; ++ai)
#pragma unroll
            for (int m = 0; m < 4; ++m)
#pragma unroll
                for (int bj = 0; bj < 2; ++bj) wb[ai][m][bj] = *(const u32x4*)(gb + (size_t)(row0 + ai * HALF + m * 16) * 1024 + col0 + bj * HALF);
        asm volatile("" ::: "memory");
#pragma unroll
        for (int ai = 0; ai < 2; ++ai)
#pragma unroll
            for (int m = 0; m < 4; ++m)
#pragma unroll
                for (int bj = 0; bj < 2; ++bj) { const u32x4 b = wb[ai][m][bj]; const f32x4 v0 = acc[ai][bj][m][0], v1 = acc[ai][bj][m][1];
                    u32x4 w; w.x = cvt_pk_bf16(v0[0] * bflo(b.x), v0[1] * bfhi(b.x)); w.y = cvt_pk_bf16(v0[2] * bflo(b.y), v0[3] * bfhi(b.y)); w.z = cvt_pk_bf16(v1[0] * bflo(b.z), v1[1] * bfhi(b.z)); w.w = cvt_pk_bf16(v1[2] * bflo(b.w), v1[3] * bfhi(b.w));
                    *(u32x4*)(out + (size_t)(row0 + ai * HALF + m * 16) * 1024 + col0 + bj * HALF) = w; }
    }
};
template <class T> __device__ __forceinline__ T* at_byte(T* base, unsigned byteoff) { return (T*)((char*)base + byteoff); }
struct EpiX1 {
    static constexpr bool PERM = true, AFTER_DRAIN = false, DUAL = false;
    const float* base; bf16_t* xb; float* rsp; PG8_LAS float* px;
    __device__ __forceinline__ void operator()(f32x4 (&acc)[2][2][4][2], const Unit& u, int wr, int wc, int fr, int fq) const {
        const unsigned e0 = (unsigned)(u.pm * BM + wr * 64 + fr) * 1024u + (unsigned)(u.pn * BM + wc * 32 + 8 * fq);
#pragma unroll
        for (int ai = 0; ai < 2; ++ai) {
#pragma unroll
            for (int mh = 0; mh < 2; ++mh) {
                f32x4 b[2][2][2];
#pragma unroll
                for (int m2 = 0; m2 < 2; ++m2)
#pragma unroll
                    for (int bj = 0; bj < 2; ++bj) { const float* p = at_byte(base, (e0 + (unsigned)((ai * HALF + (2 * mh + m2) * 16) * 1024 + bj * HALF)) * 4u); b[m2][bj][0] = *(const f32x4*)p; b[m2][bj][1] = *(const f32x4*)(p + 4); }
#pragma unroll
                for (int m2 = 0; m2 < 2; ++m2)
#pragma unroll
                    for (int bj = 0; bj < 2; ++bj) { acc[ai][bj][2 * mh + m2][0] += b[m2][bj][0]; acc[ai][bj][2 * mh + m2][1] += b[m2][bj][1]; }
                asm volatile("" ::: "memory");
            }
#pragma unroll
            for (int m = 0; m < 4; ++m) { f32x4 s4 = {0.f, 0.f, 0.f, 0.f};
#pragma unroll
                for (int bj = 0; bj < 2; ++bj)
#pragma unroll
                    for (int n = 0; n < 2; ++n) { const f32x4 v = acc[ai][bj][m][n]; s4 += v * v; }
                float ss = (s4[0] + s4[1]) + (s4[2] + s4[3]);
                ss += __shfl_xor(ss, 16); ss += __shfl_xor(ss, 32);
                if (fq == 0) px[(ai * HALF + wr * 64 + m * 16 + fr) * 4 + wc] = ss; }
#pragma unroll
            for (int m = 0; m < 4; ++m)
#pragma unroll
                for (int bj = 0; bj < 2; ++bj) { const unsigned eo = e0 + (unsigned)((ai * HALF + m * 16) * 1024 + bj * HALF); const f32x4 v0 = acc[ai][bj][m][0], v1 = acc[ai][bj][m][1];
                    u32x4 w; w.x = cvt_pk_bf16(v0[0], v0[1]); w.y = cvt_pk_bf16(v0[2], v0[3]); w.z = cvt_pk_bf16(v1[0], v1[1]); w.w = cvt_pk_bf16(v1[2], v1[3]); *(u32x4*)at_byte(xb, eo * 2u) = w; }
            asm volatile("" ::: "memory");
        }
        asm volatile("s_waitcnt lgkmcnt(0)" ::: "memory"); __builtin_amdgcn_s_barrier(); asm volatile("" ::: "memory");
        const int t = (int)threadIdx.x;
        if (t < 256) { const f32x4 p = *(const PG8_LAS f32x4*)(px + t * 4); rsp[((size_t)u.pm * BM + t) * 4 + u.pn] = (p[0] + p[1]) + (p[2] + p[3]); }
    }
};
struct EpiOut {
    static constexpr bool PERM = true, AFTER_DRAIN = false, DUAL = false;
    const bf16_t* xb; float* out;
    __device__ __forceinline__ void operator()(f32x4 (&acc)[2][2][4][2], const Unit& u, int wr, int wc, int fr, int fq) const {
        const unsigned e0 = (unsigned)(u.pm * BM + wr * 64 + fr) * 1024u + (unsigned)(u.pn * BM + wc * 32 + 8 * fq);
        u32x4 r[2][4][2];
#pragma unroll
        for (int ai = 0; ai < 2; ++ai)
#pragma unroll
            for (int m = 0; m < 4; ++m)
#pragma unroll
                for (int bj = 0; bj < 2; ++bj) r[ai][m][bj] = *(const u32x4*)at_byte(xb, (e0 + (unsigned)((ai * HALF + m * 16) * 1024 + bj * HALF)) * 2u);
        asm volatile("" ::: "memory");
#pragma unroll
        for (int ai = 0; ai < 2; ++ai)
#pragma unroll
            for (int m = 0; m < 4; ++m)
#pragma unroll
                for (int bj = 0; bj < 2; ++bj) { const u32x4 w = r[ai][m][bj]; const unsigned eo = e0 + (unsigned)((ai * HALF + m * 16) * 1024 + bj * HALF);
                    const f32x4 v0 = acc[ai][bj][m][0] + (f32x4){bflo(w.x), bfhi(w.x), bflo(w.y), bfhi(w.y)}, v1 = acc[ai][bj][m][1] + (f32x4){bflo(w.z), bfhi(w.z), bflo(w.w), bfhi(w.w)};
                    float* po = at_byte(out, eo * 4u); *(f32x4*)po = v0; *(f32x4*)(po + 4) = v1; }
    }
};
template <int CTRL> __device__ __forceinline__ float dpp_mov(float old, float src) { return __builtin_bit_cast(float, __builtin_amdgcn_update_dpp(__builtin_bit_cast(int, old), __builtin_bit_cast(int, src), CTRL, 0xf, 0xf, false)); }
struct EpiUGF {
    static constexpr bool PERM = true, AFTER_DRAIN = false, DUAL = false;
    bf16_t* act; const float* cw; const float* cb; float* sb_last; float* su0; float* sg0; PG8_LAS float* halo; const float* rsp; int variant;
    __device__ __forceinline__ void operator()(f32x4 (&acc)[2][2][4][2], const Unit& u, int wr, int wc, int fr, int fq) const {
        const int colh = wc * 32 + 8 * fq, gcol = u.pn * HALF + colh;
        if (variant == 1) {
#pragma unroll
            for (int ai = 0; ai < 2; ++ai)
#pragma unroll
                for (int bj = 0; bj < 2; ++bj)
#pragma unroll
                    for (int m = 0; m < 4; ++m)
#pragma unroll
                        for (int n = 0; n < 2; ++n) asm volatile("" :: "v"(acc[ai][bj][m][n]));
            return; }
        {
            f32x4 rp[2][4];
#pragma unroll
            for (int ai = 0; ai < 2; ++ai)
#pragma unroll
                for (int m = 0; m < 4; ++m) rp[ai][m] = *(const f32x4*)at_byte(rsp, (unsigned)(u.pm * BM + ai * HALF + wr * 64 + m * 16 + fr) * 16u);
            { const int t = (int)threadIdx.x, r4 = t >> 7, c = t & 127;
              halo[1024 + t] = (r4 < 3) ? cw[r4 * 2816 + u.pn * HALF + c] : cb[u.pn * HALF + c]; }
#pragma unroll
            for (int ai = 0; ai < 2; ++ai)
#pragma unroll
                for (int m = 0; m < 4; ++m) { const f32x4 p = rp[ai][m]; const float rstd = __builtin_amdgcn_rsqf(((p[0] + p[1]) + (p[2] + p[3])) * (1.0f / 1024.0f) + 1e-6f);
#pragma unroll
                    for (int bj = 0; bj < 2; ++bj) { acc[ai][bj][m][0] *= rstd; acc[ai][bj][m][1] *= rstd; } }
        }
        asm volatile("" ::: "memory");
        if (fr >= 14) {
#pragma unroll
            for (int ai = 0; ai < 2; ++ai)
#pragma unroll
                for (int n = 0; n < 2; ++n) *(PG8_LAS f32x4*)(halo + ((2 * ai + wr) * 2 + (fr - 14)) * 128 + colh + 4 * n) = acc[ai][0][3][n];
            if (wr == 1) {
#pragma unroll
                for (int n = 0; n < 2; ++n) *(f32x4*)(sb_last + ((size_t)u.pm * 2 + (fr - 14)) * 2816 + gcol + 4 * n) = acc[1][0][3][n];
            }
        }
        asm volatile("s_waitcnt lgkmcnt(0)" ::: "memory"); __builtin_amdgcn_s_barrier(); asm volatile("" ::: "memory");
#pragma unroll
        for (int ai = 0; ai < 2; ++ai) {
            const int seg = 2 * ai + wr;
            f32x4 prev[2];
#pragma unroll
            for (int n = 0; n < 2; ++n) prev[n] = *(const PG8_LAS f32x4*)(halo + (((seg > 0 ? seg - 1 : 0)) * 2 + (fr & 1)) * 128 + colh + 4 * n);
#pragma unroll
            for (int m = 0; m < 4; ++m) {
                float r[8];
#pragma unroll
                for (int n = 0; n < 2; ++n) { const f32x4 cur = acc[ai][0][m][n], gt = acc[ai][1][m][n];
                    const f32x4 w0 = *(const PG8_LAS f32x4*)(halo + 1024 + colh + 4 * n), w1 = *(const PG8_LAS f32x4*)(halo + 1024 + 128 + colh + 4 * n), w2 = *(const PG8_LAS f32x4*)(halo + 1024 + 256 + colh + 4 * n), bb = *(const PG8_LAS f32x4*)(halo + 1024 + 384 + colh + 4 * n);
                    f32x4 v1, v2;
#pragma unroll
                    for (int j = 0; j < 4; ++j) {
                        const float t1 = dpp_mov<0x121>(prev[n][j], prev[n][j]); v1[j] = dpp_mov<0x111>(t1, cur[j]);
                        const float t2 = dpp_mov<0x122>(prev[n][j], prev[n][j]); v2[j] = dpp_mov<0x112>(t2, cur[j]); }
                    const f32x4 c = bb + w2 * cur + w1 * v1 + w0 * v2;
                    f32x4 ez = (c * c * 0.044715f + 1.0f) * c * (-2.0f * 1.4426950408889634f * 0.7978845608028654f);
#pragma unroll
                    for (int j = 0; j < 4; ++j) ez[j] = __builtin_amdgcn_exp2f(ez[j]);
                    ez = ez + 1.0f;
#pragma unroll
                    for (int j = 0; j < 4; ++j) ez[j] = __builtin_amdgcn_rcpf(ez[j]);
                    const f32x4 o = c * gt * ez;
                    r[4 * n] = o[0]; r[4 * n + 1] = o[1]; r[4 * n + 2] = o[2]; r[4 * n + 3] = o[3];
                    prev[n] = cur; }
                const unsigned row = (unsigned)(u.pm * BM + ai * HALF + wr * 64 + m * 16 + fr);
                const bool head = (seg == 0) && (m == 0) && (fr < 2);
                if (!head) { u32x4 w; w.x = cvt_pk_bf16(r[0], r[1]); w.y = cvt_pk_bf16(r[2], r[3]); w.z = cvt_pk_bf16(r[4], r[5]); w.w = cvt_pk_bf16(r[6], r[7]);
                    if (variant == 2) asm volatile("" :: "v"(w)); else *(u32x4*)at_byte(act, (row * 2816u + (unsigned)gcol) * 2u) = w; }
                else {
#pragma unroll
                    for (int n = 0; n < 2; ++n) { *(f32x4*)(su0 + ((size_t)u.pm * 2 + fr) * 2816 + gcol + 4 * n) = acc[0][0][0][n]; *(f32x4*)(sg0 + ((size_t)u.pm * 2 + fr) * 2816 + gcol + 4 * n) = acc[0][1][0][n]; }
                }
            }
        }
    }
};
template <class Epi, class Sched, bool ALIGN_EPI = false, bool SP2 = false>
__device__ __forceinline__ void gemm_phase(PG8_LAS unsigned char* lds, const Gemm g, const Sched& S, const Epi& E) {
    const int tid = threadIdx.x, wid = __builtin_amdgcn_readfirstlane(tid >> 6), lane = tid & 63, wr = wid >> 2, wc = wid & 3, fr = lane & 15, fq = lane >> 4;
    const int K = g.K, nt = K / BK;
    unsigned voffA[2], voffB[2];
#pragma unroll
    for (int i = 0; i < 2; ++i) { int R, C; stage_rc(tid * 16 + i * 8192, R, C); const int Rb = Epi::PERM ? ((R & ~31) + perm32(R & 31)) : R;
        voffA[i] = (unsigned)(R * K + C) * 2u; voffB[i] = (unsigned)(Rb * K + C) * 2u; }
    const size_t kstep = (size_t)(BK * 2);
    const size_t hstep = (size_t)HALF * K * 2;
    const size_t tstep = 2 * hstep;
    const unsigned ldsw = (unsigned)wid * 1024u;
    const int aoff = lds_byte(wr * 64 + fr, fq * 8), boff = lds_byte(wc * 32 + fr, fq * 8);
#define PG8_SA(b, h) (((b) * 2 + (h)) * HTB)
#define PG8_SB(b, h) ((4 + (b) * 2 + (h)) * HTB)
#define PG8_STAGE(bufoff, gbase, voff) do { _Pragma("unroll") for (int _i = 0; _i < 2; ++_i) \
        __builtin_amdgcn_global_load_lds((const unsigned*)((const char*)(gbase) + (voff)[_i]), (PG8_LAS unsigned*)(lds + (bufoff) + ldsw + _i * 8192), 16, 0, 0); } while (0)
#define PG8_LDA(dst, b, h) do { _Pragma("unroll") for (int m = 0; m < 4; ++m) _Pragma("unroll") for (int k = 0; k < 2; ++k) dst[m][k] = *(const PG8_LAS bf16x8*)(lds + PG8_SA(b, h) + aoff + m * 2048 + k * 1024); } while (0)
#define PG8_LDB(dst, b, h) do { _Pragma("unroll") for (int n = 0; n < 2; ++n) _Pragma("unroll") for (int k = 0; k < 2; ++k) dst[n][k] = *(const PG8_LAS bf16x8*)(lds + PG8_SB(b, h) + boff + n * 2048 + k * 1024); } while (0)
#define PG8_MMA(ai, bj, At, Bt) do { __builtin_amdgcn_s_setprio(1); _Pragma("unroll") for (int m = 0; m < 4; ++m) _Pragma("unroll") for (int n = 0; n < 2; ++n) _Pragma("unroll") for (int k = 0; k < 2; ++k) \
        acc[ai][bj][m][n] = __builtin_amdgcn_mfma_f32_16x16x32_bf16(Bt[n][k], At[m][k], acc[ai][bj][m][n], 0, 0, 0); __builtin_amdgcn_s_setprio(0); } while (0)
#define PG8_WAIT_V(n) asm volatile("s_waitcnt vmcnt(" #n ")" ::: "memory")
#define PG8_WAIT_L(n) asm volatile("s_waitcnt lgkmcnt(" #n ")" ::: "memory")
#define PG8_BAR __builtin_amdgcn_s_barrier()
#define PG8_SCHED __builtin_amdgcn_sched_barrier(0)
    Unit cur, nxt; int ui = 0;
    if (!S.next(0, cur)) return;
    f32x4 acc[2][2][4][2];
#pragma unroll
    for (int a = 0; a < 2; ++a)
#pragma unroll
        for (int b = 0; b < 2; ++b)
#pragma unroll
            for (int m = 0; m < 4; ++m)
#pragma unroll
                for (int n = 0; n < 2; ++n) acc[a][b][m][n] = (f32x4){0.f, 0.f, 0.f, 0.f};
    bf16x8 At[4][2], B0[2][2], B1[2][2];
    const char* cA = (const char*)(cur.half ? g.A2 : g.A) + (size_t)cur.pm * tstep; const char* cB = (const char*)(cur.half ? g.Bt2 : g.Bt) + (size_t)cur.pn * tstep;
    S.a_ready(cur);
    if constexpr (SP2) {
        PG8_STAGE(PG8_SB(0, 0), cB, voffB); PG8_STAGE(PG8_SB(0, 1), cB + hstep, voffB); PG8_STAGE(PG8_SA(0, 0), cA, voffA); PG8_STAGE(PG8_SA(0, 1), cA + hstep, voffA);
        if (wr == 1) PG8_BAR;
        PG8_WAIT_V(2); PG8_BAR;
        PG8_STAGE(PG8_SB(1, 0), cB + kstep, voffB); PG8_STAGE(PG8_SA(1, 0), cA + kstep, voffA); PG8_STAGE(PG8_SB(1, 1), cB + hstep + kstep, voffB);
        PG8_WAIT_V(6); PG8_BAR;
    } else {
        PG8_STAGE(PG8_SB(0, 0), cB, voffB); PG8_STAGE(PG8_SA(0, 0), cA, voffA); PG8_STAGE(PG8_SB(0, 1), cB + hstep, voffB); PG8_STAGE(PG8_SA(0, 1), cA + hstep, voffA);
        if (wr == 1) PG8_BAR;
        PG8_WAIT_V(4); PG8_BAR;
        PG8_STAGE(PG8_SB(1, 0), cB + kstep, voffB); PG8_STAGE(PG8_SA(1, 0), cA + kstep, voffA); PG8_STAGE(PG8_SB(1, 1), cB + hstep + kstep, voffB);
        PG8_WAIT_V(6); PG8_BAR;
    }
    for (;;) {
        const bool has_next = S.next(ui + 1, nxt);
        const char* nA = has_next ? (const char*)(nxt.half ? g.A2 : g.A) + (size_t)nxt.pm * tstep : cA; const char* nB = has_next ? (const char*)(nxt.half ? g.Bt2 : g.Bt) + (size_t)nxt.pn * tstep : cB;
        for (int t = 0; t < nt; t += 2) {
            const bool last = (t == nt - 2);
            const char* a1 = cA + (size_t)(t + 1) * kstep;
            const char* a2 = last ? nA : cA + (size_t)(t + 2) * kstep; const char* b2 = last ? nB : cB + (size_t)(t + 2) * kstep;
            const char* a3 = a2 + kstep; const char* b3 = b2 + kstep;
            if (last && has_next) S.a_ready(nxt);
            if constexpr (SP2) {
            PG8_LDB(B0, 0, 0); PG8_LDB(B1, 0, 1); PG8_SCHED; PG8_LDA(At, 0, 0); PG8_STAGE(PG8_SA(1, 1), a1 + hstep, voffA);
            PG8_WAIT_V(8); PG8_WAIT_L(0); PG8_BAR; PG8_MMA(0, 0, At, B0); PG8_MMA(0, 1, At, B1); PG8_BAR; PG8_SCHED;
            PG8_LDA(At, 0, 1); PG8_STAGE(PG8_SB(0, 0), b2, voffB); PG8_STAGE(PG8_SB(0, 1), b2 + hstep, voffB); PG8_STAGE(PG8_SA(0, 0), a2, voffA);
            PG8_WAIT_V(8); PG8_WAIT_L(0); PG8_BAR; PG8_MMA(1, 0, At, B0); PG8_MMA(1, 1, At, B1); PG8_BAR; PG8_SCHED;
            PG8_LDB(B0, 1, 0); PG8_LDB(B1, 1, 1); PG8_SCHED; PG8_LDA(At, 1, 0); PG8_STAGE(PG8_SA(0, 1), a2 + hstep, voffA);
            PG8_WAIT_V(8); PG8_WAIT_L(0); PG8_BAR; PG8_MMA(0, 0, At, B0); PG8_MMA(0, 1, At, B1); PG8_BAR; PG8_SCHED;
            PG8_LDA(At, 1, 1); PG8_STAGE(PG8_SB(1, 0), b3, voffB); PG8_STAGE(PG8_SB(1, 1), b3 + hstep, voffB); PG8_STAGE(PG8_SA(1, 0), a3, voffA);
            PG8_WAIT_V(8); PG8_WAIT_L(0); PG8_BAR; PG8_MMA(1, 0, At, B0); PG8_MMA(1, 1, At, B1); PG8_BAR; PG8_SCHED;
            } else {
            PG8_LDB(B0, 0, 0); PG8_SCHED; PG8_LDA(At, 0, 0); PG8_STAGE(PG8_SA(1, 1), a1 + hstep, voffA);
            PG8_WAIT_L(8); PG8_BAR; PG8_WAIT_L(0); PG8_MMA(0, 0, At, B0); PG8_BAR; PG8_SCHED;
            PG8_LDB(B1, 0, 1); PG8_STAGE(PG8_SB(0, 0), b2, voffB);
            PG8_BAR; PG8_WAIT_L(0); PG8_MMA(0, 1, At, B1); PG8_BAR;
            PG8_LDA(At, 0, 1); PG8_STAGE(PG8_SA(0, 0), a2, voffA);
            PG8_BAR; PG8_WAIT_L(0); PG8_MMA(1, 0, At, B0); PG8_BAR; PG8_SCHED;
            PG8_STAGE(PG8_SB(0, 1), b2 + hstep, voffB);
            PG8_WAIT_V(6); PG8_BAR; PG8_MMA(1, 1, At, B1); PG8_BAR;
            PG8_LDB(B0, 1, 0); PG8_SCHED; PG8_LDA(At, 1, 0); PG8_STAGE(PG8_SA(0, 1), a2 + hstep, voffA);
            PG8_WAIT_L(8); PG8_BAR; PG8_WAIT_L(0); PG8_MMA(0, 0, At, B0); PG8_BAR; PG8_SCHED;
            PG8_LDB(B1, 1, 1); PG8_STAGE(PG8_SB(1, 0), b3, voffB);
            PG8_BAR; PG8_WAIT_L(0); PG8_MMA(0, 1, At, B1); PG8_BAR;
            PG8_LDA(At, 1, 1); PG8_STAGE(PG8_SA(1, 0), a3, voffA);
            PG8_BAR; PG8_WAIT_L(0); PG8_MMA(1, 0, At, B0); PG8_BAR; PG8_SCHED;
            PG8_STAGE(PG8_SB(1, 1), b3 + hstep, voffB);
            PG8_WAIT_V(6); PG8_BAR; PG8_MMA(1, 1, At, B1); PG8_BAR;
            }
        }
        if constexpr (ALIGN_EPI) { if (wr == 0) PG8_BAR; }
        bool keep_acc = false;
        if constexpr (Epi::DUAL) { if (cur.half == 0) { E.mid(acc, cur, wr, wc, fr, fq); keep_acc = true; } }
        if constexpr (!Epi::AFTER_DRAIN) { if (!keep_acc) { E(acc, cur, wr, wc, fr, fq); S.done(cur); } }
        if (!has_next) break;
        if (!keep_acc) {
#pragma unroll
        for (int a = 0; a < 2; ++a)
#pragma unroll
            for (int b = 0; b < 2; ++b)
#pragma unroll
                for (int m = 0; m < 4; ++m)
#pragma unroll
                    for (int n = 0; n < 2; ++n) acc[a][b][m][n] = (f32x4){0.f, 0.f, 0.f, 0.f};
        }
        cur = nxt; cA = nA; cB = nB; ++ui;
        if constexpr (ALIGN_EPI) { if (wr == 1) PG8_BAR; }
    }
    PG8_WAIT_V(0);
    if constexpr (!ALIGN_EPI) { if (wr == 0) PG8_BAR; }
    PG8_BAR;
    if constexpr (Epi::AFTER_DRAIN) { E.fused(acc, cur, wr, wc, fr, fq, lds, wid, lane); S.done(cur); }
#undef PG8_SA
#undef PG8_SB
#undef PG8_STAGE
#undef PG8_LDA
#undef PG8_LDB
#undef PG8_MMA
#undef PG8_WAIT_V
#undef PG8_WAIT_L
#undef PG8_BAR
#undef PG8_SCHED
}
}
#define GAS __attribute__((address_space(1)))
#define LAS __attribute__((address_space(3)))
typedef unsigned short bf16;
typedef unsigned v4u __attribute__((ext_vector_type(4)));
typedef float f32x4 __attribute__((ext_vector_type(4)));
typedef short bf16x8 __attribute__((ext_vector_type(8)));
typedef GAS unsigned gu32;
typedef GAS unsigned long long gu64;
#define RLX_AGENT __ATOMIC_RELAXED, __HIP_MEMORY_SCOPE_AGENT
#define LDS_WAIT() asm volatile("s_waitcnt lgkmcnt(0)" ::: "memory")
#define VM_WAIT() asm volatile("s_waitcnt vmcnt(0)" ::: "memory")
__device__ __forceinline__ unsigned long long rt() { return __builtin_amdgcn_s_memrealtime(); }
__device__ __forceinline__ unsigned f2bf(float f) { unsigned u = __builtin_bit_cast(unsigned, f); return (u + 0x7fffu + ((u >> 16) & 1u)) >> 16; }
__device__ __forceinline__ unsigned pk2(float lo, float hi) { return f2bf(lo) | (f2bf(hi) << 16); }

#define XB_TMO      128
#define XB_XCNT(j)  (256  + 64 * (j))
#define XB_XSUB(j)  (1280 + 64 * (j))
#define XB_XGEN(j)  (2304 + 64 * (j))
#define XB_TOP      3328
#define XB_TOPGEN   3392
#define XCD_BAR_WORDS 3456
#define XB_SPIN_CAP (1u << 18)

__device__ __forceinline__ unsigned xb_ld(unsigned* p)              { return __hip_atomic_load(p, __ATOMIC_RELAXED, __HIP_MEMORY_SCOPE_AGENT); }
__device__ __forceinline__ unsigned xb_add(unsigned* p, unsigned v) { return __hip_atomic_fetch_add(p, v, __ATOMIC_RELAXED, __HIP_MEMORY_SCOPE_AGENT); }
__device__ __forceinline__ unsigned xb_xcc_id() { return (unsigned)__builtin_amdgcn_s_getreg((3 << 11) | 20) & 0xFu; }
#define XB_SPIN(cond, bar) do { unsigned _sp = 0; while (cond) { __builtin_amdgcn_s_sleep(1); \
    if ((++_sp & 255u) == 0u) { if (xb_ld(&(bar)[XB_TMO])) break; if (_sp > XB_SPIN_CAP) { atomicAdd(&(bar)[XB_TMO], 1u); break; } } } } while (0)

struct XcdBarrier {
    unsigned* bar; unsigned x;
    volatile LAS unsigned* st;
};

__device__ __forceinline__ XcdBarrier xcd_barrier_post(unsigned* bar, volatile LAS unsigned* st) {
    XcdBarrier b; b.bar = bar; b.x = xb_xcc_id(); b.st = st;
    if (threadIdx.x == 0) (void)xb_add(&bar[XB_XCNT(b.x)], 1u);
    return b;
}
__device__ __forceinline__ void xcd_barrier_complete(unsigned* bar, unsigned x, unsigned& nloc, unsigned& nx) {
    const unsigned G = gridDim.x * gridDim.y * gridDim.z;
    unsigned sum, cnt, mine, sp = 0u;
    for (;;) {
        sum = 0u; cnt = 0u; mine = 0u;
#pragma unroll
        for (unsigned j = 0; j < 16; ++j) { const unsigned c = xb_ld(&bar[XB_XCNT(j)]); sum += c; cnt += (c > 0u) ? 1u : 0u; mine = (j == x) ? c : mine; }
        if (sum == G) break;
        __builtin_amdgcn_s_sleep(1);
        if ((++sp & 255u) == 0u) { if (xb_ld(&bar[XB_TMO])) break; if (sp > XB_SPIN_CAP) { atomicAdd(&bar[XB_TMO], 1u); break; } }
    }
    nloc = mine > 0u ? mine : 1u; nx = cnt > 0u ? cnt : 1u;
}

__device__ __forceinline__ void xcd_barrier(const XcdBarrier& b) {
    asm volatile("s_waitcnt vmcnt(0)" ::: "memory");
    __syncthreads();
    if (threadIdx.x == 0) {
        unsigned* bar = b.bar;
        __builtin_amdgcn_s_waitcnt(0);
        unsigned nloc = b.st[0], nx = b.st[1];
        if (nloc == 0u) { xcd_barrier_complete(bar, b.x, nloc, nx); b.st[0] = nloc; b.st[1] = nx; }
        const unsigned old = xb_add(&bar[XB_XSUB(b.x)], 1u);
        const unsigned gen = old / nloc;
        if (old + 1u == (gen + 1u) * nloc) {
            __builtin_amdgcn_fence(__ATOMIC_RELEASE, "agent");
            asm volatile("s_waitcnt vmcnt(0)" ::: "memory");
            const unsigned og = xb_add(&bar[XB_TOP], 1u);
            const unsigned tg = og / nx;
            if (og + 1u == (tg + 1u) * nx) xb_add(&bar[XB_TOPGEN], 1u);
            else XB_SPIN(xb_ld(&bar[XB_TOPGEN]) == tg, bar);
            __builtin_amdgcn_fence(__ATOMIC_ACQUIRE, "agent");
            xb_add(&bar[XB_XGEN(b.x)], 1u);
            asm volatile("s_waitcnt vmcnt(0)" ::: "memory");
        } else {
            XB_SPIN(xb_ld(&bar[XB_XGEN(b.x)]) == gen, bar);
            __builtin_amdgcn_fence(__ATOMIC_ACQUIRE, "agent");
            asm volatile("s_waitcnt vmcnt(0)" ::: "memory");
        }
    }
    __syncthreads();
}

constexpr int NWAVES = 8;
constexpr int NB = 4, SEQ = 8192, DM = 1024, M = NB * SEQ, DIN = 7168, DFF = 2816, NH = 8, HD = 128, NBLK = SEQ / 256;
constexpr float EPS = 1e-6f;
constexpr float QSCALE = 0.08838834764831845f * 1.4426950408889634f;
#ifndef MK_ONE_LAUNCH
#define MK_ONE_LAUNCH 1
#endif
constexpr int NPHASE = 15;

constexpr size_t MiB = 1u << 20;
constexpr size_t WS_CTL = 0, CTL_ZERO_BYTES = 1 * MiB;
constexpr size_t WS_WIN = 2 * MiB, WS_PA = 16 * MiB, WS_PB = 18 * MiB, WS_WOUT = 20 * MiB, WS_WUG = 22 * MiB, WS_WDN = 33 * MiB, WS_WR = 39 * MiB, WS_WI = 39 * MiB + 256 * 1024;
constexpr size_t WS_KM = 40 * MiB, WS_AG = 41 * MiB, WS_RSP = 45 * MiB;
constexpr size_t WS_XN = 48 * MiB;
constexpr size_t WS_Q = 112 * MiB;
constexpr size_t WS_K = 176 * MiB;
constexpr size_t WS_V = 240 * MiB;
constexpr size_t WS_XR = 304 * MiB, WS_GR = 368 * MiB;
constexpr size_t WS_ACT = 112 * MiB;
constexpr size_t WS_SB = 448 * MiB, WS_SU0 = 451 * MiB, WS_SG0 = 454 * MiB;
constexpr size_t WS_END = 512 * MiB;
constexpr int CW_BAR = 4096;

constexpr int LDS_BYTES = 163840;
constexpr int MISC_OFF = LDS_BYTES - 512;

__device__ __forceinline__ float wave_sum(float v) {
#pragma unroll
    for (int o = 1; o < 64; o <<= 1) v += __shfl_xor(v, o);
    return v;
}
__device__ __forceinline__ unsigned cvtpk_bf16(float lo, float hi) { unsigned r; asm volatile("v_cvt_pk_bf16_f32 %0, %1, %2" : "=v"(r) : "v"(lo), "v"(hi)); return r; }
__device__ __forceinline__ void p0_transpose_item(const float* W, int N, bf16* WT, int ldwt, int drow0, const float* gain, LAS float* scr, int kb, int nb, int lane) {
    const int k0 = 64 * kb, n0 = 64 * nb, lr = lane >> 4, lc = (lane & 15) * 4;
    f32x4 v[16];
#pragma unroll
    for (int i = 0; i < 16; ++i) v[i] = *(const GAS f32x4*)(W + (size_t)(k0 + 4 * i + lr) * N + n0 + lc);
#pragma unroll
    for (int i = 0; i < 16; ++i) { const int kk = 4 * i + lr; const float g = gain ? gain[k0 + kk] : 1.0f; LAS float* d = scr + kk * 65 + lc; d[0] = v[i][0] * g; d[1] = v[i][1] * g; d[2] = v[i][2] * g; d[3] = v[i][3] * g; }
    LDS_WAIT(); asm volatile("" ::: "memory");
    const int c = lane & 7;
#pragma unroll
    for (int j = 0; j < 8; ++j) { const int n = (lane >> 3) + 8 * j; const LAS float* s = scr + (8 * c) * 65 + n;
        v4u o; o.x = cvtpk_bf16(s[0 * 65], s[1 * 65]); o.y = cvtpk_bf16(s[2 * 65], s[3 * 65]); o.z = cvtpk_bf16(s[4 * 65], s[5 * 65]); o.w = cvtpk_bf16(s[6 * 65], s[7 * 65]);
        *(GAS v4u*)(WT + (size_t)(drow0 + n) * ldwt + k0 + 8 * c) = o; }
    LDS_WAIT(); asm volatile("" ::: "memory");
}
__device__ __forceinline__ void rms_rows_to_bf16(const float* x, bf16* o, int m0, int mstep, int lane) {
    f32x4 v[4], w[4];
    if (m0 < M) {
#pragma unroll
        for (int j = 0; j < 4; ++j) v[j] = ((const GAS f32x4*)(x + (size_t)m0 * DM) + lane)[64 * j]; }
#pragma unroll 1
    for (int m = m0; m < M; m += mstep) {
        const int mn = m + mstep;
        if (mn < M) {
#pragma unroll
            for (int j = 0; j < 4; ++j) w[j] = ((const GAS f32x4*)(x + (size_t)mn * DM) + lane)[64 * j]; }
        float s = 0.f;
#pragma unroll
        for (int j = 0; j < 4; ++j) s += (v[j].x * v[j].x + v[j].y * v[j].y) + (v[j].z * v[j].z + v[j].w * v[j].w);
        const float rstd = 1.0f / sqrtf(wave_sum(s) * (1.f / DM) + EPS);
        GAS unsigned long long* o8 = (GAS unsigned long long*)(o + (size_t)m * DM) + lane;
#pragma unroll
        for (int j = 0; j < 4; ++j) o8[64 * j] = (unsigned long long)cvtpk_bf16(v[j].x * rstd, v[j].y * rstd) | ((unsigned long long)cvtpk_bf16(v[j].z * rstd, v[j].w * rstd) << 32);
#pragma unroll
        for (int j = 0; j < 4; ++j) v[j] = w[j];
    }
}

struct Args { const float* in[21]; float* out; unsigned char* ws; int ph_lo, ph_hi, li, pad; };
enum { I_X = 0, I_N1G, I_WIN, I_CONVW, I_CONVB, I_WR, I_BR, I_WI, I_BI, I_LAM, I_QNG, I_KNG, I_PA, I_PB, I_WOUT, I_N2G, I_WUP, I_WGATE, I_FCW, I_FCB, I_WDN };

__device__ __forceinline__ void p0_prologue(const Args& a, LAS unsigned char* lds, int gw, int NGW, int wave, int lane) {
    LAS float* scr = (LAS float*)(lds + wave * 16896);
    unsigned char* ws = a.ws;
    constexpr int I_IN = 16 * 112, I_SQ = 16 * 16, I_UP = 16 * 44, I_DN = 44 * 16, I_RG = 32;
    constexpr int NITEMS = I_IN + 3 * I_SQ + 2 * I_UP + I_DN + 2 * I_RG;
    for (int it = gw; it < NITEMS; it += NGW) {
        int r = it;
        if (r < I_IN) { p0_transpose_item(a.in[I_WIN], DIN, (bf16*)(ws + WS_WIN), DM, 64 * (r % 112), a.in[I_N1G], scr, r / 112, r % 112, lane); continue; } r -= I_IN;
        if (r < I_SQ) { p0_transpose_item(a.in[I_PA], DM, (bf16*)(ws + WS_PA), DM, 64 * (r % 16), nullptr, scr, r / 16, r % 16, lane); continue; } r -= I_SQ;
        if (r < I_SQ) { p0_transpose_item(a.in[I_PB], DM, (bf16*)(ws + WS_PB), DM, 64 * (r % 16), nullptr, scr, r / 16, r % 16, lane); continue; } r -= I_SQ;
        if (r < I_SQ) { p0_transpose_item(a.in[I_WOUT], DM, (bf16*)(ws + WS_WOUT), DM, 64 * (r % 16), nullptr, scr, r / 16, r % 16, lane); continue; } r -= I_SQ;
        if (r < I_UP) { const int nb = r % 44, n0 = 64 * nb; p0_transpose_item(a.in[I_WUP], DFF, (bf16*)(ws + WS_WUG), DM, 256 * (n0 / 128) + (n0 % 128), a.in[I_N2G], scr, r / 44, nb, lane); continue; } r -= I_UP;
        if (r < I_UP) { const int nb = r % 44, n0 = 64 * nb; p0_transpose_item(a.in[I_WGATE], DFF, (bf16*)(ws + WS_WUG), DM, 256 * (n0 / 128) + 128 + (n0 % 128), a.in[I_N2G], scr, r / 44, nb, lane); continue; } r -= I_UP;
        if (r < I_DN) { p0_transpose_item(a.in[I_WDN], DM, (bf16*)(ws + WS_WDN), DFF, 64 * (r % 16), nullptr, scr, r / 16, r % 16, lane); continue; } r -= I_DN;
        if (r < I_RG) { const int blk = r >> 2, q = r & 3; p0_transpose_item(a.in[I_WR] + blk * 16384, 128, (bf16*)(ws + WS_WR) + blk * 16384, 128, 64 * (q & 1), nullptr, scr, q >> 1, q & 1, lane); continue; } r -= I_RG;
        { const int blk = r >> 2, q = r & 3; p0_transpose_item(a.in[I_WI] + blk * 16384, 128, (bf16*)(ws + WS_WI) + blk * 16384, 128, 64 * (q & 1), nullptr, scr, q >> 1, q & 1, lane); }
    }
    rms_rows_to_bf16(a.in[I_X], (bf16*)(ws + WS_XN), gw, NGW, lane);
    for (int e = gw * 64 + lane; e < 128 * 1024; e += NGW * 64) ((float*)(ws + WS_KM))[e] = 0.f;
}

constexpr int CW_RFLAG = 20480;
__device__ __forceinline__ void rnn_phase(const Args& a, LAS unsigned char* lds, int G, int wave, int lane, int tid, int variant = 0) {
    LAS bf16* XRs = (LAS bf16*)lds;
    LAS bf16* XAb = (LAS bf16*)(lds + 18432);
    LAS bf16* HB = (LAS bf16*)(lds + 18432 + 17408);
    LAS float* CWl = (LAS float*)(lds + 18432 + 2 * 17408);
    const bf16* XR = (const bf16*)(a.ws + WS_XR); const bf16* GR = (const bf16*)(a.ws + WS_GR); bf16* YA = (bf16*)(a.ws + WS_XN);
    gu64* AG = (gu64*)(a.ws + WS_AG); gu32* RFLAG = (gu32*)(a.ws + WS_CTL) + CW_RFLAG;
    const int kq = lane >> 4, fr = lane & 15;
    if (G != 256) return;
    const int w = blockIdx.x, seqi = w & 31, sub = w >> 5, bb = seqi >> 3, n = seqi & 7;
    const int dcol = 16 * wave + fr, ch = n * 128 + dcol;
    LAS unsigned char* WFl = lds + 57344 + wave * 8192;
#pragma unroll
    for (int ks = 0; ks < 4; ++ks) { *(LAS bf16x8*)(WFl + (2 * ks) * 1024 + lane * 16) = *(const GAS bf16x8*)((const bf16*)(a.ws + WS_WR) + (size_t)ch * 128 + 32 * ks + 8 * kq);
                                     *(LAS bf16x8*)(WFl + (2 * ks + 1) * 1024 + lane * 16) = *(const GAS bf16x8*)((const bf16*)(a.ws + WS_WI) + (size_t)ch * 128 + 32 * ks + 8 * kq); }
    const float nbr = -1.4426950408889634f * a.in[I_BR][ch], nbi = -1.4426950408889634f * a.in[I_BI][ch];
    const float sp = log1pf(expf(-a.in[I_LAM][ch]));
    const float c1 = -16.0f * sp, c2 = -8.0f * sp * 1.4426950408889634f;
    const int cg = tid & 15, cc = n * 128 + 8 * cg;
    for (int e = tid; e < 640; e += 512) CWl[e] = (e < 512) ? a.in[I_CONVW][(e >> 7) * 1024 + n * 128 + (e & 127)] : a.in[I_CONVB][n * 128 + (e & 127)];
    float hc = 0.f;
    int cfold = 0;
    v4u pre[3];
    {
        const int rb0 = bb * 32 + sub; const bool seqstart = (sub == 0);
#pragma unroll
        for (int pp = 0; pp < 3; ++pp) { const int p = tid + 512 * pp;
            if (p < 67 * 16) { const int row = p >> 4, c = p & 15; const bool z = seqstart && row < 3; const int srow = z ? rb0 * 256 : rb0 * 256 - 3 + row;
                v4u v = *(const GAS v4u*)(XR + (size_t)srow * DM + n * 128 + 8 * c); if (z) v = (v4u){0u, 0u, 0u, 0u}; pre[pp] = v; } }
    }
#pragma unroll 1
    for (int it = 0; it < 4; ++it) {
        const int chunk = 8 * it + sub, rb = bb * 32 + chunk;
        float av[4][4][4]; unsigned bxp[4][4][2];
        float hl = 0.f, Pa = 1.f;
#pragma unroll
        for (int s = 0; s < 4; ++s) {
            const int r0 = rb * 256 + 64 * s;
#pragma unroll
            for (int pp = 0; pp < 3; ++pp) { const int p = tid + 512 * pp; if (p < 67 * 16) *(LAS v4u*)(XRs + (p >> 4) * 136 + 8 * (p & 15)) = pre[pp]; }
            __syncthreads();
            if (s < 3 || it < 3) {
                const int nr = (s < 3) ? r0 + 64 : r0 - 192 + 2048;
#pragma unroll
                for (int pp = 0; pp < 3; ++pp) { const int p = tid + 512 * pp; if (p < 67 * 16) pre[pp] = *(const GAS v4u*)(XR + (size_t)(nr - 3 + (p >> 4)) * DM + n * 128 + 8 * (p & 15)); }
            }
#pragma unroll
            for (int pp = 0; pp < 2; ++pp) {
                const int tok = (tid >> 4) + 32 * pp;
                f32x4 a0 = *(const LAS f32x4*)(CWl + 512 + 8 * cg), a1 = *(const LAS f32x4*)(CWl + 512 + 8 * cg + 4);
#pragma unroll
                for (int k = 0; k < 4; ++k) { const v4u wv = *(const LAS v4u*)(XRs + (tok + k) * 136 + 8 * cg);
                    const f32x4 c0 = *(const LAS f32x4*)(CWl + k * 128 + 8 * cg), c1v = *(const LAS f32x4*)(CWl + k * 128 + 8 * cg + 4);
                    a0 += c0 * (f32x4){pg8::bflo(wv.x), pg8::bfhi(wv.x), pg8::bflo(wv.y), pg8::bfhi(wv.y)}; a1 += c1v * (f32x4){pg8::bflo(wv.z), pg8::bfhi(wv.z), pg8::bflo(wv.w), pg8::bfhi(wv.w)}; }
                v4u o; o.x = cvtpk_bf16(a0[0], a0[1]); o.y = cvtpk_bf16(a0[2], a0[3]); o.z = cvtpk_bf16(a1[0], a1[1]); o.w = cvtpk_bf16(a1[2], a1[3]);
                *(LAS v4u*)(XAb + tok * 136 + 8 * cg) = o;
            }
            __syncthreads();
            if (variant == 2) { _Pragma("unroll") for (int r_ = 0; r_ < 4; ++r_) { av[s][r_][0] = av[s][r_][1] = av[s][r_][2] = av[s][r_][3] = 1.f; bxp[s][r_][0] = bxp[s][r_][1] = 0u; } continue; }
#pragma unroll
            for (int rt = 0; rt < 4; ++rt) {
                f32x4 aR = {0.f, 0.f, 0.f, 0.f}, aI = {0.f, 0.f, 0.f, 0.f};
#pragma unroll
                for (int ks = 0; ks < 4; ++ks) { const bf16x8 af = *(const LAS bf16x8*)(XAb + (16 * rt + fr) * 136 + 32 * ks + 8 * kq);
                    aR = __builtin_amdgcn_mfma_f32_16x16x32_bf16(af, *(const LAS bf16x8*)(WFl + (2 * ks) * 1024 + lane * 16), aR, 0, 0, 0); aI = __builtin_amdgcn_mfma_f32_16x16x32_bf16(af, *(const LAS bf16x8*)(WFl + (2 * ks + 1) * 1024 + lane * 16), aI, 0, 0, 0); }
                float A = 1.f, H = 0.f; float bxt[4];
                {
                    f32x4 er = aR * (-1.4426950408889634f) + nbr, ei = aI * (-1.4426950408889634f) + nbi;
#pragma unroll
                    for (int rg = 0; rg < 4; ++rg) { er[rg] = __builtin_amdgcn_exp2f(er[rg]); ei[rg] = __builtin_amdgcn_exp2f(ei[rg]); }
                    er = er + 1.0f; ei = ei + 1.0f;
                    f32x4 r, ig;
#pragma unroll
                    for (int rg = 0; rg < 4; ++rg) { r[rg] = __builtin_amdgcn_rcpf(er[rg]); ig[rg] = __builtin_amdgcn_rcpf(ei[rg]); }
                    f32x4 aa = r * c2; const f32x4 x = r * c1;
#pragma unroll
                    for (int rg = 0; rg < 4; ++rg) aa[rg] = __builtin_amdgcn_exp2f(aa[rg]);
                    f32x4 poly = x * 0.2f + 1.0f; poly = poly * (x * 0.25f) + 1.0f; poly = poly * (x * (1.0f / 3.0f)) + 1.0f; poly = poly * (x * 0.5f) + 1.0f; poly = poly * (-x);
                    const f32x4 alt = 1.0f - aa * aa;
                    f32x4 em1, xa;
#pragma unroll
                    for (int rg = 0; rg < 4; ++rg) { em1[rg] = (x[rg] > -0.25f) ? poly[rg] : alt[rg]; xa[rg] = pg8::bf2f(XAb[(16 * rt + 4 * kq + rg) * 136 + dcol]); }
#pragma unroll
                    for (int rg = 0; rg < 4; ++rg) em1[rg] = __builtin_amdgcn_sqrtf(em1[rg]);
                    const f32x4 bv = em1 * ig * xa;
#pragma unroll
                    for (int rg = 0; rg < 4; ++rg) { av[s][rt][rg] = aa[rg]; bxt[rg] = bv[rg]; H = aa[rg] * H + bv[rg]; A *= aa[rg]; }
                }
                bxp[s][rt][0] = cvtpk_bf16(bxt[0], bxt[1]); bxp[s][rt][1] = cvtpk_bf16(bxt[2], bxt[3]);
                { const float A1 = __shfl_up(A, 16), H1 = __shfl_up(H, 16); if (kq >= 1) { H = A * H1 + H; A = A1 * A; } }
                { const float A2 = __shfl_up(A, 32), H2 = __shfl_up(H, 32); if (kq >= 2) { H = A * H2 + H; A = A2 * A; } }
                const float At = __shfl(A, 48 + fr), Ht = __shfl(H, 48 + fr);
                hl = At * hl + Ht; Pa *= At;
            }
        }
        if (kq == 0) __hip_atomic_store(AG + (size_t)rb * 1024 + ch, ((unsigned long long)__float_as_uint(hl) << 32) | __float_as_uint(Pa), RLX_AGENT);
        asm volatile("s_waitcnt vmcnt(0)" ::: "memory");
        __syncthreads();
        if (tid == 0) __hip_atomic_store(RFLAG + rb * 8 + n, 1u, RLX_AGENT);
        if (wave == 0) {
            unsigned spins = 0;
            for (;;) {
                const unsigned f = (lane >= cfold && lane < chunk) ? __hip_atomic_load(RFLAG + (bb * 32 + lane) * 8 + n, RLX_AGENT) : 1u;
                if (__all(f != 0u)) break;
                __builtin_amdgcn_s_sleep(2);
                if (++spins > (1u << 22)) break;
            }
        }
        __syncthreads();
        {
#pragma unroll
            for (int j0 = 0; j0 < 8; j0 += 4) { unsigned long long ah[4];
#pragma unroll
                for (int j = 0; j < 4; ++j) { const int ci = (cfold + j0 + j < chunk) ? cfold + j0 + j : (chunk > 0 ? chunk - 1 : 0); ah[j] = __hip_atomic_load(AG + (size_t)(bb * 32 + ci) * 1024 + ch, RLX_AGENT); }
#pragma unroll
                for (int j = 0; j < 4; ++j) if (cfold + j0 + j < chunk) hc = __uint_as_float((unsigned)ah[j]) * hc + __uint_as_float((unsigned)(ah[j] >> 32)); }
            cfold = chunk;
        }
        if (variant >= 1) { asm volatile("" :: "v"(hc)); _Pragma("unroll") for (int s_ = 0; s_ < 4; ++s_) _Pragma("unroll") for (int r_ = 0; r_ < 4; ++r_) { asm volatile("" :: "v"(av[s_][r_][0]), "v"(av[s_][r_][3]), "v"(bxp[s_][r_][0]), "v"(bxp[s_][r_][1])); } __syncthreads(); continue; }
        float hs = hc;
#pragma unroll
        for (int s = 0; s < 4; ++s) {
            const int r0 = rb * 256 + 64 * s;
            v4u gpre[2];
#pragma unroll
            for (int pp = 0; pp < 2; ++pp) gpre[pp] = *(const GAS v4u*)(GR + (size_t)(r0 + (tid >> 4) + 32 * pp) * DM + cc);
#pragma unroll
            for (int rt = 0; rt < 4; ++rt) {
                float A = 1.f, H = 0.f;
                const float bxv[4] = { pg8::bflo(bxp[s][rt][0]), pg8::bfhi(bxp[s][rt][0]), pg8::bflo(bxp[s][rt][1]), pg8::bfhi(bxp[s][rt][1]) };
#pragma unroll
                for (int rg = 0; rg < 4; ++rg) { H = av[s][rt][rg] * H + bxv[rg]; A *= av[s][rt][rg]; }
                float At = 1.f, Ht = 0.f, Ae = 1.f, He = 0.f;
#pragma unroll
                for (int q = 0; q < 4; ++q) { const float Aq = __shfl(A, 16 * q + fr), Hq = __shfl(H, 16 * q + fr);
                    Ae = (q == kq) ? At : Ae; He = (q == kq) ? Ht : He; Ht = Aq * Ht + Hq; At *= Aq; }
                float h = Ae * hs + He;
#pragma unroll
                for (int rg = 0; rg < 4; ++rg) { h = av[s][rt][rg] * h + bxv[rg]; HB[(16 * rt + 4 * kq + rg) * 136 + dcol] = (bf16)cvtpk_bf16(h, h); }
                hs = At * hs + Ht;
            }
            __syncthreads();
#pragma unroll
            for (int pp = 0; pp < 2; ++pp) {
                const int tok = (tid >> 4) + 32 * pp;
                const v4u hw = *(const LAS v4u*)(HB + tok * 136 + 8 * cg);
                const v4u gw = gpre[pp];
                v4u o; o.x = cvtpk_bf16(pg8::bflo(hw.x) * pg8::bflo(gw.x), pg8::bfhi(hw.x) * pg8::bfhi(gw.x)); o.y = cvtpk_bf16(pg8::bflo(hw.y) * pg8::bflo(gw.y), pg8::bfhi(hw.y) * pg8::bfhi(gw.y));
                o.z = cvtpk_bf16(pg8::bflo(hw.z) * pg8::bflo(gw.z), pg8::bfhi(hw.z) * pg8::bfhi(gw.z)); o.w = cvtpk_bf16(pg8::bflo(hw.w) * pg8::bflo(gw.w), pg8::bfhi(hw.w) * pg8::bfhi(gw.w));
                *(GAS v4u*)(YA + (size_t)(r0 + tok) * DM + cc) = o;
            }
            __syncthreads();
        }
        hc = Pa * hc + hl; cfold = chunk + 1;
    }
}
typedef short s16x4 __attribute__((ext_vector_type(4)));
typedef float f32x16 __attribute__((ext_vector_type(16)));
typedef short v4i16_t __attribute__((ext_vector_type(4)));
constexpr size_t WS_PART = 304 * MiB, WS_LIST = 496 * MiB, WS_LP = 42 * MiB;
constexpr int CW_CNT = 16384;
constexpr int LIST_PER_BH = 256 * 496;
__device__ __forceinline__ int list_off(int n) { return 256 * (31 * n - (n * (n - 1)) / 2); }
__device__ __forceinline__ unsigned cvtpk(float lo, float hi) { unsigned r; asm volatile("v_cvt_pk_bf16_f32 %0, %1, %2" : "=v"(r) : "v"(lo), "v"(hi)); return r; }
__device__ __forceinline__ s16x4 vtr(const LAS unsigned char* p) { return __builtin_bit_cast(s16x4, __builtin_amdgcn_ds_read_tr16_b64_v4i16((LAS v4i16_t*)p)); }

__device__ __forceinline__ void load_kv_block(LAS unsigned char* lds, const bf16* Kg, const bf16* Vg, size_t row0, int hh, int wave, int lane) {
#pragma unroll
    for (int i = 0; i < 8; ++i) {
        const int I = wave * 8 + i;
        { const int r = 4 * I + (lane >> 4), cp = lane & 15, c = cp ^ (r & 15);
          __builtin_amdgcn_global_load_lds((const unsigned*)(Kg + (row0 + r) * DM + hh * HD + 8 * c), (LAS unsigned*)(lds + I * 1024), 16, 0, 0); }
        { const int dt = lane >> 4, q = (lane >> 2) & 3, c8 = lane & 3;
          __builtin_amdgcn_global_load_lds((const unsigned*)(Vg + (row0 + 4 * I + q) * DM + hh * HD + 32 * dt + 8 * c8), (LAS unsigned*)(lds + 65536 + I * 1024), 16, 0, 0); }
    }
}

__device__ __forceinline__ void attn_wave(const LAS unsigned char* lds, const bf16x8 (&qf)[8], f32x16 (&O)[4], float& lsum, int kt_hi, int diag, int lane) {
    const int h2 = lane >> 5, kr = lane & 31;
    unsigned kaddr[8];
#pragma unroll
    for (int s = 0; s < 8; ++s) kaddr[s] = (unsigned)(kr * 256 + (((2 * s + h2) ^ (lane & 15)) * 16));
    const LAS unsigned char* vb = lds + 65536 + h2 * 1024 + ((lane >> 2) & 3) * 64 + ((lane >> 4) & 1) * 32 + (lane & 3) * 8;
#pragma unroll 1
    for (int kt = 0; kt < kt_hi; ++kt) {
        f32x16 S;
#pragma unroll
        for (int r = 0; r < 16; ++r) S[r] = 0.f;
#pragma unroll
        for (int s = 0; s < 8; ++s) { const bf16x8 kf = *(const LAS bf16x8*)(lds + kt * 8192 + kaddr[s]); S = __builtin_amdgcn_mfma_f32_32x32x16_bf16(kf, qf[s], S, 0, 0, 0); }
        float P[16];
#pragma unroll
        for (int r = 0; r < 16; ++r) P[r] = __builtin_amdgcn_exp2f(S[r]);
        if (kt == diag) {
#pragma unroll
            for (int r = 0; r < 16; ++r) { const int kl = (r & 3) + 8 * (r >> 2) + 4 * h2; P[r] = (kl <= kr) ? P[r] : 0.f; }
        }
        float ls = 0.f;
#pragma unroll
        for (int r = 0; r < 16; ++r) ls += P[r];
        lsum += ls;
        v4u pw0, pw1;
        pw0.x = cvtpk(P[0], P[1]); pw0.y = cvtpk(P[2], P[3]); pw0.z = cvtpk(P[4], P[5]); pw0.w = cvtpk(P[6], P[7]);
        pw1.x = cvtpk(P[8], P[9]); pw1.y = cvtpk(P[10], P[11]); pw1.z = cvtpk(P[12], P[13]); pw1.w = cvtpk(P[14], P[15]);
        const bf16x8 pb0 = __builtin_bit_cast(bf16x8, pw0), pb1 = __builtin_bit_cast(bf16x8, pw1);
        const LAS unsigned char* vk = vb + kt * 8192;
#pragma unroll
        for (int dt = 0; dt < 4; ++dt) {
            { const s16x4 lo = vtr(vk + dt * 256), hi = vtr(vk + dt * 256 + 2048);
              const bf16x8 vf = (bf16x8){lo[0], lo[1], lo[2], lo[3], hi[0], hi[1], hi[2], hi[3]};
              O[dt] = __builtin_amdgcn_mfma_f32_32x32x16_bf16(vf, pb0, O[dt], 0, 0, 0); }
            { const s16x4 lo = vtr(vk + 4096 + dt * 256), hi = vtr(vk + 4096 + dt * 256 + 2048);
              const bf16x8 vf = (bf16x8){lo[0], lo[1], lo[2], lo[3], hi[0], hi[1], hi[2], hi[3]};
              O[dt] = __builtin_amdgcn_mfma_f32_32x32x16_bf16(vf, pb1, O[dt], 0, 0, 0); }
        }
    }
}

__device__ __forceinline__ void q_unstage(LAS unsigned char* stg, const v4u (&qs)[8], bf16x8 (&qf)[8], int lane) {
    const int ra = lane >> 2, rb2 = ra + 16, part = lane & 3, h2 = lane >> 5, kr = lane & 31;
#pragma unroll
    for (int p = 0; p < 4; ++p) {
        *(LAS v4u*)(stg + ra * 80 + part * 16) = qs[2 * p]; *(LAS v4u*)(stg + rb2 * 80 + part * 16) = qs[2 * p + 1];
        asm volatile("s_waitcnt lgkmcnt(0)" ::: "memory");
        qf[2 * p] = *(const LAS bf16x8*)(stg + kr * 80 + h2 * 16); qf[2 * p + 1] = *(const LAS bf16x8*)(stg + kr * 80 + 32 + h2 * 16);
        asm volatile("s_waitcnt lgkmcnt(0)" ::: "memory");
    }
}
__device__ __forceinline__ void gate_phase(const Args& a, LAS unsigned char* lds, int vcu, int wave, int lane, int tid, int variant = 0) {
    LAS unsigned* lcnt = (LAS unsigned*)lds; LAS unsigned* gbase = lcnt + 32;
    const bf16* Qg = (const bf16*)(a.ws + WS_Q); const float* KM = (const float*)(a.ws + WS_KM);
    unsigned* CNT = (unsigned*)(a.ws + WS_CTL) + CW_CNT; unsigned* LIST = (unsigned*)(a.ws + WS_LIST);
    const int h2 = lane >> 5, kr = lane & 31;
#pragma unroll 1
    for (int ui = 0; ui < 4; ++ui) {
        const int unit = vcu * 4 + ui, bh = unit >> 5, qb = unit & 31, bb = bh >> 3, hh = bh & 7;
        const size_t rowbase = (size_t)bb * SEQ; const int tq = qb * 256 + 32 * wave + kr;
        if (tid < 32) lcnt[tid] = 0u;
        __syncthreads();
        const float* kmp = KM + ((size_t)(bb * 32 + kr) * 8 + hh) * 128 + 8 * h2;
        const bf16* qp = Qg + (rowbase + tq) * DM + hh * HD + 8 * h2;
        f32x16 acc;
#pragma unroll
        for (int r = 0; r < 16; ++r) acc[r] = 0.f;
#pragma unroll
        for (int s = 0; s < 8; ++s) {
            const f32x4 k0 = *(const GAS f32x4*)(kmp + 16 * s), k1 = *(const GAS f32x4*)(kmp + 16 * s + 4);
            const float kv[8] = {k0[0], k0[1], k0[2], k0[3], k1[0], k1[1], k1[2], k1[3]};
            unsigned hi[4], lo[4];
#pragma unroll
            for (int j = 0; j < 4; ++j) { const unsigned h0 = f2bf(kv[2 * j]), h1 = f2bf(kv[2 * j + 1]); hi[j] = h0 | (h1 << 16);
                lo[j] = pk2(kv[2 * j] - __builtin_bit_cast(float, h0 << 16), kv[2 * j + 1] - __builtin_bit_cast(float, h1 << 16)); }
            const bf16x8 ahi = __builtin_bit_cast(bf16x8, (v4u){hi[0], hi[1], hi[2], hi[3]}), alo = __builtin_bit_cast(bf16x8, (v4u){lo[0], lo[1], lo[2], lo[3]});
            const bf16x8 bq = *(const GAS bf16x8*)(qp + 16 * s);
            acc = __builtin_amdgcn_mfma_f32_32x32x16_bf16(ahi, bq, acc, 0, 0, 0); acc = __builtin_amdgcn_mfma_f32_32x32x16_bf16(alo, bq, acc, 0, 0, 0);
        }
        unsigned mask = 0u; int seln[3] = {0, 0, 0}; unsigned pos[3] = {0u, 0u, 0u};
#pragma unroll
        for (int r3 = 0; r3 < 3; ++r3) {
            if (r3 < qb) { float best = -3.0e38f; int bi = 64;
#pragma unroll
                for (int r = 0; r < 16; ++r) { const int blk = (r & 3) + 8 * (r >> 2) + 4 * h2; const bool ok = (blk < qb) && !((mask >> blk) & 1u) && (acc[r] > best); best = ok ? acc[r] : best; bi = ok ? blk : bi; }
                const float ob = __shfl_xor(best, 32); const int oi = __shfl_xor(bi, 32);
                const bool take = (ob > best) || (ob == best && oi < bi);
                bi = take ? oi : bi; bi &= 31;
                mask |= 1u << bi; seln[r3] = bi;
                if (h2 == 0) pos[r3] = __hip_atomic_fetch_add(lcnt + bi, 1u, __ATOMIC_RELAXED, __HIP_MEMORY_SCOPE_WORKGROUP); }
        }
        __syncthreads();
        if (tid < 32) { const unsigned c = lcnt[tid]; gbase[tid] = (c && !variant) ? atomicAdd(CNT + bh * 32 + tid, c) : 0u; }
        __syncthreads();
        if (h2 == 0 && !variant) {
#pragma unroll
            for (int r3 = 0; r3 < 3; ++r3) if (r3 < qb) LIST[(size_t)bh * LIST_PER_BH + list_off(seln[r3]) + gbase[seln[r3]] + pos[r3]] = ((unsigned)tq << 2) | (unsigned)r3;
        }
        __syncthreads();
    }
}

__device__ __forceinline__ void sparse_phase(const Args& a, LAS unsigned char* lds, int G, int wave, int lane, int tid, int variant = 0) {
    LAS unsigned* cntl = (LAS unsigned*)(lds + 131072 + 1024);
    LAS unsigned* pre = cntl + 1024;
    const bf16* Qg = (const bf16*)(a.ws + WS_Q); const bf16* Kg = (const bf16*)(a.ws + WS_K); const bf16* Vg = (const bf16*)(a.ws + WS_V);
    const unsigned* CNT = (const unsigned*)(a.ws + WS_CTL) + CW_CNT; const unsigned* LIST = (const unsigned*)(a.ws + WS_LIST);
    bf16* PART = (bf16*)(a.ws + WS_PART); float* LP = (float*)(a.ws + WS_LP);
    const int h2 = lane >> 5, kr = lane & 31;
    for (int i = tid; i < 1024; i += 512) cntl[i] = __hip_atomic_load(CNT + i, __ATOMIC_RELAXED, __HIP_MEMORY_SCOPE_AGENT);
    __syncthreads();
    if (wave == 0) {
        unsigned loc[16]; unsigned s = 0u;
#pragma unroll
        for (int j = 0; j < 16; ++j) { loc[j] = s; s += (cntl[16 * lane + j] + 255u) >> 8; }
        unsigned inc = s;
#pragma unroll
        for (int o = 1; o < 64; o <<= 1) { const unsigned t = __shfl_up(inc, o); if (lane >= o) inc += t; }
        const unsigned exc = inc - s;
#pragma unroll
        for (int j = 0; j < 16; ++j) pre[16 * lane + j] = exc + loc[j];
        if (lane == 63) pre[1024] = inc;
    }
    __syncthreads();
    const unsigned T = pre[1024];
    const unsigned lo = (unsigned)(((unsigned long long)blockIdx.x * T) / (unsigned)G), hi = (unsigned)(((unsigned long long)(blockIdx.x + 1) * T) / (unsigned)G);
    if (lo >= hi) return;
    int li = 0;
    { int a0 = 0, b0 = 1024; while (b0 - a0 > 1) { const int m = (a0 + b0) >> 1; if (pre[m] <= lo) a0 = m; else b0 = m; } li = a0; }
#define SP_ENTRY(LI, K2) ({ const int bh_ = (LI) >> 5, nn_ = (LI) & 31; const int idx_ = 256 * (K2) + 32 * wave + kr; (idx_ < (int)cntl[LI]) ? LIST[(size_t)bh_ * LIST_PER_BH + list_off(nn_) + idx_] : 0xffffffffu; })
#define SP_QROW(LI, E) (Qg + ((size_t)((LI) >> 8) * SEQ + (((E) == 0xffffffffu) ? 0u : ((E) >> 2))) * DM + (((LI) >> 5) & 7) * HD + 8 * (lane & 3))
#define SP_QLOAD(DST, LI, E) do { const unsigned ea_ = __shfl((E), lane >> 2), eb_ = __shfl((E), (lane >> 2) + 16); const bf16* qa_ = SP_QROW(LI, ea_); const bf16* qb_ = SP_QROW(LI, eb_); \
        _Pragma("unroll") for (int p_ = 0; p_ < 4; ++p_) { DST[2 * p_] = *(const GAS v4u*)(qa_ + 32 * p_); DST[2 * p_ + 1] = *(const GAS v4u*)(qb_ + 32 * p_); } } while (0)
    int l1 = li, l2, l3;
    unsigned t1 = lo;
    while (t1 >= pre[l1 + 1]) ++l1;
    l2 = l1; if (lo + 1 < hi) { while (lo + 1 >= pre[l2 + 1]) ++l2; }
    unsigned e1 = SP_ENTRY(l1, (int)(lo - pre[l1]));
    unsigned e2 = (lo + 1 < hi) ? SP_ENTRY(l2, (int)(lo + 1 - pre[l2])) : 0xffffffffu;
    LAS unsigned char* stg = lds + 131072 + 10240 + wave * 2560;
    v4u qs[8];
    SP_QLOAD(qs, l1, e1);
    int cur = -1;
#pragma unroll 1
    for (unsigned tile = lo; tile < hi; ++tile) {
        const int k = (int)(tile - pre[l1]); const int cnt = (int)cntl[l1];
        const int bh = l1 >> 5, nn = l1 & 31, bb = bh >> 3, hh = bh & 7; const size_t rowbase = (size_t)bb * SEQ;
        if (l1 != cur) {
            __syncthreads();
            if (variant != 4 || cur < 0) load_kv_block(lds, Kg, Vg, rowbase + (size_t)nn * 256, hh, wave, lane);
            asm volatile("s_waitcnt vmcnt(0)" ::: "memory");
            __syncthreads();
            cur = l1;
        }
        bf16x8 qf[8];
        q_unstage(stg, qs, qf, lane);
        unsigned e3 = 0xffffffffu; l3 = l2;
        if (tile + 1 < hi && variant != 5) SP_QLOAD(qs, l2, e2);
        if (tile + 2 < hi) { while (tile + 2 >= pre[l3 + 1]) ++l3; e3 = SP_ENTRY(l3, (int)(tile + 2 - pre[l3])); }
        const int idx0 = 256 * k + 32 * wave;
        if (idx0 < cnt) {
            const bool valid = (e1 != 0xffffffffu);
            const int t = (int)(e1 >> 2), j = (int)(e1 & 3u);
            f32x16 O[4];
#pragma unroll
            for (int dt = 0; dt < 4; ++dt)
#pragma unroll
                for (int r = 0; r < 16; ++r) O[dt][r] = 0.f;
            float lsum = 0.f;
            if (variant != 1) attn_wave(lds, qf, O, lsum, variant == 2 ? 4 : 8, -1, lane);
            lsum += __shfl_xor(lsum, 32);
            if (variant) {
#pragma unroll
                for (int dt = 0; dt < 4; ++dt)
#pragma unroll
                    for (int r = 0; r < 16; ++r) asm volatile("" :: "v"(O[dt][r]));
                asm volatile("" :: "v"(lsum));
            }
            if (variant == 0 || variant == 3) {
                const int psl = valid ? (int)(((unsigned)bh * SEQ + (unsigned)t) * 3u + (unsigned)j) : -1;
                if (valid && h2 == 0) LP[psl] = lsum;
                const int ra = lane >> 2, rb2 = ra + 16, part = lane & 3;
                const int psa = __shfl(psl, ra), psb = __shfl(psl, rb2);
#pragma unroll
                for (int dt = 0; dt < 4; ++dt) {
#pragma unroll
                    for (int rq = 0; rq < 4; ++rq) { const unsigned long long w = (unsigned long long)cvtpk(O[dt][4 * rq], O[dt][4 * rq + 1]) | ((unsigned long long)cvtpk(O[dt][4 * rq + 2], O[dt][4 * rq + 3]) << 32);
                        *(LAS unsigned long long*)(stg + kr * 80 + rq * 16 + h2 * 8) = w; }
                    asm volatile("s_waitcnt lgkmcnt(0)" ::: "memory");
                    const v4u ca = *(const LAS v4u*)(stg + ra * 80 + part * 16), cb2 = *(const LAS v4u*)(stg + rb2 * 80 + part * 16);
                    if (psa >= 0) *(GAS v4u*)(PART + (size_t)psa * 128 + dt * 32 + part * 8) = ca;
                    if (psb >= 0) *(GAS v4u*)(PART + (size_t)psb * 128 + dt * 32 + part * 8) = cb2;
                    asm volatile("s_waitcnt lgkmcnt(0)" ::: "memory");
                }
            }
        }
        e1 = e2; e2 = e3; l1 = l2; l2 = l3;
    }
#undef SP_ENTRY
#undef SP_QROW
#undef SP_QLOAD
}

__device__ __forceinline__ void own_phase(const Args& a, LAS unsigned char* lds, int vcu, int wave, int lane, int tid, int variant = 0) {
    bf16* Qg = (bf16*)(a.ws + WS_Q); const bf16* Kg = (const bf16*)(a.ws + WS_K); const bf16* Vg = (const bf16*)(a.ws + WS_V);
    const bf16* PART = (const bf16*)(a.ws + WS_PART); const float* LP = (const float*)(a.ws + WS_LP);
    const int h2 = lane >> 5, kr = lane & 31;
    LAS unsigned char* stg = lds + 131072 + 10240 + wave * 2560;
    const int ra = lane >> 2, rb2 = ra + 16, part = lane & 3;
#pragma unroll 1
    for (int ui = 0; ui < 4; ++ui) {
        const int unit = vcu * 4 + ui, bh = unit >> 5, qb = unit & 31, bb = bh >> 3, hh = bh & 7;
        const size_t rowbase = (size_t)bb * SEQ; const int t0 = qb * 256 + 32 * wave, t = t0 + kr;
        __syncthreads();
        load_kv_block(lds, Kg, Vg, rowbase + (size_t)qb * 256, hh, wave, lane);
        bf16* qp = Qg + (rowbase + t) * DM + hh * HD;
        v4u qs[8];
        { const bf16* qa_ = Qg + (rowbase + t0 + ra) * DM + hh * HD + 8 * part; const bf16* qb_ = Qg + (rowbase + t0 + rb2) * DM + hh * HD + 8 * part;
#pragma unroll
          for (int p_ = 0; p_ < 4; ++p_) { qs[2 * p_] = *(const GAS v4u*)(qa_ + 32 * p_); qs[2 * p_ + 1] = *(const GAS v4u*)(qb_ + 32 * p_); } }
        const int nsel = qb < 3 ? qb : 3;
        const size_t psa = ((size_t)bh * SEQ + t0 + ra) * 3, psb = ((size_t)bh * SEQ + t0 + rb2) * 3;
        float lp[3] = {0.f, 0.f, 0.f};
#pragma unroll
        for (int j = 0; j < 3; ++j) if (j < nsel) lp[j] = LP[((size_t)bh * SEQ + t) * 3 + j];
        asm volatile("s_waitcnt vmcnt(0)" ::: "memory");
        __syncthreads();
        bf16x8 qf[8];
        q_unstage(stg, qs, qf, lane);
        f32x16 O[4];
#pragma unroll
        for (int dt = 0; dt < 4; ++dt)
#pragma unroll
            for (int r = 0; r < 16; ++r) O[dt][r] = 0.f;
        float lsum = 0.f;
        attn_wave(lds, qf, O, lsum, wave + 1, wave, lane);
        lsum += __shfl_xor(lsum, 32);
        lsum += (lp[0] + lp[1]) + lp[2];
#pragma unroll 1
        for (int j = 0; j < nsel; ++j) {
            v4u pa[8];
#pragma unroll
            for (int dt = 0; dt < 4; ++dt) { pa[2 * dt] = *(const GAS v4u*)(PART + (psa + j) * 128 + dt * 32 + part * 8); pa[2 * dt + 1] = *(const GAS v4u*)(PART + (psb + j) * 128 + dt * 32 + part * 8); }
#pragma unroll
            for (int dt = 0; dt < 4; ++dt) {
                *(LAS v4u*)(stg + ra * 80 + part * 16) = pa[2 * dt]; *(LAS v4u*)(stg + rb2 * 80 + part * 16) = pa[2 * dt + 1];
                asm volatile("s_waitcnt lgkmcnt(0)" ::: "memory");
#pragma unroll
                for (int rq = 0; rq < 4; ++rq) { const unsigned long long w = *(const LAS unsigned long long*)(stg + kr * 80 + rq * 16 + h2 * 8); const unsigned w0 = (unsigned)w, w1 = (unsigned)(w >> 32);
                    O[dt][4 * rq] += pg8::bflo(w0); O[dt][4 * rq + 1] += pg8::bfhi(w0); O[dt][4 * rq + 2] += pg8::bflo(w1); O[dt][4 * rq + 3] += pg8::bfhi(w1); }
                asm volatile("s_waitcnt lgkmcnt(0)" ::: "memory");
            }
        }
        const float inv = 1.0f / lsum;
        bf16* ya = Qg + (rowbase + t0 + ra) * DM + hh * HD; bf16* yb = Qg + (rowbase + t0 + rb2) * DM + hh * HD;
#pragma unroll
        for (int dt = 0; dt < 4; ++dt) {
#pragma unroll
            for (int rq = 0; rq < 4; ++rq) { const unsigned long long w = (unsigned long long)cvtpk(O[dt][4 * rq] * inv, O[dt][4 * rq + 1] * inv) | ((unsigned long long)cvtpk(O[dt][4 * rq + 2] * inv, O[dt][4 * rq + 3] * inv) << 32);
                *(LAS unsigned long long*)(stg + kr * 80 + rq * 16 + h2 * 8) = w; }
            asm volatile("s_waitcnt lgkmcnt(0)" ::: "memory");
            const v4u ca = *(const LAS v4u*)(stg + ra * 80 + part * 16), cb2 = *(const LAS v4u*)(stg + rb2 * 80 + part * 16);
            if (variant) { asm volatile("" :: "v"(ca), "v"(cb2)); } else { *(GAS v4u*)(ya + dt * 32 + part * 8) = ca; *(GAS v4u*)(yb + dt * 32 + part * 8) = cb2; }
            asm volatile("s_waitcnt lgkmcnt(0)" ::: "memory");
        }
    }
}
__device__ __forceinline__ void fix_phase(const Args& a, int gtid, int NT) {
    const float* SB = (const float*)(a.ws + WS_SB); const float* SU0 = (const float*)(a.ws + WS_SU0); const float* SG0 = (const float*)(a.ws + WS_SG0);
    bf16* ACT = (bf16*)(a.ws + WS_ACT); const float* cw = a.in[I_FCW]; const float* cb = a.in[I_FCB];
    for (int e = gtid; e < 128 * 2 * DFF; e += NT) {
        const int col = e % DFF, r = (e / DFF) & 1, pm = e / (2 * DFF);
        const bool first = (pm & 31) == 0;
        const float up0 = SU0[((size_t)pm * 2 + r) * DFF + col], gt = SG0[((size_t)pm * 2 + r) * DFF + col];
        const float pl1 = first ? 0.f : SB[((size_t)(pm - (first ? 0 : 1)) * 2 + 1) * DFF + col], pl0 = first ? 0.f : SB[((size_t)(pm - (first ? 0 : 1)) * 2 + 0) * DFF + col];
        const float x1 = (r == 0) ? pl1 : SU0[((size_t)pm * 2 + 0) * DFF + col];
        const float x2 = (r == 0) ? pl0 : pl1;
        const float c = cb[col] + cw[2 * DFF + col] * up0 + cw[DFF + col] * x1 + cw[col] * x2;
        ACT[((size_t)pm * 256 + r) * DFF + col] = (bf16)f2bf(pg8::gelu_tanh(c) * gt);
    }
}

template <int PV> __global__ void __launch_bounds__(NWAVES * 64, 2) mk_fwd(Args args) {
    extern __shared__ __attribute__((aligned(16))) unsigned char lds_raw[];
    LAS unsigned char* lds = (LAS unsigned char*)lds_raw;
    volatile LAS unsigned* MISC = (volatile LAS unsigned*)(lds + MISC_OFF);
    const int tid = threadIdx.x, lane = tid & 63, wave = __builtin_amdgcn_readfirstlane(tid >> 6);
    const int G = gridDim.x; const int bx = blockIdx.x; const int vcu = (G % 8 == 0) ? (bx % 8) * (G / 8) + bx / 8 : bx;
    unsigned char* ws = args.ws;
    gu32* ctl = (gu32*)(ws + WS_CTL);
    for (int u = tid; u < (LDS_BYTES - 131072) / 4; u += NWAVES * 64) ((LAS unsigned*)(lds + 131072))[u] = 0u;
    __syncthreads();
    XcdBarrier bar; bar.bar = (unsigned*)(ctl + CW_BAR); bar.x = 0; bar.st = nullptr;
    if (MK_ONE_LAUNCH) bar = xcd_barrier_post((unsigned*)(ctl + CW_BAR), MISC + 8);
    const int lo = args.ph_lo, hi = args.ph_hi;
    const int tid0 = tid;
#ifndef WGM_G1
#define WGM_G1 4
#endif
#ifndef WGM_G5
#define WGM_G5 4
#endif
#ifndef PROBE_DUP
#define PROBE_DUP 0
#endif
#ifndef PROBE_VARIANT
#define PROBE_VARIANT 0
#endif
#define LAUNDER() int tid = tid0; asm volatile("" : "+v"(tid)); const int lane = tid & 63; (void)lane
#ifndef PH_MASK
#define PH_MASK 0xffff
#endif
#define IN(k) (((PH_MASK >> (k)) & 1) && lo <= (k) && (k) < hi)
#define SEAM(k) do { if (IN(k) && IN((k) + 1)) xcd_barrier(bar); } while (0)
    const int gw = vcu * NWAVES + wave, NGW = G * NWAVES;
    bf16* XN = (bf16*)(ws + WS_XN); bf16* XR = (bf16*)(ws + WS_XR); bf16* GR = (bf16*)(ws + WS_GR);
    bf16* Qb = (bf16*)(ws + WS_Q); bf16* Kb = (bf16*)(ws + WS_K); bf16* Vb = (bf16*)(ws + WS_V);
    bf16* GA = (bf16*)args.out; bf16* GB = (bf16*)args.out + (size_t)M * DM;

    if (IN(0)) { LAUNDER(); p0_prologue(args, lds, gw, NGW, wave, lane); } SEAM(0);
    if (IN(1)) { LAUNDER();
        pg8::Gemm g{XN, (const bf16*)(ws + WS_WIN), M, DIN, DM, nullptr, nullptr}; pg8::StaticOrder S; S.init(M, DIN, G, bx, WGM_G1);
        pg8::EpiG1 E{XR, GR, Qb, Kb, Vb, GA, GB, args.in[I_QNG], args.in[I_KNG], (float*)(ws + WS_KM), (LAS float*)(lds + 131072 + 1024), QSCALE, PV};
        pg8::gemm_phase<pg8::EpiG1, pg8::StaticOrder, true, true>(lds, g, S, E); } SEAM(1);
    if (IN(3)) { LAUNDER(); rnn_phase(args, lds, G, wave, lane, tid, PV); } SEAM(3);
    if (IN(5)) { LAUNDER(); gate_phase(args, lds, vcu, wave, lane, tid, PV); } SEAM(5);
    if (IN(6)) { LAUNDER(); sparse_phase(args, lds, G, wave, lane, tid, PV); } SEAM(6);
    if (IN(7)) { LAUNDER(); own_phase(args, lds, vcu, wave, lane, tid, PV); } SEAM(7);
    if (IN(8)) { LAUNDER(); pg8::Gemm g{XN  , (const bf16*)(ws + WS_PA), M, DM, DM, Qb  , (const bf16*)(ws + WS_PB)}; pg8::DualOrder S; S.init(M, DM, G, bx);
        pg8::EpiG3 E{GA, GB, Kb  };
        pg8::gemm_phase<pg8::EpiG3, pg8::DualOrder, true, true>(lds, g, S, E); } SEAM(8);
    if (IN(10)) { LAUNDER();
        pg8::Gemm g{Kb  , (const bf16*)(ws + WS_WOUT), M, DM, DM, nullptr, nullptr}; pg8::StaticOrder S; S.init(M, DM, G, bx);
        pg8::EpiX1 E{args.in[I_X], XN  , (float*)(ws + WS_RSP), (LAS float*)(lds + 131072 + 1024)};
        pg8::gemm_phase<pg8::EpiX1, pg8::StaticOrder, true, true>(lds, g, S, E); } SEAM(10);
    if (IN(12)) { LAUNDER(); pg8::Gemm g{XN  , (const bf16*)(ws + WS_WUG), M, 2 * DFF, DM, nullptr, nullptr}; pg8::StaticOrder S; S.init(M, 2 * DFF, G, bx, WGM_G5);
        pg8::EpiUGF E{(bf16*)(ws + WS_ACT), args.in[I_FCW], args.in[I_FCB], (float*)(ws + WS_SB), (float*)(ws + WS_SU0), (float*)(ws + WS_SG0), (LAS float*)(lds + 131072 + 1024), (const float*)(ws + WS_RSP), PV};
        pg8::gemm_phase<pg8::EpiUGF, pg8::StaticOrder, true, true>(lds, g, S, E); } SEAM(12);
    if (IN(13)) { LAUNDER(); fix_phase(args, vcu * 512 + tid, G * 512); } SEAM(13);
    if (IN(14)) { LAUNDER(); pg8::Gemm g{(const bf16*)(ws + WS_ACT), (const bf16*)(ws + WS_WDN), M, DM, DFF, nullptr, nullptr}; pg8::StaticOrder S; S.init(M, DM, G, bx);
        pg8::EpiOut E{XN  , args.out};
        pg8::gemm_phase<pg8::EpiOut, pg8::StaticOrder, true, true>(lds, g, S, E); }
#undef IN
#undef SEAM
}

extern "C" void kernel_launch(void* const* d_in, const int* in_sizes, int n_in, void* d_out, int out_size, void* d_ws, size_t ws_size, hipStream_t stream) {
    static int grid = 0;
    if (grid == 0) {
        if (n_in != 21 || out_size != M * DM || ws_size < WS_END) { fprintf(stderr, "kernel_launch: unexpected shapes: n_in %d out %d ws %zu\n", n_in, out_size, ws_size); grid = -1; return; }
        int dev = 0, cus = 0;
        if (hipGetDevice(&dev) != hipSuccess || hipDeviceGetAttribute(&cus, hipDeviceAttributeMultiprocessorCount, dev) != hipSuccess) { grid = -1; return; }
        if (hipFuncSetAttribute((const void*)mk_fwd<0>, hipFuncAttributeMaxDynamicSharedMemorySize, LDS_BYTES) != hipSuccess || (PROBE_VARIANT && hipFuncSetAttribute((const void*)mk_fwd<PROBE_VARIANT>, hipFuncAttributeMaxDynamicSharedMemorySize, LDS_BYTES) != hipSuccess)) { fprintf(stderr, "kernel_launch: hipFuncSetAttribute failed\n"); grid = -1; return; }
        int per_cu = 0;
        if (hipOccupancyMaxActiveBlocksPerMultiprocessor(&per_cu, (const void*)mk_fwd<0>, NWAVES * 64, LDS_BYTES) != hipSuccess || per_cu < 1) fprintf(stderr, "kernel_launch: occupancy query says %d\n", per_cu);
        (void)hipGetLastError();
        grid = cus;
    }
    if (grid < 0) return;
    (void)hipMemsetAsync((char*)d_ws + WS_CTL, 0, CTL_ZERO_BYTES, stream);
    Args a{};
    for (int i = 0; i < 21; ++i) a.in[i] = (const float*)d_in[i];
    a.out = (float*)d_out; a.ws = (unsigned char*)d_ws;
#if MK_ONE_LAUNCH
    a.ph_lo = 0; a.ph_hi = NPHASE; a.li = 0;
    hipLaunchKernelGGL(mk_fwd<0>, dim3(grid), dim3(NWAVES * 64), LDS_BYTES, stream, a);
#else
    for (int p = 0; p < NPHASE; ++p) { a.ph_lo = p; a.ph_hi = p + 1; a.li = p; const int reps = ((PROBE_DUP >> p) & 1) ? 2 : 1;
        for (int r = 0; r < reps; ++r) { if (r && PROBE_VARIANT) hipLaunchKernelGGL(mk_fwd<PROBE_VARIANT>, dim3(grid), dim3(NWAVES * 64), LDS_BYTES, stream, a); else hipLaunchKernelGGL(mk_fwd<0>, dim3(grid), dim3(NWAVES * 64), LDS_BYTES, stream, a); } }
#endif
}
```

```cpp
#include <hip/hip_runtime.h>
#include <cstdio>
#include <cstdint>
namespace pg8 {
#define PG8_LAS __attribute__((address_space(3)))
typedef unsigned short bf16_t;
typedef short bf16x8 __attribute__((ext_vector_type(8)));
typedef float f32x4 __attribute__((ext_vector_type(4)));
typedef unsigned u32x4 __attribute__((ext_vector_type(4)));
constexpr int BM = 256, BK = 64, HALF = 128, HTB = HALF * BK * 2  , STAGE_BYTES = 8 * HTB, NXCD = 8, WGM = 4;

__host__ __device__ __forceinline__ int lds_byte(int r, int c) { const int st = (r >> 4) * 2 + (c >> 5), rr = r & 15, cc = c & 31, ob = rr * 64 + cc * 2; return st * 1024 + (ob ^ (((ob >> 9) & 1) << 5)); }
__host__ __device__ __forceinline__ void stage_rc(int b, int& R, int& C) { const int st = b / 1024, sb = b % 1024, swz = sb ^ (((sb >> 9) & 1) << 5); R = (st >> 1) * 16 + swz / 64; C = (st & 1) * 32 + (swz % 64) / 2; }
__host__ __device__ __forceinline__ int perm32(int rho) { const int n = rho >> 4, i = rho & 15; return 8 * (i >> 2) + 4 * n + (i & 3); }

struct Unit { int pm, pn, half; };
struct Gemm { const bf16_t* A; const bf16_t* Bt; int M, N, K; const bf16_t* A2; const bf16_t* Bt2; };

struct StaticOrder {
    int nM, nN, nwg, G, c, wgm;
    __host__ __device__ void init(int M, int N, int G_, int c_, int wgm_ = WGM) { nM = M / BM; nN = N / BM; nwg = nM * nN; G = G_; c = c_; wgm = wgm_; }
    __host__ __device__ __forceinline__ bool next(int i, Unit& u) const {
        const long L = (long)i * G + c; if (L >= nwg) return false;
        int wgid = (int)L; { const int q = nwg / NXCD, r = nwg % NXCD, xcd = wgid % NXCD, off = wgid / NXCD; wgid = (xcd < r ? xcd * (q + 1) : r * (q + 1) + (xcd - r) * q) + off; }
        const int nig = wgm * nN, gid = wgid / nig, fm = gid * wgm, gsz = (nM - fm) < wgm ? (nM - fm) : wgm;
        u.pm = fm + ((wgid % nig) % gsz); u.pn = (wgid % nig) / gsz; u.half = 0; return true;
    }
    __device__ __forceinline__ void a_ready(const Unit&) const {}
    __device__ __forceinline__ void done(const Unit&) const {}
};
struct DualOrder {
    StaticOrder so; int G, c;
    __host__ __device__ void init(int M, int N, int G_, int c_, int wgm_ = WGM) { so.init(M, N, 1, 0, wgm_); G = G_; c = c_; }
    __host__ __device__ bool next(int i, Unit& u) const { StaticOrder t = so; t.G = G; t.c = c; if (!t.next(i >> 1, u)) return false; u.half = i & 1; return true; }
    __device__ __forceinline__ void a_ready(const Unit&) const {}
    __device__ __forceinline__ void done(const Unit&) const {}
};
__device__ __forceinline__ unsigned cvt_pk_bf16(float lo, float hi) { unsigned r; asm volatile("v_cvt_pk_bf16_f32 %0, %1, %2" : "=v"(r) : "v"(lo), "v"(hi)); return r; }
typedef float f32x2 __attribute__((ext_vector_type(2)));
__device__ __forceinline__ float bf2f(unsigned short h) { return __builtin_bit_cast(float, (unsigned)h << 16); }
__device__ __forceinline__ float bflo(unsigned w) { return __builtin_bit_cast(float, w << 16); }
__device__ __forceinline__ float bfhi(unsigned w) { return __builtin_bit_cast(float, w & 0xffff0000u); }
__device__ __forceinline__ float fast_sigmoid(float x) { return __builtin_amdgcn_rcpf(1.0f + __builtin_amdgcn_exp2f(-1.4426950408889634f * x)); }
__device__ __forceinline__ float gelu_tanh(float x) { const float z = 0.7978845608028654f * (x + 0.044715f * x * x * x); return x * fast_sigmoid(2.0f * z); }

__device__ __forceinline__ f32x4 sigmoid4(f32x4 x) { f32x4 e = x * (-1.4426950408889634f);
#pragma unroll
    for (int j = 0; j < 4; ++j) e[j] = __builtin_amdgcn_exp2f(e[j]);
    e = e + 1.0f;
#pragma unroll
    for (int j = 0; j < 4; ++j) e[j] = __builtin_amdgcn_rcpf(e[j]);
    return e; }
__device__ __forceinline__ f32x4 gelu_tanh4(f32x4 c) { f32x4 e = (c * c * 0.044715f + 1.0f) * c * (-2.0f * 1.4426950408889634f * 0.7978845608028654f);
#pragma unroll
    for (int j = 0; j < 4; ++j) e[j] = __builtin_amdgcn_exp2f(e[j]);
    e = e + 1.0f;
#pragma unroll
    for (int j = 0; j < 4; ++j) e[j] = __builtin_amdgcn_rcpf(e[j]);
    return c * e; }
struct EpiG1 {
    static constexpr bool PERM = true, AFTER_DRAIN = false, DUAL = false;
    bf16_t *o0, *o1, *o2, *o3, *o4, *o5, *o6; const float* qg; const float* kg; float* km; PG8_LAS float* px; float qscale; int variant;
    __device__ __forceinline__ void operator()(f32x4 (&acc)[2][2][4][2], const Unit& u, int wr, int wc, int fr, int fq) const {
        const int seg = u.pn >> 2;
        if (variant == 1) {
#pragma unroll
            for (int ai = 0; ai < 2; ++ai)
#pragma unroll
                for (int bj = 0; bj < 2; ++bj)
#pragma unroll
                    for (int m = 0; m < 4; ++m)
#pragma unroll
                        for (int n = 0; n < 2; ++n) asm volatile("" :: "v"(acc[ai][bj][m][n]));
            return; }
        if (variant == 7 || variant == 8) {
            bf16_t* dummy = o0 + (size_t)64 * 1024 * 1024;
            const int r8 = (variant == 8) ? (fr & 7) : fr, cx = (variant == 8) ? ((fr >> 3) * 32) : 0;
#pragma unroll
            for (int ai = 0; ai < 2; ++ai)
#pragma unroll
                for (int m = 0; m < 4; ++m)
#pragma unroll
                    for (int bj = 0; bj < 2; ++bj) { const f32x4 v0 = acc[ai][bj][m][0], v1 = acc[ai][bj][m][1];
                        u32x4 w; w.x = cvt_pk_bf16(v0[0], v0[1]); w.y = cvt_pk_bf16(v0[2], v0[3]); w.z = cvt_pk_bf16(v1[0], v1[1]); w.w = cvt_pk_bf16(v1[2], v1[3]);
                        const int rr = (variant == 8) ? (u.pm * BM + wr * 64 + ai * HALF + m * 16 + r8 + 8 * bj) : (u.pm * BM + wr * 64 + ai * HALF + m * 16 + fr);
                        const int cc = (variant == 8) ? ((u.pn & 3) * BM + wc * 64 + cx + 8 * fq) : ((u.pn & 3) * BM + wc * 32 + 8 * fq + bj * HALF);
                        *(u32x4*)(dummy + (size_t)rr * 1024 + cc) = w; }
            return; }
        bf16_t* base = seg == 0 ? o0 : seg == 1 ? o1 : seg == 2 ? o2 : seg == 3 ? o3 : seg == 4 ? o4 : seg == 5 ? o5 : o6;
        const int row0 = u.pm * BM + wr * 64 + fr, col0 = (u.pn & 3) * BM + wc * 32 + 8 * fq;
        if (seg == 2 || seg == 3) {
            float rs[2][4][2];
#pragma unroll
            for (int ai = 0; ai < 2; ++ai)
#pragma unroll
                for (int m = 0; m < 4; ++m)
#pragma unroll
                    for (int bj = 0; bj < 2; ++bj) { const f32x4 a0 = acc[ai][bj][m][0], a1 = acc[ai][bj][m][1];
                        float ss = (a0[0] * a0[0] + a0[1] * a0[1]) + (a0[2] * a0[2] + a0[3] * a0[3]) + (a1[0] * a1[0] + a1[1] * a1[1]) + (a1[2] * a1[2] + a1[3] * a1[3]);
                        ss += __shfl_xor(ss, 16); ss += __shfl_xor(ss, 32);
                        if (fq == 0) px[(ai * HALF + wr * 64 + m * 16 + fr) * 8 + bj * 4 + wc] = ss; }
            asm volatile("s_waitcnt lgkmcnt(0)" ::: "memory"); __builtin_amdgcn_s_barrier(); asm volatile("" ::: "memory");
#pragma unroll
            for (int ai = 0; ai < 2; ++ai)
#pragma unroll
                for (int m = 0; m < 4; ++m)
#pragma unroll
                    for (int bj = 0; bj < 2; ++bj) { const f32x4 p = *(const PG8_LAS f32x4*)(px + (ai * HALF + wr * 64 + m * 16 + fr) * 8 + bj * 4);
                        rs[ai][m][bj] = 1.0f / sqrtf(((p[0] + p[1]) + (p[2] + p[3])) * (1.0f / 128.0f) + 1e-6f); }
            const float* gp = (seg == 2 ? qg : kg) + wc * 32 + 8 * fq; const float gs = (seg == 2) ? qscale : 1.0f;
            const f32x4 g0 = *(const f32x4*)gp * gs, g1 = *(const f32x4*)(gp + 4) * gs;
            f32x4 cs[2][2];
#pragma unroll
            for (int bj = 0; bj < 2; ++bj) { cs[bj][0] = (f32x4){0.f, 0.f, 0.f, 0.f}; cs[bj][1] = (f32x4){0.f, 0.f, 0.f, 0.f}; }
#pragma unroll
            for (int ai = 0; ai < 2; ++ai)
#pragma unroll
                for (int m = 0; m < 4; ++m) { bf16_t* rowp = base + (size_t)(row0 + ai * HALF + m * 16) * 1024 + col0;
#pragma unroll
                    for (int bj = 0; bj < 2; ++bj) { const f32x4 v0 = acc[ai][bj][m][0] * rs[ai][m][bj] * g0, v1 = acc[ai][bj][m][1] * rs[ai][m][bj] * g1;
                        cs[bj][0] += v0; cs[bj][1] += v1;
                        u32x4 w; w.x = cvt_pk_bf16(v0[0], v0[1]); w.y = cvt_pk_bf16(v0[2], v0[3]); w.z = cvt_pk_bf16(v1[0], v1[1]); w.w = cvt_pk_bf16(v1[2], v1[3]);
                        if (variant) asm volatile("" :: "v"(w)); else __builtin_nontemporal_store(w, (u32x4*)(rowp + bj * HALF)); } }
            if (seg == 3 && !variant) {
#pragma unroll
                for (int bj = 0; bj < 2; ++bj)
#pragma unroll
                    for (int n = 0; n < 2; ++n)
#pragma unroll
                        for (int j = 0; j < 4; ++j) { float c = cs[bj][n][j]; c += __shfl_xor(c, 1); c += __shfl_xor(c, 2); c += __shfl_xor(c, 4); c += __shfl_xor(c, 8);
                            if (fr == 0) atomicAdd(km + ((size_t)u.pm * 8 + 2 * (u.pn & 3) + bj) * 128 + wc * 32 + 8 * fq + 4 * n + j, c * (1.0f / 256.0f)); }
            }
            return;
        }
#pragma unroll
        for (int ai = 0; ai < 2; ++ai)
#pragma unroll
            for (int m = 0; m < 4; ++m) { bf16_t* rowp = base + (size_t)(row0 + ai * HALF + m * 16) * 1024 + col0;
#pragma unroll
                for (int bj = 0; bj < 2; ++bj) { f32x4 v0 = acc[ai][bj][m][0], v1 = acc[ai][bj][m][1];
                    if (seg == 1) { v0 = gelu_tanh4(v0); v1 = gelu_tanh4(v1); }
                    else if (seg >= 5) { v0 = sigmoid4(v0); v1 = sigmoid4(v1); }
                    u32x4 w; w.x = cvt_pk_bf16(v0[0], v0[1]); w.y = cvt_pk_bf16(v0[2], v0[3]); w.z = cvt_pk_bf16(v1[0], v1[1]); w.w = cvt_pk_bf16(v1[2], v1[3]);
                    if (variant) asm volatile("" :: "v"(w)); else __builtin_nontemporal_store(w, (u32x4*)(rowp + bj * HALF)); } }
    }
};
struct EpiG3 {
    static constexpr bool PERM = true, AFTER_DRAIN = false, DUAL = true;
    const bf16_t* ga; const bf16_t* gb; bf16_t* out;
    __device__ __forceinline__ void mid(f32x4 (&acc)[2][2][4][2], const Unit& u, int wr, int wc, int fr, int fq) const {
        const int row0 = u.pm * BM + wr * 64 + fr, col0 = u.pn * BM + wc * 32 + 8 * fq;
#pragma unroll
        for (int ai = 0; ai < 2; ++ai) {
            u32x4 wa[4][2], wb[4][2];
#pragma unroll
            for (int m = 0; m < 4; ++m)
#pragma unroll
                for (int bj = 0; bj < 2; ++bj) { const size_t off = (size_t)(row0 + ai * HALF + m * 16) * 1024 + col0 + bj * HALF; wa[m][bj] = *(const u32x4*)(ga + off); wb[m][bj] = *(const u32x4*)(gb + off); }
#pragma unroll
            for (int m = 0; m < 4; ++m)
#pragma unroll
                for (int bj = 0; bj < 2; ++bj) { const u32x4 a = wa[m][bj], b = wb[m][bj];
                    acc[ai][bj][m][0] *= (f32x4){bflo(a.x) * __builtin_amdgcn_rcpf(bflo(b.x)), bfhi(a.x) * __builtin_amdgcn_rcpf(bfhi(b.x)), bflo(a.y) * __builtin_amdgcn_rcpf(bflo(b.y)), bfhi(a.y) * __builtin_amdgcn_rcpf(bfhi(b.y))};
                    acc[ai][bj][m][1] *= (f32x4){bflo(a.z) * __builtin_amdgcn_rcpf(bflo(b.z)), bfhi(a.z) * __builtin_amdgcn_rcpf(bfhi(b.z)), bflo(a.w) * __builtin_amdgcn_rcpf(bflo(b.w)), bfhi(a.w) * __builtin_amdgcn_rcpf(bfhi(b.w))}; }
        }
    }
    __device__ __forceinline__ void operator()(f32x4 (&acc)[2][2][4][2], const Unit& u, int wr, int wc, int fr, int fq) const {
        const int row0 = u.pm * BM + wr * 64 + fr, col0 = u.pn * BM + wc * 32 + 8 * fq;
        u32x4 wb[2][4][2];
#pragma unroll
        for (int ai = 0; ai < 2; ++ai)
#pragma unroll
            for (int m = 0; m < 4; ++m)
#pragma unroll
                for (int bj = 0; bj < 2; ++bj) wb[ai][m][bj] = *(const u32x4*)(gb + (size_t)(row0 + ai * HALF + m * 16) * 1024 + col0 + bj * HALF);
        asm volatile("" ::: "memory");
#pragma unroll
        for (int ai = 0; ai < 2; ++ai)
#pragma unroll
            for (int m = 0; m < 4; ++m)
#pragma unroll
                for (int bj = 0; bj < 2; ++bj) { const u32x4 b = wb[ai][m][bj]; const f32x4 v0 = acc[ai][bj][m][0], v1 = acc[ai][bj][m][1];
                    u32x4 w; w.x = cvt_pk_bf16(v0[0] * bflo(b.x), v0[1] * bfhi(b.x)); w.y = cvt_pk_bf16(v0[2] * bflo(b.y), v0[3] * bfhi(b.y)); w.z = cvt_pk_bf16(v1[0] * bflo(b.z), v1[1] * bfhi(b.z)); w.w = cvt_pk_bf16(v1[2] * bflo(b.w), v1[3] * bfhi(b.w));
                    *(u32x4*)(out + (size_t)(row0 + ai * HALF + m * 16) * 1024 + col0 + bj * HALF) = w; }
    }
};
template <class T> __device__ __forceinline__ T* at_byte(T* base, unsigned byteoff) { return (T*)((char*)base + byteoff); }
struct EpiX1 {
    static constexpr bool PERM = true, AFTER_DRAIN = false, DUAL = false;
    const float* base; bf16_t* xb; float* rsp; PG8_LAS float* px;
    __device__ __forceinline__ void operator()(f32x4 (&acc)[2][2][4][2], const Unit& u, int wr, int wc, int fr, int fq) const {
        const unsigned e0 = (unsigned)(u.pm * BM + wr * 64 + fr) * 1024u + (unsigned)(u.pn * BM + wc * 32 + 8 * fq);
#pragma unroll
        for (int ai = 0; ai < 2; ++ai) {
#pragma unroll
            for (int mh = 0; mh < 2; ++mh) {
                f32x4 b[2][2][2];
#pragma unroll
                for (int m2 = 0; m2 < 2; ++m2)
#pragma unroll
                    for (int bj = 0; bj < 2; ++bj) { const float* p = at_byte(base, (e0 + (unsigned)((ai * HALF + (2 * mh + m2) * 16) * 1024 + bj * HALF)) * 4u); b[m2][bj][0] = __builtin_nontemporal_load((const f32x4*)p); b[m2][bj][1] = __builtin_nontemporal_load((const f32x4*)(p + 4)); }
#pragma unroll
                for (int m2 = 0; m2 < 2; ++m2)
#pragma unroll
                    for (int bj = 0; bj < 2; ++bj) { acc[ai][bj][2 * mh + m2][0] += b[m2][bj][0]; acc[ai][bj][2 * mh + m2][1] += b[m2][bj][1]; }
                asm volatile("" ::: "memory");
            }
#pragma unroll
            for (int m = 0; m < 4; ++m) { f32x4 s4 = {0.f, 0.f, 0.f, 0.f};
#pragma unroll
                for (int bj = 0; bj < 2; ++bj)
#pragma unroll
                    for (int n = 0; n < 2; ++n) { const f32x4 v = acc[ai][bj][m][n]; s4 += v * v; }
                float ss = (s4[0] + s4[1]) + (s4[2] + s4[3]);
                ss += __shfl_xor(ss, 16); ss += __shfl_xor(ss, 32);
                if (fq == 0) px[(ai * HALF + wr * 64 + m * 16 + fr) * 4 + wc] = ss; }
#pragma unroll
            for (int m = 0; m < 4; ++m)
#pragma unroll
                for (int bj = 0; bj < 2; ++bj) { const unsigned eo = e0 + (unsigned)((ai * HALF + m * 16) * 1024 + bj * HALF); const f32x4 v0 = acc[ai][bj][m][0], v1 = acc[ai][bj][m][1];
                    u32x4 w; w.x = cvt_pk_bf16(v0[0], v0[1]); w.y = cvt_pk_bf16(v0[2], v0[3]); w.z = cvt_pk_bf16(v1[0], v1[1]); w.w = cvt_pk_bf16(v1[2], v1[3]); *(u32x4*)at_byte(xb, eo * 2u) = w; }
            asm volatile("" ::: "memory");
        }
        asm volatile("s_waitcnt lgkmcnt(0)" ::: "memory"); __builtin_amdgcn_s_barrier(); asm volatile("" ::: "memory");
        const int t = (int)threadIdx.x;
        if (t < 256) { const f32x4 p = *(const PG8_LAS f32x4*)(px + t * 4); rsp[((size_t)u.pm * BM + t) * 4 + u.pn] = (p[0] + p[1]) + (p[2] + p[3]); }
    }
};
struct EpiOut {
    static constexpr bool PERM = true, AFTER_DRAIN = false, DUAL = false;
    const bf16_t* xb; float* out;
    __device__ __forceinline__ void operator()(f32x4 (&acc)[2][2][4][2], const Unit& u, int wr, int wc, int fr, int fq) const {
        const unsigned e0 = (unsigned)(u.pm * BM + wr * 64 + fr) * 1024u + (unsigned)(u.pn * BM + wc * 32 + 8 * fq);
        u32x4 r[2][4][2];
#pragma unroll
        for (int ai = 0; ai < 2; ++ai)
#pragma unroll
            for (int m = 0; m < 4; ++m)
#pragma unroll
                for (int bj = 0; bj < 2; ++bj) r[ai][m][bj] = *(const u32x4*)at_byte(xb, (e0 + (unsigned)((ai * HALF + m * 16) * 1024 + bj * HALF)) * 2u);
        asm volatile("" ::: "memory");
#pragma unroll
        for (int ai = 0; ai < 2; ++ai)
#pragma unroll
            for (int m = 0; m < 4; ++m)
#pragma unroll
                for (int bj = 0; bj < 2; ++bj) { const u32x4 w = r[ai][m][bj]; const unsigned eo = e0 + (unsigned)((ai * HALF + m * 16) * 1024 + bj * HALF);
                    const f32x4 v0 = acc[ai][bj][m][0] + (f32x4){bflo(w.x), bfhi(w.x), bflo(w.y), bfhi(w.y)}, v1 = acc[ai][bj][m][1] + (f32x4){bflo(w.z), bfhi(w.z), bflo(w.w), bfhi(w.w)};
                    float* po = at_byte(out, eo * 4u); __builtin_nontemporal_store(v0, (f32x4*)po); __builtin_nontemporal_store(v1, (f32x4*)(po + 4)); }
    }
};
template <int CTRL> __device__ __forceinline__ float dpp_mov(float old, float src) { return __builtin_bit_cast(float, __builtin_amdgcn_update_dpp(__builtin_bit_cast(int, old), __builtin_bit_cast(int, src), CTRL, 0xf, 0xf, false)); }
struct EpiUGF {
    static constexpr bool PERM = true, AFTER_DRAIN = false, DUAL = false;
    bf16_t* act; const float* cw; const float* cb; float* sb_last; float* su0; float* sg0; PG8_LAS float* halo; const float* rsp; int variant;
    __device__ __forceinline__ void operator()(f32x4 (&acc)[2][2][4][2], const Unit& u, int wr, int wc, int fr, int fq) const {
        const int colh = wc * 32 + 8 * fq, gcol = u.pn * HALF + colh;
        if (variant == 1) {
#pragma unroll
            for (int ai = 0; ai < 2; ++ai)
#pragma unroll
                for (int bj = 0; bj < 2; ++bj)
#pragma unroll
                    for (int m = 0; m < 4; ++m)
#pragma unroll
                        for (int n = 0; n < 2; ++n) asm volatile("" :: "v"(acc[ai][bj][m][n]));
            return; }
        {
            f32x4 rp[2][4];
#pragma unroll
            for (int ai = 0; ai < 2; ++ai)
#pragma unroll
                for (int m = 0; m < 4; ++m) rp[ai][m] = *(const f32x4*)at_byte(rsp, (unsigned)(u.pm * BM + ai * HALF + wr * 64 + m * 16 + fr) * 16u);
            { const int t = (int)threadIdx.x, r4 = t >> 7, c = t & 127;
              halo[1024 + t] = (r4 < 3) ? cw[r4 * 2816 + u.pn * HALF + c] : cb[u.pn * HALF + c]; }
#pragma unroll
            for (int ai = 0; ai < 2; ++ai)
#pragma unroll
                for (int m = 0; m < 4; ++m) { const f32x4 p = rp[ai][m]; const float rstd = __builtin_amdgcn_rsqf(((p[0] + p[1]) + (p[2] + p[3])) * (1.0f / 1024.0f) + 1e-6f);
#pragma unroll
                    for (int bj = 0; bj < 2; ++bj) { acc[ai][bj][m][0] *= rstd; acc[ai][bj][m][1] *= rstd; } }
        }
        asm volatile("" ::: "memory");
        if (fr >= 14) {
#pragma unroll
            for (int ai = 0; ai < 2; ++ai)
#pragma unroll
                for (int n = 0; n < 2; ++n) *(PG8_LAS f32x4*)(halo + ((2 * ai + wr) * 2 + (fr - 14)) * 128 + colh + 4 * n) = acc[ai][0][3][n];
            if (wr == 1) {
#pragma unroll
                for (int n = 0; n < 2; ++n) *(f32x4*)(sb_last + ((size_t)u.pm * 2 + (fr - 14)) * 2816 + gcol + 4 * n) = acc[1][0][3][n];
            }
        }
        asm volatile("s_waitcnt lgkmcnt(0)" ::: "memory"); __builtin_amdgcn_s_barrier(); asm volatile("" ::: "memory");
#pragma unroll
        for (int ai = 0; ai < 2; ++ai) {
            const int seg = 2 * ai + wr;
            f32x4 prev[2];
#pragma unroll
            for (int n = 0; n < 2; ++n) prev[n] = *(const PG8_LAS f32x4*)(halo + (((seg > 0 ? seg - 1 : 0)) * 2 + (fr & 1)) * 128 + colh + 4 * n);
#pragma unroll
            for (int m = 0; m < 4; ++m) {
                float r[8];
#pragma unroll
                for (int n = 0; n < 2; ++n) { const f32x4 cur = acc[ai][0][m][n], gt = acc[ai][1][m][n];
                    const f32x4 w0 = *(const PG8_LAS f32x4*)(halo + 1024 + colh + 4 * n), w1 = *(const PG8_LAS f32x4*)(halo + 1024 + 128 + colh + 4 * n), w2 = *(const PG8_LAS f32x4*)(halo + 1024 + 256 + colh + 4 * n), bb = *(const PG8_LAS f32x4*)(halo + 1024 + 384 + colh + 4 * n);
                    f32x4 v1, v2;
#pragma unroll
                    for (int j = 0; j < 4; ++j) {
                        const float t1 = dpp_mov<0x121>(prev[n][j], prev[n][j]); v1[j] = dpp_mov<0x111>(t1, cur[j]);
                        const float t2 = dpp_mov<0x122>(prev[n][j], prev[n][j]); v2[j] = dpp_mov<0x112>(t2, cur[j]); }
                    const f32x4 c = bb + w2 * cur + w1 * v1 + w0 * v2;
                    f32x4 ez = (c * c * 0.044715f + 1.0f) * c * (-2.0f * 1.4426950408889634f * 0.7978845608028654f);
#pragma unroll
                    for (int j = 0; j < 4; ++j) ez[j] = __builtin_amdgcn_exp2f(ez[j]);
                    ez = ez + 1.0f;
#pragma unroll
                    for (int j = 0; j < 4; ++j) ez[j] = __builtin_amdgcn_rcpf(ez[j]);
                    const f32x4 o = c * gt * ez;
                    r[4 * n] = o[0]; r[4 * n + 1] = o[1]; r[4 * n + 2] = o[2]; r[4 * n + 3] = o[3];
                    prev[n] = cur; }
                const unsigned row = (unsigned)(u.pm * BM + ai * HALF + wr * 64 + m * 16 + fr);
                const bool head = (seg == 0) && (m == 0) && (fr < 2);
                if (!head) { u32x4 w; w.x = cvt_pk_bf16(r[0], r[1]); w.y = cvt_pk_bf16(r[2], r[3]); w.z = cvt_pk_bf16(r[4], r[5]); w.w = cvt_pk_bf16(r[6], r[7]);
                    if (variant == 2) asm volatile("" :: "v"(w)); else *(u32x4*)at_byte(act, (row * 2816u + (unsigned)gcol) * 2u) = w; }
                else {
#pragma unroll
                    for (int n = 0; n < 2; ++n) { *(f32x4*)(su0 + ((size_t)u.pm * 2 + fr) * 2816 + gcol + 4 * n) = acc[0][0][0][n]; *(f32x4*)(sg0 + ((size_t)u.pm * 2 + fr) * 2816 + gcol + 4 * n) = acc[0][1][0][n]; }
                }
            }
        }
    }
};
template <class Epi, class Sched, bool ALIGN_EPI = false, bool SP2 = false>
__device__ __forceinline__ void gemm_phase(PG8_LAS unsigned char* lds, const Gemm g, const Sched& S, const Epi& E) {
    const int tid = threadIdx.x, wid = __builtin_amdgcn_readfirstlane(tid >> 6), lane = tid & 63, wr = wid >> 2, wc = wid & 3, fr = lane & 15, fq = lane >> 4;
    const int K = g.K, nt = K / BK;
    unsigned voffA[2], voffB[2];
#pragma unroll
    for (int i = 0; i < 2; ++i) { int R, C; stage_rc(tid * 16 + i * 8192, R, C); const int Rb = Epi::PERM ? ((R & ~31) + perm32(R & 31)) : R;
        voffA[i] = (unsigned)(R * K + C) * 2u; voffB[i] = (unsigned)(Rb * K + C) * 2u; }
    const size_t kstep = (size_t)(BK * 2);
    const size_t hstep = (size_t)HALF * K * 2;
    const size_t tstep = 2 * hstep;
    const unsigned ldsw = (unsigned)wid * 1024u;
    const int aoff = lds_byte(wr * 64 + fr, fq * 8), boff = lds_byte(wc * 32 + fr, fq * 8);
#define PG8_SA(b, h) (((b) * 2 + (h)) * HTB)
#define PG8_SB(b, h) ((4 + (b) * 2 + (h)) * HTB)
#ifndef PG8_AUX_B
#define PG8_AUX_B 0
#endif
#define PG8_STAGE(bufoff, gbase, voff) do { _Pragma("unroll") for (int _i = 0; _i < 2; ++_i) \
        __builtin_amdgcn_global_load_lds((const unsigned*)((const char*)(gbase) + (voff)[_i]), (PG8_LAS unsigned*)(lds + (bufoff) + ldsw + _i * 8192), 16, 0, (((bufoff) >= 4 * HTB) ? PG8_AUX_B : 0)); } while (0)
#define PG8_LDA(dst, b, h) do { _Pragma("unroll") for (int m = 0; m < 4; ++m) _Pragma("unroll") for (int k = 0; k < 2; ++k) dst[m][k] = *(const PG8_LAS bf16x8*)(lds + PG8_SA(b, h) + aoff + m * 2048 + k * 1024); } while (0)
#define PG8_LDB(dst, b, h) do { _Pragma("unroll") for (int n = 0; n < 2; ++n) _Pragma("unroll") for (int k = 0; k < 2; ++k) dst[n][k] = *(const PG8_LAS bf16x8*)(lds + PG8_SB(b, h) + boff + n * 2048 + k * 1024); } while (0)
#define PG8_MMA(ai, bj, At, Bt) do { __builtin_amdgcn_s_setprio(1); _Pragma("unroll") for (int m = 0; m < 4; ++m) _Pragma("unroll") for (int n = 0; n < 2; ++n) _Pragma("unroll") for (int k = 0; k < 2; ++k) \
        acc[ai][bj][m][n] = __builtin_amdgcn_mfma_f32_16x16x32_bf16(Bt[n][k], At[m][k], acc[ai][bj][m][n], 0, 0, 0); __builtin_amdgcn_s_setprio(0); } while (0)
#define PG8_WAIT_V(n) asm volatile("s_waitcnt vmcnt(" #n ")" ::: "memory")
#define PG8_WAIT_L(n) asm volatile("s_waitcnt lgkmcnt(" #n ")" ::: "memory")
#define PG8_BAR __builtin_amdgcn_s_barrier()
#define PG8_SCHED __builtin_amdgcn_sched_barrier(0)
    Unit cur, nxt; int ui = 0;
    if (!S.next(0, cur)) return;
    f32x4 acc[2][2][4][2];
#pragma unroll
    for (int a = 0; a < 2; ++a)
#pragma unroll
        for (int b = 0; b < 2; ++b)
#pragma unroll
            for (int m = 0; m < 4; ++m)
#pragma unroll
                for (int n = 0; n < 2; ++n) acc[a][b][m][n] = (f32x4){0.f, 0.f, 0.f, 0.f};
    bf16x8 At[4][2], B0[2][2], B1[2][2];
    const char* cA = (const char*)(cur.half ? g.A2 : g.A) + (size_t)cur.pm * tstep; const char* cB = (const char*)(cur.half ? g.Bt2 : g.Bt) + (size_t)cur.pn * tstep;
    S.a_ready(cur);
    if constexpr (SP2) {
        PG8_STAGE(PG8_SB(0, 0), cB, voffB); PG8_STAGE(PG8_SB(0, 1), cB + hstep, voffB); PG8_STAGE(PG8_SA(0, 0), cA, voffA); PG8_STAGE(PG8_SA(0, 1), cA + hstep, voffA);
        if (wr == 1) PG8_BAR;
        PG8_WAIT_V(2); PG8_BAR;
        PG8_STAGE(PG8_SB(1, 0), cB + kstep, voffB); PG8_STAGE(PG8_SA(1, 0), cA + kstep, voffA); PG8_STAGE(PG8_SB(1, 1), cB + hstep + kstep, voffB);
        PG8_WAIT_V(6); PG8_BAR;
    } else {
        PG8_STAGE(PG8_SB(0, 0), cB, voffB); PG8_STAGE(PG8_SA(0, 0), cA, voffA); PG8_STAGE(PG8_SB(0, 1), cB + hstep, voffB); PG8_STAGE(PG8_SA(0, 1), cA + hstep, voffA);
        if (wr == 1) PG8_BAR;
        PG8_WAIT_V(4); PG8_BAR;
        PG8_STAGE(PG8_SB(1, 0), cB + kstep, voffB); PG8_STAGE(PG8_SA(1, 0), cA + kstep, voffA); PG8_STAGE(PG8_SB(1, 1), cB + hstep + kstep, voffB);
        PG8_WAIT_V(6); PG8_BAR;
    }
    for (;;) {
        const bool has_next = S.next(ui + 1, nxt);
        const char* nA = has_next ? (const char*)(nxt.half ? g.A2 : g.A) + (size_t)nxt.pm * tstep : cA; const char* nB = has_next ? (const char*)(nxt.half ? g.Bt2 : g.Bt) + (size_t)nxt.pn * tstep : cB;
        for (int t = 0; t < nt; t += 2) {
            const bool last = (t == nt - 2);
            const char* a1 = cA + (size_t)(t + 1) * kstep;
            const char* a2 = last ? nA : cA + (size_t)(t + 2) * kstep; const char* b2 = last ? nB : cB + (size_t)(t + 2) * kstep;
            const char* a3 = a2 + kstep; const char* b3 = b2 + kstep;
            if (last && has_next) S.a_ready(nxt);
            if constexpr (SP2) {
            PG8_LDB(B0, 0, 0); PG8_LDB(B1, 0, 1); PG8_SCHED; PG8_LDA(At, 0, 0); PG8_STAGE(PG8_SA(1, 1), a1 + hstep, voffA);
            PG8_WAIT_V(8); PG8_WAIT_L(0); PG8_BAR; PG8_MMA(0, 0, At, B0); PG8_MMA(0, 1, At, B1); PG8_BAR; PG8_SCHED;
            PG8_LDA(At, 0, 1); PG8_STAGE(PG8_SB(0, 0), b2, voffB); PG8_STAGE(PG8_SB(0, 1), b2 + hstep, voffB); PG8_STAGE(PG8_SA(0, 0), a2, voffA);
            PG8_WAIT_V(8); PG8_WAIT_L(0); PG8_BAR; PG8_MMA(1, 0, At, B0); PG8_MMA(1, 1, At, B1); PG8_BAR; PG8_SCHED;
            PG8_LDB(B0, 1, 0); PG8_LDB(B1, 1, 1); PG8_SCHED; PG8_LDA(At, 1, 0); PG8_STAGE(PG8_SA(0, 1), a2 + hstep, voffA);
            PG8_WAIT_V(8); PG8_WAIT_L(0); PG8_BAR; PG8_MMA(0, 0, At, B0); PG8_MMA(0, 1, At, B1); PG8_BAR; PG8_SCHED;
            PG8_LDA(At, 1, 1); PG8_STAGE(PG8_SB(1, 0), b3, voffB); PG8_STAGE(PG8_SB(1, 1), b3 + hstep, voffB); PG8_STAGE(PG8_SA(1, 0), a3, voffA);
            PG8_WAIT_V(8); PG8_WAIT_L(0); PG8_BAR; PG8_MMA(1, 0, At, B0); PG8_MMA(1, 1, At, B1); PG8_BAR; PG8_SCHED;
            } else {
            PG8_LDB(B0, 0, 0); PG8_SCHED; PG8_LDA(At, 0, 0); PG8_STAGE(PG8_SA(1, 1), a1 + hstep, voffA);
            PG8_WAIT_L(8); PG8_BAR; PG8_WAIT_L(0); PG8_MMA(0, 0, At, B0); PG8_BAR; PG8_SCHED;
            PG8_LDB(B1, 0, 1); PG8_STAGE(PG8_SB(0, 0), b2, voffB);
            PG8_BAR; PG8_WAIT_L(0); PG8_MMA(0, 1, At, B1); PG8_BAR;
            PG8_LDA(At, 0, 1); PG8_STAGE(PG8_SA(0, 0), a2, voffA);
            PG8_BAR; PG8_WAIT_L(0); PG8_MMA(1, 0, At, B0); PG8_BAR; PG8_SCHED;
            PG8_STAGE(PG8_SB(0, 1), b2 + hstep, voffB);
            PG8_WAIT_V(6); PG8_BAR; PG8_MMA(1, 1, At, B1); PG8_BAR;
            PG8_LDB(B0, 1, 0); PG8_SCHED; PG8_LDA(At, 1, 0); PG8_STAGE(PG8_SA(0, 1), a2 + hstep, voffA);
            PG8_WAIT_L(8); PG8_BAR; PG8_WAIT_L(0); PG8_MMA(0, 0, At, B0); PG8_BAR; PG8_SCHED;
            PG8_LDB(B1, 1, 1); PG8_STAGE(PG8_SB(1, 0), b3, voffB);
            PG8_BAR; PG8_WAIT_L(0); PG8_MMA(0, 1, At, B1); PG8_BAR;
            PG8_LDA(At, 1, 1); PG8_STAGE(PG8_SA(1, 0), a3, voffA);
            PG8_BAR; PG8_WAIT_L(0); PG8_MMA(1, 0, At, B0); PG8_BAR; PG8_SCHED;
            PG8_STAGE(PG8_SB(1, 1), b3 + hstep, voffB);
            PG8_WAIT_V(6); PG8_BAR; PG8_MMA(1, 1, At, B1); PG8_BAR;
            }
        }
        if constexpr (ALIGN_EPI) { if (wr == 0) PG8_BAR; }
        bool keep_acc = false;
        if constexpr (Epi::DUAL) { if (cur.half == 0) { E.mid(acc, cur, wr, wc, fr, fq); keep_acc = true; } }
        if constexpr (!Epi::AFTER_DRAIN) { if (!keep_acc) { E(acc, cur, wr, wc, fr, fq); S.done(cur); } }
        if (!has_next) break;
        if (!keep_acc) {
#pragma unroll
        for (int a = 0; a < 2; ++a)
#pragma unroll
            for (int b = 0; b < 2; ++b)
#pragma unroll
                for (int m = 0; m < 4; ++m)
#pragma unroll
                    for (int n = 0; n < 2; ++n) acc[a][b][m][n] = (f32x4){0.f, 0.f, 0.f, 0.f};
        }
        cur = nxt; cA = nA; cB = nB; ++ui;
        if constexpr (ALIGN_EPI) { if (wr == 1) PG8_BAR; }
    }
    PG8_WAIT_V(0);
    if constexpr (!ALIGN_EPI) { if (wr == 0) PG8_BAR; }
    PG8_BAR;
    if constexpr (Epi::AFTER_DRAIN) { E.fused(acc, cur, wr, wc, fr, fq, lds, wid, lane); S.done(cur); }
#undef PG8_SA
#undef PG8_SB
#undef PG8_STAGE
#undef PG8_LDA
#undef PG8_LDB
#undef PG8_MMA
#undef PG8_WAIT_V
#undef PG8_WAIT_L
#undef PG8_BAR
#undef PG8_SCHED
}
}
#define GAS __attribute__((address_space(1)))
#define LAS __attribute__((address_space(3)))
typedef unsigned short bf16;
typedef unsigned v4u __attribute__((ext_vector_type(4)));
typedef float f32x4 __attribute__((ext_vector_type(4)));
typedef short bf16x8 __attribute__((ext_vector_type(8)));
typedef GAS unsigned gu32;
typedef GAS unsigned long long gu64;
#define RLX_AGENT __ATOMIC_RELAXED, __HIP_MEMORY_SCOPE_AGENT
#define LDS_WAIT() asm volatile("s_waitcnt lgkmcnt(0)" ::: "memory")
#define VM_WAIT() asm volatile("s_waitcnt vmcnt(0)" ::: "memory")
__device__ __forceinline__ unsigned long long rt() { return __builtin_amdgcn_s_memrealtime(); }
__device__ __forceinline__ unsigned f2bf(float f) { unsigned u = __builtin_bit_cast(unsigned, f); return (u + 0x7fffu + ((u >> 16) & 1u)) >> 16; }
__device__ __forceinline__ unsigned pk2(float lo, float hi) { return f2bf(lo) | (f2bf(hi) << 16); }

#define XB_TMO      128
#define XB_XCNT(j)  (256  + 64 * (j))
#define XB_XSUB(j)  (1280 + 64 * (j))
#define XB_XGEN(j)  (2304 + 64 * (j))
#define XB_TOP      3328
#define XB_TOPGEN   3392
#define XCD_BAR_WORDS 3456
#define XB_SPIN_CAP (1u << 18)

__device__ __forceinline__ unsigned xb_ld(unsigned* p)              { return __hip_atomic_load(p, __ATOMIC_RELAXED, __HIP_MEMORY_SCOPE_AGENT); }
__device__ __forceinline__ unsigned xb_add(unsigned* p, unsigned v) { return __hip_atomic_fetch_add(p, v, __ATOMIC_RELAXED, __HIP_MEMORY_SCOPE_AGENT); }
__device__ __forceinline__ unsigned xb_xcc_id() { return (unsigned)__builtin_amdgcn_s_getreg((3 << 11) | 20) & 0xFu; }
#define XB_SPIN(cond, bar) do { unsigned _sp = 0; while (cond) { __builtin_amdgcn_s_sleep(1); \
    if ((++_sp & 255u) == 0u) { if (xb_ld(&(bar)[XB_TMO])) break; if (_sp > XB_SPIN_CAP) { atomicAdd(&(bar)[XB_TMO], 1u); break; } } } } while (0)

struct XcdBarrier {
    unsigned* bar; unsigned x;
    volatile LAS unsigned* st;
};

__device__ __forceinline__ XcdBarrier xcd_barrier_post(unsigned* bar, volatile LAS unsigned* st) {
    XcdBarrier b; b.bar = bar; b.x = xb_xcc_id(); b.st = st;
    if (threadIdx.x == 0) (void)xb_add(&bar[XB_XCNT(b.x)], 1u);
    return b;
}
__device__ __forceinline__ void xcd_barrier_complete(unsigned* bar, unsigned x, unsigned& nloc, unsigned& nx) {
    const unsigned G = gridDim.x * gridDim.y * gridDim.z;
    unsigned sum, cnt, mine, sp = 0u;
    for (;;) {
        sum = 0u; cnt = 0u; mine = 0u;
#pragma unroll
        for (unsigned j = 0; j < 16; ++j) { const unsigned c = xb_ld(&bar[XB_XCNT(j)]); sum += c; cnt += (c > 0u) ? 1u : 0u; mine = (j == x) ? c : mine; }
        if (sum == G) break;
        __builtin_amdgcn_s_sleep(1);
        if ((++sp & 255u) == 0u) { if (xb_ld(&bar[XB_TMO])) break; if (sp > XB_SPIN_CAP) { atomicAdd(&bar[XB_TMO], 1u); break; } }
    }
    nloc = mine > 0u ? mine : 1u; nx = cnt > 0u ? cnt : 1u;
}

__device__ __forceinline__ void xcd_barrier(const XcdBarrier& b) {
    asm volatile("s_waitcnt vmcnt(0)" ::: "memory");
    __syncthreads();
    if (threadIdx.x == 0) {
        unsigned* bar = b.bar;
        __builtin_amdgcn_s_waitcnt(0);
        unsigned nloc = b.st[0], nx = b.st[1];
        if (nloc == 0u) { xcd_barrier_complete(bar, b.x, nloc, nx); b.st[0] = nloc; b.st[1] = nx; }
        const unsigned old = xb_add(&bar[XB_XSUB(b.x)], 1u);
        const unsigned gen = old / nloc;
        if (old + 1u == (gen + 1u) * nloc) {
            __builtin_amdgcn_fence(__ATOMIC_RELEASE, "agent");
            asm volatile("s_waitcnt vmcnt(0)" ::: "memory");
            const unsigned og = xb_add(&bar[XB_TOP], 1u);
            const unsigned tg = og / nx;
            if (og + 1u == (tg + 1u) * nx) xb_add(&bar[XB_TOPGEN], 1u);
            else XB_SPIN(xb_ld(&bar[XB_TOPGEN]) == tg, bar);
            __builtin_amdgcn_fence(__ATOMIC_ACQUIRE, "agent");
            xb_add(&bar[XB_XGEN(b.x)], 1u);
            asm volatile("s_waitcnt vmcnt(0)" ::: "memory");
        } else {
            XB_SPIN(xb_ld(&bar[XB_XGEN(b.x)]) == gen, bar);
            __builtin_amdgcn_fence(__ATOMIC_ACQUIRE, "agent");
            asm volatile("s_waitcnt vmcnt(0)" ::: "memory");
        }
    }
    __syncthreads();
}

constexpr int NWAVES = 8;
constexpr int NB = 4, SEQ = 8192, DM = 1024, M = NB * SEQ, DIN = 7168, DFF = 2816, NH = 8, HD = 128, NBLK = SEQ / 256;
constexpr float EPS = 1e-6f;
constexpr float QSCALE = 0.08838834764831845f * 1.4426950408889634f;
#ifndef MK_ONE_LAUNCH
#define MK_ONE_LAUNCH 1
#endif
constexpr int NPHASE = 15;

constexpr size_t MiB = 1u << 20;
constexpr size_t WS_CTL = 0, CTL_ZERO_BYTES = 1 * MiB;
constexpr size_t WS_WIN = 2 * MiB, WS_PA = 16 * MiB, WS_PB = 18 * MiB, WS_WOUT = 20 * MiB, WS_WUG = 22 * MiB, WS_WDN = 33 * MiB, WS_WR = 39 * MiB, WS_WI = 39 * MiB + 256 * 1024;
constexpr size_t WS_KM = 40 * MiB, WS_AG = 41 * MiB, WS_RSP = 45 * MiB;
constexpr size_t WS_XN = 48 * MiB;
constexpr size_t WS_Q = 112 * MiB;
constexpr size_t WS_K = 176 * MiB;
constexpr size_t WS_V = 240 * MiB;
constexpr size_t WS_XR = 304 * MiB, WS_GR = 368 * MiB;
constexpr size_t WS_ACT = 112 * MiB;
constexpr size_t WS_SB = 448 * MiB, WS_SU0 = 451 * MiB, WS_SG0 = 454 * MiB;
constexpr size_t WS_END = 512 * MiB;
constexpr int CW_BAR = 4096;

constexpr int LDS_BYTES = 163840;
constexpr int MISC_OFF = LDS_BYTES - 512;

__device__ __forceinline__ float wave_sum(float v) {
#pragma unroll
    for (int o = 1; o < 64; o <<= 1) v += __shfl_xor(v, o);
    return v;
}
__device__ __forceinline__ unsigned cvtpk_bf16(float lo, float hi) { unsigned r; asm volatile("v_cvt_pk_bf16_f32 %0, %1, %2" : "=v"(r) : "v"(lo), "v"(hi)); return r; }
__device__ __forceinline__ void p0_transpose_item(const float* W, int N, bf16* WT, int ldwt, int drow0, const float* gain, LAS float* scr, int kb, int nb, int lane) {
    const int k0 = 64 * kb, n0 = 64 * nb, lr = lane >> 4, lc = (lane & 15) * 4;
    f32x4 v[16];
#pragma unroll
    for (int i = 0; i < 16; ++i) v[i] = __builtin_nontemporal_load((const GAS f32x4*)(W + (size_t)(k0 + 4 * i + lr) * N + n0 + lc));
#pragma unroll
    for (int i = 0; i < 16; ++i) { const int kk = 4 * i + lr; const float g = gain ? gain[k0 + kk] : 1.0f; LAS float* d = scr + kk * 65 + lc; d[0] = v[i][0] * g; d[1] = v[i][1] * g; d[2] = v[i][2] * g; d[3] = v[i][3] * g; }
    LDS_WAIT(); asm volatile("" ::: "memory");
    const int c = lane & 7;
#pragma unroll
    for (int j = 0; j < 8; ++j) { const int n = (lane >> 3) + 8 * j; const LAS float* s = scr + (8 * c) * 65 + n;
        v4u o; o.x = cvtpk_bf16(s[0 * 65], s[1 * 65]); o.y = cvtpk_bf16(s[2 * 65], s[3 * 65]); o.z = cvtpk_bf16(s[4 * 65], s[5 * 65]); o.w = cvtpk_bf16(s[6 * 65], s[7 * 65]);
        *(GAS v4u*)(WT + (size_t)(drow0 + n) * ldwt + k0 + 8 * c) = o; }
    LDS_WAIT(); asm volatile("" ::: "memory");
}
__device__ __forceinline__ void rms_rows_to_bf16(const float* x, bf16* o, int m0, int mstep, int lane) {
    f32x4 v[4], w[4];
    if (m0 < M) {
#pragma unroll
        for (int j = 0; j < 4; ++j) v[j] = __builtin_nontemporal_load(((const GAS f32x4*)(x + (size_t)m0 * DM) + lane) + 64 * j); }
#pragma unroll 1
    for (int m = m0; m < M; m += mstep) {
        const int mn = m + mstep;
        if (mn < M) {
#pragma unroll
            for (int j = 0; j < 4; ++j) w[j] = __builtin_nontemporal_load(((const GAS f32x4*)(x + (size_t)mn * DM) + lane) + 64 * j); }
        float s = 0.f;
#pragma unroll
        for (int j = 0; j < 4; ++j) s += (v[j].x * v[j].x + v[j].y * v[j].y) + (v[j].z * v[j].z + v[j].w * v[j].w);
        const float rstd = 1.0f / sqrtf(wave_sum(s) * (1.f / DM) + EPS);
        GAS unsigned long long* o8 = (GAS unsigned long long*)(o + (size_t)m * DM) + lane;
#pragma unroll
        for (int j = 0; j < 4; ++j) o8[64 * j] = (unsigned long long)cvtpk_bf16(v[j].x * rstd, v[j].y * rstd) | ((unsigned long long)cvtpk_bf16(v[j].z * rstd, v[j].w * rstd) << 32);
#pragma unroll
        for (int j = 0; j < 4; ++j) v[j] = w[j];
    }
}

struct Args { const float* in[21]; float* out; unsigned char* ws; int ph_lo, ph_hi, li, pad; };
enum { I_X = 0, I_N1G, I_WIN, I_CONVW, I_CONVB, I_WR, I_BR, I_WI, I_BI, I_LAM, I_QNG, I_KNG, I_PA, I_PB, I_WOUT, I_N2G, I_WUP, I_WGATE, I_FCW, I_FCB, I_WDN };

__device__ __forceinline__ void p0_prologue(const Args& a, LAS unsigned char* lds, int gw, int NGW, int wave, int lane) {
    LAS float* scr = (LAS float*)(lds + wave * 16896);
    unsigned char* ws = a.ws;
    constexpr int I_IN = 16 * 112, I_SQ = 16 * 16, I_UP = 16 * 44, I_DN = 44 * 16, I_RG = 32;
    constexpr int NITEMS = I_IN + 3 * I_SQ + 2 * I_UP + I_DN + 2 * I_RG;
    for (int it = gw; it < NITEMS; it += NGW) {
        int r = it;
        if (r < I_IN) { p0_transpose_item(a.in[I_WIN], DIN, (bf16*)(ws + WS_WIN), DM, 64 * (r % 112), a.in[I_N1G], scr, r / 112, r % 112, lane); continue; } r -= I_IN;
        if (r < I_SQ) { p0_transpose_item(a.in[I_PA], DM, (bf16*)(ws + WS_PA), DM, 64 * (r % 16), nullptr, scr, r / 16, r % 16, lane); continue; } r -= I_SQ;
        if (r < I_SQ) { p0_transpose_item(a.in[I_PB], DM, (bf16*)(ws + WS_PB), DM, 64 * (r % 16), nullptr, scr, r / 16, r % 16, lane); continue; } r -= I_SQ;
        if (r < I_SQ) { p0_transpose_item(a.in[I_WOUT], DM, (bf16*)(ws + WS_WOUT), DM, 64 * (r % 16), nullptr, scr, r / 16, r % 16, lane); continue; } r -= I_SQ;
        if (r < I_UP) { const int nb = r % 44, n0 = 64 * nb; p0_transpose_item(a.in[I_WUP], DFF, (bf16*)(ws + WS_WUG), DM, 256 * (n0 / 128) + (n0 % 128), a.in[I_N2G], scr, r / 44, nb, lane); continue; } r -= I_UP;
        if (r < I_UP) { const int nb = r % 44, n0 = 64 * nb; p0_transpose_item(a.in[I_WGATE], DFF, (bf16*)(ws + WS_WUG), DM, 256 * (n0 / 128) + 128 + (n0 % 128), a.in[I_N2G], scr, r / 44, nb, lane); continue; } r -= I_UP;
        if (r < I_DN) { p0_transpose_item(a.in[I_WDN], DM, (bf16*)(ws + WS_WDN), DFF, 64 * (r % 16), nullptr, scr, r / 16, r % 16, lane); continue; } r -= I_DN;
        if (r < I_RG) { const int blk = r >> 2, q = r & 3; p0_transpose_item(a.in[I_WR] + blk * 16384, 128, (bf16*)(ws + WS_WR) + blk * 16384, 128, 64 * (q & 1), nullptr, scr, q >> 1, q & 1, lane); continue; } r -= I_RG;
        { const int blk = r >> 2, q = r & 3; p0_transpose_item(a.in[I_WI] + blk * 16384, 128, (bf16*)(ws + WS_WI) + blk * 16384, 128, 64 * (q & 1), nullptr, scr, q >> 1, q & 1, lane); }
    }
    rms_rows_to_bf16(a.in[I_X], (bf16*)(ws + WS_XN), gw, NGW, lane);
    for (int e = gw * 64 + lane; e < 128 * 1024; e += NGW * 64) ((float*)(ws + WS_KM))[e] = 0.f;
}

constexpr int CW_RFLAG = 20480;
__device__ __forceinline__ void rnn_phase(const Args& a, LAS unsigned char* lds, int G, int wave, int lane, int tid, int variant = 0) {
    LAS bf16* XRs = (LAS bf16*)lds;
    LAS bf16* XAb = (LAS bf16*)(lds + 18432);
    LAS bf16* HB = (LAS bf16*)(lds + 18432 + 17408);
    LAS float* CWl = (LAS float*)(lds + 18432 + 2 * 17408);
    const bf16* XR = (const bf16*)(a.ws + WS_XR); const bf16* GR = (const bf16*)(a.ws + WS_GR); bf16* YA = (bf16*)(a.ws + WS_XN);
    gu64* AG = (gu64*)(a.ws + WS_AG); gu32* RFLAG = (gu32*)(a.ws + WS_CTL) + CW_RFLAG;
    const int kq = lane >> 4, fr = lane & 15;
    if (G != 256) return;
    const int w = blockIdx.x, seqi = w & 31, sub = w >> 5, bb = seqi >> 3, n = seqi & 7;
    const int dcol = 16 * wave + fr, ch = n * 128 + dcol;
    LAS unsigned char* WFl = lds + 57344 + wave * 8192;
#pragma unroll
    for (int ks = 0; ks < 4; ++ks) { *(LAS bf16x8*)(WFl + (2 * ks) * 1024 + lane * 16) = *(const GAS bf16x8*)((const bf16*)(a.ws + WS_WR) + (size_t)ch * 128 + 32 * ks + 8 * kq);
                                     *(LAS bf16x8*)(WFl + (2 * ks + 1) * 1024 + lane * 16) = *(const GAS bf16x8*)((const bf16*)(a.ws + WS_WI) + (size_t)ch * 128 + 32 * ks + 8 * kq); }
    const float nbr = -1.4426950408889634f * a.in[I_BR][ch], nbi = -1.4426950408889634f * a.in[I_BI][ch];
    const float sp = log1pf(expf(-a.in[I_LAM][ch]));
    const float c1 = -16.0f * sp, c2 = -8.0f * sp * 1.4426950408889634f;
    const int cg = tid & 15, cc = n * 128 + 8 * cg;
    for (int e = tid; e < 640; e += 512) CWl[e] = (e < 512) ? a.in[I_CONVW][(e >> 7) * 1024 + n * 128 + (e & 127)] : a.in[I_CONVB][n * 128 + (e & 127)];
    float hc = 0.f;
    int cfold = 0;
    v4u pre[3];
    {
        const int rb0 = bb * 32 + sub; const bool seqstart = (sub == 0);
#pragma unroll
        for (int pp = 0; pp < 3; ++pp) { const int p = tid + 512 * pp;
            if (p < 67 * 16) { const int row = p >> 4, c = p & 15; const bool z = seqstart && row < 3; const int srow = z ? rb0 * 256 : rb0 * 256 - 3 + row;
                v4u v = __builtin_nontemporal_load((const GAS v4u*)(XR + (size_t)srow * DM + n * 128 + 8 * c)); if (z) v = (v4u){0u, 0u, 0u, 0u}; pre[pp] = v; } }
    }
#pragma unroll 1
    for (int it = 0; it < 4; ++it) {
        const int chunk = 8 * it + sub, rb = bb * 32 + chunk;
        float av[4][4][4]; unsigned bxp[4][4][2];
        float hl = 0.f, Pa = 1.f;
#pragma unroll
        for (int s = 0; s < 4; ++s) {
            const int r0 = rb * 256 + 64 * s;
#pragma unroll
            for (int pp = 0; pp < 3; ++pp) { const int p = tid + 512 * pp; if (p < 67 * 16) *(LAS v4u*)(XRs + (p >> 4) * 136 + 8 * (p & 15)) = pre[pp]; }
            __syncthreads();
            if (s < 3 || it < 3) {
                const int nr = (s < 3) ? r0 + 64 : r0 - 192 + 2048;
#pragma unroll
                for (int pp = 0; pp < 3; ++pp) { const int p = tid + 512 * pp; if (p < 67 * 16) pre[pp] = __builtin_nontemporal_load((const GAS v4u*)(XR + (size_t)(nr - 3 + (p >> 4)) * DM + n * 128 + 8 * (p & 15))); }
            }
#pragma unroll
            for (int pp = 0; pp < 2; ++pp) {
                const int tok = (tid >> 4) + 32 * pp;
                f32x4 a0 = *(const LAS f32x4*)(CWl + 512 + 8 * cg), a1 = *(const LAS f32x4*)(CWl + 512 + 8 * cg + 4);
#pragma unroll
                for (int k = 0; k < 4; ++k) { const v4u wv = *(const LAS v4u*)(XRs + (tok + k) * 136 + 8 * cg);
                    const f32x4 c0 = *(const LAS f32x4*)(CWl + k * 128 + 8 * cg), c1v = *(const LAS f32x4*)(CWl + k * 128 + 8 * cg + 4);
                    a0 += c0 * (f32x4){pg8::bflo(wv.x), pg8::bfhi(wv.x), pg8::bflo(wv.y), pg8::bfhi(wv.y)}; a1 += c1v * (f32x4){pg8::bflo(wv.z), pg8::bfhi(wv.z), pg8::bflo(wv.w), pg8::bfhi(wv.w)}; }
                v4u o; o.x = cvtpk_bf16(a0[0], a0[1]); o.y = cvtpk_bf16(a0[2], a0[3]); o.z = cvtpk_bf16(a1[0], a1[1]); o.w = cvtpk_bf16(a1[2], a1[3]);
                *(LAS v4u*)(XAb + tok * 136 + 8 * cg) = o;
            }
            __syncthreads();
            if (variant == 2) { _Pragma("unroll") for (int r_ = 0; r_ < 4; ++r_) { av[s][r_][0] = av[s][r_][1] = av[s][r_][2] = av[s][r_][3] = 1.f; bxp[s][r_][0] = bxp[s][r_][1] = 0u; } continue; }
#pragma unroll
            for (int rt = 0; rt < 4; ++rt) {
                f32x4 aR = {0.f, 0.f, 0.f, 0.f}, aI = {0.f, 0.f, 0.f, 0.f};
#pragma unroll
                for (int ks = 0; ks < 4; ++ks) { const bf16x8 af = *(const LAS bf16x8*)(XAb + (16 * rt + fr) * 136 + 32 * ks + 8 * kq);
                    aR = __builtin_amdgcn_mfma_f32_16x16x32_bf16(af, *(const LAS bf16x8*)(WFl + (2 * ks) * 1024 + lane * 16), aR, 0, 0, 0); aI = __builtin_amdgcn_mfma_f32_16x16x32_bf16(af, *(const LAS bf16x8*)(WFl + (2 * ks + 1) * 1024 + lane * 16), aI, 0, 0, 0); }
                float A = 1.f, H = 0.f; float bxt[4];
                {
                    f32x4 er = aR * (-1.4426950408889634f) + nbr, ei = aI * (-1.4426950408889634f) + nbi;
#pragma unroll
                    for (int rg = 0; rg < 4; ++rg) { er[rg] = __builtin_amdgcn_exp2f(er[rg]); ei[rg] = __builtin_amdgcn_exp2f(ei[rg]); }
                    er = er + 1.0f; ei = ei + 1.0f;
                    f32x4 r, ig;
#pragma unroll
                    for (int rg = 0; rg < 4; ++rg) { r[rg] = __builtin_amdgcn_rcpf(er[rg]); ig[rg] = __builtin_amdgcn_rcpf(ei[rg]); }
                    f32x4 aa = r * c2; const f32x4 x = r * c1;
#pragma unroll
                    for (int rg = 0; rg < 4; ++rg) aa[rg] = __builtin_amdgcn_exp2f(aa[rg]);
                    f32x4 poly = x * 0.2f + 1.0f; poly = poly * (x * 0.25f) + 1.0f; poly = poly * (x * (1.0f / 3.0f)) + 1.0f; poly = poly * (x * 0.5f) + 1.0f; poly = poly * (-x);
                    const f32x4 alt = 1.0f - aa * aa;
                    f32x4 em1, xa;
#pragma unroll
                    for (int rg = 0; rg < 4; ++rg) { em1[rg] = (x[rg] > -0.25f) ? poly[rg] : alt[rg]; xa[rg] = pg8::bf2f(XAb[(16 * rt + 4 * kq + rg) * 136 + dcol]); }
#pragma unroll
                    for (int rg = 0; rg < 4; ++rg) em1[rg] = __builtin_amdgcn_sqrtf(em1[rg]);
                    const f32x4 bv = em1 * ig * xa;
#pragma unroll
                    for (int rg = 0; rg < 4; ++rg) { av[s][rt][rg] = aa[rg]; bxt[rg] = bv[rg]; H = aa[rg] * H + bv[rg]; A *= aa[rg]; }
                }
                bxp[s][rt][0] = cvtpk_bf16(bxt[0], bxt[1]); bxp[s][rt][1] = cvtpk_bf16(bxt[2], bxt[3]);
                { const float A1 = __shfl_up(A, 16), H1 = __shfl_up(H, 16); if (kq >= 1) { H = A * H1 + H; A = A1 * A; } }
                { const float A2 = __shfl_up(A, 32), H2 = __shfl_up(H, 32); if (kq >= 2) { H = A * H2 + H; A = A2 * A; } }
                const float At = __shfl(A, 48 + fr), Ht = __shfl(H, 48 + fr);
                hl = At * hl + Ht; Pa *= At;
            }
        }
        if (kq == 0) __hip_atomic_store(AG + (size_t)rb * 1024 + ch, ((unsigned long long)__float_as_uint(hl) << 32) | __float_as_uint(Pa), RLX_AGENT);
        asm volatile("s_waitcnt vmcnt(0)" ::: "memory");
        __syncthreads();
        if (tid == 0) __hip_atomic_store(RFLAG + rb * 8 + n, 1u, RLX_AGENT);
        if (wave == 0) {
            unsigned spins = 0;
            for (;;) {
                const unsigned f = (lane >= cfold && lane < chunk) ? __hip_atomic_load(RFLAG + (bb * 32 + lane) * 8 + n, RLX_AGENT) : 1u;
                if (__all(f != 0u)) break;
                __builtin_amdgcn_s_sleep(2);
                if (++spins > (1u << 22)) break;
            }
        }
        __syncthreads();
        {
#pragma unroll
            for (int j0 = 0; j0 < 8; j0 += 4) { unsigned long long ah[4];
#pragma unroll
                for (int j = 0; j < 4; ++j) { const int ci = (cfold + j0 + j < chunk) ? cfold + j0 + j : (chunk > 0 ? chunk - 1 : 0); ah[j] = __hip_atomic_load(AG + (size_t)(bb * 32 + ci) * 1024 + ch, RLX_AGENT); }
#pragma unroll
                for (int j = 0; j < 4; ++j) if (cfold + j0 + j < chunk) hc = __uint_as_float((unsigned)ah[j]) * hc + __uint_as_float((unsigned)(ah[j] >> 32)); }
            cfold = chunk;
        }
        if (variant >= 1) { asm volatile("" :: "v"(hc)); _Pragma("unroll") for (int s_ = 0; s_ < 4; ++s_) _Pragma("unroll") for (int r_ = 0; r_ < 4; ++r_) { asm volatile("" :: "v"(av[s_][r_][0]), "v"(av[s_][r_][3]), "v"(bxp[s_][r_][0]), "v"(bxp[s_][r_][1])); } __syncthreads(); continue; }
        float hs = hc;
#pragma unroll
        for (int s = 0; s < 4; ++s) {
            const int r0 = rb * 256 + 64 * s;
            v4u gpre[2];
#pragma unroll
            for (int pp = 0; pp < 2; ++pp) gpre[pp] = __builtin_nontemporal_load((const GAS v4u*)(GR + (size_t)(r0 + (tid >> 4) + 32 * pp) * DM + cc));
#pragma unroll
            for (int rt = 0; rt < 4; ++rt) {
                float A = 1.f, H = 0.f;
                const float bxv[4] = { pg8::bflo(bxp[s][rt][0]), pg8::bfhi(bxp[s][rt][0]), pg8::bflo(bxp[s][rt][1]), pg8::bfhi(bxp[s][rt][1]) };
#pragma unroll
                for (int rg = 0; rg < 4; ++rg) { H = av[s][rt][rg] * H + bxv[rg]; A *= av[s][rt][rg]; }
                float At = 1.f, Ht = 0.f, Ae = 1.f, He = 0.f;
#pragma unroll
                for (int q = 0; q < 4; ++q) { const float Aq = __shfl(A, 16 * q + fr), Hq = __shfl(H, 16 * q + fr);
                    Ae = (q == kq) ? At : Ae; He = (q == kq) ? Ht : He; Ht = Aq * Ht + Hq; At *= Aq; }
                float h = Ae * hs + He;
#pragma unroll
                for (int rg = 0; rg < 4; ++rg) { h = av[s][rt][rg] * h + bxv[rg]; HB[(16 * rt + 4 * kq + rg) * 136 + dcol] = (bf16)cvtpk_bf16(h, h); }
                hs = At * hs + Ht;
            }
            __syncthreads();
#pragma unroll
            for (int pp = 0; pp < 2; ++pp) {
                const int tok = (tid >> 4) + 32 * pp;
                const v4u hw = *(const LAS v4u*)(HB + tok * 136 + 8 * cg);
                const v4u gw = gpre[pp];
                v4u o; o.x = cvtpk_bf16(pg8::bflo(hw.x) * pg8::bflo(gw.x), pg8::bfhi(hw.x) * pg8::bfhi(gw.x)); o.y = cvtpk_bf16(pg8::bflo(hw.y) * pg8::bflo(gw.y), pg8::bfhi(hw.y) * pg8::bfhi(gw.y));
                o.z = cvtpk_bf16(pg8::bflo(hw.z) * pg8::bflo(gw.z), pg8::bfhi(hw.z) * pg8::bfhi(gw.z)); o.w = cvtpk_bf16(pg8::bflo(hw.w) * pg8::bflo(gw.w), pg8::bfhi(hw.w) * pg8::bfhi(gw.w));
                __builtin_nontemporal_store(o, (GAS v4u*)(YA + (size_t)(r0 + tok) * DM + cc));
            }
            __syncthreads();
        }
        hc = Pa * hc + hl; cfold = chunk + 1;
    }
}
typedef short s16x4 __attribute__((ext_vector_type(4)));
typedef float f32x16 __attribute__((ext_vector_type(16)));
typedef short v4i16_t __attribute__((ext_vector_type(4)));
constexpr size_t WS_PART = 304 * MiB, WS_LIST = 496 * MiB, WS_LP = 42 * MiB;
constexpr int CW_CNT = 16384;
constexpr int LIST_PER_BH = 256 * 496;
__device__ __forceinline__ int list_off(int n) { return 256 * (31 * n - (n * (n - 1)) / 2); }
__device__ __forceinline__ unsigned cvtpk(float lo, float hi) { unsigned r; asm volatile("v_cvt_pk_bf16_f32 %0, %1, %2" : "=v"(r) : "v"(lo), "v"(hi)); return r; }
__device__ __forceinline__ s16x4 vtr(const LAS unsigned char* p) { return __builtin_bit_cast(s16x4, __builtin_amdgcn_ds_read_tr16_b64_v4i16((LAS v4i16_t*)p)); }

__device__ __forceinline__ void load_kv_block(LAS unsigned char* lds, const bf16* Kg, const bf16* Vg, size_t row0, int hh, int wave, int lane) {
#pragma unroll
    for (int i = 0; i < 8; ++i) {
        const int I = wave * 8 + i;
        { const int r = 4 * I + (lane >> 4), cp = lane & 15, c = cp ^ (r & 15);
          __builtin_amdgcn_global_load_lds((const unsigned*)(Kg + (row0 + r) * DM + hh * HD + 8 * c), (LAS unsigned*)(lds + I * 1024), 16, 0, 0); }
        { const int dt = lane >> 4, q = (lane >> 2) & 3, c8 = lane & 3;
          __builtin_amdgcn_global_load_lds((const unsigned*)(Vg + (row0 + 4 * I + q) * DM + hh * HD + 32 * dt + 8 * c8), (LAS unsigned*)(lds + 65536 + I * 1024), 16, 0, 0); }
    }
}

__device__ __forceinline__ void attn_wave(const LAS unsigned char* lds, const bf16x8 (&qf)[8], f32x16 (&O)[4], float& lsum, int kt_hi, int diag, int lane) {
    const int h2 = lane >> 5, kr = lane & 31;
    unsigned kaddr[8];
#pragma unroll
    for (int s = 0; s < 8; ++s) kaddr[s] = (unsigned)(kr * 256 + (((2 * s + h2) ^ (lane & 15)) * 16));
    const LAS unsigned char* vb = lds + 65536 + h2 * 1024 + ((lane >> 2) & 3) * 64 + ((lane >> 4) & 1) * 32 + (lane & 3) * 8;
#pragma unroll 1
    for (int kt = 0; kt < kt_hi; ++kt) {
        f32x16 S;
#pragma unroll
        for (int r = 0; r < 16; ++r) S[r] = 0.f;
#pragma unroll
        for (int s = 0; s < 8; ++s) { const bf16x8 kf = *(const LAS bf16x8*)(lds + kt * 8192 + kaddr[s]); S = __builtin_amdgcn_mfma_f32_32x32x16_bf16(kf, qf[s], S, 0, 0, 0); }
        float P[16];
#pragma unroll
        for (int r = 0; r < 16; ++r) P[r] = __builtin_amdgcn_exp2f(S[r]);
        if (kt == diag) {
#pragma unroll
            for (int r = 0; r < 16; ++r) { const int kl = (r & 3) + 8 * (r >> 2) + 4 * h2; P[r] = (kl <= kr) ? P[r] : 0.f; }
        }
        float ls = 0.f;
#pragma unroll
        for (int r = 0; r < 16; ++r) ls += P[r];
        lsum += ls;
        v4u pw0, pw1;
        pw0.x = cvtpk(P[0], P[1]); pw0.y = cvtpk(P[2], P[3]); pw0.z = cvtpk(P[4], P[5]); pw0.w = cvtpk(P[6], P[7]);
        pw1.x = cvtpk(P[8], P[9]); pw1.y = cvtpk(P[10], P[11]); pw1.z = cvtpk(P[12], P[13]); pw1.w = cvtpk(P[14], P[15]);
        const bf16x8 pb0 = __builtin_bit_cast(bf16x8, pw0), pb1 = __builtin_bit_cast(bf16x8, pw1);
        const LAS unsigned char* vk = vb + kt * 8192;
#pragma unroll
        for (int dt = 0; dt < 4; ++dt) {
            { const s16x4 lo = vtr(vk + dt * 256), hi = vtr(vk + dt * 256 + 2048);
              const bf16x8 vf = (bf16x8){lo[0], lo[1], lo[2], lo[3], hi[0], hi[1], hi[2], hi[3]};
              O[dt] = __builtin_amdgcn_mfma_f32_32x32x16_bf16(vf, pb0, O[dt], 0, 0, 0); }
            { const s16x4 lo = vtr(vk + 4096 + dt * 256), hi = vtr(vk + 4096 + dt * 256 + 2048);
              const bf16x8 vf = (bf16x8){lo[0], lo[1], lo[2], lo[3], hi[0], hi[1], hi[2], hi[3]};
              O[dt] = __builtin_amdgcn_mfma_f32_32x32x16_bf16(vf, pb1, O[dt], 0, 0, 0); }
        }
    }
}

__device__ __forceinline__ void q_unstage(LAS unsigned char* stg, const v4u (&qs)[8], bf16x8 (&qf)[8], int lane) {
    const int ra = lane >> 2, rb2 = ra + 16, part = lane & 3, h2 = lane >> 5, kr = lane & 31;
#pragma unroll
    for (int p = 0; p < 4; ++p) {
        *(LAS v4u*)(stg + ra * 80 + part * 16) = qs[2 * p]; *(LAS v4u*)(stg + rb2 * 80 + part * 16) = qs[2 * p + 1];
        asm volatile("s_waitcnt lgkmcnt(0)" ::: "memory");
        qf[2 * p] = *(const LAS bf16x8*)(stg + kr * 80 + h2 * 16); qf[2 * p + 1] = *(const LAS bf16x8*)(stg + kr * 80 + 32 + h2 * 16);
        asm volatile("s_waitcnt lgkmcnt(0)" ::: "memory");
    }
}
__device__ __forceinline__ void gate_phase(const Args& a, LAS unsigned char* lds, int vcu, int wave, int lane, int tid, int variant = 0) {
    LAS unsigned* lcnt = (LAS unsigned*)lds; LAS unsigned* gbase = lcnt + 32;
    const bf16* Qg = (const bf16*)(a.ws + WS_Q); const float* KM = (const float*)(a.ws + WS_KM);
    unsigned* CNT = (unsigned*)(a.ws + WS_CTL) + CW_CNT; unsigned* LIST = (unsigned*)(a.ws + WS_LIST);
    const int h2 = lane >> 5, kr = lane & 31;
#pragma unroll 1
    for (int ui = 0; ui < 4; ++ui) {
        const int unit = vcu * 4 + ui, bh = unit >> 5, qb = unit & 31, bb = bh >> 3, hh = bh & 7;
        const size_t rowbase = (size_t)bb * SEQ; const int tq = qb * 256 + 32 * wave + kr;
        if (tid < 32) lcnt[tid] = 0u;
        __syncthreads();
        const float* kmp = KM + ((size_t)(bb * 32 + kr) * 8 + hh) * 128 + 8 * h2;
        const bf16* qp = Qg + (rowbase + tq) * DM + hh * HD + 8 * h2;
        f32x16 acc;
#pragma unroll
        for (int r = 0; r < 16; ++r) acc[r] = 0.f;
#pragma unroll
        for (int s = 0; s < 8; ++s) {
            const f32x4 k0 = *(const GAS f32x4*)(kmp + 16 * s), k1 = *(const GAS f32x4*)(kmp + 16 * s + 4);
            const float kv[8] = {k0[0], k0[1], k0[2], k0[3], k1[0], k1[1], k1[2], k1[3]};
            unsigned hi[4], lo[4];
#pragma unroll
            for (int j = 0; j < 4; ++j) { const unsigned h0 = f2bf(kv[2 * j]), h1 = f2bf(kv[2 * j + 1]); hi[j] = h0 | (h1 << 16);
                lo[j] = pk2(kv[2 * j] - __builtin_bit_cast(float, h0 << 16), kv[2 * j + 1] - __builtin_bit_cast(float, h1 << 16)); }
            const bf16x8 ahi = __builtin_bit_cast(bf16x8, (v4u){hi[0], hi[1], hi[2], hi[3]}), alo = __builtin_bit_cast(bf16x8, (v4u){lo[0], lo[1], lo[2], lo[3]});
            const bf16x8 bq = *(const GAS bf16x8*)(qp + 16 * s);
            acc = __builtin_amdgcn_mfma_f32_32x32x16_bf16(ahi, bq, acc, 0, 0, 0); acc = __builtin_amdgcn_mfma_f32_32x32x16_bf16(alo, bq, acc, 0, 0, 0);
        }
        unsigned mask = 0u; int seln[3] = {0, 0, 0}; unsigned pos[3] = {0u, 0u, 0u};
#pragma unroll
        for (int r3 = 0; r3 < 3; ++r3) {
            if (r3 < qb) { float best = -3.0e38f; int bi = 64;
#pragma unroll
                for (int r = 0; r < 16; ++r) { const int blk = (r & 3) + 8 * (r >> 2) + 4 * h2; const bool ok = (blk < qb) && !((mask >> blk) & 1u) && (acc[r] > best); best = ok ? acc[r] : best; bi = ok ? blk : bi; }
                const float ob = __shfl_xor(best, 32); const int oi = __shfl_xor(bi, 32);
                const bool take = (ob > best) || (ob == best && oi < bi);
                bi = take ? oi : bi; bi &= 31;
                mask |= 1u << bi; seln[r3] = bi;
                if (h2 == 0) pos[r3] = __hip_atomic_fetch_add(lcnt + bi, 1u, __ATOMIC_RELAXED, __HIP_MEMORY_SCOPE_WORKGROUP); }
        }
        __syncthreads();
        if (tid < 32) { const unsigned c = lcnt[tid]; gbase[tid] = (c && !variant) ? atomicAdd(CNT + bh * 32 + tid, c) : 0u; }
        __syncthreads();
        if (h2 == 0 && !variant) {
#pragma unroll
            for (int r3 = 0; r3 < 3; ++r3) if (r3 < qb) LIST[(size_t)bh * LIST_PER_BH + list_off(seln[r3]) + gbase[seln[r3]] + pos[r3]] = ((unsigned)tq << 2) | (unsigned)r3;
        }
        __syncthreads();
    }
}

__device__ __forceinline__ void sparse_phase(const Args& a, LAS unsigned char* lds, int G, int wave, int lane, int tid, int variant = 0) {
    LAS unsigned* cntl = (LAS unsigned*)(lds + 131072 + 1024);
    LAS unsigned* pre = cntl + 1024;
    const bf16* Qg = (const bf16*)(a.ws + WS_Q); const bf16* Kg = (const bf16*)(a.ws + WS_K); const bf16* Vg = (const bf16*)(a.ws + WS_V);
    const unsigned* CNT = (const unsigned*)(a.ws + WS_CTL) + CW_CNT; const unsigned* LIST = (const unsigned*)(a.ws + WS_LIST);
    bf16* PART = (bf16*)(a.ws + WS_PART); float* LP = (float*)(a.ws + WS_LP);
    const int h2 = lane >> 5, kr = lane & 31;
    for (int i = tid; i < 1024; i += 512) cntl[i] = __hip_atomic_load(CNT + i, __ATOMIC_RELAXED, __HIP_MEMORY_SCOPE_AGENT);
    __syncthreads();
    if (wave == 0) {
        unsigned loc[16]; unsigned s = 0u;
#pragma unroll
        for (int j = 0; j < 16; ++j) { loc[j] = s; s += (cntl[16 * lane + j] + 255u) >> 8; }
        unsigned inc = s;
#pragma unroll
        for (int o = 1; o < 64; o <<= 1) { const unsigned t = __shfl_up(inc, o); if (lane >= o) inc += t; }
        const unsigned exc = inc - s;
#pragma unroll
        for (int j = 0; j < 16; ++j) pre[16 * lane + j] = exc + loc[j];
        if (lane == 63) pre[1024] = inc;
    }
    __syncthreads();
    const unsigned T = pre[1024];
    const unsigned lo = (unsigned)(((unsigned long long)blockIdx.x * T) / (unsigned)G), hi = (unsigned)(((unsigned long long)(blockIdx.x + 1) * T) / (unsigned)G);
    if (lo >= hi) return;
    int li = 0;
    { int a0 = 0, b0 = 1024; while (b0 - a0 > 1) { const int m = (a0 + b0) >> 1; if (pre[m] <= lo) a0 = m; else b0 = m; } li = a0; }
#define SP_ENTRY(LI, K2) ({ const int bh_ = (LI) >> 5, nn_ = (LI) & 31; const int idx_ = 256 * (K2) + 32 * wave + kr; (idx_ < (int)cntl[LI]) ? LIST[(size_t)bh_ * LIST_PER_BH + list_off(nn_) + idx_] : 0xffffffffu; })
#define SP_QROW(LI, E) (Qg + ((size_t)((LI) >> 8) * SEQ + (((E) == 0xffffffffu) ? 0u : ((E) >> 2))) * DM + (((LI) >> 5) & 7) * HD + 8 * (lane & 3))
#define SP_QLOAD(DST, LI, E) do { const unsigned ea_ = __shfl((E), lane >> 2), eb_ = __shfl((E), (lane >> 2) + 16); const bf16* qa_ = SP_QROW(LI, ea_); const bf16* qb_ = SP_QROW(LI, eb_); \
        _Pragma("unroll") for (int p_ = 0; p_ < 4; ++p_) { DST[2 * p_] = *(const GAS v4u*)(qa_ + 32 * p_); DST[2 * p_ + 1] = *(const GAS v4u*)(qb_ + 32 * p_); } } while (0)
    int l1 = li, l2, l3;
    unsigned t1 = lo;
    while (t1 >= pre[l1 + 1]) ++l1;
    l2 = l1; if (lo + 1 < hi) { while (lo + 1 >= pre[l2 + 1]) ++l2; }
    unsigned e1 = SP_ENTRY(l1, (int)(lo - pre[l1]));
    unsigned e2 = (lo + 1 < hi) ? SP_ENTRY(l2, (int)(lo + 1 - pre[l2])) : 0xffffffffu;
    LAS unsigned char* stg = lds + 131072 + 10240 + wave * 2560;
    v4u qs[8];
    SP_QLOAD(qs, l1, e1);
    int cur = -1;
#pragma unroll 1
    for (unsigned tile = lo; tile < hi; ++tile) {
        const int k = (int)(tile - pre[l1]); const int cnt = (int)cntl[l1];
        const int bh = l1 >> 5, nn = l1 & 31, bb = bh >> 3, hh = bh & 7; const size_t rowbase = (size_t)bb * SEQ;
        if (l1 != cur) {
            __syncthreads();
            if (variant != 4 || cur < 0) load_kv_block(lds, Kg, Vg, rowbase + (size_t)nn * 256, hh, wave, lane);
            asm volatile("s_waitcnt vmcnt(0)" ::: "memory");
            __syncthreads();
            cur = l1;
        }
        bf16x8 qf[8];
        q_unstage(stg, qs, qf, lane);
        unsigned e3 = 0xffffffffu; l3 = l2;
        if (tile + 1 < hi && variant != 5) SP_QLOAD(qs, l2, e2);
        if (tile + 2 < hi) { while (tile + 2 >= pre[l3 + 1]) ++l3; e3 = SP_ENTRY(l3, (int)(tile + 2 - pre[l3])); }
        const int idx0 = 256 * k + 32 * wave;
        if (idx0 < cnt) {
            const bool valid = (e1 != 0xffffffffu);
            const int t = (int)(e1 >> 2), j = (int)(e1 & 3u);
            f32x16 O[4];
#pragma unroll
            for (int dt = 0; dt < 4; ++dt)
#pragma unroll
                for (int r = 0; r < 16; ++r) O[dt][r] = 0.f;
            float lsum = 0.f;
            if (variant != 1) attn_wave(lds, qf, O, lsum, variant == 2 ? 4 : 8, -1, lane);
            lsum += __shfl_xor(lsum, 32);
            if (variant) {
#pragma unroll
                for (int dt = 0; dt < 4; ++dt)
#pragma unroll
                    for (int r = 0; r < 16; ++r) asm volatile("" :: "v"(O[dt][r]));
                asm volatile("" :: "v"(lsum));
            }
            if (variant == 0 || variant == 3) {
                const int psl = valid ? (int)(((unsigned)bh * SEQ + (unsigned)t) * 3u + (unsigned)j) : -1;
                if (valid && h2 == 0) LP[psl] = lsum;
                const int ra = lane >> 2, rb2 = ra + 16, part = lane & 3;
                const int psa = __shfl(psl, ra), psb = __shfl(psl, rb2);
#pragma unroll
                for (int dt = 0; dt < 4; ++dt) {
#pragma unroll
                    for (int rq = 0; rq < 4; ++rq) { const unsigned long long w = (unsigned long long)cvtpk(O[dt][4 * rq], O[dt][4 * rq + 1]) | ((unsigned long long)cvtpk(O[dt][4 * rq + 2], O[dt][4 * rq + 3]) << 32);
                        *(LAS unsigned long long*)(stg + kr * 80 + rq * 16 + h2 * 8) = w; }
                    asm volatile("s_waitcnt lgkmcnt(0)" ::: "memory");
                    const v4u ca = *(const LAS v4u*)(stg + ra * 80 + part * 16), cb2 = *(const LAS v4u*)(stg + rb2 * 80 + part * 16);
                    if (psa >= 0) *(GAS v4u*)(PART + (size_t)psa * 128 + dt * 32 + part * 8) = ca;
                    if (psb >= 0) *(GAS v4u*)(PART + (size_t)psb * 128 + dt * 32 + part * 8) = cb2;
                    asm volatile("s_waitcnt lgkmcnt(0)" ::: "memory");
                }
            }
        }
        e1 = e2; e2 = e3; l1 = l2; l2 = l3;
    }
#undef SP_ENTRY
#undef SP_QROW
#undef SP_QLOAD
}

__device__ __forceinline__ void own_phase(const Args& a, LAS unsigned char* lds, int vcu, int wave, int lane, int tid, int variant = 0) {
    bf16* Qg = (bf16*)(a.ws + WS_Q); const bf16* Kg = (const bf16*)(a.ws + WS_K); const bf16* Vg = (const bf16*)(a.ws + WS_V);
    const bf16* PART = (const bf16*)(a.ws + WS_PART); const float* LP = (const float*)(a.ws + WS_LP);
    const int h2 = lane >> 5, kr = lane & 31;
    LAS unsigned char* stg = lds + 131072 + 10240 + wave * 2560;
    const int ra = lane >> 2, rb2 = ra + 16, part = lane & 3;
#pragma unroll 1
    for (int ui = 0; ui < 4; ++ui) {
        const int unit = vcu * 4 + ui, bh = unit >> 5, qb = unit & 31, bb = bh >> 3, hh = bh & 7;
        const size_t rowbase = (size_t)bb * SEQ; const int t0 = qb * 256 + 32 * wave, t = t0 + kr;
        __syncthreads();
        load_kv_block(lds, Kg, Vg, rowbase + (size_t)qb * 256, hh, wave, lane);
        bf16* qp = Qg + (rowbase + t) * DM + hh * HD;
        v4u qs[8];
        { const bf16* qa_ = Qg + (rowbase + t0 + ra) * DM + hh * HD + 8 * part; const bf16* qb_ = Qg + (rowbase + t0 + rb2) * DM + hh * HD + 8 * part;
#pragma unroll
          for (int p_ = 0; p_ < 4; ++p_) { qs[2 * p_] = *(const GAS v4u*)(qa_ + 32 * p_); qs[2 * p_ + 1] = *(const GAS v4u*)(qb_ + 32 * p_); } }
        const int nsel = qb < 3 ? qb : 3;
        const size_t psa = ((size_t)bh * SEQ + t0 + ra) * 3, psb = ((size_t)bh * SEQ + t0 + rb2) * 3;
        float lp[3] = {0.f, 0.f, 0.f};
#pragma unroll
        for (int j = 0; j < 3; ++j) if (j < nsel) lp[j] = LP[((size_t)bh * SEQ + t) * 3 + j];
        asm volatile("s_waitcnt vmcnt(0)" ::: "memory");
        __syncthreads();
        bf16x8 qf[8];
        q_unstage(stg, qs, qf, lane);
        f32x16 O[4];
#pragma unroll
        for (int dt = 0; dt < 4; ++dt)
#pragma unroll
            for (int r = 0; r < 16; ++r) O[dt][r] = 0.f;
        float lsum = 0.f;
        attn_wave(lds, qf, O, lsum, wave + 1, wave, lane);
        lsum += __shfl_xor(lsum, 32);
        lsum += (lp[0] + lp[1]) + lp[2];
#pragma unroll 1
        for (int j = 0; j < nsel; ++j) {
            v4u pa[8];
#pragma unroll
            for (int dt = 0; dt < 4; ++dt) { pa[2 * dt] = __builtin_nontemporal_load((const GAS v4u*)(PART + (psa + j) * 128 + dt * 32 + part * 8)); pa[2 * dt + 1] = __builtin_nontemporal_load((const GAS v4u*)(PART + (psb + j) * 128 + dt * 32 + part * 8)); }
#pragma unroll
            for (int dt = 0; dt < 4; ++dt) {
                *(LAS v4u*)(stg + ra * 80 + part * 16) = pa[2 * dt]; *(LAS v4u*)(stg + rb2 * 80 + part * 16) = pa[2 * dt + 1];
                asm volatile("s_waitcnt lgkmcnt(0)" ::: "memory");
#pragma unroll
                for (int rq = 0; rq < 4; ++rq) { const unsigned long long w = *(const LAS unsigned long long*)(stg + kr * 80 + rq * 16 + h2 * 8); const unsigned w0 = (unsigned)w, w1 = (unsigned)(w >> 32);
                    O[dt][4 * rq] += pg8::bflo(w0); O[dt][4 * rq + 1] += pg8::bfhi(w0); O[dt][4 * rq + 2] += pg8::bflo(w1); O[dt][4 * rq + 3] += pg8::bfhi(w1); }
                asm volatile("s_waitcnt lgkmcnt(0)" ::: "memory");
            }
        }
        const float inv = 1.0f / lsum;
        bf16* ya = Qg + (rowbase + t0 + ra) * DM + hh * HD; bf16* yb = Qg + (rowbase + t0 + rb2) * DM + hh * HD;
#pragma unroll
        for (int dt = 0; dt < 4; ++dt) {
#pragma unroll
            for (int rq = 0; rq < 4; ++rq) { const unsigned long long w = (unsigned long long)cvtpk(O[dt][4 * rq] * inv, O[dt][4 * rq + 1] * inv) | ((unsigned long long)cvtpk(O[dt][4 * rq + 2] * inv, O[dt][4 * rq + 3] * inv) << 32);
                *(LAS unsigned long long*)(stg + kr * 80 + rq * 16 + h2 * 8) = w; }
            asm volatile("s_waitcnt lgkmcnt(0)" ::: "memory");
            const v4u ca = *(const LAS v4u*)(stg + ra * 80 + part * 16), cb2 = *(const LAS v4u*)(stg + rb2 * 80 + part * 16);
            if (variant) { asm volatile("" :: "v"(ca), "v"(cb2)); } else { *(GAS v4u*)(ya + dt * 32 + part * 8) = ca; *(GAS v4u*)(yb + dt * 32 + part * 8) = cb2; }
            asm volatile("s_waitcnt lgkmcnt(0)" ::: "memory");
        }
    }
}
__device__ __forceinline__ void fix_rows(const Args& a, int pm, int tid) {
    const float* SB = (const float*)(a.ws + WS_SB); const float* SU0 = (const float*)(a.ws + WS_SU0); const float* SG0 = (const float*)(a.ws + WS_SG0);
    bf16* ACT = (bf16*)(a.ws + WS_ACT); const float* cw = a.in[I_FCW]; const float* cb = a.in[I_FCB];
    const bool first = (pm & 31) == 0;
    const int pp = first ? pm : pm - 1;
    for (int e = tid; e < 2 * DFF; e += NWAVES * 64) {
        const int col = e % DFF, r = e / DFF;
        const float up0 = SU0[((size_t)pm * 2 + r) * DFF + col], gt = SG0[((size_t)pm * 2 + r) * DFF + col];
        const float pl1 = first ? 0.f : SB[((size_t)pp * 2 + 1) * DFF + col], pl0 = first ? 0.f : SB[((size_t)pp * 2 + 0) * DFF + col];
        const float x1 = (r == 0) ? pl1 : SU0[((size_t)pm * 2 + 0) * DFF + col];
        const float x2 = (r == 0) ? pl0 : pl1;
        const float c = cb[col] + cw[2 * DFF + col] * up0 + cw[DFF + col] * x1 + cw[col] * x2;
        ACT[((size_t)pm * 256 + r) * DFF + col] = (bf16)f2bf(pg8::gelu_tanh(c) * gt);
    }
}

template <int PV> __global__ void __launch_bounds__(NWAVES * 64, 2) mk_fwd(Args args) {
    extern __shared__ __attribute__((aligned(16))) unsigned char lds_raw[];
    LAS unsigned char* lds = (LAS unsigned char*)lds_raw;
    volatile LAS unsigned* MISC = (volatile LAS unsigned*)(lds + MISC_OFF);
    const int tid = threadIdx.x, lane = tid & 63, wave = __builtin_amdgcn_readfirstlane(tid >> 6);
    const int G = gridDim.x; const int bx = blockIdx.x; const int vcu = (G % 8 == 0) ? (bx % 8) * (G / 8) + bx / 8 : bx;
    unsigned char* ws = args.ws;
    gu32* ctl = (gu32*)(ws + WS_CTL);
    for (int u = tid; u < (LDS_BYTES - 131072) / 4; u += NWAVES * 64) ((LAS unsigned*)(lds + 131072))[u] = 0u;
    __syncthreads();
    XcdBarrier bar; bar.bar = (unsigned*)(ctl + CW_BAR); bar.x = 0; bar.st = nullptr;
    if (MK_ONE_LAUNCH) bar = xcd_barrier_post((unsigned*)(ctl + CW_BAR), MISC + 8);
    const int lo = args.ph_lo, hi = args.ph_hi;
    const int tid0 = tid;
#ifndef WGM_G1
#define WGM_G1 4
#endif
#ifndef WGM_G5
#define WGM_G5 4
#endif
#ifndef PROBE_DUP
#define PROBE_DUP 0
#endif
#ifndef PROBE_VARIANT
#define PROBE_VARIANT 0
#endif
#define LAUNDER() int tid = tid0; asm volatile("" : "+v"(tid)); const int lane = tid & 63; (void)lane
#ifndef PH_MASK
#define PH_MASK 0xffff
#endif
#define IN(k) (((PH_MASK >> (k)) & 1) && lo <= (k) && (k) < hi)
#define SEAM(k) do { if (IN(k) && IN((k) + 1)) xcd_barrier(bar); } while (0)
    const int gw = vcu * NWAVES + wave, NGW = G * NWAVES;
    bf16* XN = (bf16*)(ws + WS_XN); bf16* XR = (bf16*)(ws + WS_XR); bf16* GR = (bf16*)(ws + WS_GR);
    bf16* Qb = (bf16*)(ws + WS_Q); bf16* Kb = (bf16*)(ws + WS_K); bf16* Vb = (bf16*)(ws + WS_V);
    bf16* GA = (bf16*)args.out; bf16* GB = (bf16*)args.out + (size_t)M * DM;

    if (IN(0)) { LAUNDER(); p0_prologue(args, lds, gw, NGW, wave, lane); } SEAM(0);
    if (IN(1)) { LAUNDER();
        pg8::Gemm g{XN, (const bf16*)(ws + WS_WIN), M, DIN, DM, nullptr, nullptr}; pg8::StaticOrder S; S.init(M, DIN, G, bx, WGM_G1);
        pg8::EpiG1 E{XR, GR, Qb, Kb, Vb, GA, GB, args.in[I_QNG], args.in[I_KNG], (float*)(ws + WS_KM), (LAS float*)(lds + 131072 + 1024), QSCALE, PV};
        pg8::gemm_phase<pg8::EpiG1, pg8::StaticOrder, true, true>(lds, g, S, E); } SEAM(1);
    if (IN(3)) { LAUNDER(); rnn_phase(args, lds, G, wave, lane, tid, PV); __syncthreads(); gate_phase(args, lds, vcu, wave, lane, tid, PV); } SEAM(3);
    if (IN(6)) { LAUNDER(); sparse_phase(args, lds, G, wave, lane, tid, PV); } SEAM(6);
    if (IN(7)) { LAUNDER(); own_phase(args, lds, vcu, wave, lane, tid, PV); } SEAM(7);
    if (IN(8)) { LAUNDER(); pg8::Gemm g{XN  , (const bf16*)(ws + WS_PA), M, DM, DM, Qb  , (const bf16*)(ws + WS_PB)}; pg8::DualOrder S; S.init(M, DM, G, bx);
        pg8::EpiG3 E{GA, GB, Kb  };
        pg8::gemm_phase<pg8::EpiG3, pg8::DualOrder, true, true>(lds, g, S, E); } SEAM(8);
    if (IN(10)) { LAUNDER();
        pg8::Gemm g{Kb  , (const bf16*)(ws + WS_WOUT), M, DM, DM, nullptr, nullptr}; pg8::StaticOrder S; S.init(M, DM, G, bx);
        pg8::EpiX1 E{args.in[I_X], XN  , (float*)(ws + WS_RSP), (LAS float*)(lds + 131072 + 1024)};
        pg8::gemm_phase<pg8::EpiX1, pg8::StaticOrder, true, true>(lds, g, S, E); } SEAM(10);
    if (IN(12)) { LAUNDER(); pg8::Gemm g{XN  , (const bf16*)(ws + WS_WUG), M, 2 * DFF, DM, nullptr, nullptr}; pg8::StaticOrder S; S.init(M, 2 * DFF, G, bx, WGM_G5);
        pg8::EpiUGF E{(bf16*)(ws + WS_ACT), args.in[I_FCW], args.in[I_FCB], (float*)(ws + WS_SB), (float*)(ws + WS_SU0), (float*)(ws + WS_SG0), (LAS float*)(lds + 131072 + 1024), (const float*)(ws + WS_RSP), PV};
        pg8::gemm_phase<pg8::EpiUGF, pg8::StaticOrder, true, true>(lds, g, S, E); } SEAM(12);
    if (IN(14)) { LAUNDER(); pg8::Gemm g{(const bf16*)(ws + WS_ACT), (const bf16*)(ws + WS_WDN), M, DM, DFF, nullptr, nullptr}; pg8::StaticOrder S; S.init(M, DM, G, bx);
        { pg8::Unit fu; for (int i = 0; S.next(i, fu); ++i) fix_rows(args, fu.pm, tid); asm volatile("s_waitcnt vmcnt(0)" ::: "memory"); __syncthreads(); }
        pg8::EpiOut E{XN  , args.out};
        pg8::gemm_phase<pg8::EpiOut, pg8::StaticOrder, true, true>(lds, g, S, E); }
#undef IN
#undef SEAM
}

extern "C" void kernel_launch(void* const* d_in, const int* in_sizes, int n_in, void* d_out, int out_size, void* d_ws, size_t ws_size, hipStream_t stream) {
    static int grid = 0;
    if (grid == 0) {
        if (n_in != 21 || out_size != M * DM || ws_size < WS_END) { fprintf(stderr, "kernel_launch: unexpected shapes: n_in %d out %d ws %zu\n", n_in, out_size, ws_size); grid = -1; return; }
        int dev = 0, cus = 0;
        if (hipGetDevice(&dev) != hipSuccess || hipDeviceGetAttribute(&cus, hipDeviceAttributeMultiprocessorCount, dev) != hipSuccess) { grid = -1; return; }
        if (hipFuncSetAttribute((const void*)mk_fwd<0>, hipFuncAttributeMaxDynamicSharedMemorySize, LDS_BYTES) != hipSuccess || (PROBE_VARIANT && hipFuncSetAttribute((const void*)mk_fwd<PROBE_VARIANT>, hipFuncAttributeMaxDynamicSharedMemorySize, LDS_BYTES) != hipSuccess)) { fprintf(stderr, "kernel_launch: hipFuncSetAttribute failed\n"); grid = -1; return; }
        int per_cu = 0;
        if (hipOccupancyMaxActiveBlocksPerMultiprocessor(&per_cu, (const void*)mk_fwd<0>, NWAVES * 64, LDS_BYTES) != hipSuccess || per_cu < 1) fprintf(stderr, "kernel_launch: occupancy query says %d\n", per_cu);
        (void)hipGetLastError();
        grid = cus;
    }
    if (grid < 0) return;
    (void)hipMemsetAsync((char*)d_ws + WS_CTL, 0, CTL_ZERO_BYTES, stream);
    Args a{};
    for (int i = 0; i < 21; ++i) a.in[i] = (const float*)d_in[i];
    a.out = (float*)d_out; a.ws = (unsigned char*)d_ws;
#if MK_ONE_LAUNCH
    a.ph_lo = 0; a.ph_hi = NPHASE; a.li = 0;
    hipLaunchKernelGGL(mk_fwd<0>, dim3(grid), dim3(NWAVES * 64), LDS_BYTES, stream, a);
#else
    for (int p = 0; p < NPHASE; ++p) { a.ph_lo = p; a.ph_hi = p + 1; a.li = p; const int reps = ((PROBE_DUP >> p) & 1) ? 2 : 1;
        for (int r = 0; r < reps; ++r) { if (r && PROBE_VARIANT) hipLaunchKernelGGL(mk_fwd<PROBE_VARIANT>, dim3(grid), dim3(NWAVES * 64), LDS_BYTES, stream, a); else hipLaunchKernelGGL(mk_fwd<0>, dim3(grid), dim3(NWAVES * 64), LDS_BYTES, stream, a); } }
#endif
}
```

```cpp
#include <hip/hip_runtime.h>
#include <cstdio>
#include <cstdint>
namespace pg8 {
#define PG8_LAS __attribute__((address_space(3)))
typedef unsigned short bf16_t;
typedef short bf16x8 __attribute__((ext_vector_type(8)));
typedef float f32x4 __attribute__((ext_vector_type(4)));
typedef unsigned u32x4 __attribute__((ext_vector_type(4)));
constexpr int BM = 256, BK = 64, HALF = 128, HTB = HALF * BK * 2  , STAGE_BYTES = 8 * HTB, NXCD = 8, WGM = 4;

__host__ __device__ __forceinline__ int lds_byte(int r, int c) { const int st = (r >> 4) * 2 + (c >> 5), rr = r & 15, cc = c & 31, ob = rr * 64 + cc * 2; return st * 1024 + (ob ^ (((ob >> 9) & 1) << 5)); }
__host__ __device__ __forceinline__ void stage_rc(int b, int& R, int& C) { const int st = b / 1024, sb = b % 1024, swz = sb ^ (((sb >> 9) & 1) << 5); R = (st >> 1) * 16 + swz / 64; C = (st & 1) * 32 + (swz % 64) / 2; }
__host__ __device__ __forceinline__ int perm32(int rho) { const int n = rho >> 4, i = rho & 15; return 8 * (i >> 2) + 4 * n + (i & 3); }

struct Unit { int pm, pn, half; };
struct Gemm { const bf16_t* A; const bf16_t* Bt; int M, N, K; const bf16_t* A2; const bf16_t* Bt2; };

struct StaticOrder {
    int nM, nN, nwg, G, c, wgm;
    __host__ __device__ void init(int M, int N, int G_, int c_, int wgm_ = WGM) { nM = M / BM; nN = N / BM; nwg = nM * nN; G = G_; c = c_; wgm = wgm_; }
    __host__ __device__ __forceinline__ bool next(int i, Unit& u) const {
        const long L = (long)i * G + c; if (L >= nwg) return false;
        int wgid = (int)L; { const int q = nwg / NXCD, r = nwg % NXCD, xcd = wgid % NXCD, off = wgid / NXCD; wgid = (xcd < r ? xcd * (q + 1) : r * (q + 1) + (xcd - r) * q) + off; }
        const int nig = wgm * nN, gid = wgid / nig, fm = gid * wgm, gsz = (nM - fm) < wgm ? (nM - fm) : wgm;
        u.pm = fm + ((wgid % nig) % gsz); u.pn = (wgid % nig) / gsz; u.half = 0; return true;
    }
    __device__ __forceinline__ void a_ready(const Unit&) const {}
    __device__ __forceinline__ void done(const Unit&) const {}
};
struct DualOrder {
    StaticOrder so; int G, c;
    __host__ __device__ void init(int M, int N, int G_, int c_, int wgm_ = WGM) { so.init(M, N, 1, 0, wgm_); G = G_; c = c_; }
    __host__ __device__ bool next(int i, Unit& u) const { StaticOrder t = so; t.G = G; t.c = c; if (!t.next(i >> 1, u)) return false; u.half = i & 1; return true; }
    __device__ __forceinline__ void a_ready(const Unit&) const {}
    __device__ __forceinline__ void done(const Unit&) const {}
};
struct TableOrder {
    PG8_LAS int* tab; int n;
    template <class Base> __device__ __forceinline__ void fill(const Base& B, PG8_LAS int* t) {
        tab = t;
        const int i = (int)threadIdx.x;
        if (i < 32) { Unit u; const bool ok = B.next(i, u); tab[4 * i] = ok ? u.pm : -1; tab[4 * i + 1] = u.pn; tab[4 * i + 2] = u.half; }
        __syncthreads();
        int c = 0;
#pragma unroll 1
        for (int k = 0; k < 32; ++k) { if (tab[4 * k] < 0) break; ++c; }
        n = __builtin_amdgcn_readfirstlane(c);
    }
    __device__ __forceinline__ bool next(int i, Unit& u) const { if (i >= n) return false; u.pm = __builtin_amdgcn_readfirstlane(tab[4 * i]); u.pn = __builtin_amdgcn_readfirstlane(tab[4 * i + 1]); u.half = __builtin_amdgcn_readfirstlane(tab[4 * i + 2]); return true; }
    __device__ __forceinline__ void a_ready(const Unit&) const {}
    __device__ __forceinline__ void done(const Unit&) const {}
};
__device__ __forceinline__ unsigned cvt_pk_bf16(float lo, float hi) { unsigned r; asm volatile("v_cvt_pk_bf16_f32 %0, %1, %2" : "=v"(r) : "v"(lo), "v"(hi)); return r; }
typedef float f32x2 __attribute__((ext_vector_type(2)));
__device__ __forceinline__ float bf2f(unsigned short h) { return __builtin_bit_cast(float, (unsigned)h << 16); }
__device__ __forceinline__ float bflo(unsigned w) { return __builtin_bit_cast(float, w << 16); }
__device__ __forceinline__ float bfhi(unsigned w) { return __builtin_bit_cast(float, w & 0xffff0000u); }
__device__ __forceinline__ float fast_sigmoid(float x) { return __builtin_amdgcn_rcpf(1.0f + __builtin_amdgcn_exp2f(-1.4426950408889634f * x)); }
__device__ __forceinline__ float gelu_tanh(float x) { const float z = 0.7978845608028654f * (x + 0.044715f * x * x * x); return x * fast_sigmoid(2.0f * z); }

__device__ __forceinline__ f32x4 sigmoid4(f32x4 x) { f32x4 e = x * (-1.4426950408889634f);
#pragma unroll
    for (int j = 0; j < 4; ++j) e[j] = __builtin_amdgcn_exp2f(e[j]);
    e = e + 1.0f;
#pragma unroll
    for (int j = 0; j < 4; ++j) e[j] = __builtin_amdgcn_rcpf(e[j]);
    return e; }
__device__ __forceinline__ f32x4 gelu_tanh4(f32x4 c) { f32x4 e = (c * c * 0.044715f + 1.0f) * c * (-2.0f * 1.4426950408889634f * 0.7978845608028654f);
#pragma unroll
    for (int j = 0; j < 4; ++j) e[j] = __builtin_amdgcn_exp2f(e[j]);
    e = e + 1.0f;
#pragma unroll
    for (int j = 0; j < 4; ++j) e[j] = __builtin_amdgcn_rcpf(e[j]);
    return c * e; }
struct EpiG1 {
    static constexpr bool PERM = true, AFTER_DRAIN = false, DUAL = false;
    bf16_t *o0, *o1, *o2, *o3, *o4, *o5, *o6; const float* qg; const float* kg; float* km; PG8_LAS float* px; float qscale; int variant;
    __device__ __forceinline__ void operator()(f32x4 (&acc)[2][2][4][2], const Unit& u, int wr, int wc, int fr, int fq) const {
        const int seg = u.pn >> 2;
        if (variant == 1) {
#pragma unroll
            for (int ai = 0; ai < 2; ++ai)
#pragma unroll
                for (int bj = 0; bj < 2; ++bj)
#pragma unroll
                    for (int m = 0; m < 4; ++m)
#pragma unroll
                        for (int n = 0; n < 2; ++n) asm volatile("" :: "v"(acc[ai][bj][m][n]));
            return; }
        if (variant == 7 || variant == 8) {
            bf16_t* dummy = o0 + (size_t)64 * 1024 * 1024;
            const int r8 = (variant == 8) ? (fr & 7) : fr, cx = (variant == 8) ? ((fr >> 3) * 32) : 0;
#pragma unroll
            for (int ai = 0; ai < 2; ++ai)
#pragma unroll
                for (int m = 0; m < 4; ++m)
#pragma unroll
                    for (int bj = 0; bj < 2; ++bj) { const f32x4 v0 = acc[ai][bj][m][0], v1 = acc[ai][bj][m][1];
                        u32x4 w; w.x = cvt_pk_bf16(v0[0], v0[1]); w.y = cvt_pk_bf16(v0[2], v0[3]); w.z = cvt_pk_bf16(v1[0], v1[1]); w.w = cvt_pk_bf16(v1[2], v1[3]);
                        const int rr = (variant == 8) ? (u.pm * BM + wr * 64 + ai * HALF + m * 16 + r8 + 8 * bj) : (u.pm * BM + wr * 64 + ai * HALF + m * 16 + fr);
                        const int cc = (variant == 8) ? ((u.pn & 3) * BM + wc * 64 + cx + 8 * fq) : ((u.pn & 3) * BM + wc * 32 + 8 * fq + bj * HALF);
                        *(u32x4*)(dummy + (size_t)rr * 1024 + cc) = w; }
            return; }
        bf16_t* base = seg == 0 ? o0 : seg == 1 ? o1 : seg == 2 ? o2 : seg == 3 ? o3 : seg == 4 ? o4 : seg == 5 ? o5 : o6;
        const int row0 = u.pm * BM + wr * 64 + fr, col0 = (u.pn & 3) * BM + wc * 32 + 8 * fq;
        if (seg == 2 || seg == 3) {
            float rs[2][4][2];
#pragma unroll
            for (int ai = 0; ai < 2; ++ai)
#pragma unroll
                for (int m = 0; m < 4; ++m)
#pragma unroll
                    for (int bj = 0; bj < 2; ++bj) { const f32x4 a0 = acc[ai][bj][m][0], a1 = acc[ai][bj][m][1];
                        float ss = (a0[0] * a0[0] + a0[1] * a0[1]) + (a0[2] * a0[2] + a0[3] * a0[3]) + (a1[0] * a1[0] + a1[1] * a1[1]) + (a1[2] * a1[2] + a1[3] * a1[3]);
                        ss += __shfl_xor(ss, 16); ss += __shfl_xor(ss, 32);
                        if (fq == 0) px[(ai * HALF + wr * 64 + m * 16 + fr) * 8 + bj * 4 + wc] = ss; }
            asm volatile("s_waitcnt lgkmcnt(0)" ::: "memory"); __builtin_amdgcn_s_barrier(); asm volatile("" ::: "memory");
#pragma unroll
            for (int ai = 0; ai < 2; ++ai)
#pragma unroll
                for (int m = 0; m < 4; ++m)
#pragma unroll
                    for (int bj = 0; bj < 2; ++bj) { const f32x4 p = *(const PG8_LAS f32x4*)(px + (ai * HALF + wr * 64 + m * 16 + fr) * 8 + bj * 4);
                        rs[ai][m][bj] = 1.0f / sqrtf(((p[0] + p[1]) + (p[2] + p[3])) * (1.0f / 128.0f) + 1e-6f); }
            const float* gp = (seg == 2 ? qg : kg) + wc * 32 + 8 * fq; const float gs = (seg == 2) ? qscale : 1.0f;
            const f32x4 g0 = *(const f32x4*)gp * gs, g1 = *(const f32x4*)(gp + 4) * gs;
            f32x4 cs[2][2];
#pragma unroll
            for (int bj = 0; bj < 2; ++bj) { cs[bj][0] = (f32x4){0.f, 0.f, 0.f, 0.f}; cs[bj][1] = (f32x4){0.f, 0.f, 0.f, 0.f}; }
#pragma unroll
            for (int ai = 0; ai < 2; ++ai)
#pragma unroll
                for (int m = 0; m < 4; ++m) { bf16_t* rowp = base + (size_t)(row0 + ai * HALF + m * 16) * 1024 + col0;
#pragma unroll
                    for (int bj = 0; bj < 2; ++bj) { const f32x4 v0 = acc[ai][bj][m][0] * rs[ai][m][bj] * g0, v1 = acc[ai][bj][m][1] * rs[ai][m][bj] * g1;
                        cs[bj][0] += v0; cs[bj][1] += v1;
                        u32x4 w; w.x = cvt_pk_bf16(v0[0], v0[1]); w.y = cvt_pk_bf16(v0[2], v0[3]); w.z = cvt_pk_bf16(v1[0], v1[1]); w.w = cvt_pk_bf16(v1[2], v1[3]);
                        if (variant) asm volatile("" :: "v"(w)); else __builtin_nontemporal_store(w, (u32x4*)(rowp + bj * HALF)); } }
            if (seg == 3 && !variant) {
#pragma unroll
                for (int bj = 0; bj < 2; ++bj)
#pragma unroll
                    for (int n = 0; n < 2; ++n)
#pragma unroll
                        for (int j = 0; j < 4; ++j) { float c = cs[bj][n][j]; c += __shfl_xor(c, 1); c += __shfl_xor(c, 2); c += __shfl_xor(c, 4); c += __shfl_xor(c, 8);
                            if (fr == 0) atomicAdd(km + ((size_t)u.pm * 8 + 2 * (u.pn & 3) + bj) * 128 + wc * 32 + 8 * fq + 4 * n + j, c * (1.0f / 256.0f)); }
            }
            return;
        }
#pragma unroll
        for (int ai = 0; ai < 2; ++ai)
#pragma unroll
            for (int m = 0; m < 4; ++m) { bf16_t* rowp = base + (size_t)(row0 + ai * HALF + m * 16) * 1024 + col0;
#pragma unroll
                for (int bj = 0; bj < 2; ++bj) { f32x4 v0 = acc[ai][bj][m][0], v1 = acc[ai][bj][m][1];
                    if (seg == 1) { v0 = gelu_tanh4(v0); v1 = gelu_tanh4(v1); }
                    else if (seg >= 5) { v0 = sigmoid4(v0); v1 = sigmoid4(v1); }
                    u32x4 w; w.x = cvt_pk_bf16(v0[0], v0[1]); w.y = cvt_pk_bf16(v0[2], v0[3]); w.z = cvt_pk_bf16(v1[0], v1[1]); w.w = cvt_pk_bf16(v1[2], v1[3]);
                    if (variant) asm volatile("" :: "v"(w)); else __builtin_nontemporal_store(w, (u32x4*)(rowp + bj * HALF)); } }
    }
};
struct EpiG3 {
    static constexpr bool PERM = true, AFTER_DRAIN = false, DUAL = true;
    const bf16_t* ga; const bf16_t* gb; bf16_t* out;
    __device__ __forceinline__ void mid(f32x4 (&acc)[2][2][4][2], const Unit& u, int wr, int wc, int fr, int fq) const {
        const int row0 = u.pm * BM + wr * 64 + fr, col0 = u.pn * BM + wc * 32 + 8 * fq;
#pragma unroll
        for (int ai = 0; ai < 2; ++ai) {
            u32x4 wa[4][2], wb[4][2];
#pragma unroll
            for (int m = 0; m < 4; ++m)
#pragma unroll
                for (int bj = 0; bj < 2; ++bj) { const size_t off = (size_t)(row0 + ai * HALF + m * 16) * 1024 + col0 + bj * HALF; wa[m][bj] = *(const u32x4*)(ga + off); wb[m][bj] = *(const u32x4*)(gb + off); }
#pragma unroll
            for (int m = 0; m < 4; ++m)
#pragma unroll
                for (int bj = 0; bj < 2; ++bj) { const u32x4 a = wa[m][bj], b = wb[m][bj];
                    acc[ai][bj][m][0] *= (f32x4){bflo(a.x) * __builtin_amdgcn_rcpf(bflo(b.x)), bfhi(a.x) * __builtin_amdgcn_rcpf(bfhi(b.x)), bflo(a.y) * __builtin_amdgcn_rcpf(bflo(b.y)), bfhi(a.y) * __builtin_amdgcn_rcpf(bfhi(b.y))};
                    acc[ai][bj][m][1] *= (f32x4){bflo(a.z) * __builtin_amdgcn_rcpf(bflo(b.z)), bfhi(a.z) * __builtin_amdgcn_rcpf(bfhi(b.z)), bflo(a.w) * __builtin_amdgcn_rcpf(bflo(b.w)), bfhi(a.w) * __builtin_amdgcn_rcpf(bfhi(b.w))}; }
        }
    }
    __device__ __forceinline__ void operator()(f32x4 (&acc)[2][2][4][2], const Unit& u, int wr, int wc, int fr, int fq) const {
        const int row0 = u.pm * BM + wr * 64 + fr, col0 = u.pn * BM + wc * 32 + 8 * fq;
        u32x4 wb[2][4][2];
#pragma unroll
        for (int ai = 0; ai < 2; ++ai)
#pragma unroll
            for (int m = 0; m < 4; ++m)
#pragma unroll
                for (int bj = 0; bj < 2; ++bj) wb[ai][m][bj] = *(const u32x4*)(gb + (size_t)(row0 + ai * HALF + m * 16) * 1024 + col0 + bj * HALF);
        asm volatile("" ::: "memory");
#pragma unroll
        for (int ai = 0; ai < 2; ++ai)
#pragma unroll
            for (int m = 0; m < 4; ++m)
#pragma unroll
                for (int bj = 0; bj < 2; ++bj) { const u32x4 b = wb[ai][m][bj]; const f32x4 v0 = acc[ai][bj][m][0], v1 = acc[ai][bj][m][1];
                    u32x4 w; w.x = cvt_pk_bf16(v0[0] * bflo(b.x), v0[1] * bfhi(b.x)); w.y = cvt_pk_bf16(v0[2] * bflo(b.y), v0[3] * bfhi(b.y)); w.z = cvt_pk_bf16(v1[0] * bflo(b.z), v1[1] * bfhi(b.z)); w.w = cvt_pk_bf16(v1[2] * bflo(b.w), v1[3] * bfhi(b.w));
                    *(u32x4*)(out + (size_t)(row0 + ai * HALF + m * 16) * 1024 + col0 + bj * HALF) = w; }
    }
};
template <class T> __device__ __forceinline__ T* at_byte(T* base, unsigned byteoff) { return (T*)((char*)base + byteoff); }
struct EpiX1 {
    static constexpr bool PERM = true, AFTER_DRAIN = false, DUAL = false;
    const float* base; bf16_t* xb; float* rsp; PG8_LAS float* px;
    __device__ __forceinline__ void operator()(f32x4 (&acc)[2][2][4][2], const Unit& u, int wr, int wc, int fr, int fq) const {
        const unsigned e0 = (unsigned)(u.pm * BM + wr * 64 + fr) * 1024u + (unsigned)(u.pn * BM + wc * 32 + 8 * fq);
#pragma unroll
        for (int ai = 0; ai < 2; ++ai) {
#pragma unroll
            for (int mh = 0; mh < 2; ++mh) {
                f32x4 b[2][2][2];
#pragma unroll
                for (int m2 = 0; m2 < 2; ++m2)
#pragma unroll
                    for (int bj = 0; bj < 2; ++bj) { const float* p = at_byte(base, (e0 + (unsigned)((ai * HALF + (2 * mh + m2) * 16) * 1024 + bj * HALF)) * 4u); b[m2][bj][0] = __builtin_nontemporal_load((const f32x4*)p); b[m2][bj][1] = __builtin_nontemporal_load((const f32x4*)(p + 4)); }
#pragma unroll
                for (int m2 = 0; m2 < 2; ++m2)
#pragma unroll
                    for (int bj = 0; bj < 2; ++bj) { acc[ai][bj][2 * mh + m2][0] += b[m2][bj][0]; acc[ai][bj][2 * mh + m2][1] += b[m2][bj][1]; }
                asm volatile("" ::: "memory");
            }
#pragma unroll
            for (int m = 0; m < 4; ++m) { f32x4 s4 = {0.f, 0.f, 0.f, 0.f};
#pragma unroll
                for (int bj = 0; bj < 2; ++bj)
#pragma unroll
                    for (int n = 0; n < 2; ++n) { const f32x4 v = acc[ai][bj][m][n]; s4 += v * v; }
                float ss = (s4[0] + s4[1]) + (s4[2] + s4[3]);
                ss += __shfl_xor(ss, 16); ss += __shfl_xor(ss, 32);
                if (fq == 0) px[(ai * HALF + wr * 64 + m * 16 + fr) * 4 + wc] = ss; }
#pragma unroll
            for (int m = 0; m < 4; ++m)
#pragma unroll
                for (int bj = 0; bj < 2; ++bj) { const unsigned eo = e0 + (unsigned)((ai * HALF + m * 16) * 1024 + bj * HALF); const f32x4 v0 = acc[ai][bj][m][0], v1 = acc[ai][bj][m][1];
                    u32x4 w; w.x = cvt_pk_bf16(v0[0], v0[1]); w.y = cvt_pk_bf16(v0[2], v0[3]); w.z = cvt_pk_bf16(v1[0], v1[1]); w.w = cvt_pk_bf16(v1[2], v1[3]); *(u32x4*)at_byte(xb, eo * 2u) = w; }
            asm volatile("" ::: "memory");
        }
        asm volatile("s_waitcnt lgkmcnt(0)" ::: "memory"); __builtin_amdgcn_s_barrier(); asm volatile("" ::: "memory");
        const int t = (int)threadIdx.x;
        if (t < 256) { const f32x4 p = *(const PG8_LAS f32x4*)(px + t * 4); rsp[((size_t)u.pm * BM + t) * 4 + u.pn] = (p[0] + p[1]) + (p[2] + p[3]); }
    }
};
struct EpiOut {
    static constexpr bool PERM = true, AFTER_DRAIN = false, DUAL = false;
    const bf16_t* xb; float* out;
    __device__ __forceinline__ void operator()(f32x4 (&acc)[2][2][4][2], const Unit& u, int wr, int wc, int fr, int fq) const {
        const unsigned e0 = (unsigned)(u.pm * BM + wr * 64 + fr) * 1024u + (unsigned)(u.pn * BM + wc * 32 + 8 * fq);
        u32x4 r[2][4][2];
#pragma unroll
        for (int ai = 0; ai < 2; ++ai)
#pragma unroll
            for (int m = 0; m < 4; ++m)
#pragma unroll
                for (int bj = 0; bj < 2; ++bj) r[ai][m][bj] = *(const u32x4*)at_byte(xb, (e0 + (unsigned)((ai * HALF + m * 16) * 1024 + bj * HALF)) * 2u);
        asm volatile("" ::: "memory");
#pragma unroll
        for (int ai = 0; ai < 2; ++ai)
#pragma unroll
            for (int m = 0; m < 4; ++m)
#pragma unroll
                for (int bj = 0; bj < 2; ++bj) { const u32x4 w = r[ai][m][bj]; const unsigned eo = e0 + (unsigned)((ai * HALF + m * 16) * 1024 + bj * HALF);
                    const f32x4 v0 = acc[ai][bj][m][0] + (f32x4){bflo(w.x), bfhi(w.x), bflo(w.y), bfhi(w.y)}, v1 = acc[ai][bj][m][1] + (f32x4){bflo(w.z), bfhi(w.z), bflo(w.w), bfhi(w.w)};
                    float* po = at_byte(out, eo * 4u); __builtin_nontemporal_store(v0, (f32x4*)po); __builtin_nontemporal_store(v1, (f32x4*)(po + 4)); }
    }
};
template <int CTRL> __device__ __forceinline__ float dpp_mov(float old, float src) { return __builtin_bit_cast(float, __builtin_amdgcn_update_dpp(__builtin_bit_cast(int, old), __builtin_bit_cast(int, src), CTRL, 0xf, 0xf, false)); }
struct EpiUGF {
    static constexpr bool PERM = true, AFTER_DRAIN = false, DUAL = false;
    bf16_t* act; const float* cw; const float* cb; float* sb_last; float* su0; float* sg0; PG8_LAS float* halo; const float* rsp; int variant;
    __device__ __forceinline__ void operator()(f32x4 (&acc)[2][2][4][2], const Unit& u, int wr, int wc, int fr, int fq) const {
        const int colh = wc * 32 + 8 * fq, gcol = u.pn * HALF + colh;
        if (variant == 1) {
#pragma unroll
            for (int ai = 0; ai < 2; ++ai)
#pragma unroll
                for (int bj = 0; bj < 2; ++bj)
#pragma unroll
                    for (int m = 0; m < 4; ++m)
#pragma unroll
                        for (int n = 0; n < 2; ++n) asm volatile("" :: "v"(acc[ai][bj][m][n]));
            return; }
        {
            f32x4 rp[2][4];
#pragma unroll
            for (int ai = 0; ai < 2; ++ai)
#pragma unroll
                for (int m = 0; m < 4; ++m) rp[ai][m] = *(const f32x4*)at_byte(rsp, (unsigned)(u.pm * BM + ai * HALF + wr * 64 + m * 16 + fr) * 16u);
            { const int t = (int)threadIdx.x, r4 = t >> 7, c = t & 127;
              halo[1024 + t] = (r4 < 3) ? cw[r4 * 2816 + u.pn * HALF + c] : cb[u.pn * HALF + c]; }
#pragma unroll
            for (int ai = 0; ai < 2; ++ai)
#pragma unroll
                for (int m = 0; m < 4; ++m) { const f32x4 p = rp[ai][m]; const float rstd = __builtin_amdgcn_rsqf(((p[0] + p[1]) + (p[2] + p[3])) * (1.0f / 1024.0f) + 1e-6f);
#pragma unroll
                    for (int bj = 0; bj < 2; ++bj) { acc[ai][bj][m][0] *= rstd; acc[ai][bj][m][1] *= rstd; } }
        }
        asm volatile("" ::: "memory");
        if (fr >= 14) {
#pragma unroll
            for (int ai = 0; ai < 2; ++ai)
#pragma unroll
                for (int n = 0; n < 2; ++n) *(PG8_LAS f32x4*)(halo + ((2 * ai + wr) * 2 + (fr - 14)) * 128 + colh + 4 * n) = acc[ai][0][3][n];
            if (wr == 1) {
#pragma unroll
                for (int n = 0; n < 2; ++n) *(f32x4*)(sb_last + ((size_t)u.pm * 2 + (fr - 14)) * 2816 + gcol + 4 * n) = acc[1][0][3][n];
            }
        }
        asm volatile("s_waitcnt lgkmcnt(0)" ::: "memory"); __builtin_amdgcn_s_barrier(); asm volatile("" ::: "memory");
#pragma unroll
        for (int ai = 0; ai < 2; ++ai) {
            const int seg = 2 * ai + wr;
            f32x4 prev[2];
#pragma unroll
            for (int n = 0; n < 2; ++n) prev[n] = *(const PG8_LAS f32x4*)(halo + (((seg > 0 ? seg - 1 : 0)) * 2 + (fr & 1)) * 128 + colh + 4 * n);
#pragma unroll
            for (int m = 0; m < 4; ++m) {
                float r[8];
#pragma unroll
                for (int n = 0; n < 2; ++n) { const f32x4 cur = acc[ai][0][m][n], gt = acc[ai][1][m][n];
                    const f32x4 w0 = *(const PG8_LAS f32x4*)(halo + 1024 + colh + 4 * n), w1 = *(const PG8_LAS f32x4*)(halo + 1024 + 128 + colh + 4 * n), w2 = *(const PG8_LAS f32x4*)(halo + 1024 + 256 + colh + 4 * n), bb = *(const PG8_LAS f32x4*)(halo + 1024 + 384 + colh + 4 * n);
                    f32x4 v1, v2;
#pragma unroll
                    for (int j = 0; j < 4; ++j) {
                        const float t1 = dpp_mov<0x121>(prev[n][j], prev[n][j]); v1[j] = dpp_mov<0x111>(t1, cur[j]);
                        const float t2 = dpp_mov<0x122>(prev[n][j], prev[n][j]); v2[j] = dpp_mov<0x112>(t2, cur[j]); }
                    const f32x4 c = bb + w2 * cur + w1 * v1 + w0 * v2;
                    f32x4 ez = (c * c * 0.044715f + 1.0f) * c * (-2.0f * 1.4426950408889634f * 0.7978845608028654f);
#pragma unroll
                    for (int j = 0; j < 4; ++j) ez[j] = __builtin_amdgcn_exp2f(ez[j]);
                    ez = ez + 1.0f;
#pragma unroll
                    for (int j = 0; j < 4; ++j) ez[j] = __builtin_amdgcn_rcpf(ez[j]);
                    const f32x4 o = c * gt * ez;
                    r[4 * n] = o[0]; r[4 * n + 1] = o[1]; r[4 * n + 2] = o[2]; r[4 * n + 3] = o[3];
                    prev[n] = cur; }
                const unsigned row = (unsigned)(u.pm * BM + ai * HALF + wr * 64 + m * 16 + fr);
                const bool head = (seg == 0) && (m == 0) && (fr < 2);
                if (!head) { u32x4 w; w.x = cvt_pk_bf16(r[0], r[1]); w.y = cvt_pk_bf16(r[2], r[3]); w.z = cvt_pk_bf16(r[4], r[5]); w.w = cvt_pk_bf16(r[6], r[7]);
                    if (variant == 2) asm volatile("" :: "v"(w)); else *(u32x4*)at_byte(act, (row * 2816u + (unsigned)gcol) * 2u) = w; }
                else {
#pragma unroll
                    for (int n = 0; n < 2; ++n) { *(f32x4*)(su0 + ((size_t)u.pm * 2 + fr) * 2816 + gcol + 4 * n) = acc[0][0][0][n]; *(f32x4*)(sg0 + ((size_t)u.pm * 2 + fr) * 2816 + gcol + 4 * n) = acc[0][1][0][n]; }
                }
            }
        }
    }
};
template <class Epi, class Sched, bool ALIGN_EPI = false, bool SP2 = false>
__device__ __forceinline__ void gemm_phase(PG8_LAS unsigned char* lds, const Gemm g, const Sched& S, const Epi& E) {
    const int tid = threadIdx.x, wid = __builtin_amdgcn_readfirstlane(tid >> 6), lane = tid & 63, wr = wid >> 2, wc = wid & 3, fr = lane & 15, fq = lane >> 4;
    const int K = g.K, nt = K / BK;
    unsigned voffA[2], voffB[2];
#pragma unroll
    for (int i = 0; i < 2; ++i) { int R, C; stage_rc(tid * 16 + i * 8192, R, C); const int Rb = Epi::PERM ? ((R & ~31) + perm32(R & 31)) : R;
        voffA[i] = (unsigned)(R * K + C) * 2u; voffB[i] = (unsigned)(Rb * K + C) * 2u; }
    const size_t kstep = (size_t)(BK * 2);
    const size_t hstep = (size_t)HALF * K * 2;
    const size_t tstep = 2 * hstep;
    const unsigned ldsw = (unsigned)wid * 1024u;
    const int aoff = lds_byte(wr * 64 + fr, fq * 8), boff = lds_byte(wc * 32 + fr, fq * 8);
#define PG8_SA(b, h) (((b) * 2 + (h)) * HTB)
#define PG8_SB(b, h) ((4 + (b) * 2 + (h)) * HTB)
#ifndef PG8_AUX_B
#define PG8_AUX_B 0
#endif
#define PG8_STAGE(bufoff, gbase, voff) do { _Pragma("unroll") for (int _i = 0; _i < 2; ++_i) \
        __builtin_amdgcn_global_load_lds((const unsigned*)((const char*)(gbase) + (voff)[_i]), (PG8_LAS unsigned*)(lds + (bufoff) + ldsw + _i * 8192), 16, 0, (((bufoff) >= 4 * HTB) ? PG8_AUX_B : 0)); } while (0)
#define PG8_LDA(dst, b, h) do { _Pragma("unroll") for (int m = 0; m < 4; ++m) _Pragma("unroll") for (int k = 0; k < 2; ++k) dst[m][k] = *(const PG8_LAS bf16x8*)(lds + PG8_SA(b, h) + aoff + m * 2048 + k * 1024); } while (0)
#define PG8_LDB(dst, b, h) do { _Pragma("unroll") for (int n = 0; n < 2; ++n) _Pragma("unroll") for (int k = 0; k < 2; ++k) dst[n][k] = *(const PG8_LAS bf16x8*)(lds + PG8_SB(b, h) + boff + n * 2048 + k * 1024); } while (0)
#define PG8_MMA(ai, bj, At, Bt) do { __builtin_amdgcn_s_setprio(1); _Pragma("unroll") for (int m = 0; m < 4; ++m) _Pragma("unroll") for (int n = 0; n < 2; ++n) _Pragma("unroll") for (int k = 0; k < 2; ++k) \
        acc[ai][bj][m][n] = __builtin_amdgcn_mfma_f32_16x16x32_bf16(Bt[n][k], At[m][k], acc[ai][bj][m][n], 0, 0, 0); __builtin_amdgcn_s_setprio(0); } while (0)
#define PG8_WAIT_V(n) asm volatile("s_waitcnt vmcnt(" #n ")" ::: "memory")
#define PG8_WAIT_L(n) asm volatile("s_waitcnt lgkmcnt(" #n ")" ::: "memory")
#define PG8_BAR __builtin_amdgcn_s_barrier()
#define PG8_SCHED __builtin_amdgcn_sched_barrier(0)
    Unit cur, nxt; int ui = 0;
    if (!S.next(0, cur)) return;
    f32x4 acc[2][2][4][2];
#pragma unroll
    for (int a = 0; a < 2; ++a)
#pragma unroll
        for (int b = 0; b < 2; ++b)
#pragma unroll
            for (int m = 0; m < 4; ++m)
#pragma unroll
                for (int n = 0; n < 2; ++n) acc[a][b][m][n] = (f32x4){0.f, 0.f, 0.f, 0.f};
    bf16x8 At[4][2], B0[2][2], B1[2][2];
    const char* cA = (const char*)(cur.half ? g.A2 : g.A) + (size_t)cur.pm * tstep; const char* cB = (const char*)(cur.half ? g.Bt2 : g.Bt) + (size_t)cur.pn * tstep;
    S.a_ready(cur);
    if constexpr (SP2) {
        PG8_STAGE(PG8_SB(0, 0), cB, voffB); PG8_STAGE(PG8_SB(0, 1), cB + hstep, voffB); PG8_STAGE(PG8_SA(0, 0), cA, voffA); PG8_STAGE(PG8_SA(0, 1), cA + hstep, voffA);
        if (wr == 1) PG8_BAR;
        PG8_WAIT_V(2); PG8_BAR;
        PG8_STAGE(PG8_SB(1, 0), cB + kstep, voffB); PG8_STAGE(PG8_SA(1, 0), cA + kstep, voffA); PG8_STAGE(PG8_SB(1, 1), cB + hstep + kstep, voffB);
        PG8_WAIT_V(6); PG8_BAR;
    } else {
        PG8_STAGE(PG8_SB(0, 0), cB, voffB); PG8_STAGE(PG8_SA(0, 0), cA, voffA); PG8_STAGE(PG8_SB(0, 1), cB + hstep, voffB); PG8_STAGE(PG8_SA(0, 1), cA + hstep, voffA);
        if (wr == 1) PG8_BAR;
        PG8_WAIT_V(4); PG8_BAR;
        PG8_STAGE(PG8_SB(1, 0), cB + kstep, voffB); PG8_STAGE(PG8_SA(1, 0), cA + kstep, voffA); PG8_STAGE(PG8_SB(1, 1), cB + hstep + kstep, voffB);
        PG8_WAIT_V(6); PG8_BAR;
    }
    for (;;) {
        const bool has_next = S.next(ui + 1, nxt);
        const char* nA = has_next ? (const char*)(nxt.half ? g.A2 : g.A) + (size_t)nxt.pm * tstep : cA; const char* nB = has_next ? (const char*)(nxt.half ? g.Bt2 : g.Bt) + (size_t)nxt.pn * tstep : cB;
        for (int t = 0; t < nt; t += 2) {
            const bool last = (t == nt - 2);
            const char* a1 = cA + (size_t)(t + 1) * kstep;
            const char* a2 = last ? nA : cA + (size_t)(t + 2) * kstep; const char* b2 = last ? nB : cB + (size_t)(t + 2) * kstep;
            const char* a3 = a2 + kstep; const char* b3 = b2 + kstep;
            if (last && has_next) S.a_ready(nxt);
            if constexpr (SP2) {
            PG8_LDB(B0, 0, 0); PG8_LDB(B1, 0, 1); PG8_SCHED; PG8_LDA(At, 0, 0); PG8_STAGE(PG8_SA(1, 1), a1 + hstep, voffA);
            PG8_WAIT_V(8); PG8_WAIT_L(0); PG8_BAR; PG8_MMA(0, 0, At, B0); PG8_MMA(0, 1, At, B1); PG8_BAR; PG8_SCHED;
            PG8_LDA(At, 0, 1); PG8_STAGE(PG8_SB(0, 0), b2, voffB); PG8_STAGE(PG8_SB(0, 1), b2 + hstep, voffB); PG8_STAGE(PG8_SA(0, 0), a2, voffA);
            PG8_WAIT_V(8); PG8_WAIT_L(0); PG8_BAR; PG8_MMA(1, 0, At, B0); PG8_MMA(1, 1, At, B1); PG8_BAR; PG8_SCHED;
            PG8_LDB(B0, 1, 0); PG8_LDB(B1, 1, 1); PG8_SCHED; PG8_LDA(At, 1, 0); PG8_STAGE(PG8_SA(0, 1), a2 + hstep, voffA);
            PG8_WAIT_V(8); PG8_WAIT_L(0); PG8_BAR; PG8_MMA(0, 0, At, B0); PG8_MMA(0, 1, At, B1); PG8_BAR; PG8_SCHED;
            PG8_LDA(At, 1, 1); PG8_STAGE(PG8_SB(1, 0), b3, voffB); PG8_STAGE(PG8_SB(1, 1), b3 + hstep, voffB); PG8_STAGE(PG8_SA(1, 0), a3, voffA);
            PG8_WAIT_V(8); PG8_WAIT_L(0); PG8_BAR; PG8_MMA(1, 0, At, B0); PG8_MMA(1, 1, At, B1); PG8_BAR; PG8_SCHED;
            } else {
            PG8_LDB(B0, 0, 0); PG8_SCHED; PG8_LDA(At, 0, 0); PG8_STAGE(PG8_SA(1, 1), a1 + hstep, voffA);
            PG8_WAIT_L(8); PG8_BAR; PG8_WAIT_L(0); PG8_MMA(0, 0, At, B0); PG8_BAR; PG8_SCHED;
            PG8_LDB(B1, 0, 1); PG8_STAGE(PG8_SB(0, 0), b2, voffB);
            PG8_BAR; PG8_WAIT_L(0); PG8_MMA(0, 1, At, B1); PG8_BAR;
            PG8_LDA(At, 0, 1); PG8_STAGE(PG8_SA(0, 0), a2, voffA);
            PG8_BAR; PG8_WAIT_L(0); PG8_MMA(1, 0, At, B0); PG8_BAR; PG8_SCHED;
            PG8_STAGE(PG8_SB(0, 1), b2 + hstep, voffB);
            PG8_WAIT_V(6); PG8_BAR; PG8_MMA(1, 1, At, B1); PG8_BAR;
            PG8_LDB(B0, 1, 0); PG8_SCHED; PG8_LDA(At, 1, 0); PG8_STAGE(PG8_SA(0, 1), a2 + hstep, voffA);
            PG8_WAIT_L(8); PG8_BAR; PG8_WAIT_L(0); PG8_MMA(0, 0, At, B0); PG8_BAR; PG8_SCHED;
            PG8_LDB(B1, 1, 1); PG8_STAGE(PG8_SB(1, 0), b3, voffB);
            PG8_BAR; PG8_WAIT_L(0); PG8_MMA(0, 1, At, B1); PG8_BAR;
            PG8_LDA(At, 1, 1); PG8_STAGE(PG8_SA(1, 0), a3, voffA);
            PG8_BAR; PG8_WAIT_L(0); PG8_MMA(1, 0, At, B0); PG8_BAR; PG8_SCHED;
            PG8_STAGE(PG8_SB(1, 1), b3 + hstep, voffB);
            PG8_WAIT_V(6); PG8_BAR; PG8_MMA(1, 1, At, B1); PG8_BAR;
            }
        }
        if constexpr (ALIGN_EPI) { if (wr == 0) PG8_BAR; }
        bool keep_acc = false;
        if constexpr (Epi::DUAL) { if (cur.half == 0) { E.mid(acc, cur, wr, wc, fr, fq); keep_acc = true; } }
        if constexpr (!Epi::AFTER_DRAIN) { if (!keep_acc) { E(acc, cur, wr, wc, fr, fq); S.done(cur); } }
        if (!has_next) break;
        if (!keep_acc) {
#pragma unroll
        for (int a = 0; a < 2; ++a)
#pragma unroll
            for (int b = 0; b < 2; ++b)
#pragma unroll
                for (int m = 0; m < 4; ++m)
#pragma unroll
                    for (int n = 0; n < 2; ++n) acc[a][b][m][n] = (f32x4){0.f, 0.f, 0.f, 0.f};
        }
        cur = nxt; cA = nA; cB = nB; ++ui;
        if constexpr (ALIGN_EPI) { if (wr == 1) PG8_BAR; }
    }
    PG8_WAIT_V(0);
    if constexpr (!ALIGN_EPI) { if (wr == 0) PG8_BAR; }
    PG8_BAR;
    if constexpr (Epi::AFTER_DRAIN) { E.fused(acc, cur, wr, wc, fr, fq, lds, wid, lane); S.done(cur); }
#undef PG8_SA
#undef PG8_SB
#undef PG8_STAGE
#undef PG8_LDA
#undef PG8_LDB
#undef PG8_MMA
#undef PG8_WAIT_V
#undef PG8_WAIT_L
#undef PG8_BAR
#undef PG8_SCHED
}
}
#define GAS __attribute__((address_space(1)))
#define LAS __attribute__((address_space(3)))
typedef unsigned short bf16;
typedef unsigned v4u __attribute__((ext_vector_type(4)));
typedef float f32x4 __attribute__((ext_vector_type(4)));
typedef short bf16x8 __attribute__((ext_vector_type(8)));
typedef GAS unsigned gu32;
typedef GAS unsigned long long gu64;
#define RLX_AGENT __ATOMIC_RELAXED, __HIP_MEMORY_SCOPE_AGENT
#define LDS_WAIT() asm volatile("s_waitcnt lgkmcnt(0)" ::: "memory")
#define VM_WAIT() asm volatile("s_waitcnt vmcnt(0)" ::: "memory")
__device__ __forceinline__ unsigned long long rt() { return __builtin_amdgcn_s_memrealtime(); }
__device__ __forceinline__ unsigned f2bf(float f) { unsigned u = __builtin_bit_cast(unsigned, f); return (u + 0x7fffu + ((u >> 16) & 1u)) >> 16; }
__device__ __forceinline__ unsigned pk2(float lo, float hi) { return f2bf(lo) | (f2bf(hi) << 16); }

#define XB_TMO      128
#define XB_XCNT(j)  (256  + 64 * (j))
#define XB_XSUB(j)  (1280 + 64 * (j))
#define XB_XGEN(j)  (2304 + 64 * (j))
#define XB_TOP      3328
#define XB_TOPGEN   3392
#define XCD_BAR_WORDS 3456
#define XB_SPIN_CAP (1u << 18)

__device__ __forceinline__ unsigned xb_ld(unsigned* p)              { return __hip_atomic_load(p, __ATOMIC_RELAXED, __HIP_MEMORY_SCOPE_AGENT); }
__device__ __forceinline__ unsigned xb_add(unsigned* p, unsigned v) { return __hip_atomic_fetch_add(p, v, __ATOMIC_RELAXED, __HIP_MEMORY_SCOPE_AGENT); }
__device__ __forceinline__ unsigned xb_xcc_id() { return (unsigned)__builtin_amdgcn_s_getreg((3 << 11) | 20) & 0xFu; }
#define XB_SPIN(cond, bar) do { unsigned _sp = 0; while (cond) { __builtin_amdgcn_s_sleep(1); \
    if ((++_sp & 255u) == 0u) { if (xb_ld(&(bar)[XB_TMO])) break; if (_sp > XB_SPIN_CAP) { atomicAdd(&(bar)[XB_TMO], 1u); break; } } } } while (0)

struct XcdBarrier {
    unsigned* bar; unsigned x;
    volatile LAS unsigned* st;
};

__device__ __forceinline__ XcdBarrier xcd_barrier_post(unsigned* bar, volatile LAS unsigned* st) {
    XcdBarrier b; b.bar = bar; b.x = xb_xcc_id(); b.st = st;
    if (threadIdx.x == 0) (void)xb_add(&bar[XB_XCNT(b.x)], 1u);
    return b;
}
__device__ __forceinline__ void xcd_barrier_complete(unsigned* bar, unsigned x, unsigned& nloc, unsigned& nx) {
    const unsigned G = gridDim.x * gridDim.y * gridDim.z;
    unsigned sum, cnt, mine, sp = 0u;
    for (;;) {
        sum = 0u; cnt = 0u; mine = 0u;
#pragma unroll
        for (unsigned j = 0; j < 16; ++j) { const unsigned c = xb_ld(&bar[XB_XCNT(j)]); sum += c; cnt += (c > 0u) ? 1u : 0u; mine = (j == x) ? c : mine; }
        if (sum == G) break;
        __builtin_amdgcn_s_sleep(1);
        if ((++sp & 255u) == 0u) { if (xb_ld(&bar[XB_TMO])) break; if (sp > XB_SPIN_CAP) { atomicAdd(&bar[XB_TMO], 1u); break; } }
    }
    nloc = mine > 0u ? mine : 1u; nx = cnt > 0u ? cnt : 1u;
}

__device__ __forceinline__ void xcd_barrier(const XcdBarrier& b) {
    asm volatile("s_waitcnt vmcnt(0)" ::: "memory");
    __syncthreads();
    if (threadIdx.x == 0) {
        unsigned* bar = b.bar;
        __builtin_amdgcn_s_waitcnt(0);
        unsigned nloc = b.st[0], nx = b.st[1];
        if (nloc == 0u) { xcd_barrier_complete(bar, b.x, nloc, nx); b.st[0] = nloc; b.st[1] = nx; }
        const unsigned old = xb_add(&bar[XB_XSUB(b.x)], 1u);
        const unsigned gen = old / nloc;
        if (old + 1u == (gen + 1u) * nloc) {
            __builtin_amdgcn_fence(__ATOMIC_RELEASE, "agent");
            asm volatile("s_waitcnt vmcnt(0)" ::: "memory");
            const unsigned og = xb_add(&bar[XB_TOP], 1u);
            const unsigned tg = og / nx;
            if (og + 1u == (tg + 1u) * nx) xb_add(&bar[XB_TOPGEN], 1u);
            else XB_SPIN(xb_ld(&bar[XB_TOPGEN]) == tg, bar);
            __builtin_amdgcn_fence(__ATOMIC_ACQUIRE, "agent");
            xb_add(&bar[XB_XGEN(b.x)], 1u);
            asm volatile("s_waitcnt vmcnt(0)" ::: "memory");
        } else {
            XB_SPIN(xb_ld(&bar[XB_XGEN(b.x)]) == gen, bar);
            __builtin_amdgcn_fence(__ATOMIC_ACQUIRE, "agent");
            asm volatile("s_waitcnt vmcnt(0)" ::: "memory");
        }
    }
    __syncthreads();
}

constexpr int NWAVES = 8;
constexpr int NB = 4, SEQ = 8192, DM = 1024, M = NB * SEQ, DIN = 7168, DFF = 2816, NH = 8, HD = 128, NBLK = SEQ / 256;
constexpr float EPS = 1e-6f;
constexpr float QSCALE = 0.08838834764831845f * 1.4426950408889634f;
#ifndef MK_ONE_LAUNCH
#define MK_ONE_LAUNCH 1
#endif
constexpr int NPHASE = 15;

constexpr size_t MiB = 1u << 20;
constexpr size_t WS_CTL = 0, CTL_ZERO_BYTES = 96 * 1024;
constexpr size_t WS_WIN = 2 * MiB, WS_PA = 16 * MiB, WS_PB = 18 * MiB, WS_WOUT = 20 * MiB, WS_WUG = 22 * MiB, WS_WDN = 33 * MiB, WS_WR = 39 * MiB, WS_WI = 39 * MiB + 256 * 1024;
constexpr size_t WS_KM = 40 * MiB, WS_AG = 41 * MiB, WS_RSP = 45 * MiB;
constexpr size_t WS_XN = 48 * MiB;
constexpr size_t WS_Q = 112 * MiB;
constexpr size_t WS_K = 176 * MiB;
constexpr size_t WS_V = 240 * MiB;
constexpr size_t WS_XR = 304 * MiB, WS_GR = 368 * MiB;
constexpr size_t WS_ACT = 112 * MiB;
constexpr size_t WS_SB = 448 * MiB, WS_SU0 = 451 * MiB, WS_SG0 = 454 * MiB;
constexpr size_t WS_END = 512 * MiB;
constexpr int CW_BAR = 4096;

constexpr int LDS_BYTES = 163840;
constexpr int MISC_OFF = LDS_BYTES - 512;

__device__ __forceinline__ float wave_sum(float v) {
#pragma unroll
    for (int o = 1; o < 64; o <<= 1) v += __shfl_xor(v, o);
    return v;
}
__device__ __forceinline__ unsigned cvtpk_bf16(float lo, float hi) { unsigned r; asm volatile("v_cvt_pk_bf16_f32 %0, %1, %2" : "=v"(r) : "v"(lo), "v"(hi)); return r; }
__device__ __forceinline__ void p0_transpose_item(const float* W, int N, bf16* WT, int ldwt, int drow0, const float* gain, LAS float* scr, int kb, int nb, int lane) {
    const int k0 = 64 * kb, n0 = 64 * nb, lr = lane >> 4, lc = (lane & 15) * 4;
    f32x4 v[16];
#pragma unroll
    for (int i = 0; i < 16; ++i) v[i] = __builtin_nontemporal_load((const GAS f32x4*)(W + (size_t)(k0 + 4 * i + lr) * N + n0 + lc));
#pragma unroll
    for (int i = 0; i < 16; ++i) { const int kk = 4 * i + lr; const float g = gain ? gain[k0 + kk] : 1.0f; LAS float* d = scr + kk * 65 + lc; d[0] = v[i][0] * g; d[1] = v[i][1] * g; d[2] = v[i][2] * g; d[3] = v[i][3] * g; }
    LDS_WAIT(); asm volatile("" ::: "memory");
    const int c = lane & 7;
#pragma unroll
    for (int j = 0; j < 8; ++j) { const int n = (lane >> 3) + 8 * j; const LAS float* s = scr + (8 * c) * 65 + n;
        v4u o; o.x = cvtpk_bf16(s[0 * 65], s[1 * 65]); o.y = cvtpk_bf16(s[2 * 65], s[3 * 65]); o.z = cvtpk_bf16(s[4 * 65], s[5 * 65]); o.w = cvtpk_bf16(s[6 * 65], s[7 * 65]);
        *(GAS v4u*)(WT + (size_t)(drow0 + n) * ldwt + k0 + 8 * c) = o; }
    LDS_WAIT(); asm volatile("" ::: "memory");
}
__device__ __forceinline__ void rms_rows_to_bf16(const float* x, bf16* o, int m0, int mstep, int lane) {
    f32x4 v[4], w[4];
    if (m0 < M) {
#pragma unroll
        for (int j = 0; j < 4; ++j) v[j] = __builtin_nontemporal_load(((const GAS f32x4*)(x + (size_t)m0 * DM) + lane) + 64 * j); }
#pragma unroll 1
    for (int m = m0; m < M; m += mstep) {
        const int mn = m + mstep;
        if (mn < M) {
#pragma unroll
            for (int j = 0; j < 4; ++j) w[j] = __builtin_nontemporal_load(((const GAS f32x4*)(x + (size_t)mn * DM) + lane) + 64 * j); }
        float s = 0.f;
#pragma unroll
        for (int j = 0; j < 4; ++j) s += (v[j].x * v[j].x + v[j].y * v[j].y) + (v[j].z * v[j].z + v[j].w * v[j].w);
        const float rstd = 1.0f / sqrtf(wave_sum(s) * (1.f / DM) + EPS);
        GAS unsigned long long* o8 = (GAS unsigned long long*)(o + (size_t)m * DM) + lane;
#pragma unroll
        for (int j = 0; j < 4; ++j) o8[64 * j] = (unsigned long long)cvtpk_bf16(v[j].x * rstd, v[j].y * rstd) | ((unsigned long long)cvtpk_bf16(v[j].z * rstd, v[j].w * rstd) << 32);
#pragma unroll
        for (int j = 0; j < 4; ++j) v[j] = w[j];
    }
}

struct Args { const float* in[21]; float* out; unsigned char* ws; int ph_lo, ph_hi, li, pad; };
enum { I_X = 0, I_N1G, I_WIN, I_CONVW, I_CONVB, I_WR, I_BR, I_WI, I_BI, I_LAM, I_QNG, I_KNG, I_PA, I_PB, I_WOUT, I_N2G, I_WUP, I_WGATE, I_FCW, I_FCB, I_WDN };

__device__ __forceinline__ void p0_prologue(const Args& a, LAS unsigned char* lds, int gw, int NGW, int wave, int lane) {
    LAS float* scr = (LAS float*)(lds + wave * 16896);
    unsigned char* ws = a.ws;
    constexpr int I_IN = 16 * 112, I_SQ = 16 * 16, I_UP = 16 * 44, I_DN = 44 * 16, I_RG = 32;
    constexpr int NITEMS = I_IN + 3 * I_SQ + 2 * I_UP + I_DN + 2 * I_RG;
    for (int it = gw; it < NITEMS; it += NGW) {
        int r = it;
        if (r < I_IN) { p0_transpose_item(a.in[I_WIN], DIN, (bf16*)(ws + WS_WIN), DM, 64 * (r % 112), a.in[I_N1G], scr, r / 112, r % 112, lane); continue; } r -= I_IN;
        if (r < I_SQ) { p0_transpose_item(a.in[I_PA], DM, (bf16*)(ws + WS_PA), DM, 64 * (r % 16), nullptr, scr, r / 16, r % 16, lane); continue; } r -= I_SQ;
        if (r < I_SQ) { p0_transpose_item(a.in[I_PB], DM, (bf16*)(ws + WS_PB), DM, 64 * (r % 16), nullptr, scr, r / 16, r % 16, lane); continue; } r -= I_SQ;
        if (r < I_SQ) { p0_transpose_item(a.in[I_WOUT], DM, (bf16*)(ws + WS_WOUT), DM, 64 * (r % 16), nullptr, scr, r / 16, r % 16, lane); continue; } r -= I_SQ;
        if (r < I_UP) { const int nb = r % 44, n0 = 64 * nb; p0_transpose_item(a.in[I_WUP], DFF, (bf16*)(ws + WS_WUG), DM, 256 * (n0 / 128) + (n0 % 128), a.in[I_N2G], scr, r / 44, nb, lane); continue; } r -= I_UP;
        if (r < I_UP) { const int nb = r % 44, n0 = 64 * nb; p0_transpose_item(a.in[I_WGATE], DFF, (bf16*)(ws + WS_WUG), DM, 256 * (n0 / 128) + 128 + (n0 % 128), a.in[I_N2G], scr, r / 44, nb, lane); continue; } r -= I_UP;
        if (r < I_DN) { p0_transpose_item(a.in[I_WDN], DM, (bf16*)(ws + WS_WDN), DFF, 64 * (r % 16), nullptr, scr, r / 16, r % 16, lane); continue; } r -= I_DN;
        if (r < I_RG) { const int blk = r >> 2, q = r & 3; p0_transpose_item(a.in[I_WR] + blk * 16384, 128, (bf16*)(ws + WS_WR) + blk * 16384, 128, 64 * (q & 1), nullptr, scr, q >> 1, q & 1, lane); continue; } r -= I_RG;
        { const int blk = r >> 2, q = r & 3; p0_transpose_item(a.in[I_WI] + blk * 16384, 128, (bf16*)(ws + WS_WI) + blk * 16384, 128, 64 * (q & 1), nullptr, scr, q >> 1, q & 1, lane); }
    }
    rms_rows_to_bf16(a.in[I_X], (bf16*)(ws + WS_XN), gw, NGW, lane);
    for (int e = gw * 64 + lane; e < 128 * 1024; e += NGW * 64) ((float*)(ws + WS_KM))[e] = 0.f;
}

constexpr int CW_RFLAG = 20480;
__device__ __forceinline__ void rnn_phase(const Args& a, LAS unsigned char* lds, int G, int wave, int lane, int tid, int variant = 0) {
    LAS bf16* XRs = (LAS bf16*)lds;
    LAS bf16* XAb = (LAS bf16*)(lds + 18432);
    LAS bf16* HB = (LAS bf16*)(lds + 18432 + 17408);
    LAS float* CWl = (LAS float*)(lds + 18432 + 2 * 17408);
    const bf16* XR = (const bf16*)(a.ws + WS_XR); const bf16* GR = (const bf16*)(a.ws + WS_GR); bf16* YA = (bf16*)(a.ws + WS_XN);
    gu64* AG = (gu64*)(a.ws + WS_AG); gu32* RFLAG = (gu32*)(a.ws + WS_CTL) + CW_RFLAG;
    const int kq = lane >> 4, fr = lane & 15;
    if (G != 256) return;
    const int w = blockIdx.x, seqi = w & 31, sub = w >> 5, bb = seqi >> 3, n = seqi & 7;
    const int dcol = 16 * wave + fr, ch = n * 128 + dcol;
    LAS unsigned char* WFl = lds + 57344 + wave * 8192;
#pragma unroll
    for (int ks = 0; ks < 4; ++ks) { *(LAS bf16x8*)(WFl + (2 * ks) * 1024 + lane * 16) = *(const GAS bf16x8*)((const bf16*)(a.ws + WS_WR) + (size_t)ch * 128 + 32 * ks + 8 * kq);
                                     *(LAS bf16x8*)(WFl + (2 * ks + 1) * 1024 + lane * 16) = *(const GAS bf16x8*)((const bf16*)(a.ws + WS_WI) + (size_t)ch * 128 + 32 * ks + 8 * kq); }
    const float nbr = -1.4426950408889634f * a.in[I_BR][ch], nbi = -1.4426950408889634f * a.in[I_BI][ch];
    const float sp = log1pf(expf(-a.in[I_LAM][ch]));
    const float c1 = -16.0f * sp, c2 = -8.0f * sp * 1.4426950408889634f;
    const int cg = tid & 15, cc = n * 128 + 8 * cg;
    for (int e = tid; e < 640; e += 512) CWl[e] = (e < 512) ? a.in[I_CONVW][(e >> 7) * 1024 + n * 128 + (e & 127)] : a.in[I_CONVB][n * 128 + (e & 127)];
    float hc = 0.f;
    int cfold = 0;
    v4u pre[3];
    {
        const int rb0 = bb * 32 + sub; const bool seqstart = (sub == 0);
#pragma unroll
        for (int pp = 0; pp < 3; ++pp) { const int p = tid + 512 * pp;
            if (p < 67 * 16) { const int row = p >> 4, c = p & 15; const bool z = seqstart && row < 3; const int srow = z ? rb0 * 256 : rb0 * 256 - 3 + row;
                v4u v = __builtin_nontemporal_load((const GAS v4u*)(XR + (size_t)srow * DM + n * 128 + 8 * c)); if (z) v = (v4u){0u, 0u, 0u, 0u}; pre[pp] = v; } }
    }
#pragma unroll 1
    for (int it = 0; it < 4; ++it) {
        const int chunk = 8 * it + sub, rb = bb * 32 + chunk;
        float av[4][4][4]; unsigned bxp[4][4][2];
        float hl = 0.f, Pa = 1.f;
#pragma unroll
        for (int s = 0; s < 4; ++s) {
            const int r0 = rb * 256 + 64 * s;
#pragma unroll
            for (int pp = 0; pp < 3; ++pp) { const int p = tid + 512 * pp; if (p < 67 * 16) *(LAS v4u*)(XRs + (p >> 4) * 136 + 8 * (p & 15)) = pre[pp]; }
            __syncthreads();
            if (s < 3 || it < 3) {
                const int nr = (s < 3) ? r0 + 64 : r0 - 192 + 2048;
#pragma unroll
                for (int pp = 0; pp < 3; ++pp) { const int p = tid + 512 * pp; if (p < 67 * 16) pre[pp] = __builtin_nontemporal_load((const GAS v4u*)(XR + (size_t)(nr - 3 + (p >> 4)) * DM + n * 128 + 8 * (p & 15))); }
            }
#pragma unroll
            for (int pp = 0; pp < 2; ++pp) {
                const int tok = (tid >> 4) + 32 * pp;
                f32x4 a0 = *(const LAS f32x4*)(CWl + 512 + 8 * cg), a1 = *(const LAS f32x4*)(CWl + 512 + 8 * cg + 4);
#pragma unroll
                for (int k = 0; k < 4; ++k) { const v4u wv = *(const LAS v4u*)(XRs + (tok + k) * 136 + 8 * cg);
                    const f32x4 c0 = *(const LAS f32x4*)(CWl + k * 128 + 8 * cg), c1v = *(const LAS f32x4*)(CWl + k * 128 + 8 * cg + 4);
                    a0 += c0 * (f32x4){pg8::bflo(wv.x), pg8::bfhi(wv.x), pg8::bflo(wv.y), pg8::bfhi(wv.y)}; a1 += c1v * (f32x4){pg8::bflo(wv.z), pg8::bfhi(wv.z), pg8::bflo(wv.w), pg8::bfhi(wv.w)}; }
                v4u o; o.x = cvtpk_bf16(a0[0], a0[1]); o.y = cvtpk_bf16(a0[2], a0[3]); o.z = cvtpk_bf16(a1[0], a1[1]); o.w = cvtpk_bf16(a1[2], a1[3]);
                *(LAS v4u*)(XAb + tok * 136 + 8 * cg) = o;
            }
            __syncthreads();
            if (variant == 2) { _Pragma("unroll") for (int r_ = 0; r_ < 4; ++r_) { av[s][r_][0] = av[s][r_][1] = av[s][r_][2] = av[s][r_][3] = 1.f; bxp[s][r_][0] = bxp[s][r_][1] = 0u; } continue; }
#pragma unroll
            for (int rt = 0; rt < 4; ++rt) {
                f32x4 aR = {0.f, 0.f, 0.f, 0.f}, aI = {0.f, 0.f, 0.f, 0.f};
#pragma unroll
                for (int ks = 0; ks < 4; ++ks) { const bf16x8 af = *(const LAS bf16x8*)(XAb + (16 * rt + fr) * 136 + 32 * ks + 8 * kq);
                    aR = __builtin_amdgcn_mfma_f32_16x16x32_bf16(af, *(const LAS bf16x8*)(WFl + (2 * ks) * 1024 + lane * 16), aR, 0, 0, 0); aI = __builtin_amdgcn_mfma_f32_16x16x32_bf16(af, *(const LAS bf16x8*)(WFl + (2 * ks + 1) * 1024 + lane * 16), aI, 0, 0, 0); }
                float A = 1.f, H = 0.f; float bxt[4];
                {
                    f32x4 er = aR * (-1.4426950408889634f) + nbr, ei = aI * (-1.4426950408889634f) + nbi;
#pragma unroll
                    for (int rg = 0; rg < 4; ++rg) { er[rg] = __builtin_amdgcn_exp2f(er[rg]); ei[rg] = __builtin_amdgcn_exp2f(ei[rg]); }
                    er = er + 1.0f; ei = ei + 1.0f;
                    f32x4 r, ig;
#pragma unroll
                    for (int rg = 0; rg < 4; ++rg) { r[rg] = __builtin_amdgcn_rcpf(er[rg]); ig[rg] = __builtin_amdgcn_rcpf(ei[rg]); }
                    f32x4 aa = r * c2; const f32x4 x = r * c1;
#pragma unroll
                    for (int rg = 0; rg < 4; ++rg) aa[rg] = __builtin_amdgcn_exp2f(aa[rg]);
                    f32x4 poly = x * 0.2f + 1.0f; poly = poly * (x * 0.25f) + 1.0f; poly = poly * (x * (1.0f / 3.0f)) + 1.0f; poly = poly * (x * 0.5f) + 1.0f; poly = poly * (-x);
                    const f32x4 alt = 1.0f - aa * aa;
                    f32x4 em1, xa;
#pragma unroll
                    for (int rg = 0; rg < 4; ++rg) { em1[rg] = (x[rg] > -0.25f) ? poly[rg] : alt[rg]; xa[rg] = pg8::bf2f(XAb[(16 * rt + 4 * kq + rg) * 136 + dcol]); }
#pragma unroll
                    for (int rg = 0; rg < 4; ++rg) em1[rg] = __builtin_amdgcn_sqrtf(em1[rg]);
                    const f32x4 bv = em1 * ig * xa;
#pragma unroll
                    for (int rg = 0; rg < 4; ++rg) { av[s][rt][rg] = aa[rg]; bxt[rg] = bv[rg]; H = aa[rg] * H + bv[rg]; A *= aa[rg]; }
                }
                bxp[s][rt][0] = cvtpk_bf16(bxt[0], bxt[1]); bxp[s][rt][1] = cvtpk_bf16(bxt[2], bxt[3]);
                { const float A1 = __shfl_up(A, 16), H1 = __shfl_up(H, 16); if (kq >= 1) { H = A * H1 + H; A = A1 * A; } }
                { const float A2 = __shfl_up(A, 32), H2 = __shfl_up(H, 32); if (kq >= 2) { H = A * H2 + H; A = A2 * A; } }
                const float At = __shfl(A, 48 + fr), Ht = __shfl(H, 48 + fr);
                hl = At * hl + Ht; Pa *= At;
            }
        }
        if (kq == 0) __hip_atomic_store(AG + (size_t)rb * 1024 + ch, ((unsigned long long)__float_as_uint(hl) << 32) | __float_as_uint(Pa), RLX_AGENT);
        asm volatile("s_waitcnt vmcnt(0)" ::: "memory");
        __syncthreads();
        if (tid == 0) __hip_atomic_store(RFLAG + rb * 8 + n, 1u, RLX_AGENT);
        if (wave == 0) {
            unsigned spins = 0;
            for (;;) {
                const unsigned f = (lane >= cfold && lane < chunk) ? __hip_atomic_load(RFLAG + (bb * 32 + lane) * 8 + n, RLX_AGENT) : 1u;
                if (__all(f != 0u)) break;
                __builtin_amdgcn_s_sleep(2);
                if (++spins > (1u << 22)) break;
            }
        }
        __syncthreads();
        {
#pragma unroll
            for (int j0 = 0; j0 < 8; j0 += 4) { unsigned long long ah[4];
#pragma unroll
                for (int j = 0; j < 4; ++j) { const int ci = (cfold + j0 + j < chunk) ? cfold + j0 + j : (chunk > 0 ? chunk - 1 : 0); ah[j] = __hip_atomic_load(AG + (size_t)(bb * 32 + ci) * 1024 + ch, RLX_AGENT); }
#pragma unroll
                for (int j = 0; j < 4; ++j) if (cfold + j0 + j < chunk) hc = __uint_as_float((unsigned)ah[j]) * hc + __uint_as_float((unsigned)(ah[j] >> 32)); }
            cfold = chunk;
        }
        if (variant >= 1) { asm volatile("" :: "v"(hc)); _Pragma("unroll") for (int s_ = 0; s_ < 4; ++s_) _Pragma("unroll") for (int r_ = 0; r_ < 4; ++r_) { asm volatile("" :: "v"(av[s_][r_][0]), "v"(av[s_][r_][3]), "v"(bxp[s_][r_][0]), "v"(bxp[s_][r_][1])); } __syncthreads(); continue; }
        float hs = hc;
#pragma unroll
        for (int s = 0; s < 4; ++s) {
            const int r0 = rb * 256 + 64 * s;
            v4u gpre[2];
#pragma unroll
            for (int pp = 0; pp < 2; ++pp) gpre[pp] = __builtin_nontemporal_load((const GAS v4u*)(GR + (size_t)(r0 + (tid >> 4) + 32 * pp) * DM + cc));
#pragma unroll
            for (int rt = 0; rt < 4; ++rt) {
                float A = 1.f, H = 0.f;
                const float bxv[4] = { pg8::bflo(bxp[s][rt][0]), pg8::bfhi(bxp[s][rt][0]), pg8::bflo(bxp[s][rt][1]), pg8::bfhi(bxp[s][rt][1]) };
#pragma unroll
                for (int rg = 0; rg < 4; ++rg) { H = av[s][rt][rg] * H + bxv[rg]; A *= av[s][rt][rg]; }
                float At = 1.f, Ht = 0.f, Ae = 1.f, He = 0.f;
#pragma unroll
                for (int q = 0; q < 4; ++q) { const float Aq = __shfl(A, 16 * q + fr), Hq = __shfl(H, 16 * q + fr);
                    Ae = (q == kq) ? At : Ae; He = (q == kq) ? Ht : He; Ht = Aq * Ht + Hq; At *= Aq; }
                float h = Ae * hs + He;
#pragma unroll
                for (int rg = 0; rg < 4; ++rg) { h = av[s][rt][rg] * h + bxv[rg]; HB[(16 * rt + 4 * kq + rg) * 136 + dcol] = (bf16)cvtpk_bf16(h, h); }
                hs = At * hs + Ht;
            }
            __syncthreads();
#pragma unroll
            for (int pp = 0; pp < 2; ++pp) {
                const int tok = (tid >> 4) + 32 * pp;
                const v4u hw = *(const LAS v4u*)(HB + tok * 136 + 8 * cg);
                const v4u gw = gpre[pp];
                v4u o; o.x = cvtpk_bf16(pg8::bflo(hw.x) * pg8::bflo(gw.x), pg8::bfhi(hw.x) * pg8::bfhi(gw.x)); o.y = cvtpk_bf16(pg8::bflo(hw.y) * pg8::bflo(gw.y), pg8::bfhi(hw.y) * pg8::bfhi(gw.y));
                o.z = cvtpk_bf16(pg8::bflo(hw.z) * pg8::bflo(gw.z), pg8::bfhi(hw.z) * pg8::bfhi(gw.z)); o.w = cvtpk_bf16(pg8::bflo(hw.w) * pg8::bflo(gw.w), pg8::bfhi(hw.w) * pg8::bfhi(gw.w));
                __builtin_nontemporal_store(o, (GAS v4u*)(YA + (size_t)(r0 + tok) * DM + cc));
            }
            __syncthreads();
        }
        hc = Pa * hc + hl; cfold = chunk + 1;
    }
}
typedef short s16x4 __attribute__((ext_vector_type(4)));
typedef float f32x16 __attribute__((ext_vector_type(16)));
typedef short v4i16_t __attribute__((ext_vector_type(4)));
constexpr size_t WS_PART = 304 * MiB, WS_LIST = 496 * MiB, WS_LP = 42 * MiB;
constexpr int CW_CNT = 16384;
constexpr int LIST_PER_BH = 256 * 496;
__device__ __forceinline__ int list_off(int n) { return 256 * (31 * n - (n * (n - 1)) / 2); }
__device__ __forceinline__ unsigned cvtpk(float lo, float hi) { unsigned r; asm volatile("v_cvt_pk_bf16_f32 %0, %1, %2" : "=v"(r) : "v"(lo), "v"(hi)); return r; }
__device__ __forceinline__ s16x4 vtr(const LAS unsigned char* p) { return __builtin_bit_cast(s16x4, __builtin_amdgcn_ds_read_tr16_b64_v4i16((LAS v4i16_t*)p)); }

__device__ __forceinline__ void load_kv_block(LAS unsigned char* lds, const bf16* Kg, const bf16* Vg, size_t row0, int hh, int wave, int lane) {
#pragma unroll
    for (int i = 0; i < 8; ++i) {
        const int I = wave * 8 + i;
        { const int r = 4 * I + (lane >> 4), cp = lane & 15, c = cp ^ (r & 15);
          __builtin_amdgcn_global_load_lds((const unsigned*)(Kg + (row0 + r) * DM + hh * HD + 8 * c), (LAS unsigned*)(lds + I * 1024), 16, 0, 0); }
        { const int dt = lane >> 4, q = (lane >> 2) & 3, c8 = lane & 3;
          __builtin_amdgcn_global_load_lds((const unsigned*)(Vg + (row0 + 4 * I + q) * DM + hh * HD + 32 * dt + 8 * c8), (LAS unsigned*)(lds + 65536 + I * 1024), 16, 0, 0); }
    }
}

__device__ __forceinline__ void attn_wave(const LAS unsigned char* lds, const bf16x8 (&qf)[8], f32x16 (&O)[4], float& lsum, int kt_hi, int diag, int lane) {
    const int h2 = lane >> 5, kr = lane & 31;
    unsigned kaddr[8];
#pragma unroll
    for (int s = 0; s < 8; ++s) kaddr[s] = (unsigned)(kr * 256 + (((2 * s + h2) ^ (lane & 15)) * 16));
    const LAS unsigned char* vb = lds + 65536 + h2 * 1024 + ((lane >> 2) & 3) * 64 + ((lane >> 4) & 1) * 32 + (lane & 3) * 8;
#pragma unroll 1
    for (int kt = 0; kt < kt_hi; ++kt) {
        f32x16 S;
#pragma unroll
        for (int r = 0; r < 16; ++r) S[r] = 0.f;
#pragma unroll
        for (int s = 0; s < 8; ++s) { const bf16x8 kf = *(const LAS bf16x8*)(lds + kt * 8192 + kaddr[s]); S = __builtin_amdgcn_mfma_f32_32x32x16_bf16(kf, qf[s], S, 0, 0, 0); }
        float P[16];
#pragma unroll
        for (int r = 0; r < 16; ++r) P[r] = __builtin_amdgcn_exp2f(S[r]);
        if (kt == diag) {
#pragma unroll
            for (int r = 0; r < 16; ++r) { const int kl = (r & 3) + 8 * (r >> 2) + 4 * h2; P[r] = (kl <= kr) ? P[r] : 0.f; }
        }
        float ls = 0.f;
#pragma unroll
        for (int r = 0; r < 16; ++r) ls += P[r];
        lsum += ls;
        v4u pw0, pw1;
        pw0.x = cvtpk(P[0], P[1]); pw0.y = cvtpk(P[2], P[3]); pw0.z = cvtpk(P[4], P[5]); pw0.w = cvtpk(P[6], P[7]);
        pw1.x = cvtpk(P[8], P[9]); pw1.y = cvtpk(P[10], P[11]); pw1.z = cvtpk(P[12], P[13]); pw1.w = cvtpk(P[14], P[15]);
        const bf16x8 pb0 = __builtin_bit_cast(bf16x8, pw0), pb1 = __builtin_bit_cast(bf16x8, pw1);
        const LAS unsigned char* vk = vb + kt * 8192;
#pragma unroll
        for (int dt = 0; dt < 4; ++dt) {
            { const s16x4 lo = vtr(vk + dt * 256), hi = vtr(vk + dt * 256 + 2048);
              const bf16x8 vf = (bf16x8){lo[0], lo[1], lo[2], lo[3], hi[0], hi[1], hi[2], hi[3]};
              O[dt] = __builtin_amdgcn_mfma_f32_32x32x16_bf16(vf, pb0, O[dt], 0, 0, 0); }
            { const s16x4 lo = vtr(vk + 4096 + dt * 256), hi = vtr(vk + 4096 + dt * 256 + 2048);
              const bf16x8 vf = (bf16x8){lo[0], lo[1], lo[2], lo[3], hi[0], hi[1], hi[2], hi[3]};
              O[dt] = __builtin_amdgcn_mfma_f32_32x32x16_bf16(vf, pb1, O[dt], 0, 0, 0); }
        }
    }
}

__device__ __forceinline__ void q_unstage(LAS unsigned char* stg, const v4u (&qs)[8], bf16x8 (&qf)[8], int lane) {
    const int ra = lane >> 2, rb2 = ra + 16, part = lane & 3, h2 = lane >> 5, kr = lane & 31;
#pragma unroll
    for (int p = 0; p < 4; ++p) {
        *(LAS v4u*)(stg + ra * 80 + part * 16) = qs[2 * p]; *(LAS v4u*)(stg + rb2 * 80 + part * 16) = qs[2 * p + 1];
        asm volatile("s_waitcnt lgkmcnt(0)" ::: "memory");
        qf[2 * p] = *(const LAS bf16x8*)(stg + kr * 80 + h2 * 16); qf[2 * p + 1] = *(const LAS bf16x8*)(stg + kr * 80 + 32 + h2 * 16);
        asm volatile("s_waitcnt lgkmcnt(0)" ::: "memory");
    }
}
__device__ __forceinline__ void gate_phase(const Args& a, LAS unsigned char* lds, int vcu, int wave, int lane, int tid, int variant = 0) {
    LAS unsigned* lcnt = (LAS unsigned*)lds; LAS unsigned* gbase = lcnt + 128;
    const bf16* Qg = (const bf16*)(a.ws + WS_Q); const float* KM = (const float*)(a.ws + WS_KM);
    unsigned* CNT = (unsigned*)(a.ws + WS_CTL) + CW_CNT; unsigned* LIST = (unsigned*)(a.ws + WS_LIST);
    const int h2 = lane >> 5, kr = lane & 31;
    if (tid < 128) lcnt[tid] = 0u;
    __syncthreads();
    int seln[4][3]; unsigned pos[4][3];
#pragma unroll
    for (int ui = 0; ui < 4; ++ui) {
        const int unit = vcu * 4 + ui, bh = unit >> 5, qb = unit & 31, bb = bh >> 3, hh = bh & 7;
        const size_t rowbase = (size_t)bb * SEQ; const int tq = qb * 256 + 32 * wave + kr;
        const float* kmp = KM + ((size_t)(bb * 32 + kr) * 8 + hh) * 128 + 8 * h2;
        const bf16* qp = Qg + (rowbase + tq) * DM + hh * HD + 8 * h2;
        f32x16 acc;
#pragma unroll
        for (int r = 0; r < 16; ++r) acc[r] = 0.f;
#pragma unroll
        for (int s = 0; s < 8; ++s) {
            const f32x4 k0 = *(const GAS f32x4*)(kmp + 16 * s), k1 = *(const GAS f32x4*)(kmp + 16 * s + 4);
            const float kv[8] = {k0[0], k0[1], k0[2], k0[3], k1[0], k1[1], k1[2], k1[3]};
            unsigned hi[4], lo[4];
#pragma unroll
            for (int j = 0; j < 4; ++j) { const unsigned hw = cvtpk(kv[2 * j], kv[2 * j + 1]); hi[j] = hw;
                lo[j] = cvtpk(kv[2 * j] - __builtin_bit_cast(float, hw << 16), kv[2 * j + 1] - __builtin_bit_cast(float, hw & 0xffff0000u)); }
            const bf16x8 ahi = __builtin_bit_cast(bf16x8, (v4u){hi[0], hi[1], hi[2], hi[3]}), alo = __builtin_bit_cast(bf16x8, (v4u){lo[0], lo[1], lo[2], lo[3]});
            const bf16x8 bq = *(const GAS bf16x8*)(qp + 16 * s);
            acc = __builtin_amdgcn_mfma_f32_32x32x16_bf16(ahi, bq, acc, 0, 0, 0); acc = __builtin_amdgcn_mfma_f32_32x32x16_bf16(alo, bq, acc, 0, 0, 0);
        }
        unsigned mask = 0u;
#pragma unroll
        for (int r3 = 0; r3 < 3; ++r3) {
            seln[ui][r3] = 0; pos[ui][r3] = 0u;
            if (r3 < qb) { float best = -3.0e38f; int bi = 64;
#pragma unroll
                for (int r = 0; r < 16; ++r) { const int blk = (r & 3) + 8 * (r >> 2) + 4 * h2; const bool ok = (blk < qb) && !((mask >> blk) & 1u) && (acc[r] > best); best = ok ? acc[r] : best; bi = ok ? blk : bi; }
                const float ob = __shfl_xor(best, 32); const int oi = __shfl_xor(bi, 32);
                const bool take = (ob > best) || (ob == best && oi < bi);
                bi = take ? oi : bi; bi &= 31;
                mask |= 1u << bi; seln[ui][r3] = bi;
                if (h2 == 0) pos[ui][r3] = __hip_atomic_fetch_add(lcnt + ui * 32 + bi, 1u, __ATOMIC_RELAXED, __HIP_MEMORY_SCOPE_WORKGROUP); }
        }
    }
    __syncthreads();
    if (tid < 128) { const unsigned c = lcnt[tid]; const int bh = (vcu * 4 + (tid >> 5)) >> 5; gbase[tid] = (c && !variant) ? atomicAdd(CNT + bh * 32 + (tid & 31), c) : 0u; }
    __syncthreads();
    if (h2 == 0 && !variant) {
#pragma unroll
        for (int ui = 0; ui < 4; ++ui) { const int unit = vcu * 4 + ui, bh = unit >> 5, qb = unit & 31; const int tq = qb * 256 + 32 * wave + kr;
#pragma unroll
            for (int r3 = 0; r3 < 3; ++r3) if (r3 < qb) LIST[(size_t)bh * LIST_PER_BH + list_off(seln[ui][r3]) + gbase[ui * 32 + seln[ui][r3]] + pos[ui][r3]] = ((unsigned)tq << 2) | (unsigned)r3; }
    }
    __syncthreads();
}

__device__ __forceinline__ void sparse_phase(const Args& a, LAS unsigned char* lds, int G, int wave, int lane, int tid, int variant = 0) {
    LAS unsigned* cntl = (LAS unsigned*)(lds + 131072 + 1024);
    LAS unsigned* pre = cntl + 1024;
    const bf16* Qg = (const bf16*)(a.ws + WS_Q); const bf16* Kg = (const bf16*)(a.ws + WS_K); const bf16* Vg = (const bf16*)(a.ws + WS_V);
    const unsigned* CNT = (const unsigned*)(a.ws + WS_CTL) + CW_CNT; const unsigned* LIST = (const unsigned*)(a.ws + WS_LIST);
    bf16* PART = (bf16*)(a.ws + WS_PART); float* LP = (float*)(a.ws + WS_LP);
    const int h2 = lane >> 5, kr = lane & 31;
    for (int i = tid; i < 1024; i += 512) cntl[i] = __hip_atomic_load(CNT + i, __ATOMIC_RELAXED, __HIP_MEMORY_SCOPE_AGENT);
    __syncthreads();
    LAS unsigned* pre2 = (LAS unsigned*)(lds + 131072 + 10240);
    if (wave == 0) {
        unsigned loc[16], loc2[16]; unsigned s = 0u, s2 = 0u;
#pragma unroll
        for (int j = 0; j < 16; ++j) { const unsigned t = (cntl[16 * lane + j] + 255u) >> 8; loc[j] = s; loc2[j] = s2; s += t; s2 += t ? 2u * t + 1u : 0u; }
        unsigned inc = s, inc2 = s2;
#pragma unroll
        for (int o = 1; o < 64; o <<= 1) { const unsigned t = __shfl_up(inc, o), t2 = __shfl_up(inc2, o); if (lane >= o) { inc += t; inc2 += t2; } }
        const unsigned exc = inc - s, exc2 = inc2 - s2;
#pragma unroll
        for (int j = 0; j < 16; ++j) { pre[16 * lane + j] = exc + loc[j]; pre2[16 * lane + j] = exc2 + loc2[j]; }
        if (lane == 63) { pre[1024] = inc; pre2[1024] = inc2; }
    }
    __syncthreads();
    const unsigned T = pre[1024], C = pre2[1024];
    unsigned lo, hi;
    {
        unsigned bnd[2];
#pragma unroll
        for (int e = 0; e < 2; ++e) {
            const unsigned cb = (unsigned)(((unsigned long long)(blockIdx.x + e) * C) / (unsigned)G);
            if (blockIdx.x + e >= (unsigned)G) { bnd[e] = T; continue; }
            int a0 = 0, b0 = 1024; while (b0 - a0 > 1) { const int m = (a0 + b0) >> 1; if (pre2[m] <= cb) a0 = m; else b0 = m; }
            const unsigned tl = pre[a0 + 1] - pre[a0], base = pre2[a0] + 1u;
            const unsigned k = (cb > base) ? (cb - base + 1u) / 2u : 0u;
            bnd[e] = (k >= tl) ? pre[a0 + 1] : pre[a0] + k;
        }
        lo = bnd[0]; hi = bnd[1];
    }
    __syncthreads();
    if (lo >= hi) return;
    int li = 0;
    { int a0 = 0, b0 = 1024; while (b0 - a0 > 1) { const int m = (a0 + b0) >> 1; if (pre[m] <= lo) a0 = m; else b0 = m; } li = a0; }
#define SP_ENTRY(LI, K2) ({ const int bh_ = (LI) >> 5, nn_ = (LI) & 31; const int idx_ = 256 * (K2) + 32 * wave + kr; (idx_ < (int)cntl[LI]) ? LIST[(size_t)bh_ * LIST_PER_BH + list_off(nn_) + idx_] : 0xffffffffu; })
#define SP_QROW(LI, E) (Qg + ((size_t)((LI) >> 8) * SEQ + (((E) == 0xffffffffu) ? 0u : ((E) >> 2))) * DM + (((LI) >> 5) & 7) * HD + 8 * (lane & 3))
#define SP_QLOAD(DST, LI, E) do { const unsigned ea_ = __shfl((E), lane >> 2), eb_ = __shfl((E), (lane >> 2) + 16); const bf16* qa_ = SP_QROW(LI, ea_); const bf16* qb_ = SP_QROW(LI, eb_); \
        _Pragma("unroll") for (int p_ = 0; p_ < 4; ++p_) { DST[2 * p_] = *(const GAS v4u*)(qa_ + 32 * p_); DST[2 * p_ + 1] = *(const GAS v4u*)(qb_ + 32 * p_); } } while (0)
    int l1 = li, l2, l3;
    unsigned t1 = lo;
    while (t1 >= pre[l1 + 1]) ++l1;
    l2 = l1; if (lo + 1 < hi) { while (lo + 1 >= pre[l2 + 1]) ++l2; }
    unsigned e1 = SP_ENTRY(l1, (int)(lo - pre[l1]));
    unsigned e2 = (lo + 1 < hi) ? SP_ENTRY(l2, (int)(lo + 1 - pre[l2])) : 0xffffffffu;
    LAS unsigned char* stg = lds + 131072 + 10240 + wave * 2560;
    v4u qs[8];
    SP_QLOAD(qs, l1, e1);
    int cur = -1;
#pragma unroll 1
    for (unsigned tile = lo; tile < hi; ++tile) {
        const int k = (int)(tile - pre[l1]); const int cnt = (int)cntl[l1];
        const int bh = l1 >> 5, nn = l1 & 31, bb = bh >> 3, hh = bh & 7; const size_t rowbase = (size_t)bb * SEQ;
        if (l1 != cur) {
            __syncthreads();
            if (variant != 4 || cur < 0) load_kv_block(lds, Kg, Vg, rowbase + (size_t)nn * 256, hh, wave, lane);
            asm volatile("s_waitcnt vmcnt(0)" ::: "memory");
            __syncthreads();
            cur = l1;
        }
        bf16x8 qf[8];
        q_unstage(stg, qs, qf, lane);
        unsigned e3 = 0xffffffffu; l3 = l2;
        if (tile + 1 < hi && variant != 5) SP_QLOAD(qs, l2, e2);
        if (tile + 2 < hi) { while (tile + 2 >= pre[l3 + 1]) ++l3; e3 = SP_ENTRY(l3, (int)(tile + 2 - pre[l3])); }
        const int idx0 = 256 * k + 32 * wave;
        if (idx0 < cnt) {
            const bool valid = (e1 != 0xffffffffu);
            const int t = (int)(e1 >> 2), j = (int)(e1 & 3u);
            f32x16 O[4];
#pragma unroll
            for (int dt = 0; dt < 4; ++dt)
#pragma unroll
                for (int r = 0; r < 16; ++r) O[dt][r] = 0.f;
            float lsum = 0.f;
            if (variant != 1) attn_wave(lds, qf, O, lsum, variant == 2 ? 4 : 8, -1, lane);
            lsum += __shfl_xor(lsum, 32);
            if (variant) {
#pragma unroll
                for (int dt = 0; dt < 4; ++dt)
#pragma unroll
                    for (int r = 0; r < 16; ++r) asm volatile("" :: "v"(O[dt][r]));
                asm volatile("" :: "v"(lsum));
            }
            if (variant == 0 || variant == 3) {
                const int psl = valid ? (int)(((unsigned)bh * SEQ + (unsigned)t) * 3u + (unsigned)j) : -1;
                if (valid && h2 == 0) LP[psl] = lsum;
                const int ra = lane >> 2, rb2 = ra + 16, part = lane & 3;
                const int psa = __shfl(psl, ra), psb = __shfl(psl, rb2);
#pragma unroll
                for (int dt = 0; dt < 4; ++dt) {
#pragma unroll
                    for (int rq = 0; rq < 4; ++rq) { const unsigned long long w = (unsigned long long)cvtpk(O[dt][4 * rq], O[dt][4 * rq + 1]) | ((unsigned long long)cvtpk(O[dt][4 * rq + 2], O[dt][4 * rq + 3]) << 32);
                        *(LAS unsigned long long*)(stg + kr * 80 + rq * 16 + h2 * 8) = w; }
                    asm volatile("s_waitcnt lgkmcnt(0)" ::: "memory");
                    const v4u ca = *(const LAS v4u*)(stg + ra * 80 + part * 16), cb2 = *(const LAS v4u*)(stg + rb2 * 80 + part * 16);
                    if (psa >= 0) *(GAS v4u*)(PART + (size_t)psa * 128 + dt * 32 + part * 8) = ca;
                    if (psb >= 0) *(GAS v4u*)(PART + (size_t)psb * 128 + dt * 32 + part * 8) = cb2;
                    asm volatile("s_waitcnt lgkmcnt(0)" ::: "memory");
                }
            }
        }
        e1 = e2; e2 = e3; l1 = l2; l2 = l3;
    }
#undef SP_ENTRY
#undef SP_QROW
#undef SP_QLOAD
}

__device__ __forceinline__ void own_phase(const Args& a, LAS unsigned char* lds, int vcu, int wave, int lane, int tid, int variant = 0) {
    bf16* Qg = (bf16*)(a.ws + WS_Q); const bf16* Kg = (const bf16*)(a.ws + WS_K); const bf16* Vg = (const bf16*)(a.ws + WS_V);
    const bf16* PART = (const bf16*)(a.ws + WS_PART); const float* LP = (const float*)(a.ws + WS_LP);
    const int h2 = lane >> 5, kr = lane & 31;
    LAS unsigned char* stg = lds + 131072 + 10240 + wave * 2560;
    const int ra = lane >> 2, rb2 = ra + 16, part = lane & 3;
#pragma unroll 1
    for (int ui = 0; ui < 4; ++ui) {
        const int unit = vcu * 4 + ui, bh = unit >> 5, qb = unit & 31, bb = bh >> 3, hh = bh & 7;
        const size_t rowbase = (size_t)bb * SEQ; const int t0 = qb * 256 + 32 * wave, t = t0 + kr;
        __syncthreads();
        load_kv_block(lds, Kg, Vg, rowbase + (size_t)qb * 256, hh, wave, lane);
        bf16* qp = Qg + (rowbase + t) * DM + hh * HD;
        v4u qs[8];
        { const bf16* qa_ = Qg + (rowbase + t0 + ra) * DM + hh * HD + 8 * part; const bf16* qb_ = Qg + (rowbase + t0 + rb2) * DM + hh * HD + 8 * part;
#pragma unroll
          for (int p_ = 0; p_ < 4; ++p_) { qs[2 * p_] = *(const GAS v4u*)(qa_ + 32 * p_); qs[2 * p_ + 1] = *(const GAS v4u*)(qb_ + 32 * p_); } }
        const int nsel = qb < 3 ? qb : 3;
        const size_t psa = ((size_t)bh * SEQ + t0 + ra) * 3, psb = ((size_t)bh * SEQ + t0 + rb2) * 3;
        float lp[3] = {0.f, 0.f, 0.f};
#pragma unroll
        for (int j = 0; j < 3; ++j) if (j < nsel) lp[j] = LP[((size_t)bh * SEQ + t) * 3 + j];
        asm volatile("s_waitcnt vmcnt(0)" ::: "memory");
        __syncthreads();
        bf16x8 qf[8];
        q_unstage(stg, qs, qf, lane);
        f32x16 O[4];
#pragma unroll
        for (int dt = 0; dt < 4; ++dt)
#pragma unroll
            for (int r = 0; r < 16; ++r) O[dt][r] = 0.f;
        float lsum = 0.f;
        attn_wave(lds, qf, O, lsum, wave + 1, wave, lane);
        lsum += __shfl_xor(lsum, 32);
        lsum += (lp[0] + lp[1]) + lp[2];
#pragma unroll 1
        for (int j = 0; j < nsel; ++j) {
            v4u pa[8];
#pragma unroll
            for (int dt = 0; dt < 4; ++dt) { pa[2 * dt] = __builtin_nontemporal_load((const GAS v4u*)(PART + (psa + j) * 128 + dt * 32 + part * 8)); pa[2 * dt + 1] = __builtin_nontemporal_load((const GAS v4u*)(PART + (psb + j) * 128 + dt * 32 + part * 8)); }
#pragma unroll
            for (int dt = 0; dt < 4; ++dt) {
                *(LAS v4u*)(stg + ra * 80 + part * 16) = pa[2 * dt]; *(LAS v4u*)(stg + rb2 * 80 + part * 16) = pa[2 * dt + 1];
                asm volatile("s_waitcnt lgkmcnt(0)" ::: "memory");
#pragma unroll
                for (int rq = 0; rq < 4; ++rq) { const unsigned long long w = *(const LAS unsigned long long*)(stg + kr * 80 + rq * 16 + h2 * 8); const unsigned w0 = (unsigned)w, w1 = (unsigned)(w >> 32);
                    O[dt][4 * rq] += pg8::bflo(w0); O[dt][4 * rq + 1] += pg8::bfhi(w0); O[dt][4 * rq + 2] += pg8::bflo(w1); O[dt][4 * rq + 3] += pg8::bfhi(w1); }
                asm volatile("s_waitcnt lgkmcnt(0)" ::: "memory");
            }
        }
        const float inv = 1.0f / lsum;
        bf16* ya = Qg + (rowbase + t0 + ra) * DM + hh * HD; bf16* yb = Qg + (rowbase + t0 + rb2) * DM + hh * HD;
#pragma unroll
        for (int dt = 0; dt < 4; ++dt) {
#pragma unroll
            for (int rq = 0; rq < 4; ++rq) { const unsigned long long w = (unsigned long long)cvtpk(O[dt][4 * rq] * inv, O[dt][4 * rq + 1] * inv) | ((unsigned long long)cvtpk(O[dt][4 * rq + 2] * inv, O[dt][4 * rq + 3] * inv) << 32);
                *(LAS unsigned long long*)(stg + kr * 80 + rq * 16 + h2 * 8) = w; }
            asm volatile("s_waitcnt lgkmcnt(0)" ::: "memory");
            const v4u ca = *(const LAS v4u*)(stg + ra * 80 + part * 16), cb2 = *(const LAS v4u*)(stg + rb2 * 80 + part * 16);
            if (variant) { asm volatile("" :: "v"(ca), "v"(cb2)); } else { *(GAS v4u*)(ya + dt * 32 + part * 8) = ca; *(GAS v4u*)(yb + dt * 32 + part * 8) = cb2; }
            asm volatile("s_waitcnt lgkmcnt(0)" ::: "memory");
        }
    }
}
__device__ __forceinline__ void fix_rows(const Args& a, int pm, int tid) {
    const float* SB = (const float*)(a.ws + WS_SB); const float* SU0 = (const float*)(a.ws + WS_SU0); const float* SG0 = (const float*)(a.ws + WS_SG0);
    bf16* ACT = (bf16*)(a.ws + WS_ACT); const float* cw = a.in[I_FCW]; const float* cb = a.in[I_FCB];
    const bool first = (pm & 31) == 0;
    const int pp = first ? pm : pm - 1;
    for (int e = tid; e < 2 * DFF; e += NWAVES * 64) {
        const int col = e % DFF, r = e / DFF;
        const float up0 = SU0[((size_t)pm * 2 + r) * DFF + col], gt = SG0[((size_t)pm * 2 + r) * DFF + col];
        const float pl1 = first ? 0.f : SB[((size_t)pp * 2 + 1) * DFF + col], pl0 = first ? 0.f : SB[((size_t)pp * 2 + 0) * DFF + col];
        const float x1 = (r == 0) ? pl1 : SU0[((size_t)pm * 2 + 0) * DFF + col];
        const float x2 = (r == 0) ? pl0 : pl1;
        const float c = cb[col] + cw[2 * DFF + col] * up0 + cw[DFF + col] * x1 + cw[col] * x2;
        ACT[((size_t)pm * 256 + r) * DFF + col] = (bf16)f2bf(pg8::gelu_tanh(c) * gt);
    }
}

template <int PV> __global__ void __launch_bounds__(NWAVES * 64, 2) mk_fwd(Args args) {
    extern __shared__ __attribute__((aligned(16))) unsigned char lds_raw[];
    LAS unsigned char* lds = (LAS unsigned char*)lds_raw;
    volatile LAS unsigned* MISC = (volatile LAS unsigned*)(lds + MISC_OFF);
    const int tid = threadIdx.x, lane = tid & 63, wave = __builtin_amdgcn_readfirstlane(tid >> 6);
    const int G = gridDim.x; const int bx = blockIdx.x; const int vcu = (G % 8 == 0) ? (bx % 8) * (G / 8) + bx / 8 : bx;
    unsigned char* ws = args.ws;
    gu32* ctl = (gu32*)(ws + WS_CTL);
    for (int u = tid; u < (LDS_BYTES - 131072) / 4; u += NWAVES * 64) ((LAS unsigned*)(lds + 131072))[u] = 0u;
    __syncthreads();
    XcdBarrier bar; bar.bar = (unsigned*)(ctl + CW_BAR); bar.x = 0; bar.st = nullptr;
    if (MK_ONE_LAUNCH) bar = xcd_barrier_post((unsigned*)(ctl + CW_BAR), MISC + 8);
    const int lo = args.ph_lo, hi = args.ph_hi;
    const int tid0 = tid;
#ifndef WGM_G1
#define WGM_G1 4
#endif
#ifndef WGM_G5
#define WGM_G5 4
#endif
#ifndef PROBE_DUP
#define PROBE_DUP 0
#endif
#ifndef PROBE_VARIANT
#define PROBE_VARIANT 0
#endif
#define LAUNDER() int tid = tid0; asm volatile("" : "+v"(tid)); const int lane = tid & 63; (void)lane
#ifndef PH_MASK
#define PH_MASK 0xffff
#endif
#define IN(k) (((PH_MASK >> (k)) & 1) && lo <= (k) && (k) < hi)
#define SEAM(k) do { if (IN(k) && IN((k) + 1)) xcd_barrier(bar); } while (0)
    const int gw = vcu * NWAVES + wave, NGW = G * NWAVES;
    bf16* XN = (bf16*)(ws + WS_XN); bf16* XR = (bf16*)(ws + WS_XR); bf16* GR = (bf16*)(ws + WS_GR);
    bf16* Qb = (bf16*)(ws + WS_Q); bf16* Kb = (bf16*)(ws + WS_K); bf16* Vb = (bf16*)(ws + WS_V);
    bf16* GA = (bf16*)args.out; bf16* GB = (bf16*)args.out + (size_t)M * DM;

    if (IN(0)) { LAUNDER(); p0_prologue(args, lds, gw, NGW, wave, lane); } SEAM(0);
    if (IN(1)) { LAUNDER();
        pg8::Gemm g{XN, (const bf16*)(ws + WS_WIN), M, DIN, DM, nullptr, nullptr}; pg8::StaticOrder S; S.init(M, DIN, G, bx, WGM_G1);
        pg8::EpiG1 E{XR, GR, Qb, Kb, Vb, GA, GB, args.in[I_QNG], args.in[I_KNG], (float*)(ws + WS_KM), (LAS float*)(lds + 131072 + 1024), QSCALE, PV};
        pg8::TableOrder TS; TS.fill(S, (LAS int*)(lds + 131072 + 512)); pg8::gemm_phase<pg8::EpiG1, pg8::TableOrder, true, true>(lds, g, TS, E); } SEAM(1);
    if (IN(3)) { LAUNDER(); rnn_phase(args, lds, G, wave, lane, tid, PV); __syncthreads(); gate_phase(args, lds, vcu, wave, lane, tid, PV); } SEAM(3);
    if (IN(6)) { LAUNDER(); sparse_phase(args, lds, G, wave, lane, tid, PV); } SEAM(6);
    if (IN(7)) { LAUNDER(); own_phase(args, lds, vcu, wave, lane, tid, PV); } SEAM(7);
    if (IN(8)) { LAUNDER(); pg8::Gemm g{XN  , (const bf16*)(ws + WS_PA), M, DM, DM, Qb  , (const bf16*)(ws + WS_PB)}; pg8::DualOrder S; S.init(M, DM, G, bx);
        pg8::EpiG3 E{GA, GB, Kb  };
        pg8::TableOrder TS; TS.fill(S, (LAS int*)(lds + 131072 + 512)); pg8::gemm_phase<pg8::EpiG3, pg8::TableOrder, true, true>(lds, g, TS, E); } SEAM(8);
    if (IN(10)) { LAUNDER();
        pg8::Gemm g{Kb  , (const bf16*)(ws + WS_WOUT), M, DM, DM, nullptr, nullptr}; pg8::StaticOrder S; S.init(M, DM, G, bx);
        pg8::EpiX1 E{args.in[I_X], XN  , (float*)(ws + WS_RSP), (LAS float*)(lds + 131072 + 1024)};
        pg8::TableOrder TS; TS.fill(S, (LAS int*)(lds + 131072 + 512)); pg8::gemm_phase<pg8::EpiX1, pg8::TableOrder, true, true>(lds, g, TS, E); } SEAM(10);
    if (IN(12)) { LAUNDER(); pg8::Gemm g{XN  , (const bf16*)(ws + WS_WUG), M, 2 * DFF, DM, nullptr, nullptr}; pg8::StaticOrder S; S.init(M, 2 * DFF, G, bx, WGM_G5);
        pg8::EpiUGF E{(bf16*)(ws + WS_ACT), args.in[I_FCW], args.in[I_FCB], (float*)(ws + WS_SB), (float*)(ws + WS_SU0), (float*)(ws + WS_SG0), (LAS float*)(lds + 131072 + 1024), (const float*)(ws + WS_RSP), PV};
        pg8::TableOrder TS; TS.fill(S, (LAS int*)(lds + 131072 + 512)); pg8::gemm_phase<pg8::EpiUGF, pg8::TableOrder, true, true>(lds, g, TS, E); } SEAM(12);
    if (IN(14)) { LAUNDER(); pg8::Gemm g{(const bf16*)(ws + WS_ACT), (const bf16*)(ws + WS_WDN), M, DM, DFF, nullptr, nullptr}; pg8::StaticOrder S; S.init(M, DM, G, bx);
        { pg8::Unit fu; for (int i = 0; S.next(i, fu); ++i) fix_rows(args, fu.pm, tid); asm volatile("s_waitcnt vmcnt(0)" ::: "memory"); __syncthreads(); }
        pg8::EpiOut E{XN  , args.out};
        pg8::TableOrder TS; TS.fill(S, (LAS int*)(lds + 131072 + 512)); pg8::gemm_phase<pg8::EpiOut, pg8::TableOrder, true, true>(lds, g, TS, E); }
#undef IN
#undef SEAM
}

extern "C" void kernel_launch(void* const* d_in, const int* in_sizes, int n_in, void* d_out, int out_size, void* d_ws, size_t ws_size, hipStream_t stream) {
    static int grid = 0;
    if (grid == 0) {
        if (n_in != 21 || out_size != M * DM || ws_size < WS_END) { fprintf(stderr, "kernel_launch: unexpected shapes: n_in %d out %d ws %zu\n", n_in, out_size, ws_size); grid = -1; return; }
        int dev = 0, cus = 0;
        if (hipGetDevice(&dev) != hipSuccess || hipDeviceGetAttribute(&cus, hipDeviceAttributeMultiprocessorCount, dev) != hipSuccess) { grid = -1; return; }
        if (hipFuncSetAttribute((const void*)mk_fwd<0>, hipFuncAttributeMaxDynamicSharedMemorySize, LDS_BYTES) != hipSuccess || (PROBE_VARIANT && hipFuncSetAttribute((const void*)mk_fwd<PROBE_VARIANT>, hipFuncAttributeMaxDynamicSharedMemorySize, LDS_BYTES) != hipSuccess)) { fprintf(stderr, "kernel_launch: hipFuncSetAttribute failed\n"); grid = -1; return; }
        int per_cu = 0;
        if (hipOccupancyMaxActiveBlocksPerMultiprocessor(&per_cu, (const void*)mk_fwd<0>, NWAVES * 64, LDS_BYTES) != hipSuccess || per_cu < 1) fprintf(stderr, "kernel_launch: occupancy query says %d\n", per_cu);
        (void)hipGetLastError();
        grid = cus;
    }
    if (grid < 0) return;
    (void)hipMemsetAsync((char*)d_ws + WS_CTL, 0, CTL_ZERO_BYTES, stream);
    Args a{};
    for (int i = 0; i < 21; ++i) a.in[i] = (const float*)d_in[i];
    a.out = (float*)d_out; a.ws = (unsigned char*)d_ws;
#if MK_ONE_LAUNCH
    a.ph_lo = 0; a.ph_hi = NPHASE; a.li = 0;
    hipLaunchKernelGGL(mk_fwd<0>, dim3(grid), dim3(NWAVES * 64), LDS_BYTES, stream, a);
#else
    for (int p = 0; p < NPHASE; ++p) { a.ph_lo = p; a.ph_hi = p + 1; a.li = p; const int reps = ((PROBE_DUP >> p) & 1) ? 2 : 1;
        for (int r = 0; r < reps; ++r) { if (r && PROBE_VARIANT) hipLaunchKernelGGL(mk_fwd<PROBE_VARIANT>, dim3(grid), dim3(NWAVES * 64), LDS_BYTES, stream, a); else hipLaunchKernelGGL(mk_fwd<0>, dim3(grid), dim3(NWAVES * 64), LDS_BYTES, stream, a); } }
#endif
}
```

```cpp
#include <hip/hip_runtime.h>
#include <cstdio>
#include <cstdint>
namespace pg8 {
#define PG8_LAS __attribute__((address_space(3)))
typedef unsigned short bf16_t;
typedef short bf16x8 __attribute__((ext_vector_type(8)));
typedef float f32x4 __attribute__((ext_vector_type(4)));
typedef unsigned u32x4 __attribute__((ext_vector_type(4)));
constexpr int BM = 256, BK = 64, HALF = 128, HTB = HALF * BK * 2  , STAGE_BYTES = 8 * HTB, NXCD = 8, WGM = 4;

__host__ __device__ __forceinline__ int lds_byte(int r, int c) { const int st = (r >> 4) * 2 + (c >> 5), rr = r & 15, cc = c & 31, ob = rr * 64 + cc * 2; return st * 1024 + (ob ^ (((ob >> 9) & 1) << 5)); }
__host__ __device__ __forceinline__ void stage_rc(int b, int& R, int& C) { const int st = b / 1024, sb = b % 1024, swz = sb ^ (((sb >> 9) & 1) << 5); R = (st >> 1) * 16 + swz / 64; C = (st & 1) * 32 + (swz % 64) / 2; }
__host__ __device__ __forceinline__ int perm32(int rho) { const int n = rho >> 4, i = rho & 15; return 8 * (i >> 2) + 4 * n + (i & 3); }

struct Unit { int pm, pn, half; };
struct Gemm { const bf16_t* A; const bf16_t* Bt; int M, N, K; const bf16_t* A2; const bf16_t* Bt2; };

struct StaticOrder {
    int nM, nN, nwg, G, c, wgm;
    __host__ __device__ void init(int M, int N, int G_, int c_, int wgm_ = WGM) { nM = M / BM; nN = N / BM; nwg = nM * nN; G = G_; c = c_; wgm = wgm_; }
    __host__ __device__ __forceinline__ bool next(int i, Unit& u) const {
        const long L = (long)i * G + c; if (L >= nwg) return false;
        int wgid = (int)L; { const int q = nwg / NXCD, r = nwg % NXCD, xcd = wgid % NXCD, off = wgid / NXCD; wgid = (xcd < r ? xcd * (q + 1) : r * (q + 1) + (xcd - r) * q) + off; }
        const int nig = wgm * nN, gid = wgid / nig, fm = gid * wgm, gsz = (nM - fm) < wgm ? (nM - fm) : wgm;
        u.pm = fm + ((wgid % nig) % gsz); u.pn = (wgid % nig) / gsz; u.half = 0; return true;
    }
    __device__ __forceinline__ void a_ready(const Unit&) const {}
    __device__ __forceinline__ void done(const Unit&) const {}
};
struct DualOrder {
    StaticOrder so; int G, c;
    __host__ __device__ void init(int M, int N, int G_, int c_, int wgm_ = WGM) { so.init(M, N, 1, 0, wgm_); G = G_; c = c_; }
    __host__ __device__ bool next(int i, Unit& u) const { StaticOrder t = so; t.G = G; t.c = c; if (!t.next(i >> 1, u)) return false; u.half = i & 1; return true; }
    __device__ __forceinline__ void a_ready(const Unit&) const {}
    __device__ __forceinline__ void done(const Unit&) const {}
};
struct TableOrder {
    PG8_LAS int* tab; int n;
    template <class Base> __device__ __forceinline__ void fill(const Base& B, PG8_LAS int* t) {
        tab = t;
        const int i = (int)threadIdx.x;
        if (i < 32) { Unit u; const bool ok = B.next(i, u); tab[4 * i] = ok ? u.pm : -1; tab[4 * i + 1] = u.pn; tab[4 * i + 2] = u.half; }
        __syncthreads();
        int c = 0;
#pragma unroll 1
        for (int k = 0; k < 32; ++k) { if (tab[4 * k] < 0) break; ++c; }
        n = __builtin_amdgcn_readfirstlane(c);
    }
    __device__ __forceinline__ bool next(int i, Unit& u) const { if (i >= n) return false; u.pm = __builtin_amdgcn_readfirstlane(tab[4 * i]); u.pn = __builtin_amdgcn_readfirstlane(tab[4 * i + 1]); u.half = __builtin_amdgcn_readfirstlane(tab[4 * i + 2]); return true; }
    __device__ __forceinline__ void a_ready(const Unit&) const {}
    __device__ __forceinline__ void done(const Unit&) const {}
};
__device__ __forceinline__ unsigned cvt_pk_bf16(float lo, float hi) { unsigned r; asm volatile("v_cvt_pk_bf16_f32 %0, %1, %2" : "=v"(r) : "v"(lo), "v"(hi)); return r; }
typedef float f32x2 __attribute__((ext_vector_type(2)));
__device__ __forceinline__ float bf2f(unsigned short h) { return __builtin_bit_cast(float, (unsigned)h << 16); }
__device__ __forceinline__ float bflo(unsigned w) { return __builtin_bit_cast(float, w << 16); }
__device__ __forceinline__ float bfhi(unsigned w) { return __builtin_bit_cast(float, w & 0xffff0000u); }
__device__ __forceinline__ float fast_sigmoid(float x) { return __builtin_amdgcn_rcpf(1.0f + __builtin_amdgcn_exp2f(-1.4426950408889634f * x)); }
__device__ __forceinline__ float gelu_tanh(float x) { const float z = 0.7978845608028654f * (x + 0.044715f * x * x * x); return x * fast_sigmoid(2.0f * z); }

__device__ __forceinline__ f32x4 sigmoid4(f32x4 x) { f32x4 e = x * (-1.4426950408889634f);
#pragma unroll
    for (int j = 0; j < 4; ++j) e[j] = __builtin_amdgcn_exp2f(e[j]);
    e = e + 1.0f;
#pragma unroll
    for (int j = 0; j < 4; ++j) e[j] = __builtin_amdgcn_rcpf(e[j]);
    return e; }
__device__ __forceinline__ f32x4 gelu_tanh4(f32x4 c) { f32x4 e = (c * c * 0.044715f + 1.0f) * c * (-2.0f * 1.4426950408889634f * 0.7978845608028654f);
#pragma unroll
    for (int j = 0; j < 4; ++j) e[j] = __builtin_amdgcn_exp2f(e[j]);
    e = e + 1.0f;
#pragma unroll
    for (int j = 0; j < 4; ++j) e[j] = __builtin_amdgcn_rcpf(e[j]);
    return c * e; }
struct EpiG1 {
    static constexpr bool PERM = true, AFTER_DRAIN = false, DUAL = false;
    bf16_t *o0, *o1, *o2, *o3, *o4, *o5, *o6; const float* qg; const float* kg; float* km; PG8_LAS float* px; float qscale; int variant;
    __device__ __forceinline__ void operator()(f32x4 (&acc)[2][2][4][2], const Unit& u, int wr, int wc, int fr, int fq) const {
        const int seg = u.pn >> 2;
        if (variant == 1) {
#pragma unroll
            for (int ai = 0; ai < 2; ++ai)
#pragma unroll
                for (int bj = 0; bj < 2; ++bj)
#pragma unroll
                    for (int m = 0; m < 4; ++m)
#pragma unroll
                        for (int n = 0; n < 2; ++n) asm volatile("" :: "v"(acc[ai][bj][m][n]));
            return; }
        if (variant == 7 || variant == 8) {
            bf16_t* dummy = o0 + (size_t)64 * 1024 * 1024;
            const int r8 = (variant == 8) ? (fr & 7) : fr, cx = (variant == 8) ? ((fr >> 3) * 32) : 0;
#pragma unroll
            for (int ai = 0; ai < 2; ++ai)
#pragma unroll
                for (int m = 0; m < 4; ++m)
#pragma unroll
                    for (int bj = 0; bj < 2; ++bj) { const f32x4 v0 = acc[ai][bj][m][0], v1 = acc[ai][bj][m][1];
                        u32x4 w; w.x = cvt_pk_bf16(v0[0], v0[1]); w.y = cvt_pk_bf16(v0[2], v0[3]); w.z = cvt_pk_bf16(v1[0], v1[1]); w.w = cvt_pk_bf16(v1[2], v1[3]);
                        const int rr = (variant == 8) ? (u.pm * BM + wr * 64 + ai * HALF + m * 16 + r8 + 8 * bj) : (u.pm * BM + wr * 64 + ai * HALF + m * 16 + fr);
                        const int cc = (variant == 8) ? ((u.pn & 3) * BM + wc * 64 + cx + 8 * fq) : ((u.pn & 3) * BM + wc * 32 + 8 * fq + bj * HALF);
                        *(u32x4*)(dummy + (size_t)rr * 1024 + cc) = w; }
            return; }
        bf16_t* base = seg == 0 ? o0 : seg == 1 ? o1 : seg == 2 ? o2 : seg == 3 ? o3 : seg == 4 ? o4 : seg == 5 ? o5 : o6;
        const int row0 = u.pm * BM + wr * 64 + fr, col0 = (u.pn & 3) * BM + wc * 32 + 8 * fq;
        if (seg == 2 || seg == 3) {
            float rs[2][4][2];
#pragma unroll
            for (int ai = 0; ai < 2; ++ai)
#pragma unroll
                for (int m = 0; m < 4; ++m)
#pragma unroll
                    for (int bj = 0; bj < 2; ++bj) { const f32x4 a0 = acc[ai][bj][m][0], a1 = acc[ai][bj][m][1];
                        float ss = (a0[0] * a0[0] + a0[1] * a0[1]) + (a0[2] * a0[2] + a0[3] * a0[3]) + (a1[0] * a1[0] + a1[1] * a1[1]) + (a1[2] * a1[2] + a1[3] * a1[3]);
                        ss += __shfl_xor(ss, 16); ss += __shfl_xor(ss, 32);
                        if (fq == 0) px[(ai * HALF + wr * 64 + m * 16 + fr) * 8 + bj * 4 + wc] = ss; }
            asm volatile("s_waitcnt lgkmcnt(0)" ::: "memory"); __builtin_amdgcn_s_barrier(); asm volatile("" ::: "memory");
#pragma unroll
            for (int ai = 0; ai < 2; ++ai)
#pragma unroll
                for (int m = 0; m < 4; ++m)
#pragma unroll
                    for (int bj = 0; bj < 2; ++bj) { const f32x4 p = *(const PG8_LAS f32x4*)(px + (ai * HALF + wr * 64 + m * 16 + fr) * 8 + bj * 4);
                        rs[ai][m][bj] = 1.0f / sqrtf(((p[0] + p[1]) + (p[2] + p[3])) * (1.0f / 128.0f) + 1e-6f); }
            const float* gp = (seg == 2 ? qg : kg) + wc * 32 + 8 * fq; const float gs = (seg == 2) ? qscale : 1.0f;
            const f32x4 g0 = *(const f32x4*)gp * gs, g1 = *(const f32x4*)(gp + 4) * gs;
            f32x4 cs[2][2];
#pragma unroll
            for (int bj = 0; bj < 2; ++bj) { cs[bj][0] = (f32x4){0.f, 0.f, 0.f, 0.f}; cs[bj][1] = (f32x4){0.f, 0.f, 0.f, 0.f}; }
#pragma unroll
            for (int ai = 0; ai < 2; ++ai)
#pragma unroll
                for (int m = 0; m < 4; ++m) { bf16_t* rowp = base + (size_t)(row0 + ai * HALF + m * 16) * 1024 + col0;
#pragma unroll
                    for (int bj = 0; bj < 2; ++bj) { const f32x4 v0 = acc[ai][bj][m][0] * rs[ai][m][bj] * g0, v1 = acc[ai][bj][m][1] * rs[ai][m][bj] * g1;
                        cs[bj][0] += v0; cs[bj][1] += v1;
                        u32x4 w; w.x = cvt_pk_bf16(v0[0], v0[1]); w.y = cvt_pk_bf16(v0[2], v0[3]); w.z = cvt_pk_bf16(v1[0], v1[1]); w.w = cvt_pk_bf16(v1[2], v1[3]);
                        if (variant) asm volatile("" :: "v"(w)); else __builtin_nontemporal_store(w, (u32x4*)(rowp + bj * HALF)); } }
            if (seg == 3 && !variant) {
#pragma unroll
                for (int bj = 0; bj < 2; ++bj)
#pragma unroll
                    for (int n = 0; n < 2; ++n)
#pragma unroll
                        for (int j = 0; j < 4; ++j) { float c = cs[bj][n][j]; c += __shfl_xor(c, 1); c += __shfl_xor(c, 2); c += __shfl_xor(c, 4); c += __shfl_xor(c, 8);
                            if (fr == 0) atomicAdd(km + ((size_t)u.pm * 8 + 2 * (u.pn & 3) + bj) * 128 + wc * 32 + 8 * fq + 4 * n + j, c * (1.0f / 256.0f)); }
            }
            return;
        }
#pragma unroll
        for (int ai = 0; ai < 2; ++ai)
#pragma unroll
            for (int m = 0; m < 4; ++m) { bf16_t* rowp = base + (size_t)(row0 + ai * HALF + m * 16) * 1024 + col0;
#pragma unroll
                for (int bj = 0; bj < 2; ++bj) { f32x4 v0 = acc[ai][bj][m][0], v1 = acc[ai][bj][m][1];
                    if (seg == 1) { v0 = gelu_tanh4(v0); v1 = gelu_tanh4(v1); }
                    else if (seg >= 5) { v0 = sigmoid4(v0); v1 = sigmoid4(v1); }
                    u32x4 w; w.x = cvt_pk_bf16(v0[0], v0[1]); w.y = cvt_pk_bf16(v0[2], v0[3]); w.z = cvt_pk_bf16(v1[0], v1[1]); w.w = cvt_pk_bf16(v1[2], v1[3]);
                    if (variant) asm volatile("" :: "v"(w)); else __builtin_nontemporal_store(w, (u32x4*)(rowp + bj * HALF)); } }
    }
};
struct EpiG3 {
    static constexpr bool PERM = true, AFTER_DRAIN = false, DUAL = true;
    const bf16_t* ga; const bf16_t* gb; bf16_t* out;
    __device__ __forceinline__ void mid(f32x4 (&acc)[2][2][4][2], const Unit& u, int wr, int wc, int fr, int fq) const {
        const int row0 = u.pm * BM + wr * 64 + fr, col0 = u.pn * BM + wc * 32 + 8 * fq;
#pragma unroll
        for (int ai = 0; ai < 2; ++ai) {
            u32x4 wa[4][2], wb[4][2];
#pragma unroll
            for (int m = 0; m < 4; ++m)
#pragma unroll
                for (int bj = 0; bj < 2; ++bj) { const size_t off = (size_t)(row0 + ai * HALF + m * 16) * 1024 + col0 + bj * HALF; wa[m][bj] = *(const u32x4*)(ga + off); wb[m][bj] = *(const u32x4*)(gb + off); }
#pragma unroll
            for (int m = 0; m < 4; ++m)
#pragma unroll
                for (int bj = 0; bj < 2; ++bj) { const u32x4 a = wa[m][bj], b = wb[m][bj];
                    acc[ai][bj][m][0] *= (f32x4){bflo(a.x) * __builtin_amdgcn_rcpf(bflo(b.x)), bfhi(a.x) * __builtin_amdgcn_rcpf(bfhi(b.x)), bflo(a.y) * __builtin_amdgcn_rcpf(bflo(b.y)), bfhi(a.y) * __builtin_amdgcn_rcpf(bfhi(b.y))};
                    acc[ai][bj][m][1] *= (f32x4){bflo(a.z) * __builtin_amdgcn_rcpf(bflo(b.z)), bfhi(a.z) * __builtin_amdgcn_rcpf(bfhi(b.z)), bflo(a.w) * __builtin_amdgcn_rcpf(bflo(b.w)), bfhi(a.w) * __builtin_amdgcn_rcpf(bfhi(b.w))}; }
        }
    }
    __device__ __forceinline__ void operator()(f32x4 (&acc)[2][2][4][2], const Unit& u, int wr, int wc, int fr, int fq) const {
        const int row0 = u.pm * BM + wr * 64 + fr, col0 = u.pn * BM + wc * 32 + 8 * fq;
        u32x4 wb[2][4][2];
#pragma unroll
        for (int ai = 0; ai < 2; ++ai)
#pragma unroll
            for (int m = 0; m < 4; ++m)
#pragma unroll
                for (int bj = 0; bj < 2; ++bj) wb[ai][m][bj] = *(const u32x4*)(gb + (size_t)(row0 + ai * HALF + m * 16) * 1024 + col0 + bj * HALF);
        asm volatile("" ::: "memory");
#pragma unroll
        for (int ai = 0; ai < 2; ++ai)
#pragma unroll
            for (int m = 0; m < 4; ++m)
#pragma unroll
                for (int bj = 0; bj < 2; ++bj) { const u32x4 b = wb[ai][m][bj]; const f32x4 v0 = acc[ai][bj][m][0], v1 = acc[ai][bj][m][1];
                    u32x4 w; w.x = cvt_pk_bf16(v0[0] * bflo(b.x), v0[1] * bfhi(b.x)); w.y = cvt_pk_bf16(v0[2] * bflo(b.y), v0[3] * bfhi(b.y)); w.z = cvt_pk_bf16(v1[0] * bflo(b.z), v1[1] * bfhi(b.z)); w.w = cvt_pk_bf16(v1[2] * bflo(b.w), v1[3] * bfhi(b.w));
                    *(u32x4*)(out + (size_t)(row0 + ai * HALF + m * 16) * 1024 + col0 + bj * HALF) = w; }
    }
};
template <class T> __device__ __forceinline__ T* at_byte(T* base, unsigned byteoff) { return (T*)((char*)base + byteoff); }
struct EpiX1 {
    static constexpr bool PERM = true, AFTER_DRAIN = false, DUAL = false;
    const float* base; bf16_t* xb; float* rsp; PG8_LAS float* px;
    __device__ __forceinline__ void operator()(f32x4 (&acc)[2][2][4][2], const Unit& u, int wr, int wc, int fr, int fq) const {
        const unsigned e0 = (unsigned)(u.pm * BM + wr * 64 + fr) * 1024u + (unsigned)(u.pn * BM + wc * 32 + 8 * fq);
#pragma unroll
        for (int ai = 0; ai < 2; ++ai) {
            {
                f32x4 b[4][2][2];
#pragma unroll
                for (int m = 0; m < 4; ++m)
#pragma unroll
                    for (int bj = 0; bj < 2; ++bj) { const float* p = at_byte(base, (e0 + (unsigned)((ai * HALF + m * 16) * 1024 + bj * HALF)) * 4u); b[m][bj][0] = __builtin_nontemporal_load((const f32x4*)p); b[m][bj][1] = __builtin_nontemporal_load((const f32x4*)(p + 4)); }
#pragma unroll
                for (int m = 0; m < 4; ++m)
#pragma unroll
                    for (int bj = 0; bj < 2; ++bj) { acc[ai][bj][m][0] += b[m][bj][0]; acc[ai][bj][m][1] += b[m][bj][1]; }
                asm volatile("" ::: "memory");
            }
#pragma unroll
            for (int m = 0; m < 4; ++m) { f32x4 s4 = {0.f, 0.f, 0.f, 0.f};
#pragma unroll
                for (int bj = 0; bj < 2; ++bj)
#pragma unroll
                    for (int n = 0; n < 2; ++n) { const f32x4 v = acc[ai][bj][m][n]; s4 += v * v; }
                float ss = (s4[0] + s4[1]) + (s4[2] + s4[3]);
                ss += __shfl_xor(ss, 16); ss += __shfl_xor(ss, 32);
                if (fq == 0) px[(ai * HALF + wr * 64 + m * 16 + fr) * 4 + wc] = ss; }
#pragma unroll
            for (int m = 0; m < 4; ++m)
#pragma unroll
                for (int bj = 0; bj < 2; ++bj) { const unsigned eo = e0 + (unsigned)((ai * HALF + m * 16) * 1024 + bj * HALF); const f32x4 v0 = acc[ai][bj][m][0], v1 = acc[ai][bj][m][1];
                    u32x4 w; w.x = cvt_pk_bf16(v0[0], v0[1]); w.y = cvt_pk_bf16(v0[2], v0[3]); w.z = cvt_pk_bf16(v1[0], v1[1]); w.w = cvt_pk_bf16(v1[2], v1[3]); *(u32x4*)at_byte(xb, eo * 2u) = w; }
            asm volatile("" ::: "memory");
        }
        asm volatile("s_waitcnt lgkmcnt(0)" ::: "memory"); __builtin_amdgcn_s_barrier(); asm volatile("" ::: "memory");
        const int t = (int)threadIdx.x;
        if (t < 256) { const f32x4 p = *(const PG8_LAS f32x4*)(px + t * 4); rsp[((size_t)u.pm * BM + t) * 4 + u.pn] = (p[0] + p[1]) + (p[2] + p[3]); }
    }
};
struct EpiOut {
    static constexpr bool PERM = true, AFTER_DRAIN = false, DUAL = false;
    const bf16_t* xb; float* out;
    __device__ __forceinline__ void operator()(f32x4 (&acc)[2][2][4][2], const Unit& u, int wr, int wc, int fr, int fq) const {
        const unsigned e0 = (unsigned)(u.pm * BM + wr * 64 + fr) * 1024u + (unsigned)(u.pn * BM + wc * 32 + 8 * fq);
        u32x4 r[2][4][2];
#pragma unroll
        for (int ai = 0; ai < 2; ++ai)
#pragma unroll
            for (int m = 0; m < 4; ++m)
#pragma unroll
                for (int bj = 0; bj < 2; ++bj) r[ai][m][bj] = *(const u32x4*)at_byte(xb, (e0 + (unsigned)((ai * HALF + m * 16) * 1024 + bj * HALF)) * 2u);
        asm volatile("" ::: "memory");
#pragma unroll
        for (int ai = 0; ai < 2; ++ai)
#pragma unroll
            for (int m = 0; m < 4; ++m)
#pragma unroll
                for (int bj = 0; bj < 2; ++bj) { const u32x4 w = r[ai][m][bj]; const unsigned eo = e0 + (unsigned)((ai * HALF + m * 16) * 1024 + bj * HALF);
                    const f32x4 v0 = acc[ai][bj][m][0] + (f32x4){bflo(w.x), bfhi(w.x), bflo(w.y), bfhi(w.y)}, v1 = acc[ai][bj][m][1] + (f32x4){bflo(w.z), bfhi(w.z), bflo(w.w), bfhi(w.w)};
                    float* po = at_byte(out, eo * 4u); __builtin_nontemporal_store(v0, (f32x4*)po); __builtin_nontemporal_store(v1, (f32x4*)(po + 4)); }
    }
};
template <int CTRL> __device__ __forceinline__ float dpp_mov(float old, float src) { return __builtin_bit_cast(float, __builtin_amdgcn_update_dpp(__builtin_bit_cast(int, old), __builtin_bit_cast(int, src), CTRL, 0xf, 0xf, false)); }
struct EpiUGF {
    static constexpr bool PERM = true, AFTER_DRAIN = false, DUAL = false;
    bf16_t* act; const float* cw; const float* cb; float* sb_last; float* su0; float* sg0; PG8_LAS float* halo; const float* rsp; int variant;
    __device__ __forceinline__ void operator()(f32x4 (&acc)[2][2][4][2], const Unit& u, int wr, int wc, int fr, int fq) const {
        const int colh = wc * 32 + 8 * fq, gcol = u.pn * HALF + colh;
        if (variant == 1) {
#pragma unroll
            for (int ai = 0; ai < 2; ++ai)
#pragma unroll
                for (int bj = 0; bj < 2; ++bj)
#pragma unroll
                    for (int m = 0; m < 4; ++m)
#pragma unroll
                        for (int n = 0; n < 2; ++n) asm volatile("" :: "v"(acc[ai][bj][m][n]));
            return; }
        {
            f32x4 rp[2][4];
#pragma unroll
            for (int ai = 0; ai < 2; ++ai)
#pragma unroll
                for (int m = 0; m < 4; ++m) rp[ai][m] = *(const f32x4*)at_byte(rsp, (unsigned)(u.pm * BM + ai * HALF + wr * 64 + m * 16 + fr) * 16u);
            { const int t = (int)threadIdx.x, r4 = t >> 7, c = t & 127;
              halo[1024 + t] = (r4 < 3) ? cw[r4 * 2816 + u.pn * HALF + c] : cb[u.pn * HALF + c]; }
#pragma unroll
            for (int ai = 0; ai < 2; ++ai)
#pragma unroll
                for (int m = 0; m < 4; ++m) { const f32x4 p = rp[ai][m]; const float rstd = __builtin_amdgcn_rsqf(((p[0] + p[1]) + (p[2] + p[3])) * (1.0f / 1024.0f) + 1e-6f);
#pragma unroll
                    for (int bj = 0; bj < 2; ++bj) { acc[ai][bj][m][0] *= rstd; acc[ai][bj][m][1] *= rstd; } }
        }
        asm volatile("" ::: "memory");
        if (fr >= 14) {
#pragma unroll
            for (int ai = 0; ai < 2; ++ai)
#pragma unroll
                for (int n = 0; n < 2; ++n) *(PG8_LAS f32x4*)(halo + ((2 * ai + wr) * 2 + (fr - 14)) * 128 + colh + 4 * n) = acc[ai][0][3][n];
            if (wr == 1) {
#pragma unroll
                for (int n = 0; n < 2; ++n) *(f32x4*)(sb_last + ((size_t)u.pm * 2 + (fr - 14)) * 2816 + gcol + 4 * n) = acc[1][0][3][n];
            }
        }
        asm volatile("s_waitcnt lgkmcnt(0)" ::: "memory"); __builtin_amdgcn_s_barrier(); asm volatile("" ::: "memory");
#pragma unroll
        for (int ai = 0; ai < 2; ++ai) {
            const int seg = 2 * ai + wr;
            f32x4 prev[2];
#pragma unroll
            for (int n = 0; n < 2; ++n) prev[n] = *(const PG8_LAS f32x4*)(halo + (((seg > 0 ? seg - 1 : 0)) * 2 + (fr & 1)) * 128 + colh + 4 * n);
#pragma unroll
            for (int m = 0; m < 4; ++m) {
                float r[8];
#pragma unroll
                for (int n = 0; n < 2; ++n) { const f32x4 cur = acc[ai][0][m][n], gt = acc[ai][1][m][n];
                    const f32x4 w0 = *(const PG8_LAS f32x4*)(halo + 1024 + colh + 4 * n), w1 = *(const PG8_LAS f32x4*)(halo + 1024 + 128 + colh + 4 * n), w2 = *(const PG8_LAS f32x4*)(halo + 1024 + 256 + colh + 4 * n), bb = *(const PG8_LAS f32x4*)(halo + 1024 + 384 + colh + 4 * n);
                    f32x4 v1, v2;
#pragma unroll
                    for (int j = 0; j < 4; ++j) {
                        const float t1 = dpp_mov<0x121>(prev[n][j], prev[n][j]); v1[j] = dpp_mov<0x111>(t1, cur[j]);
                        const float t2 = dpp_mov<0x122>(prev[n][j], prev[n][j]); v2[j] = dpp_mov<0x112>(t2, cur[j]); }
                    const f32x4 c = bb + w2 * cur + w1 * v1 + w0 * v2;
                    f32x4 ez = (c * c * 0.044715f + 1.0f) * c * (-2.0f * 1.4426950408889634f * 0.7978845608028654f);
#pragma unroll
                    for (int j = 0; j < 4; ++j) ez[j] = __builtin_amdgcn_exp2f(ez[j]);
                    ez = ez + 1.0f;
#pragma unroll
                    for (int j = 0; j < 4; ++j) ez[j] = __builtin_amdgcn_rcpf(ez[j]);
                    const f32x4 o = c * gt * ez;
                    r[4 * n] = o[0]; r[4 * n + 1] = o[1]; r[4 * n + 2] = o[2]; r[4 * n + 3] = o[3];
                    prev[n] = cur; }
                const unsigned row = (unsigned)(u.pm * BM + ai * HALF + wr * 64 + m * 16 + fr);
                const bool head = (seg == 0) && (m == 0) && (fr < 2);
                if (!head) { u32x4 w; w.x = cvt_pk_bf16(r[0], r[1]); w.y = cvt_pk_bf16(r[2], r[3]); w.z = cvt_pk_bf16(r[4], r[5]); w.w = cvt_pk_bf16(r[6], r[7]);
                    if (variant == 2) asm volatile("" :: "v"(w)); else *(u32x4*)at_byte(act, (row * 2816u + (unsigned)gcol) * 2u) = w; }
                else {
#pragma unroll
                    for (int n = 0; n < 2; ++n) { *(f32x4*)(su0 + ((size_t)u.pm * 2 + fr) * 2816 + gcol + 4 * n) = acc[0][0][0][n]; *(f32x4*)(sg0 + ((size_t)u.pm * 2 + fr) * 2816 + gcol + 4 * n) = acc[0][1][0][n]; }
                }
            }
        }
    }
};
template <class Epi, class Sched, bool ALIGN_EPI = false, bool SP2 = false>
__device__ __forceinline__ void gemm_phase(PG8_LAS unsigned char* lds, const Gemm g, const Sched& S, const Epi& E) {
    const int tid = threadIdx.x, wid = __builtin_amdgcn_readfirstlane(tid >> 6), lane = tid & 63, wr = wid >> 2, wc = wid & 3, fr = lane & 15, fq = lane >> 4;
    const int K = g.K, nt = K / BK;
    unsigned voffA[2], voffB[2];
#pragma unroll
    for (int i = 0; i < 2; ++i) { int R, C; stage_rc(tid * 16 + i * 8192, R, C); const int Rb = Epi::PERM ? ((R & ~31) + perm32(R & 31)) : R;
        voffA[i] = (unsigned)(R * K + C) * 2u; voffB[i] = (unsigned)(Rb * K + C) * 2u; }
    const size_t kstep = (size_t)(BK * 2);
    const size_t hstep = (size_t)HALF * K * 2;
    const size_t tstep = 2 * hstep;
    const unsigned ldsw = (unsigned)wid * 1024u;
    const int aoff = lds_byte(wr * 64 + fr, fq * 8), boff = lds_byte(wc * 32 + fr, fq * 8);
#define PG8_SA(b, h) (((b) * 2 + (h)) * HTB)
#define PG8_SB(b, h) ((4 + (b) * 2 + (h)) * HTB)
#ifndef PG8_AUX_B
#define PG8_AUX_B 0
#endif
#define PG8_STAGE(bufoff, gbase, voff) do { _Pragma("unroll") for (int _i = 0; _i < 2; ++_i) \
        __builtin_amdgcn_global_load_lds((const unsigned*)((const char*)(gbase) + (voff)[_i]), (PG8_LAS unsigned*)(lds + (bufoff) + ldsw + _i * 8192), 16, 0, (((bufoff) >= 4 * HTB) ? PG8_AUX_B : 0)); } while (0)
#define PG8_LDA(dst, b, h) do { _Pragma("unroll") for (int m = 0; m < 4; ++m) _Pragma("unroll") for (int k = 0; k < 2; ++k) dst[m][k] = *(const PG8_LAS bf16x8*)(lds + PG8_SA(b, h) + aoff + m * 2048 + k * 1024); } while (0)
#define PG8_LDB(dst, b, h) do { _Pragma("unroll") for (int n = 0; n < 2; ++n) _Pragma("unroll") for (int k = 0; k < 2; ++k) dst[n][k] = *(const PG8_LAS bf16x8*)(lds + PG8_SB(b, h) + boff + n * 2048 + k * 1024); } while (0)
#define PG8_MMA(ai, bj, At, Bt) do { __builtin_amdgcn_s_setprio(1); _Pragma("unroll") for (int m = 0; m < 4; ++m) _Pragma("unroll") for (int n = 0; n < 2; ++n) _Pragma("unroll") for (int k = 0; k < 2; ++k) \
        acc[ai][bj][m][n] = __builtin_amdgcn_mfma_f32_16x16x32_bf16(Bt[n][k], At[m][k], acc[ai][bj][m][n], 0, 0, 0); __builtin_amdgcn_s_setprio(0); } while (0)
#define PG8_WAIT_V(n) asm volatile("s_waitcnt vmcnt(" #n ")" ::: "memory")
#define PG8_WAIT_L(n) asm volatile("s_waitcnt lgkmcnt(" #n ")" ::: "memory")
#define PG8_BAR __builtin_amdgcn_s_barrier()
#define PG8_SCHED __builtin_amdgcn_sched_barrier(0)
    Unit cur, nxt; int ui = 0;
    if (!S.next(0, cur)) return;
    f32x4 acc[2][2][4][2];
#pragma unroll
    for (int a = 0; a < 2; ++a)
#pragma unroll
        for (int b = 0; b < 2; ++b)
#pragma unroll
            for (int m = 0; m < 4; ++m)
#pragma unroll
                for (int n = 0; n < 2; ++n) acc[a][b][m][n] = (f32x4){0.f, 0.f, 0.f, 0.f};
    bf16x8 At[4][2], B0[2][2], B1[2][2];
    const char* cA = (const char*)(cur.half ? g.A2 : g.A) + (size_t)cur.pm * tstep; const char* cB = (const char*)(cur.half ? g.Bt2 : g.Bt) + (size_t)cur.pn * tstep;
    S.a_ready(cur);
    if constexpr (SP2) {
        PG8_STAGE(PG8_SB(0, 0), cB, voffB); PG8_STAGE(PG8_SB(0, 1), cB + hstep, voffB); PG8_STAGE(PG8_SA(0, 0), cA, voffA); PG8_STAGE(PG8_SA(0, 1), cA + hstep, voffA);
        if (wr == 1) PG8_BAR;
        PG8_WAIT_V(2); PG8_BAR;
        PG8_STAGE(PG8_SB(1, 0), cB + kstep, voffB); PG8_STAGE(PG8_SA(1, 0), cA + kstep, voffA); PG8_STAGE(PG8_SB(1, 1), cB + hstep + kstep, voffB);
        PG8_WAIT_V(6); PG8_BAR;
    } else {
        PG8_STAGE(PG8_SB(0, 0), cB, voffB); PG8_STAGE(PG8_SA(0, 0), cA, voffA); PG8_STAGE(PG8_SB(0, 1), cB + hstep, voffB); PG8_STAGE(PG8_SA(0, 1), cA + hstep, voffA);
        if (wr == 1) PG8_BAR;
        PG8_WAIT_V(4); PG8_BAR;
        PG8_STAGE(PG8_SB(1, 0), cB + kstep, voffB); PG8_STAGE(PG8_SA(1, 0), cA + kstep, voffA); PG8_STAGE(PG8_SB(1, 1), cB + hstep + kstep, voffB);
        PG8_WAIT_V(6); PG8_BAR;
    }
    for (;;) {
        const bool has_next = S.next(ui + 1, nxt);
        const char* nA = has_next ? (const char*)(nxt.half ? g.A2 : g.A) + (size_t)nxt.pm * tstep : cA; const char* nB = has_next ? (const char*)(nxt.half ? g.Bt2 : g.Bt) + (size_t)nxt.pn * tstep : cB;
        for (int t = 0; t < nt; t += 2) {
            const bool last = (t == nt - 2);
            const char* a1 = cA + (size_t)(t + 1) * kstep;
            const char* a2 = last ? nA : cA + (size_t)(t + 2) * kstep; const char* b2 = last ? nB : cB + (size_t)(t + 2) * kstep;
            const char* a3 = a2 + kstep; const char* b3 = b2 + kstep;
            if (last && has_next) S.a_ready(nxt);
            if constexpr (SP2) {
            PG8_LDB(B0, 0, 0); PG8_LDB(B1, 0, 1); PG8_SCHED; PG8_LDA(At, 0, 0); PG8_STAGE(PG8_SA(1, 1), a1 + hstep, voffA);
            PG8_WAIT_V(8); PG8_WAIT_L(0); PG8_BAR; PG8_MMA(0, 0, At, B0); PG8_MMA(0, 1, At, B1); PG8_BAR; PG8_SCHED;
            PG8_LDA(At, 0, 1); PG8_STAGE(PG8_SB(0, 0), b2, voffB); PG8_STAGE(PG8_SB(0, 1), b2 + hstep, voffB); PG8_STAGE(PG8_SA(0, 0), a2, voffA);
            PG8_WAIT_V(8); PG8_WAIT_L(0); PG8_BAR; PG8_MMA(1, 0, At, B0); PG8_MMA(1, 1, At, B1); PG8_BAR; PG8_SCHED;
            PG8_LDB(B0, 1, 0); PG8_LDB(B1, 1, 1); PG8_SCHED; PG8_LDA(At, 1, 0); PG8_STAGE(PG8_SA(0, 1), a2 + hstep, voffA);
            PG8_WAIT_V(8); PG8_WAIT_L(0); PG8_BAR; PG8_MMA(0, 0, At, B0); PG8_MMA(0, 1, At, B1); PG8_BAR; PG8_SCHED;
            PG8_LDA(At, 1, 1); PG8_STAGE(PG8_SB(1, 0), b3, voffB); PG8_STAGE(PG8_SB(1, 1), b3 + hstep, voffB); PG8_STAGE(PG8_SA(1, 0), a3, voffA);
            PG8_WAIT_V(8); PG8_WAIT_L(0); PG8_BAR; PG8_MMA(1, 0, At, B0); PG8_MMA(1, 1, At, B1); PG8_BAR; PG8_SCHED;
            } else {
            PG8_LDB(B0, 0, 0); PG8_SCHED; PG8_LDA(At, 0, 0); PG8_STAGE(PG8_SA(1, 1), a1 + hstep, voffA);
            PG8_WAIT_L(8); PG8_BAR; PG8_WAIT_L(0); PG8_MMA(0, 0, At, B0); PG8_BAR; PG8_SCHED;
            PG8_LDB(B1, 0, 1); PG8_STAGE(PG8_SB(0, 0), b2, voffB);
            PG8_BAR; PG8_WAIT_L(0); PG8_MMA(0, 1, At, B1); PG8_BAR;
            PG8_LDA(At, 0, 1); PG8_STAGE(PG8_SA(0, 0), a2, voffA);
            PG8_BAR; PG8_WAIT_L(0); PG8_MMA(1, 0, At, B0); PG8_BAR; PG8_SCHED;
            PG8_STAGE(PG8_SB(0, 1), b2 + hstep, voffB);
            PG8_WAIT_V(6); PG8_BAR; PG8_MMA(1, 1, At, B1); PG8_BAR;
            PG8_LDB(B0, 1, 0); PG8_SCHED; PG8_LDA(At, 1, 0); PG8_STAGE(PG8_SA(0, 1), a2 + hstep, voffA);
            PG8_WAIT_L(8); PG8_BAR; PG8_WAIT_L(0); PG8_MMA(0, 0, At, B0); PG8_BAR; PG8_SCHED;
            PG8_LDB(B1, 1, 1); PG8_STAGE(PG8_SB(1, 0), b3, voffB);
            PG8_BAR; PG8_WAIT_L(0); PG8_MMA(0, 1, At, B1); PG8_BAR;
            PG8_LDA(At, 1, 1); PG8_STAGE(PG8_SA(1, 0), a3, voffA);
            PG8_BAR; PG8_WAIT_L(0); PG8_MMA(1, 0, At, B0); PG8_BAR; PG8_SCHED;
            PG8_STAGE(PG8_SB(1, 1), b3 + hstep, voffB);
            PG8_WAIT_V(6); PG8_BAR; PG8_MMA(1, 1, At, B1); PG8_BAR;
            }
        }
        if constexpr (ALIGN_EPI) { if (wr == 0) PG8_BAR; }
        bool keep_acc = false;
        if constexpr (Epi::DUAL) { if (cur.half == 0) { E.mid(acc, cur, wr, wc, fr, fq); keep_acc = true; } }
        if constexpr (!Epi::AFTER_DRAIN) { if (!keep_acc) { E(acc, cur, wr, wc, fr, fq); S.done(cur); } }
        if (!has_next) break;
        if (!keep_acc) {
#pragma unroll
        for (int a = 0; a < 2; ++a)
#pragma unroll
            for (int b = 0; b < 2; ++b)
#pragma unroll
                for (int m = 0; m < 4; ++m)
#pragma unroll
                    for (int n = 0; n < 2; ++n) acc[a][b][m][n] = (f32x4){0.f, 0.f, 0.f, 0.f};
        }
        cur = nxt; cA = nA; cB = nB; ++ui;
        if constexpr (ALIGN_EPI) { if (wr == 1) PG8_BAR; }
    }
    PG8_WAIT_V(0);
    if constexpr (!ALIGN_EPI) { if (wr == 0) PG8_BAR; }
    PG8_BAR;
    if constexpr (Epi::AFTER_DRAIN) { E.fused(acc, cur, wr, wc, fr, fq, lds, wid, lane); S.done(cur); }
#undef PG8_SA
#undef PG8_SB
#undef PG8_STAGE
#undef PG8_LDA
#undef PG8_LDB
#undef PG8_MMA
#undef PG8_WAIT_V
#undef PG8_WAIT_L
#undef PG8_BAR
#undef PG8_SCHED
}
}
#define GAS __attribute__((address_space(1)))
#define LAS __attribute__((address_space(3)))
typedef unsigned short bf16;
typedef unsigned v4u __attribute__((ext_vector_type(4)));
typedef float f32x4 __attribute__((ext_vector_type(4)));
typedef short bf16x8 __attribute__((ext_vector_type(8)));
typedef GAS unsigned gu32;
typedef GAS unsigned long long gu64;
#define RLX_AGENT __ATOMIC_RELAXED, __HIP_MEMORY_SCOPE_AGENT
#define LDS_WAIT() asm volatile("s_waitcnt lgkmcnt(0)" ::: "memory")
#define VM_WAIT() asm volatile("s_waitcnt vmcnt(0)" ::: "memory")
__device__ __forceinline__ unsigned long long rt() { return __builtin_amdgcn_s_memrealtime(); }
__device__ __forceinline__ unsigned f2bf(float f) { unsigned u = __builtin_bit_cast(unsigned, f); return (u + 0x7fffu + ((u >> 16) & 1u)) >> 16; }
__device__ __forceinline__ unsigned pk2(float lo, float hi) { return f2bf(lo) | (f2bf(hi) << 16); }

#define XB_TMO      128
#define XB_XCNT(j)  (256  + 64 * (j))
#define XB_XSUB(j)  (1280 + 64 * (j))
#define XB_XGEN(j)  (2304 + 64 * (j))
#define XB_TOP      3328
#define XB_TOPGEN   3392
#define XCD_BAR_WORDS 3456
#define XB_SPIN_CAP (1u << 18)

__device__ __forceinline__ unsigned xb_ld(unsigned* p)              { return __hip_atomic_load(p, __ATOMIC_RELAXED, __HIP_MEMORY_SCOPE_AGENT); }
__device__ __forceinline__ unsigned xb_add(unsigned* p, unsigned v) { return __hip_atomic_fetch_add(p, v, __ATOMIC_RELAXED, __HIP_MEMORY_SCOPE_AGENT); }
__device__ __forceinline__ unsigned xb_xcc_id() { return (unsigned)__builtin_amdgcn_s_getreg((3 << 11) | 20) & 0xFu; }
#define XB_SPIN(cond, bar) do { unsigned _sp = 0; while (cond) { __builtin_amdgcn_s_sleep(1); \
    if ((++_sp & 255u) == 0u) { if (xb_ld(&(bar)[XB_TMO])) break; if (_sp > XB_SPIN_CAP) { atomicAdd(&(bar)[XB_TMO], 1u); break; } } } } while (0)

struct XcdBarrier {
    unsigned* bar; unsigned x;
    volatile LAS unsigned* st;
};

__device__ __forceinline__ XcdBarrier xcd_barrier_post(unsigned* bar, volatile LAS unsigned* st) {
    XcdBarrier b; b.bar = bar; b.x = xb_xcc_id(); b.st = st;
    if (threadIdx.x == 0) (void)xb_add(&bar[XB_XCNT(b.x)], 1u);
    return b;
}
__device__ __forceinline__ void xcd_barrier_complete(unsigned* bar, unsigned x, unsigned& nloc, unsigned& nx) {
    const unsigned G = gridDim.x * gridDim.y * gridDim.z;
    unsigned sum, cnt, mine, sp = 0u;
    for (;;) {
        sum = 0u; cnt = 0u; mine = 0u;
#pragma unroll
        for (unsigned j = 0; j < 16; ++j) { const unsigned c = xb_ld(&bar[XB_XCNT(j)]); sum += c; cnt += (c > 0u) ? 1u : 0u; mine = (j == x) ? c : mine; }
        if (sum == G) break;
        __builtin_amdgcn_s_sleep(1);
        if ((++sp & 255u) == 0u) { if (xb_ld(&bar[XB_TMO])) break; if (sp > XB_SPIN_CAP) { atomicAdd(&bar[XB_TMO], 1u); break; } }
    }
    nloc = mine > 0u ? mine : 1u; nx = cnt > 0u ? cnt : 1u;
}

__device__ __forceinline__ void xcd_barrier(const XcdBarrier& b) {
    asm volatile("s_waitcnt vmcnt(0)" ::: "memory");
    __syncthreads();
    if (threadIdx.x == 0) {
        unsigned* bar = b.bar;
        __builtin_amdgcn_s_waitcnt(0);
        unsigned nloc = b.st[0], nx = b.st[1];
        if (nloc == 0u) { xcd_barrier_complete(bar, b.x, nloc, nx); b.st[0] = nloc; b.st[1] = nx; }
        const unsigned old = xb_add(&bar[XB_XSUB(b.x)], 1u);
        const unsigned gen = old / nloc;
        if (old + 1u == (gen + 1u) * nloc) {
            __builtin_amdgcn_fence(__ATOMIC_RELEASE, "agent");
            asm volatile("s_waitcnt vmcnt(0)" ::: "memory");
            const unsigned og = xb_add(&bar[XB_TOP], 1u);
            const unsigned tg = og / nx;
            if (og + 1u == (tg + 1u) * nx) xb_add(&bar[XB_TOPGEN], 1u);
            else XB_SPIN(xb_ld(&bar[XB_TOPGEN]) == tg, bar);
            __builtin_amdgcn_fence(__ATOMIC_ACQUIRE, "agent");
            xb_add(&bar[XB_XGEN(b.x)], 1u);
            asm volatile("s_waitcnt vmcnt(0)" ::: "memory");
        } else {
            XB_SPIN(xb_ld(&bar[XB_XGEN(b.x)]) == gen, bar);
            __builtin_amdgcn_fence(__ATOMIC_ACQUIRE, "agent");
            asm volatile("s_waitcnt vmcnt(0)" ::: "memory");
        }
    }
    __syncthreads();
}

constexpr int NWAVES = 8;
constexpr int NB = 4, SEQ = 8192, DM = 1024, M = NB * SEQ, DIN = 7168, DFF = 2816, NH = 8, HD = 128, NBLK = SEQ / 256;
constexpr float EPS = 1e-6f;
constexpr float QSCALE = 0.08838834764831845f * 1.4426950408889634f;
#ifndef MK_ONE_LAUNCH
#define MK_ONE_LAUNCH 1
#endif
constexpr int NPHASE = 15;

constexpr size_t MiB = 1u << 20;
constexpr size_t WS_CTL = 0, CTL_ZERO_BYTES = 96 * 1024;
constexpr size_t WS_WIN = 2 * MiB, WS_PA = 16 * MiB, WS_PB = 18 * MiB, WS_WOUT = 20 * MiB, WS_WUG = 22 * MiB, WS_WDN = 33 * MiB, WS_WR = 39 * MiB, WS_WI = 39 * MiB + 256 * 1024;
constexpr size_t WS_KM = 40 * MiB, WS_AG = 41 * MiB, WS_RSP = 45 * MiB;
constexpr size_t WS_XN = 48 * MiB;
constexpr size_t WS_Q = 112 * MiB;
constexpr size_t WS_K = 176 * MiB;
constexpr size_t WS_V = 240 * MiB;
constexpr size_t WS_XR = 304 * MiB, WS_GR = 368 * MiB;
constexpr size_t WS_ACT = 112 * MiB;
constexpr size_t WS_SB = 448 * MiB, WS_SU0 = 451 * MiB, WS_SG0 = 454 * MiB;
constexpr size_t WS_END = 512 * MiB;
constexpr int CW_BAR = 4096;

constexpr int LDS_BYTES = 163840;
constexpr int MISC_OFF = LDS_BYTES - 512;

__device__ __forceinline__ float wave_sum(float v) {
#pragma unroll
    for (int o = 1; o < 64; o <<= 1) v += __shfl_xor(v, o);
    return v;
}
__device__ __forceinline__ unsigned cvtpk_bf16(float lo, float hi) { unsigned r; asm volatile("v_cvt_pk_bf16_f32 %0, %1, %2" : "=v"(r) : "v"(lo), "v"(hi)); return r; }
__device__ __forceinline__ void p0_transpose_item(const float* W, int N, bf16* WT, int ldwt, int drow0, const float* gain, LAS float* scr, int kb, int nb, int lane) {
    const int k0 = 64 * kb, n0 = 64 * nb, lr = lane >> 4, lc = (lane & 15) * 4;
    f32x4 v[16];
#pragma unroll
    for (int i = 0; i < 16; ++i) v[i] = __builtin_nontemporal_load((const GAS f32x4*)(W + (size_t)(k0 + 4 * i + lr) * N + n0 + lc));
#pragma unroll
    for (int i = 0; i < 16; ++i) { const int kk = 4 * i + lr; const float g = gain ? gain[k0 + kk] : 1.0f; LAS float* d = scr + kk * 65 + lc; d[0] = v[i][0] * g; d[1] = v[i][1] * g; d[2] = v[i][2] * g; d[3] = v[i][3] * g; }
    LDS_WAIT(); asm volatile("" ::: "memory");
    const int c = lane & 7;
#pragma unroll
    for (int j = 0; j < 8; ++j) { const int n = (lane >> 3) + 8 * j; const LAS float* s = scr + (8 * c) * 65 + n;
        v4u o; o.x = cvtpk_bf16(s[0 * 65], s[1 * 65]); o.y = cvtpk_bf16(s[2 * 65], s[3 * 65]); o.z = cvtpk_bf16(s[4 * 65], s[5 * 65]); o.w = cvtpk_bf16(s[6 * 65], s[7 * 65]);
        *(GAS v4u*)(WT + (size_t)(drow0 + n) * ldwt + k0 + 8 * c) = o; }
    LDS_WAIT(); asm volatile("" ::: "memory");
}
__device__ __forceinline__ void rms_rows_to_bf16(const float* x, bf16* o, int m0, int mstep, int lane) {
    f32x4 v[4], w[4];
    if (m0 < M) {
#pragma unroll
        for (int j = 0; j < 4; ++j) v[j] = __builtin_nontemporal_load(((const GAS f32x4*)(x + (size_t)m0 * DM) + lane) + 64 * j); }
#pragma unroll 1
    for (int m = m0; m < M; m += mstep) {
        const int mn = m + mstep;
        if (mn < M) {
#pragma unroll
            for (int j = 0; j < 4; ++j) w[j] = __builtin_nontemporal_load(((const GAS f32x4*)(x + (size_t)mn * DM) + lane) + 64 * j); }
        float s = 0.f;
#pragma unroll
        for (int j = 0; j < 4; ++j) s += (v[j].x * v[j].x + v[j].y * v[j].y) + (v[j].z * v[j].z + v[j].w * v[j].w);
        const float rstd = 1.0f / sqrtf(wave_sum(s) * (1.f / DM) + EPS);
        GAS unsigned long long* o8 = (GAS unsigned long long*)(o + (size_t)m * DM) + lane;
#pragma unroll
        for (int j = 0; j < 4; ++j) o8[64 * j] = (unsigned long long)cvtpk_bf16(v[j].x * rstd, v[j].y * rstd) | ((unsigned long long)cvtpk_bf16(v[j].z * rstd, v[j].w * rstd) << 32);
#pragma unroll
        for (int j = 0; j < 4; ++j) v[j] = w[j];
    }
}

struct Args { const float* in[21]; float* out; unsigned char* ws; int ph_lo, ph_hi, li, pad; };
enum { I_X = 0, I_N1G, I_WIN, I_CONVW, I_CONVB, I_WR, I_BR, I_WI, I_BI, I_LAM, I_QNG, I_KNG, I_PA, I_PB, I_WOUT, I_N2G, I_WUP, I_WGATE, I_FCW, I_FCB, I_WDN };

__device__ __forceinline__ void p0_prologue(const Args& a, LAS unsigned char* lds, int gw, int NGW, int wave, int lane) {
    LAS float* scr = (LAS float*)(lds + wave * 16896);
    unsigned char* ws = a.ws;
    constexpr int I_IN = 16 * 112, I_SQ = 16 * 16, I_UP = 16 * 44, I_DN = 44 * 16, I_RG = 32;
    constexpr int NITEMS = I_IN + 3 * I_SQ + 2 * I_UP + I_DN + 2 * I_RG;
    for (int it = gw; it < NITEMS; it += NGW) {
        int r = it;
        if (r < I_IN) { p0_transpose_item(a.in[I_WIN], DIN, (bf16*)(ws + WS_WIN), DM, 64 * (r % 112), a.in[I_N1G], scr, r / 112, r % 112, lane); continue; } r -= I_IN;
        if (r < I_SQ) { p0_transpose_item(a.in[I_PA], DM, (bf16*)(ws + WS_PA), DM, 64 * (r % 16), nullptr, scr, r / 16, r % 16, lane); continue; } r -= I_SQ;
        if (r < I_SQ) { p0_transpose_item(a.in[I_PB], DM, (bf16*)(ws + WS_PB), DM, 64 * (r % 16), nullptr, scr, r / 16, r % 16, lane); continue; } r -= I_SQ;
        if (r < I_SQ) { p0_transpose_item(a.in[I_WOUT], DM, (bf16*)(ws + WS_WOUT), DM, 64 * (r % 16), nullptr, scr, r / 16, r % 16, lane); continue; } r -= I_SQ;
        if (r < I_UP) { const int nb = r % 44, n0 = 64 * nb; p0_transpose_item(a.in[I_WUP], DFF, (bf16*)(ws + WS_WUG), DM, 256 * (n0 / 128) + (n0 % 128), a.in[I_N2G], scr, r / 44, nb, lane); continue; } r -= I_UP;
        if (r < I_UP) { const int nb = r % 44, n0 = 64 * nb; p0_transpose_item(a.in[I_WGATE], DFF, (bf16*)(ws + WS_WUG), DM, 256 * (n0 / 128) + 128 + (n0 % 128), a.in[I_N2G], scr, r / 44, nb, lane); continue; } r -= I_UP;
        if (r < I_DN) { p0_transpose_item(a.in[I_WDN], DM, (bf16*)(ws + WS_WDN), DFF, 64 * (r % 16), nullptr, scr, r / 16, r % 16, lane); continue; } r -= I_DN;
        if (r < I_RG) { const int blk = r >> 2, q = r & 3; p0_transpose_item(a.in[I_WR] + blk * 16384, 128, (bf16*)(ws + WS_WR) + blk * 16384, 128, 64 * (q & 1), nullptr, scr, q >> 1, q & 1, lane); continue; } r -= I_RG;
        { const int blk = r >> 2, q = r & 3; p0_transpose_item(a.in[I_WI] + blk * 16384, 128, (bf16*)(ws + WS_WI) + blk * 16384, 128, 64 * (q & 1), nullptr, scr, q >> 1, q & 1, lane); }
    }
    rms_rows_to_bf16(a.in[I_X], (bf16*)(ws + WS_XN), gw, NGW, lane);
    for (int e = gw * 64 + lane; e < 128 * 1024; e += NGW * 64) ((float*)(ws + WS_KM))[e] = 0.f;
}

constexpr int CW_RFLAG = 20480;
__device__ __forceinline__ void rnn_phase(const Args& a, LAS unsigned char* lds, int G, int wave, int lane, int tid, int variant = 0) {
    LAS bf16* XRs = (LAS bf16*)lds;
    LAS bf16* XAb = (LAS bf16*)(lds + 18432);
    LAS bf16* HB = (LAS bf16*)(lds + 18432 + 17408);
    LAS float* CWl = (LAS float*)(lds + 18432 + 2 * 17408);
    const bf16* XR = (const bf16*)(a.ws + WS_XR); const bf16* GR = (const bf16*)(a.ws + WS_GR); bf16* YA = (bf16*)(a.ws + WS_XN);
    gu64* AG = (gu64*)(a.ws + WS_AG); gu32* RFLAG = (gu32*)(a.ws + WS_CTL) + CW_RFLAG;
    const int kq = lane >> 4, fr = lane & 15;
    if (G != 256) return;
    const int w = blockIdx.x, seqi = w & 31, sub = w >> 5, bb = seqi >> 3, n = seqi & 7;
    const int dcol = 16 * wave + fr, ch = n * 128 + dcol;
    LAS unsigned char* WFl = lds + 57344 + wave * 8192;
#pragma unroll
    for (int ks = 0; ks < 4; ++ks) { *(LAS bf16x8*)(WFl + (2 * ks) * 1024 + lane * 16) = *(const GAS bf16x8*)((const bf16*)(a.ws + WS_WR) + (size_t)ch * 128 + 32 * ks + 8 * kq);
                                     *(LAS bf16x8*)(WFl + (2 * ks + 1) * 1024 + lane * 16) = *(const GAS bf16x8*)((const bf16*)(a.ws + WS_WI) + (size_t)ch * 128 + 32 * ks + 8 * kq); }
    const float nbr = -1.4426950408889634f * a.in[I_BR][ch], nbi = -1.4426950408889634f * a.in[I_BI][ch];
    const float sp = log1pf(expf(-a.in[I_LAM][ch]));
    const float c1 = -16.0f * sp, c2 = -8.0f * sp * 1.4426950408889634f;
    const int cg = tid & 15, cc = n * 128 + 8 * cg;
    for (int e = tid; e < 640; e += 512) CWl[e] = (e < 512) ? a.in[I_CONVW][(e >> 7) * 1024 + n * 128 + (e & 127)] : a.in[I_CONVB][n * 128 + (e & 127)];
    float hc = 0.f;
    int cfold = 0;
    v4u pre[3];
    {
        const int rb0 = bb * 32 + sub; const bool seqstart = (sub == 0);
#pragma unroll
        for (int pp = 0; pp < 3; ++pp) { const int p = tid + 512 * pp;
            if (p < 67 * 16) { const int row = p >> 4, c = p & 15; const bool z = seqstart && row < 3; const int srow = z ? rb0 * 256 : rb0 * 256 - 3 + row;
                v4u v = __builtin_nontemporal_load((const GAS v4u*)(XR + (size_t)srow * DM + n * 128 + 8 * c)); if (z) v = (v4u){0u, 0u, 0u, 0u}; pre[pp] = v; } }
    }
#pragma unroll 1
    for (int it = 0; it < 4; ++it) {
        const int chunk = 8 * it + sub, rb = bb * 32 + chunk;
        float av[4][4][4]; unsigned bxp[4][4][2];
        float hl = 0.f, Pa = 1.f;
#pragma unroll
        for (int s = 0; s < 4; ++s) {
            const int r0 = rb * 256 + 64 * s;
#pragma unroll
            for (int pp = 0; pp < 3; ++pp) { const int p = tid + 512 * pp; if (p < 67 * 16) *(LAS v4u*)(XRs + (p >> 4) * 136 + 8 * (p & 15)) = pre[pp]; }
            __syncthreads();
            if (s < 3 || it < 3) {
                const int nr = (s < 3) ? r0 + 64 : r0 - 192 + 2048;
#pragma unroll
                for (int pp = 0; pp < 3; ++pp) { const int p = tid + 512 * pp; if (p < 67 * 16) pre[pp] = __builtin_nontemporal_load((const GAS v4u*)(XR + (size_t)(nr - 3 + (p >> 4)) * DM + n * 128 + 8 * (p & 15))); }
            }
#pragma unroll
            for (int pp = 0; pp < 2; ++pp) {
                const int tok = (tid >> 4) + 32 * pp;
                f32x4 a0 = *(const LAS f32x4*)(CWl + 512 + 8 * cg), a1 = *(const LAS f32x4*)(CWl + 512 + 8 * cg + 4);
#pragma unroll
                for (int k = 0; k < 4; ++k) { const v4u wv = *(const LAS v4u*)(XRs + (tok + k) * 136 + 8 * cg);
                    const f32x4 c0 = *(const LAS f32x4*)(CWl + k * 128 + 8 * cg), c1v = *(const LAS f32x4*)(CWl + k * 128 + 8 * cg + 4);
                    a0 += c0 * (f32x4){pg8::bflo(wv.x), pg8::bfhi(wv.x), pg8::bflo(wv.y), pg8::bfhi(wv.y)}; a1 += c1v * (f32x4){pg8::bflo(wv.z), pg8::bfhi(wv.z), pg8::bflo(wv.w), pg8::bfhi(wv.w)}; }
                v4u o; o.x = cvtpk_bf16(a0[0], a0[1]); o.y = cvtpk_bf16(a0[2], a0[3]); o.z = cvtpk_bf16(a1[0], a1[1]); o.w = cvtpk_bf16(a1[2], a1[3]);
                *(LAS v4u*)(XAb + tok * 136 + 8 * cg) = o;
            }
            __syncthreads();
            if (variant == 2) { _Pragma("unroll") for (int r_ = 0; r_ < 4; ++r_) { av[s][r_][0] = av[s][r_][1] = av[s][r_][2] = av[s][r_][3] = 1.f; bxp[s][r_][0] = bxp[s][r_][1] = 0u; } continue; }
#pragma unroll
            for (int rt = 0; rt < 4; ++rt) {
                f32x4 aR = {0.f, 0.f, 0.f, 0.f}, aI = {0.f, 0.f, 0.f, 0.f};
#pragma unroll
                for (int ks = 0; ks < 4; ++ks) { const bf16x8 af = *(const LAS bf16x8*)(XAb + (16 * rt + fr) * 136 + 32 * ks + 8 * kq);
                    aR = __builtin_amdgcn_mfma_f32_16x16x32_bf16(af, *(const LAS bf16x8*)(WFl + (2 * ks) * 1024 + lane * 16), aR, 0, 0, 0); aI = __builtin_amdgcn_mfma_f32_16x16x32_bf16(af, *(const LAS bf16x8*)(WFl + (2 * ks + 1) * 1024 + lane * 16), aI, 0, 0, 0); }
                float A = 1.f, H = 0.f; float bxt[4];
                {
                    f32x4 er = aR * (-1.4426950408889634f) + nbr, ei = aI * (-1.4426950408889634f) + nbi;
#pragma unroll
                    for (int rg = 0; rg < 4; ++rg) { er[rg] = __builtin_amdgcn_exp2f(er[rg]); ei[rg] = __builtin_amdgcn_exp2f(ei[rg]); }
                    er = er + 1.0f; ei = ei + 1.0f;
                    f32x4 r, ig;
#pragma unroll
                    for (int rg = 0; rg < 4; ++rg) { r[rg] = __builtin_amdgcn_rcpf(er[rg]); ig[rg] = __builtin_amdgcn_rcpf(ei[rg]); }
                    f32x4 aa = r * c2; const f32x4 x = r * c1;
#pragma unroll
                    for (int rg = 0; rg < 4; ++rg) aa[rg] = __builtin_amdgcn_exp2f(aa[rg]);
                    f32x4 poly = x * 0.2f + 1.0f; poly = poly * (x * 0.25f) + 1.0f; poly = poly * (x * (1.0f / 3.0f)) + 1.0f; poly = poly * (x * 0.5f) + 1.0f; poly = poly * (-x);
                    const f32x4 alt = 1.0f - aa * aa;
                    f32x4 em1, xa;
#pragma unroll
                    for (int rg = 0; rg < 4; ++rg) { em1[rg] = (x[rg] > -0.25f) ? poly[rg] : alt[rg]; xa[rg] = pg8::bf2f(XAb[(16 * rt + 4 * kq + rg) * 136 + dcol]); }
#pragma unroll
                    for (int rg = 0; rg < 4; ++rg) em1[rg] = __builtin_amdgcn_sqrtf(em1[rg]);
                    const f32x4 bv = em1 * ig * xa;
#pragma unroll
                    for (int rg = 0; rg < 4; ++rg) { av[s][rt][rg] = aa[rg]; bxt[rg] = bv[rg]; H = aa[rg] * H + bv[rg]; A *= aa[rg]; }
                }
                bxp[s][rt][0] = cvtpk_bf16(bxt[0], bxt[1]); bxp[s][rt][1] = cvtpk_bf16(bxt[2], bxt[3]);
                { const float A1 = __shfl_up(A, 16), H1 = __shfl_up(H, 16); if (kq >= 1) { H = A * H1 + H; A = A1 * A; } }
                { const float A2 = __shfl_up(A, 32), H2 = __shfl_up(H, 32); if (kq >= 2) { H = A * H2 + H; A = A2 * A; } }
                const float At = __shfl(A, 48 + fr), Ht = __shfl(H, 48 + fr);
                hl = At * hl + Ht; Pa *= At;
            }
        }
        if (kq == 0) __hip_atomic_store(AG + (size_t)rb * 1024 + ch, ((unsigned long long)__float_as_uint(hl) << 32) | __float_as_uint(Pa), RLX_AGENT);
        asm volatile("s_waitcnt vmcnt(0)" ::: "memory");
        __syncthreads();
        if (tid == 0) __hip_atomic_store(RFLAG + rb * 8 + n, 1u, RLX_AGENT);
        if (wave == 0) {
            unsigned spins = 0;
            for (;;) {
                const unsigned f = (lane >= cfold && lane < chunk) ? __hip_atomic_load(RFLAG + (bb * 32 + lane) * 8 + n, RLX_AGENT) : 1u;
                if (__all(f != 0u)) break;
                __builtin_amdgcn_s_sleep(2);
                if (++spins > (1u << 22)) break;
            }
        }
        __syncthreads();
        {
#pragma unroll
            for (int j0 = 0; j0 < 8; j0 += 4) { unsigned long long ah[4];
#pragma unroll
                for (int j = 0; j < 4; ++j) { const int ci = (cfold + j0 + j < chunk) ? cfold + j0 + j : (chunk > 0 ? chunk - 1 : 0); ah[j] = __hip_atomic_load(AG + (size_t)(bb * 32 + ci) * 1024 + ch, RLX_AGENT); }
#pragma unroll
                for (int j = 0; j < 4; ++j) if (cfold + j0 + j < chunk) hc = __uint_as_float((unsigned)ah[j]) * hc + __uint_as_float((unsigned)(ah[j] >> 32)); }
            cfold = chunk;
        }
        if (variant >= 1) { asm volatile("" :: "v"(hc)); _Pragma("unroll") for (int s_ = 0; s_ < 4; ++s_) _Pragma("unroll") for (int r_ = 0; r_ < 4; ++r_) { asm volatile("" :: "v"(av[s_][r_][0]), "v"(av[s_][r_][3]), "v"(bxp[s_][r_][0]), "v"(bxp[s_][r_][1])); } __syncthreads(); continue; }
        float hs = hc;
#pragma unroll
        for (int s = 0; s < 4; ++s) {
            const int r0 = rb * 256 + 64 * s;
            v4u gpre[2];
#pragma unroll
            for (int pp = 0; pp < 2; ++pp) gpre[pp] = __builtin_nontemporal_load((const GAS v4u*)(GR + (size_t)(r0 + (tid >> 4) + 32 * pp) * DM + cc));
#pragma unroll
            for (int rt = 0; rt < 4; ++rt) {
                float A = 1.f, H = 0.f;
                const float bxv[4] = { pg8::bflo(bxp[s][rt][0]), pg8::bfhi(bxp[s][rt][0]), pg8::bflo(bxp[s][rt][1]), pg8::bfhi(bxp[s][rt][1]) };
#pragma unroll
                for (int rg = 0; rg < 4; ++rg) { H = av[s][rt][rg] * H + bxv[rg]; A *= av[s][rt][rg]; }
                float At = 1.f, Ht = 0.f, Ae = 1.f, He = 0.f;
#pragma unroll
                for (int q = 0; q < 4; ++q) { const float Aq = __shfl(A, 16 * q + fr), Hq = __shfl(H, 16 * q + fr);
                    Ae = (q == kq) ? At : Ae; He = (q == kq) ? Ht : He; Ht = Aq * Ht + Hq; At *= Aq; }
                float h = Ae * hs + He;
#pragma unroll
                for (int rg = 0; rg < 4; ++rg) { h = av[s][rt][rg] * h + bxv[rg]; HB[(16 * rt + 4 * kq + rg) * 136 + dcol] = (bf16)cvtpk_bf16(h, h); }
                hs = At * hs + Ht;
            }
            __syncthreads();
#pragma unroll
            for (int pp = 0; pp < 2; ++pp) {
                const int tok = (tid >> 4) + 32 * pp;
                const v4u hw = *(const LAS v4u*)(HB + tok * 136 + 8 * cg);
                const v4u gw = gpre[pp];
                v4u o; o.x = cvtpk_bf16(pg8::bflo(hw.x) * pg8::bflo(gw.x), pg8::bfhi(hw.x) * pg8::bfhi(gw.x)); o.y = cvtpk_bf16(pg8::bflo(hw.y) * pg8::bflo(gw.y), pg8::bfhi(hw.y) * pg8::bfhi(gw.y));
                o.z = cvtpk_bf16(pg8::bflo(hw.z) * pg8::bflo(gw.z), pg8::bfhi(hw.z) * pg8::bfhi(gw.z)); o.w = cvtpk_bf16(pg8::bflo(hw.w) * pg8::bflo(gw.w), pg8::bfhi(hw.w) * pg8::bfhi(gw.w));
                __builtin_nontemporal_store(o, (GAS v4u*)(YA + (size_t)(r0 + tok) * DM + cc));
            }
            __syncthreads();
        }
        hc = Pa * hc + hl; cfold = chunk + 1;
    }
}
typedef short s16x4 __attribute__((ext_vector_type(4)));
typedef float f32x16 __attribute__((ext_vector_type(16)));
typedef short v4i16_t __attribute__((ext_vector_type(4)));
constexpr size_t WS_PART = 304 * MiB, WS_LIST = 496 * MiB, WS_LP = 42 * MiB;
constexpr int CW_CNT = 16384;
constexpr int LIST_PER_BH = 256 * 496;
__device__ __forceinline__ int list_off(int n) { return 256 * (31 * n - (n * (n - 1)) / 2); }
__device__ __forceinline__ unsigned cvtpk(float lo, float hi) { unsigned r; asm volatile("v_cvt_pk_bf16_f32 %0, %1, %2" : "=v"(r) : "v"(lo), "v"(hi)); return r; }
__device__ __forceinline__ s16x4 vtr(const LAS unsigned char* p) { return __builtin_bit_cast(s16x4, __builtin_amdgcn_ds_read_tr16_b64_v4i16((LAS v4i16_t*)p)); }

__device__ __forceinline__ void load_kv_block(LAS unsigned char* lds, const bf16* Kg, const bf16* Vg, size_t row0, int hh, int wave, int lane) {
#pragma unroll
    for (int i = 0; i < 8; ++i) {
        const int I = wave * 8 + i;
        { const int r = 4 * I + (lane >> 4), cp = lane & 15, c = cp ^ (r & 15);
          __builtin_amdgcn_global_load_lds((const unsigned*)(Kg + (row0 + r) * DM + hh * HD + 8 * c), (LAS unsigned*)(lds + I * 1024), 16, 0, 0); }
        { const int dt = lane >> 4, q = (lane >> 2) & 3, c8 = lane & 3;
          __builtin_amdgcn_global_load_lds((const unsigned*)(Vg + (row0 + 4 * I + q) * DM + hh * HD + 32 * dt + 8 * c8), (LAS unsigned*)(lds + 65536 + I * 1024), 16, 0, 0); }
    }
}

__device__ __forceinline__ void attn_wave(const LAS unsigned char* lds, const bf16x8 (&qf)[8], f32x16 (&O)[4], float& lsum, int kt_hi, int diag, int lane) {
    const int h2 = lane >> 5, kr = lane & 31;
    unsigned kaddr[8];
#pragma unroll
    for (int s = 0; s < 8; ++s) kaddr[s] = (unsigned)(kr * 256 + (((2 * s + h2) ^ (lane & 15)) * 16));
    const LAS unsigned char* vb = lds + 65536 + h2 * 1024 + ((lane >> 2) & 3) * 64 + ((lane >> 4) & 1) * 32 + (lane & 3) * 8;
#pragma unroll 1
    for (int kt = 0; kt < kt_hi; ++kt) {
        f32x16 S;
#pragma unroll
        for (int r = 0; r < 16; ++r) S[r] = 0.f;
#pragma unroll
        for (int s = 0; s < 8; ++s) { const bf16x8 kf = *(const LAS bf16x8*)(lds + kt * 8192 + kaddr[s]); S = __builtin_amdgcn_mfma_f32_32x32x16_bf16(kf, qf[s], S, 0, 0, 0); }
        float P[16];
#pragma unroll
        for (int r = 0; r < 16; ++r) P[r] = __builtin_amdgcn_exp2f(S[r]);
        if (kt == diag) {
#pragma unroll
            for (int r = 0; r < 16; ++r) { const int kl = (r & 3) + 8 * (r >> 2) + 4 * h2; P[r] = (kl <= kr) ? P[r] : 0.f; }
        }
        float ls = 0.f;
#pragma unroll
        for (int r = 0; r < 16; ++r) ls += P[r];
        lsum += ls;
        v4u pw0, pw1;
        pw0.x = cvtpk(P[0], P[1]); pw0.y = cvtpk(P[2], P[3]); pw0.z = cvtpk(P[4], P[5]); pw0.w = cvtpk(P[6], P[7]);
        pw1.x = cvtpk(P[8], P[9]); pw1.y = cvtpk(P[10], P[11]); pw1.z = cvtpk(P[12], P[13]); pw1.w = cvtpk(P[14], P[15]);
        const bf16x8 pb0 = __builtin_bit_cast(bf16x8, pw0), pb1 = __builtin_bit_cast(bf16x8, pw1);
        const LAS unsigned char* vk = vb + kt * 8192;
#pragma unroll
        for (int dt = 0; dt < 4; ++dt) {
            { const s16x4 lo = vtr(vk + dt * 256), hi = vtr(vk + dt * 256 + 2048);
              const bf16x8 vf = (bf16x8){lo[0], lo[1], lo[2], lo[3], hi[0], hi[1], hi[2], hi[3]};
              O[dt] = __builtin_amdgcn_mfma_f32_32x32x16_bf16(vf, pb0, O[dt], 0, 0, 0); }
            { const s16x4 lo = vtr(vk + 4096 + dt * 256), hi = vtr(vk + 4096 + dt * 256 + 2048);
              const bf16x8 vf = (bf16x8){lo[0], lo[1], lo[2], lo[3], hi[0], hi[1], hi[2], hi[3]};
              O[dt] = __builtin_amdgcn_mfma_f32_32x32x16_bf16(vf, pb1, O[dt], 0, 0, 0); }
        }
    }
}

__device__ __forceinline__ void q_unstage(LAS unsigned char* stg, const v4u (&qs)[8], bf16x8 (&qf)[8], int lane) {
    const int ra = lane >> 2, rb2 = ra + 16, part = lane & 3, h2 = lane >> 5, kr = lane & 31;
#pragma unroll
    for (int p = 0; p < 4; ++p) {
        *(LAS v4u*)(stg + ra * 80 + part * 16) = qs[2 * p]; *(LAS v4u*)(stg + rb2 * 80 + part * 16) = qs[2 * p + 1];
        asm volatile("s_waitcnt lgkmcnt(0)" ::: "memory");
        qf[2 * p] = *(const LAS bf16x8*)(stg + kr * 80 + h2 * 16); qf[2 * p + 1] = *(const LAS bf16x8*)(stg + kr * 80 + 32 + h2 * 16);
        asm volatile("s_waitcnt lgkmcnt(0)" ::: "memory");
    }
}
__device__ __forceinline__ void gate_phase(const Args& a, LAS unsigned char* lds, int vcu, int wave, int lane, int tid, int variant = 0) {
    LAS unsigned* lcnt = (LAS unsigned*)lds; LAS unsigned* gbase = lcnt + 128;
    const bf16* Qg = (const bf16*)(a.ws + WS_Q); const float* KM = (const float*)(a.ws + WS_KM);
    unsigned* CNT = (unsigned*)(a.ws + WS_CTL) + CW_CNT; unsigned* LIST = (unsigned*)(a.ws + WS_LIST);
    const int h2 = lane >> 5, kr = lane & 31;
    if (tid < 128) lcnt[tid] = 0u;
    __syncthreads();
    int seln[4][3]; unsigned pos[4][3];
#pragma unroll
    for (int ui = 0; ui < 4; ++ui) {
        const int unit = vcu * 4 + ui, bh = unit >> 5, qb = unit & 31, bb = bh >> 3, hh = bh & 7;
        const size_t rowbase = (size_t)bb * SEQ; const int tq = qb * 256 + 32 * wave + kr;
        const float* kmp = KM + ((size_t)(bb * 32 + kr) * 8 + hh) * 128 + 8 * h2;
        const bf16* qp = Qg + (rowbase + tq) * DM + hh * HD + 8 * h2;
        f32x16 acc;
#pragma unroll
        for (int r = 0; r < 16; ++r) acc[r] = 0.f;
#pragma unroll
        for (int s = 0; s < 8; ++s) {
            const f32x4 k0 = *(const GAS f32x4*)(kmp + 16 * s), k1 = *(const GAS f32x4*)(kmp + 16 * s + 4);
            const float kv[8] = {k0[0], k0[1], k0[2], k0[3], k1[0], k1[1], k1[2], k1[3]};
            unsigned hi[4], lo[4];
#pragma unroll
            for (int j = 0; j < 4; ++j) { const unsigned hw = cvtpk(kv[2 * j], kv[2 * j + 1]); hi[j] = hw;
                lo[j] = cvtpk(kv[2 * j] - __builtin_bit_cast(float, hw << 16), kv[2 * j + 1] - __builtin_bit_cast(float, hw & 0xffff0000u)); }
            const bf16x8 ahi = __builtin_bit_cast(bf16x8, (v4u){hi[0], hi[1], hi[2], hi[3]}), alo = __builtin_bit_cast(bf16x8, (v4u){lo[0], lo[1], lo[2], lo[3]});
            const bf16x8 bq = *(const GAS bf16x8*)(qp + 16 * s);
            acc = __builtin_amdgcn_mfma_f32_32x32x16_bf16(ahi, bq, acc, 0, 0, 0); acc = __builtin_amdgcn_mfma_f32_32x32x16_bf16(alo, bq, acc, 0, 0, 0);
        }
        unsigned mask = 0u;
#pragma unroll
        for (int r3 = 0; r3 < 3; ++r3) {
            seln[ui][r3] = 0; pos[ui][r3] = 0u;
            if (r3 < qb) { float best = -3.0e38f; int bi = 64;
#pragma unroll
                for (int r = 0; r < 16; ++r) { const int blk = (r & 3) + 8 * (r >> 2) + 4 * h2; const bool ok = (blk < qb) && !((mask >> blk) & 1u) && (acc[r] > best); best = ok ? acc[r] : best; bi = ok ? blk : bi; }
                const float ob = __shfl_xor(best, 32); const int oi = __shfl_xor(bi, 32);
                const bool take = (ob > best) || (ob == best && oi < bi);
                bi = take ? oi : bi; bi &= 31;
                mask |= 1u << bi; seln[ui][r3] = bi;
                if (h2 == 0) pos[ui][r3] = __hip_atomic_fetch_add(lcnt + ui * 32 + bi, 1u, __ATOMIC_RELAXED, __HIP_MEMORY_SCOPE_WORKGROUP); }
        }
    }
    __syncthreads();
    if (tid < 128) { const unsigned c = lcnt[tid]; const int bh = (vcu * 4 + (tid >> 5)) >> 5; gbase[tid] = (c && !variant) ? atomicAdd(CNT + bh * 32 + (tid & 31), c) : 0u; }
    __syncthreads();
    if (h2 == 0 && !variant) {
#pragma unroll
        for (int ui = 0; ui < 4; ++ui) { const int unit = vcu * 4 + ui, bh = unit >> 5, qb = unit & 31; const int tq = qb * 256 + 32 * wave + kr;
#pragma unroll
            for (int r3 = 0; r3 < 3; ++r3) if (r3 < qb) LIST[(size_t)bh * LIST_PER_BH + list_off(seln[ui][r3]) + gbase[ui * 32 + seln[ui][r3]] + pos[ui][r3]] = ((unsigned)tq << 2) | (unsigned)r3; }
    }
    __syncthreads();
}

__device__ __forceinline__ void sparse_phase(const Args& a, LAS unsigned char* lds, int G, int wave, int lane, int tid, int variant = 0) {
    LAS unsigned* cntl = (LAS unsigned*)(lds + 131072 + 1024);
    LAS unsigned* pre = cntl + 1024;
    const bf16* Qg = (const bf16*)(a.ws + WS_Q); const bf16* Kg = (const bf16*)(a.ws + WS_K); const bf16* Vg = (const bf16*)(a.ws + WS_V);
    const unsigned* CNT = (const unsigned*)(a.ws + WS_CTL) + CW_CNT; const unsigned* LIST = (const unsigned*)(a.ws + WS_LIST);
    bf16* PART = (bf16*)(a.ws + WS_PART); float* LP = (float*)(a.ws + WS_LP);
    const int h2 = lane >> 5, kr = lane & 31;
    for (int i = tid; i < 1024; i += 512) cntl[i] = __hip_atomic_load(CNT + i, __ATOMIC_RELAXED, __HIP_MEMORY_SCOPE_AGENT);
    __syncthreads();
    LAS unsigned* pre2 = (LAS unsigned*)(lds + 131072 + 10240);
    if (wave == 0) {
        unsigned loc[16], loc2[16]; unsigned s = 0u, s2 = 0u;
#pragma unroll
        for (int j = 0; j < 16; ++j) { const unsigned t = (cntl[16 * lane + j] + 255u) >> 8; loc[j] = s; loc2[j] = s2; s += t; s2 += t ? 2u * t + 1u : 0u; }
        unsigned inc = s, inc2 = s2;
#pragma unroll
        for (int o = 1; o < 64; o <<= 1) { const unsigned t = __shfl_up(inc, o), t2 = __shfl_up(inc2, o); if (lane >= o) { inc += t; inc2 += t2; } }
        const unsigned exc = inc - s, exc2 = inc2 - s2;
#pragma unroll
        for (int j = 0; j < 16; ++j) { pre[16 * lane + j] = exc + loc[j]; pre2[16 * lane + j] = exc2 + loc2[j]; }
        if (lane == 63) { pre[1024] = inc; pre2[1024] = inc2; }
    }
    __syncthreads();
    const unsigned T = pre[1024], C = pre2[1024];
    unsigned lo, hi;
    {
        unsigned bnd[2];
#pragma unroll
        for (int e = 0; e < 2; ++e) {
            const unsigned cb = (unsigned)(((unsigned long long)(blockIdx.x + e) * C) / (unsigned)G);
            if (blockIdx.x + e >= (unsigned)G) { bnd[e] = T; continue; }
            int a0 = 0, b0 = 1024; while (b0 - a0 > 1) { const int m = (a0 + b0) >> 1; if (pre2[m] <= cb) a0 = m; else b0 = m; }
            const unsigned tl = pre[a0 + 1] - pre[a0], base = pre2[a0] + 1u;
            const unsigned k = (cb > base) ? (cb - base + 1u) / 2u : 0u;
            bnd[e] = (k >= tl) ? pre[a0 + 1] : pre[a0] + k;
        }
        lo = bnd[0]; hi = bnd[1];
    }
    __syncthreads();
    if (lo >= hi) return;
    int li = 0;
    { int a0 = 0, b0 = 1024; while (b0 - a0 > 1) { const int m = (a0 + b0) >> 1; if (pre[m] <= lo) a0 = m; else b0 = m; } li = a0; }
#define SP_ENTRY(LI, K2) ({ const int bh_ = (LI) >> 5, nn_ = (LI) & 31; const int idx_ = 256 * (K2) + 32 * wave + kr; (idx_ < (int)cntl[LI]) ? LIST[(size_t)bh_ * LIST_PER_BH + list_off(nn_) + idx_] : 0xffffffffu; })
#define SP_QROW(LI, E) (Qg + ((size_t)((LI) >> 8) * SEQ + (((E) == 0xffffffffu) ? 0u : ((E) >> 2))) * DM + (((LI) >> 5) & 7) * HD + 8 * (lane & 3))
#define SP_QLOAD(DST, LI, E) do { const unsigned ea_ = __shfl((E), lane >> 2), eb_ = __shfl((E), (lane >> 2) + 16); const bf16* qa_ = SP_QROW(LI, ea_); const bf16* qb_ = SP_QROW(LI, eb_); \
        _Pragma("unroll") for (int p_ = 0; p_ < 4; ++p_) { DST[2 * p_] = *(const GAS v4u*)(qa_ + 32 * p_); DST[2 * p_ + 1] = *(const GAS v4u*)(qb_ + 32 * p_); } } while (0)
    int l1 = li, l2, l3;
    unsigned t1 = lo;
    while (t1 >= pre[l1 + 1]) ++l1;
    l2 = l1; if (lo + 1 < hi) { while (lo + 1 >= pre[l2 + 1]) ++l2; }
    unsigned e1 = SP_ENTRY(l1, (int)(lo - pre[l1]));
    unsigned e2 = (lo + 1 < hi) ? SP_ENTRY(l2, (int)(lo + 1 - pre[l2])) : 0xffffffffu;
    LAS unsigned char* stg = lds + 131072 + 10240 + wave * 2560;
    v4u qs[8];
    SP_QLOAD(qs, l1, e1);
    int cur = -1;
#pragma unroll 1
    for (unsigned tile = lo; tile < hi; ++tile) {
        const int k = (int)(tile - pre[l1]); const int cnt = (int)cntl[l1];
        const int bh = l1 >> 5, nn = l1 & 31, bb = bh >> 3, hh = bh & 7; const size_t rowbase = (size_t)bb * SEQ;
        if (l1 != cur) {
            __syncthreads();
            if (variant != 4 || cur < 0) load_kv_block(lds, Kg, Vg, rowbase + (size_t)nn * 256, hh, wave, lane);
            asm volatile("s_waitcnt vmcnt(0)" ::: "memory");
            __syncthreads();
            cur = l1;
        }
        bf16x8 qf[8];
        q_unstage(stg, qs, qf, lane);
        unsigned e3 = 0xffffffffu; l3 = l2;
        if (tile + 1 < hi && variant != 5) SP_QLOAD(qs, l2, e2);
        if (tile + 2 < hi) { while (tile + 2 >= pre[l3 + 1]) ++l3; e3 = SP_ENTRY(l3, (int)(tile + 2 - pre[l3])); }
        const int idx0 = 256 * k + 32 * wave;
        if (idx0 < cnt) {
            const bool valid = (e1 != 0xffffffffu);
            const int t = (int)(e1 >> 2), j = (int)(e1 & 3u);
            f32x16 O[4];
#pragma unroll
            for (int dt = 0; dt < 4; ++dt)
#pragma unroll
                for (int r = 0; r < 16; ++r) O[dt][r] = 0.f;
            float lsum = 0.f;
            if (variant != 1) attn_wave(lds, qf, O, lsum, variant == 2 ? 4 : 8, -1, lane);
            lsum += __shfl_xor(lsum, 32);
            if (variant) {
#pragma unroll
                for (int dt = 0; dt < 4; ++dt)
#pragma unroll
                    for (int r = 0; r < 16; ++r) asm volatile("" :: "v"(O[dt][r]));
                asm volatile("" :: "v"(lsum));
            }
            if (variant == 0 || variant == 3) {
                const int psl = valid ? (int)(((unsigned)bh * SEQ + (unsigned)t) * 3u + (unsigned)j) : -1;
                if (valid && h2 == 0) LP[psl] = lsum;
                const int ra = lane >> 2, rb2 = ra + 16, part = lane & 3;
                const int psa = __shfl(psl, ra), psb = __shfl(psl, rb2);
#pragma unroll
                for (int dt = 0; dt < 4; ++dt) {
#pragma unroll
                    for (int rq = 0; rq < 4; ++rq) { const unsigned long long w = (unsigned long long)cvtpk(O[dt][4 * rq], O[dt][4 * rq + 1]) | ((unsigned long long)cvtpk(O[dt][4 * rq + 2], O[dt][4 * rq + 3]) << 32);
                        *(LAS unsigned long long*)(stg + kr * 80 + rq * 16 + h2 * 8) = w; }
                    asm volatile("s_waitcnt lgkmcnt(0)" ::: "memory");
                    const v4u ca = *(const LAS v4u*)(stg + ra * 80 + part * 16), cb2 = *(const LAS v4u*)(stg + rb2 * 80 + part * 16);
                    if (psa >= 0) *(GAS v4u*)(PART + (size_t)psa * 128 + dt * 32 + part * 8) = ca;
                    if (psb >= 0) *(GAS v4u*)(PART + (size_t)psb * 128 + dt * 32 + part * 8) = cb2;
                    asm volatile("s_waitcnt lgkmcnt(0)" ::: "memory");
                }
            }
        }
        e1 = e2; e2 = e3; l1 = l2; l2 = l3;
    }
#undef SP_ENTRY
#undef SP_QROW
#undef SP_QLOAD
}

__device__ __forceinline__ void own_phase(const Args& a, LAS unsigned char* lds, int vcu, int wave, int lane, int tid, int variant = 0) {
    bf16* Qg = (bf16*)(a.ws + WS_Q); const bf16* Kg = (const bf16*)(a.ws + WS_K); const bf16* Vg = (const bf16*)(a.ws + WS_V);
    const bf16* PART = (const bf16*)(a.ws + WS_PART); const float* LP = (const float*)(a.ws + WS_LP);
    const int h2 = lane >> 5, kr = lane & 31;
    LAS unsigned char* stg = lds + 131072 + 10240 + wave * 2560;
    const int ra = lane >> 2, rb2 = ra + 16, part = lane & 3;
#pragma unroll 1
    for (int ui = 0; ui < 4; ++ui) {
        const int unit = vcu * 4 + ui, bh = unit >> 5, qb = unit & 31, bb = bh >> 3, hh = bh & 7;
        const size_t rowbase = (size_t)bb * SEQ; const int t0 = qb * 256 + 32 * wave, t = t0 + kr;
        __syncthreads();
        load_kv_block(lds, Kg, Vg, rowbase + (size_t)qb * 256, hh, wave, lane);
        bf16* qp = Qg + (rowbase + t) * DM + hh * HD;
        v4u qs[8];
        { const bf16* qa_ = Qg + (rowbase + t0 + ra) * DM + hh * HD + 8 * part; const bf16* qb_ = Qg + (rowbase + t0 + rb2) * DM + hh * HD + 8 * part;
#pragma unroll
          for (int p_ = 0; p_ < 4; ++p_) { qs[2 * p_] = *(const GAS v4u*)(qa_ + 32 * p_); qs[2 * p_ + 1] = *(const GAS v4u*)(qb_ + 32 * p_); } }
        const int nsel = qb < 3 ? qb : 3;
        const size_t psa = ((size_t)bh * SEQ + t0 + ra) * 3, psb = ((size_t)bh * SEQ + t0 + rb2) * 3;
        float lp[3] = {0.f, 0.f, 0.f};
#pragma unroll
        for (int j = 0; j < 3; ++j) if (j < nsel) lp[j] = LP[((size_t)bh * SEQ + t) * 3 + j];
        asm volatile("s_waitcnt vmcnt(0)" ::: "memory");
        __syncthreads();
        bf16x8 qf[8];
        q_unstage(stg, qs, qf, lane);
        f32x16 O[4];
#pragma unroll
        for (int dt = 0; dt < 4; ++dt)
#pragma unroll
            for (int r = 0; r < 16; ++r) O[dt][r] = 0.f;
        float lsum = 0.f;
        attn_wave(lds, qf, O, lsum, wave + 1, wave, lane);
        lsum += __shfl_xor(lsum, 32);
        lsum += (lp[0] + lp[1]) + lp[2];
#pragma unroll 1
        for (int j = 0; j < nsel; ++j) {
            v4u pa[8];
#pragma unroll
            for (int dt = 0; dt < 4; ++dt) { pa[2 * dt] = __builtin_nontemporal_load((const GAS v4u*)(PART + (psa + j) * 128 + dt * 32 + part * 8)); pa[2 * dt + 1] = __builtin_nontemporal_load((const GAS v4u*)(PART + (psb + j) * 128 + dt * 32 + part * 8)); }
#pragma unroll
            for (int dt = 0; dt < 4; ++dt) {
                *(LAS v4u*)(stg + ra * 80 + part * 16) = pa[2 * dt]; *(LAS v4u*)(stg + rb2 * 80 + part * 16) = pa[2 * dt + 1];
                asm volatile("s_waitcnt lgkmcnt(0)" ::: "memory");
#pragma unroll
                for (int rq = 0; rq < 4; ++rq) { const unsigned long long w = *(const LAS unsigned long long*)(stg + kr * 80 + rq * 16 + h2 * 8); const unsigned w0 = (unsigned)w, w1 = (unsigned)(w >> 32);
                    O[dt][4 * rq] += pg8::bflo(w0); O[dt][4 * rq + 1] += pg8::bfhi(w0); O[dt][4 * rq + 2] += pg8::bflo(w1); O[dt][4 * rq + 3] += pg8::bfhi(w1); }
                asm volatile("s_waitcnt lgkmcnt(0)" ::: "memory");
            }
        }
        const float inv = 1.0f / lsum;
        bf16* ya = Qg + (rowbase + t0 + ra) * DM + hh * HD; bf16* yb = Qg + (rowbase + t0 + rb2) * DM + hh * HD;
#pragma unroll
        for (int dt = 0; dt < 4; ++dt) {
#pragma unroll
            for (int rq = 0; rq < 4; ++rq) { const unsigned long long w = (unsigned long long)cvtpk(O[dt][4 * rq] * inv, O[dt][4 * rq + 1] * inv) | ((unsigned long long)cvtpk(O[dt][4 * rq + 2] * inv, O[dt][4 * rq + 3] * inv) << 32);
                *(LAS unsigned long long*)(stg + kr * 80 + rq * 16 + h2 * 8) = w; }
            asm volatile("s_waitcnt lgkmcnt(0)" ::: "memory");
            const v4u ca = *(const LAS v4u*)(stg + ra * 80 + part * 16), cb2 = *(const LAS v4u*)(stg + rb2 * 80 + part * 16);
            if (variant) { asm volatile("" :: "v"(ca), "v"(cb2)); } else { *(GAS v4u*)(ya + dt * 32 + part * 8) = ca; *(GAS v4u*)(yb + dt * 32 + part * 8) = cb2; }
            asm volatile("s_waitcnt lgkmcnt(0)" ::: "memory");
        }
    }
}
__device__ __forceinline__ void fix_rows(const Args& a, int pm, int tid) {
    const float* SB = (const float*)(a.ws + WS_SB); const float* SU0 = (const float*)(a.ws + WS_SU0); const float* SG0 = (const float*)(a.ws + WS_SG0);
    bf16* ACT = (bf16*)(a.ws + WS_ACT); const float* cw = a.in[I_FCW]; const float* cb = a.in[I_FCB];
    const bool first = (pm & 31) == 0;
    const int pp = first ? pm : pm - 1;
    for (int e = tid; e < 2 * DFF; e += NWAVES * 64) {
        const int col = e % DFF, r = e / DFF;
        const float up0 = SU0[((size_t)pm * 2 + r) * DFF + col], gt = SG0[((size_t)pm * 2 + r) * DFF + col];
        const float pl1 = first ? 0.f : SB[((size_t)pp * 2 + 1) * DFF + col], pl0 = first ? 0.f : SB[((size_t)pp * 2 + 0) * DFF + col];
        const float x1 = (r == 0) ? pl1 : SU0[((size_t)pm * 2 + 0) * DFF + col];
        const float x2 = (r == 0) ? pl0 : pl1;
        const float c = cb[col] + cw[2 * DFF + col] * up0 + cw[DFF + col] * x1 + cw[col] * x2;
        ACT[((size_t)pm * 256 + r) * DFF + col] = (bf16)f2bf(pg8::gelu_tanh(c) * gt);
    }
}

template <int PV> __global__ void __launch_bounds__(NWAVES * 64, 2) mk_fwd(Args args) {
    extern __shared__ __attribute__((aligned(16))) unsigned char lds_raw[];
    LAS unsigned char* lds = (LAS unsigned char*)lds_raw;
    volatile LAS unsigned* MISC = (volatile LAS unsigned*)(lds + MISC_OFF);
    const int tid = threadIdx.x, lane = tid & 63, wave = __builtin_amdgcn_readfirstlane(tid >> 6);
    const int G = gridDim.x; const int bx = blockIdx.x; const int vcu = (G % 8 == 0) ? (bx % 8) * (G / 8) + bx / 8 : bx;
    unsigned char* ws = args.ws;
    gu32* ctl = (gu32*)(ws + WS_CTL);
    for (int u = tid; u < (LDS_BYTES - 131072) / 4; u += NWAVES * 64) ((LAS unsigned*)(lds + 131072))[u] = 0u;
    __syncthreads();
    XcdBarrier bar; bar.bar = (unsigned*)(ctl + CW_BAR); bar.x = 0; bar.st = nullptr;
    if (MK_ONE_LAUNCH) bar = xcd_barrier_post((unsigned*)(ctl + CW_BAR), MISC + 8);
    const int lo = args.ph_lo, hi = args.ph_hi;
    const int tid0 = tid;
#ifndef WGM_G1
#define WGM_G1 4
#endif
#ifndef WGM_G5
#define WGM_G5 4
#endif
#ifndef PROBE_DUP
#define PROBE_DUP 0
#endif
#ifndef PROBE_VARIANT
#define PROBE_VARIANT 0
#endif
#define LAUNDER() int tid = tid0; asm volatile("" : "+v"(tid)); const int lane = tid & 63; (void)lane
#ifndef PH_MASK
#define PH_MASK 0xffff
#endif
#define IN(k) (((PH_MASK >> (k)) & 1) && lo <= (k) && (k) < hi)
#define SEAM(k) do { if (IN(k) && IN((k) + 1)) xcd_barrier(bar); } while (0)
    const int gw = vcu * NWAVES + wave, NGW = G * NWAVES;
    bf16* XN = (bf16*)(ws + WS_XN); bf16* XR = (bf16*)(ws + WS_XR); bf16* GR = (bf16*)(ws + WS_GR);
    bf16* Qb = (bf16*)(ws + WS_Q); bf16* Kb = (bf16*)(ws + WS_K); bf16* Vb = (bf16*)(ws + WS_V);
    bf16* GA = (bf16*)args.out; bf16* GB = (bf16*)args.out + (size_t)M * DM;

    if (IN(0)) { LAUNDER(); p0_prologue(args, lds, gw, NGW, wave, lane); } SEAM(0);
    if (IN(1)) { LAUNDER();
        pg8::Gemm g{XN, (const bf16*)(ws + WS_WIN), M, DIN, DM, nullptr, nullptr}; pg8::StaticOrder S; S.init(M, DIN, G, bx, WGM_G1);
        pg8::EpiG1 E{XR, GR, Qb, Kb, Vb, GA, GB, args.in[I_QNG], args.in[I_KNG], (float*)(ws + WS_KM), (LAS float*)(lds + 131072 + 1024), QSCALE, PV};
        pg8::TableOrder TS; TS.fill(S, (LAS int*)(lds + 131072 + 512)); pg8::gemm_phase<pg8::EpiG1, pg8::TableOrder, true, true>(lds, g, TS, E); } SEAM(1);
    if (IN(3)) { LAUNDER(); rnn_phase(args, lds, G, wave, lane, tid, PV); __syncthreads(); gate_phase(args, lds, vcu, wave, lane, tid, PV); } SEAM(3);
    if (IN(6)) { LAUNDER(); sparse_phase(args, lds, G, wave, lane, tid, PV); } SEAM(6);
    if (IN(7)) { LAUNDER(); own_phase(args, lds, vcu, wave, lane, tid, PV); } SEAM(7);
    if (IN(8)) { LAUNDER(); pg8::Gemm g{XN  , (const bf16*)(ws + WS_PA), M, DM, DM, Qb  , (const bf16*)(ws + WS_PB)}; pg8::DualOrder S; S.init(M, DM, G, bx);
        pg8::EpiG3 E{GA, GB, Kb  };
        pg8::TableOrder TS; TS.fill(S, (LAS int*)(lds + 131072 + 512)); pg8::gemm_phase<pg8::EpiG3, pg8::TableOrder, true, true>(lds, g, TS, E); } SEAM(8);
    if (IN(10)) { LAUNDER();
        pg8::Gemm g{Kb  , (const bf16*)(ws + WS_WOUT), M, DM, DM, nullptr, nullptr}; pg8::StaticOrder S; S.init(M, DM, G, bx);
        pg8::EpiX1 E{args.in[I_X], XN  , (float*)(ws + WS_RSP), (LAS float*)(lds + 131072 + 1024)};
        pg8::TableOrder TS; TS.fill(S, (LAS int*)(lds + 131072 + 512)); pg8::gemm_phase<pg8::EpiX1, pg8::TableOrder, true, true>(lds, g, TS, E); } SEAM(10);
    if (IN(12)) { LAUNDER(); pg8::Gemm g{XN  , (const bf16*)(ws + WS_WUG), M, 2 * DFF, DM, nullptr, nullptr}; pg8::StaticOrder S; S.init(M, 2 * DFF, G, bx, WGM_G5);
        pg8::EpiUGF E{(bf16*)(ws + WS_ACT), args.in[I_FCW], args.in[I_FCB], (float*)(ws + WS_SB), (float*)(ws + WS_SU0), (float*)(ws + WS_SG0), (LAS float*)(lds + 131072 + 1024), (const float*)(ws + WS_RSP), PV};
        pg8::TableOrder TS; TS.fill(S, (LAS int*)(lds + 131072 + 512)); pg8::gemm_phase<pg8::EpiUGF, pg8::TableOrder, true, true>(lds, g, TS, E); } SEAM(12);
    if (IN(14)) { LAUNDER(); pg8::Gemm g{(const bf16*)(ws + WS_ACT), (const bf16*)(ws + WS_WDN), M, DM, DFF, nullptr, nullptr}; pg8::StaticOrder S; S.init(M, DM, G, bx);
        { pg8::Unit fu; for (int i = 0; S.next(i, fu); ++i) fix_rows(args, fu.pm, tid); asm volatile("s_waitcnt vmcnt(0)" ::: "memory"); __syncthreads(); }
        pg8::EpiOut E{XN  , args.out};
        pg8::TableOrder TS; TS.fill(S, (LAS int*)(lds + 131072 + 512)); pg8::gemm_phase<pg8::EpiOut, pg8::TableOrder, true, true>(lds, g, TS, E); }
#undef IN
#undef SEAM
}

extern "C" void kernel_launch(void* const* d_in, const int* in_sizes, int n_in, void* d_out, int out_size, void* d_ws, size_t ws_size, hipStream_t stream) {
    static int grid = 0;
    if (grid == 0) {
        if (n_in != 21 || out_size != M * DM || ws_size < WS_END) { fprintf(stderr, "kernel_launch: unexpected shapes: n_in %d out %d ws %zu\n", n_in, out_size, ws_size); grid = -1; return; }
        int dev = 0, cus = 0;
        if (hipGetDevice(&dev) != hipSuccess || hipDeviceGetAttribute(&cus, hipDeviceAttributeMultiprocessorCount, dev) != hipSuccess) { grid = -1; return; }
        if (hipFuncSetAttribute((const void*)mk_fwd<0>, hipFuncAttributeMaxDynamicSharedMemorySize, LDS_BYTES) != hipSuccess || (PROBE_VARIANT && hipFuncSetAttribute((const void*)mk_fwd<PROBE_VARIANT>, hipFuncAttributeMaxDynamicSharedMemorySize, LDS_BYTES) != hipSuccess)) { fprintf(stderr, "kernel_launch: hipFuncSetAttribute failed\n"); grid = -1; return; }
        int per_cu = 0;
        if (hipOccupancyMaxActiveBlocksPerMultiprocessor(&per_cu, (const void*)mk_fwd<0>, NWAVES * 64, LDS_BYTES) != hipSuccess || per_cu < 1) fprintf(stderr, "kernel_launch: occupancy query says %d\n", per_cu);
        (void)hipGetLastError();
        grid = cus;
    }
    if (grid < 0) return;
    (void)hipMemsetAsync((char*)d_ws + WS_CTL, 0, CTL_ZERO_BYTES, stream);
    Args a{};
    for (int i = 0; i < 21; ++i) a.in[i] = (const float*)d_in[i];
    a.out = (float*)d_out; a.ws = (unsigned char*)d_ws;
#if MK_ONE_LAUNCH
    a.ph_lo = 0; a.ph_hi = NPHASE; a.li = 0;
    hipLaunchKernelGGL(mk_fwd<0>, dim3(grid), dim3(NWAVES * 64), LDS_BYTES, stream, a);
#else
    for (int p = 0; p < NPHASE; ++p) { a.ph_lo = p; a.ph_hi = p + 1; a.li = p; const int reps = ((PROBE_DUP >> p) & 1) ? 2 : 1;
        for (int r = 0; r < reps; ++r) { if (r && PROBE_VARIANT) hipLaunchKernelGGL(mk_fwd<PROBE_VARIANT>, dim3(grid), dim3(NWAVES * 64), LDS_BYTES, stream, a); else hipLaunchKernelGGL(mk_fwd<0>, dim3(grid), dim3(NWAVES * 64), LDS_BYTES, stream, a); } }
#endif
}
```

```cpp
#include <hip/hip_runtime.h>
#include <cstdio>
#include <cstdint>

constexpr int NWAVES = 8;
constexpr int NB = 4, SEQ = 8192, DM = 1024, M = NB * SEQ, DIN = 7168, DFF = 2816, NH = 8, HD = 128, NBLK = SEQ / 256;
constexpr float EPS = 1e-6f;
constexpr float QSCALE = 0.08838834764831845f * 1.4426950408889634f;
#ifndef MK_ONE_LAUNCH
#define MK_ONE_LAUNCH 1
#endif
constexpr int NPHASE = 15;

constexpr size_t MiB = 1u << 20;
constexpr size_t WS_CTL = 0, CTL_ZERO_BYTES = 96 * 1024;
constexpr size_t WS_WIN = 2 * MiB, WS_PA = 16 * MiB, WS_PB = 18 * MiB, WS_WOUT = 20 * MiB, WS_WUG = 22 * MiB, WS_WDN = 33 * MiB, WS_WR = 39 * MiB, WS_WI = 39 * MiB + 256 * 1024;
constexpr size_t WS_KM = 40 * MiB, WS_AG = 41 * MiB, WS_RSP = 45 * MiB, WS_RS0 = 46 * MiB;
constexpr size_t WS_XN = 48 * MiB;
constexpr size_t WS_Q = 112 * MiB;
constexpr size_t WS_K = 176 * MiB;
constexpr size_t WS_V = 240 * MiB;
constexpr size_t WS_XR = 304 * MiB, WS_GR = 368 * MiB;
constexpr size_t WS_ACT = 112 * MiB;
constexpr size_t WS_SB = 448 * MiB, WS_SU0 = 451 * MiB, WS_SG0 = 454 * MiB;
constexpr size_t WS_END = 512 * MiB;
constexpr int CW_BAR = 4096;

constexpr int LDS_BYTES = 163840;
constexpr int MISC_OFF = LDS_BYTES - 512;

namespace pg8 {
#define PG8_LAS __attribute__((address_space(3)))
typedef unsigned short bf16_t;
typedef short bf16x8 __attribute__((ext_vector_type(8)));
typedef float f32x4 __attribute__((ext_vector_type(4)));
typedef unsigned u32x4 __attribute__((ext_vector_type(4)));
constexpr int BM = 256, BK = 64, HALF = 128, HTB = HALF * BK * 2  , STAGE_BYTES = 8 * HTB, NXCD = 8, WGM = 4;

__host__ __device__ __forceinline__ int lds_byte(int r, int c) { const int st = (r >> 4) * 2 + (c >> 5), rr = r & 15, cc = c & 31, ob = rr * 64 + cc * 2; return st * 1024 + (ob ^ (((ob >> 9) & 1) << 5)); }
__host__ __device__ __forceinline__ void stage_rc(int b, int& R, int& C) { const int st = b / 1024, sb = b % 1024, swz = sb ^ (((sb >> 9) & 1) << 5); R = (st >> 1) * 16 + swz / 64; C = (st & 1) * 32 + (swz % 64) / 2; }
__host__ __device__ __forceinline__ int perm32(int rho) { const int n = rho >> 4, i = rho & 15; return 8 * (i >> 2) + 4 * n + (i & 3); }

struct Unit { int pm, pn, half; };
struct Gemm { const bf16_t* A; const bf16_t* Bt; int M, N, K; const bf16_t* A2; const bf16_t* Bt2; };

struct StaticOrder {
    int nM, nN, nwg, G, c, wgm;
    __host__ __device__ void init(int M, int N, int G_, int c_, int wgm_ = WGM) { nM = M / BM; nN = N / BM; nwg = nM * nN; G = G_; c = c_; wgm = wgm_; }
    __host__ __device__ __forceinline__ bool next(int i, Unit& u) const {
        const long L = (long)i * G + c; if (L >= nwg) return false;
        int wgid = (int)L; { const int q = nwg / NXCD, r = nwg % NXCD, xcd = wgid % NXCD, off = wgid / NXCD; wgid = (xcd < r ? xcd * (q + 1) : r * (q + 1) + (xcd - r) * q) + off; }
        const int nig = wgm * nN, gid = wgid / nig, fm = gid * wgm, gsz = (nM - fm) < wgm ? (nM - fm) : wgm;
        u.pm = fm + ((wgid % nig) % gsz); u.pn = (wgid % nig) / gsz; u.half = 0; return true;
    }
    __device__ __forceinline__ void a_ready(const Unit&) const {}
    __device__ __forceinline__ void done(const Unit&) const {}
};
struct DualOrder {
    StaticOrder so; int G, c;
    __host__ __device__ void init(int M, int N, int G_, int c_, int wgm_ = WGM) { so.init(M, N, 1, 0, wgm_); G = G_; c = c_; }
    __host__ __device__ bool next(int i, Unit& u) const { StaticOrder t = so; t.G = G; t.c = c; if (!t.next(i >> 1, u)) return false; u.half = i & 1; return true; }
    __device__ __forceinline__ void a_ready(const Unit&) const {}
    __device__ __forceinline__ void done(const Unit&) const {}
};
__device__ __forceinline__ int lane_id_fresh() { int l; asm volatile("v_mbcnt_lo_u32_b32 %0, -1, 0\n\tv_mbcnt_hi_u32_b32 %0, -1, %0" : "=v"(l)); return l; }
__device__ __forceinline__ int lane_id_now() { return (int)__builtin_amdgcn_mbcnt_hi(~0u, __builtin_amdgcn_mbcnt_lo(~0u, 0u)); }
struct TableOrder {
    PG8_LAS int* tab; int n;
    template <class Base> __device__ __forceinline__ void fill(const Base& B, PG8_LAS int* t, const int i) {
        tab = t;
        if (i < 64) {
            Unit u; u.pm = 0; u.pn = 0; u.half = 0; const bool ok = (i < 32) && B.next(i, u);
            if (i < 32) { tab[4 * i] = ok ? u.pm : -1; tab[4 * i + 1] = u.pn; tab[4 * i + 2] = u.half; }
            const unsigned long long m = __ballot(ok);
            if (i == 0) tab[3] = __builtin_popcountll(m);
        }
        __syncthreads();
        n = __builtin_amdgcn_readfirstlane(tab[3]);
    }
    template <class Base> static __device__ __forceinline__ void fill_wave(const Base& B, PG8_LAS int* t) {
        const int i = lane_id_fresh();
        Unit u; u.pm = 0; u.pn = 0; u.half = 0; const bool ok = (i < 32) && B.next(i, u);
        if (i < 32) { t[4 * i] = ok ? u.pm : -1; t[4 * i + 1] = u.pn; t[4 * i + 2] = u.half; }
        const unsigned long long m = __ballot(ok);
        if (i == 0) t[3] = __builtin_popcountll(m);
    }
    __device__ __forceinline__ void attach(PG8_LAS int* t) { tab = t; n = __builtin_amdgcn_readfirstlane(t[3]); }
    __device__ __forceinline__ bool next(int i, Unit& u) const { if (i >= n) return false; u.pm = __builtin_amdgcn_readfirstlane(tab[4 * i]); u.pn = __builtin_amdgcn_readfirstlane(tab[4 * i + 1]); u.half = __builtin_amdgcn_readfirstlane(tab[4 * i + 2]); return true; }
    __device__ __forceinline__ void a_ready(const Unit&) const {}
    __device__ __forceinline__ void done(const Unit&) const {}
};
__device__ __forceinline__ unsigned cvt_pk_bf16(float lo, float hi) { unsigned r; asm volatile("v_cvt_pk_bf16_f32 %0, %1, %2" : "=v"(r) : "v"(lo), "v"(hi)); return r; }
typedef float f32x2 __attribute__((ext_vector_type(2)));
template <class T> __device__ __forceinline__ T* at_byte(T* base, unsigned byteoff) { return (T*)((char*)base + byteoff); }
__device__ __forceinline__ float bf2f(unsigned short h) { return __builtin_bit_cast(float, (unsigned)h << 16); }
__device__ __forceinline__ float bflo(unsigned w) { return __builtin_bit_cast(float, w << 16); }
__device__ __forceinline__ float bfhi(unsigned w) { return __builtin_bit_cast(float, w & 0xffff0000u); }
__device__ __forceinline__ float fast_sigmoid(float x) { return __builtin_amdgcn_rcpf(1.0f + __builtin_amdgcn_exp2f(-1.4426950408889634f * x)); }
__device__ __forceinline__ float gelu_tanh(float x) { const float z = 0.7978845608028654f * (x + 0.044715f * x * x * x); return x * fast_sigmoid(2.0f * z); }

__device__ __forceinline__ f32x4 sigmoid4(f32x4 x) { f32x4 e = x * (-1.4426950408889634f);
#pragma unroll
    for (int j = 0; j < 4; ++j) e[j] = __builtin_amdgcn_exp2f(e[j]);
    e = e + 1.0f;
#pragma unroll
    for (int j = 0; j < 4; ++j) e[j] = __builtin_amdgcn_rcpf(e[j]);
    return e; }
__device__ __forceinline__ f32x4 gelu_tanh4(f32x4 c) { f32x4 e = (c * c * 0.044715f + 1.0f) * c * (-2.0f * 1.4426950408889634f * 0.7978845608028654f);
#pragma unroll
    for (int j = 0; j < 4; ++j) e[j] = __builtin_amdgcn_exp2f(e[j]);
    e = e + 1.0f;
#pragma unroll
    for (int j = 0; j < 4; ++j) e[j] = __builtin_amdgcn_rcpf(e[j]);
    return c * e; }
__device__ __forceinline__ unsigned q8x4(f32x4 s) {
    const f32x4 t = s * 255.0f + 8388608.0f;
    const unsigned b0 = __builtin_bit_cast(unsigned, fmaxf(t[0], 8388609.0f)), b1 = __builtin_bit_cast(unsigned, fmaxf(t[1], 8388609.0f)), b2 = __builtin_bit_cast(unsigned, fmaxf(t[2], 8388609.0f)), b3 = __builtin_bit_cast(unsigned, fmaxf(t[3], 8388609.0f));
    const unsigned p01 = __builtin_amdgcn_perm(b1, b0, 0x0c0c0400u), p23 = __builtin_amdgcn_perm(b3, b2, 0x0c0c0400u);
    return __builtin_amdgcn_perm(p23, p01, 0x05040100u);
}
__device__ __forceinline__ f32x4 ub4(unsigned w) { return (f32x4){(float)(w & 0xffu), (float)((w >> 8) & 0xffu), (float)((w >> 16) & 0xffu), (float)(w >> 24)}; }
__device__ __forceinline__ f32x4 rcp4(f32x4 v) { return (f32x4){__builtin_amdgcn_rcpf(v[0]), __builtin_amdgcn_rcpf(v[1]), __builtin_amdgcn_rcpf(v[2]), __builtin_amdgcn_rcpf(v[3])}; }
struct EpiG1 {
    static constexpr bool PERM = true, AFTER_DRAIN = false, DUAL = false;
    unsigned char* ws; unsigned char* ob; const float* qg; const float* kg; PG8_LAS float* px; float qscale; int variant;
    __device__ __forceinline__ void operator()(f32x4 (&acc)[2][2][4][2], const Unit& u, int wr, int wc, int fr, int fq) const {
        { const int ln = lane_id_fresh(); fr = ln & 15; fq = ln >> 4; }
        const int seg = u.pn >> 2;
        if (variant == 1) {
#pragma unroll
            for (int ai = 0; ai < 2; ++ai)
#pragma unroll
                for (int bj = 0; bj < 2; ++bj)
#pragma unroll
                    for (int m = 0; m < 4; ++m)
#pragma unroll
                        for (int n = 0; n < 2; ++n) asm volatile("" :: "v"(acc[ai][bj][m][n]));
            return; }
        if (variant == 7 || variant == 8) {
            bf16_t* dummy = (bf16_t*)(ws + WS_XR) + (size_t)64 * 1024 * 1024;
            const int r8 = (variant == 8) ? (fr & 7) : fr, cx = (variant == 8) ? ((fr >> 3) * 32) : 0;
#pragma unroll
            for (int ai = 0; ai < 2; ++ai)
#pragma unroll
                for (int m = 0; m < 4; ++m)
#pragma unroll
                    for (int bj = 0; bj < 2; ++bj) { const f32x4 v0 = acc[ai][bj][m][0], v1 = acc[ai][bj][m][1];
                        u32x4 w; w.x = cvt_pk_bf16(v0[0], v0[1]); w.y = cvt_pk_bf16(v0[2], v0[3]); w.z = cvt_pk_bf16(v1[0], v1[1]); w.w = cvt_pk_bf16(v1[2], v1[3]);
                        const int rr = (variant == 8) ? (u.pm * BM + wr * 64 + ai * HALF + m * 16 + r8 + 8 * bj) : (u.pm * BM + wr * 64 + ai * HALF + m * 16 + fr);
                        const int cc = (variant == 8) ? ((u.pn & 3) * BM + wc * 64 + cx + 8 * fq) : ((u.pn & 3) * BM + wc * 32 + 8 * fq + bj * HALF);
                        *(u32x4*)(dummy + (size_t)rr * 1024 + cc) = w; }
            return; }
        bf16_t* base = (bf16_t*)(seg >= 5 ? ob + (size_t)(seg - 5) * (32 * MiB) : ws + (seg == 0 ? WS_XR : seg == 1 ? WS_GR : seg == 2 ? WS_Q : seg == 3 ? WS_K : WS_V)); float* km = (float*)(ws + WS_KM);
        const int row0 = u.pm * BM + wr * 64 + fr, col0 = (u.pn & 3) * BM + wc * 32 + 8 * fq;
        if (seg == 2 || seg == 3) {
            float rs[2][4][2];
            const float* gp = (seg == 2 ? qg : kg) + wc * 32 + 8 * fq; const float gs = (seg == 2) ? qscale : 1.0f;
            const f32x4 g0r = *(const f32x4*)gp, g1r = *(const f32x4*)(gp + 4);
#pragma unroll
            for (int ai = 0; ai < 2; ++ai)
#pragma unroll
                for (int m = 0; m < 4; ++m)
#pragma unroll
                    for (int bj = 0; bj < 2; ++bj) { const f32x4 a0 = acc[ai][bj][m][0], a1 = acc[ai][bj][m][1];
                        float ss = (a0[0] * a0[0] + a0[1] * a0[1]) + (a0[2] * a0[2] + a0[3] * a0[3]) + (a1[0] * a1[0] + a1[1] * a1[1]) + (a1[2] * a1[2] + a1[3] * a1[3]);
                        ss += __shfl_xor(ss, 16); ss += __shfl_xor(ss, 32);
                        if (fq == 0) px[(ai * HALF + wr * 64 + m * 16 + fr) * 8 + bj * 4 + wc] = ss; }
            asm volatile("s_waitcnt lgkmcnt(0)" ::: "memory"); __builtin_amdgcn_s_barrier(); asm volatile("" ::: "memory");
#pragma unroll
            for (int ai = 0; ai < 2; ++ai)
#pragma unroll
                for (int m = 0; m < 4; ++m)
#pragma unroll
                    for (int bj = 0; bj < 2; ++bj) { const f32x4 p = *(const PG8_LAS f32x4*)(px + (ai * HALF + wr * 64 + m * 16 + fr) * 8 + bj * 4);
                        rs[ai][m][bj] = __builtin_amdgcn_rsqf(((p[0] + p[1]) + (p[2] + p[3])) * (1.0f / 128.0f) + 1e-6f); }
            const f32x4 g0 = g0r * gs, g1 = g1r * gs;
            f32x4 cs[2][2];
#pragma unroll
            for (int bj = 0; bj < 2; ++bj) { cs[bj][0] = (f32x4){0.f, 0.f, 0.f, 0.f}; cs[bj][1] = (f32x4){0.f, 0.f, 0.f, 0.f}; }
#pragma unroll
            for (int ai = 0; ai < 2; ++ai)
#pragma unroll
                for (int m = 0; m < 4; ++m) { bf16_t* rowp = base + (size_t)(row0 + ai * HALF + m * 16) * 1024 + col0;
#pragma unroll
                    for (int bj = 0; bj < 2; ++bj) { const f32x4 v0 = acc[ai][bj][m][0] * rs[ai][m][bj] * g0, v1 = acc[ai][bj][m][1] * rs[ai][m][bj] * g1;
                        cs[bj][0] += v0; cs[bj][1] += v1;
                        u32x4 w; w.x = cvt_pk_bf16(v0[0], v0[1]); w.y = cvt_pk_bf16(v0[2], v0[3]); w.z = cvt_pk_bf16(v1[0], v1[1]); w.w = cvt_pk_bf16(v1[2], v1[3]);
                        if (variant) asm volatile("" :: "v"(w)); else __builtin_nontemporal_store(w, (u32x4*)(rowp + bj * HALF)); }
                    asm volatile("" : "+v"(cs[0][0]), "+v"(cs[0][1]), "+v"(cs[1][0]), "+v"(cs[1][1]) :: "memory"); }
            if (seg == 3 && !variant) {
                PG8_LAS float* kx = px + 2304;
#pragma unroll
                for (int bj = 0; bj < 2; ++bj)
#pragma unroll
                    for (int n = 0; n < 2; ++n)
#pragma unroll
                        for (int j = 0; j < 4; ++j) { float c = cs[bj][n][j]; c += __shfl_xor(c, 1); c += __shfl_xor(c, 2); c += __shfl_xor(c, 4); c += __shfl_xor(c, 8);
                            if (fr == 0) kx[wr * 256 + bj * 128 + wc * 32 + 8 * fq + 4 * n + j] = c; }
                asm volatile("s_waitcnt lgkmcnt(0)" ::: "memory"); __builtin_amdgcn_s_barrier(); asm volatile("" ::: "memory");
                const int t = (wr * 4 + wc) * 64 + fq * 16 + fr;
                if (t < 256) km[((size_t)u.pm * 8 + 2 * (u.pn & 3) + (t >> 7)) * 128 + (t & 127)] = (kx[t] + kx[256 + t]) * (1.0f / 256.0f);
            }
            return;
        }
        if (seg >= 5) {
            unsigned char* g8 = (unsigned char*)base + ((size_t)(u.pm * 4 + (u.pn & 3)) << 16) + (unsigned)((wr * 4 + wc) * 8192 + (fq * 16 + fr) * 16);
#pragma unroll
            for (int ai = 0; ai < 2; ++ai)
#pragma unroll
                for (int m = 0; m < 4; ++m) { u32x4 w;
                    w.x = q8x4(sigmoid4(acc[ai][0][m][0])); w.y = q8x4(sigmoid4(acc[ai][0][m][1])); w.z = q8x4(sigmoid4(acc[ai][1][m][0])); w.w = q8x4(sigmoid4(acc[ai][1][m][1]));
                    if (variant) asm volatile("" :: "v"(w)); else __builtin_nontemporal_store(w, (u32x4*)(g8 + (ai * 4 + m) * 1024)); }
            return;
        }
#pragma unroll
        for (int ai = 0; ai < 2; ++ai)
#pragma unroll
            for (int m = 0; m < 4; ++m) { bf16_t* rowp = base + (size_t)(row0 + ai * HALF + m * 16) * 1024 + col0;
#pragma unroll
                for (int bj = 0; bj < 2; ++bj) { f32x4 v0 = acc[ai][bj][m][0], v1 = acc[ai][bj][m][1];
                    if (seg == 1) { v0 = gelu_tanh4(v0); v1 = gelu_tanh4(v1); }
                    u32x4 w; w.x = cvt_pk_bf16(v0[0], v0[1]); w.y = cvt_pk_bf16(v0[2], v0[3]); w.z = cvt_pk_bf16(v1[0], v1[1]); w.w = cvt_pk_bf16(v1[2], v1[3]);
                    if (variant) asm volatile("" :: "v"(w)); else __builtin_nontemporal_store(w, (u32x4*)(rowp + bj * HALF)); } }
    }
};
struct EpiG3 {
    static constexpr bool PERM = true, AFTER_DRAIN = false, DUAL = true;
    unsigned char* ws; const unsigned char* ob;
    struct Carry { u32x4 wb[2][4]; };
    __device__ __forceinline__ void mid(f32x4 (&acc)[2][2][4][2], const Unit& u, int wr, int wc, int fr, int fq, Carry& cy) const {
        const unsigned char* ga = ob; const unsigned char* gb = ob + 32 * MiB;
        const unsigned go = (unsigned)((u.pm * 4 + u.pn) << 16) + (unsigned)((wr * 4 + wc) * 8192 + (fq * 16 + fr) * 16);
        u32x4 wa[2][4];
#pragma unroll
        for (int ai = 0; ai < 2; ++ai)
#pragma unroll
            for (int m = 0; m < 4; ++m) { wa[ai][m] = *(const u32x4*)at_byte(ga, go + (unsigned)((ai * 4 + m) * 1024)); cy.wb[ai][m] = *(const u32x4*)at_byte(gb, go + (unsigned)((ai * 4 + m) * 1024)); }
#pragma unroll
        for (int ai = 0; ai < 2; ++ai)
#pragma unroll
            for (int m = 0; m < 4; ++m) { const u32x4 a = wa[ai][m], b = cy.wb[ai][m];
                acc[ai][0][m][0] *= ub4(a.x) * rcp4(ub4(b.x)); acc[ai][0][m][1] *= ub4(a.y) * rcp4(ub4(b.y));
                acc[ai][1][m][0] *= ub4(a.z) * rcp4(ub4(b.z)); acc[ai][1][m][1] *= ub4(a.w) * rcp4(ub4(b.w)); }
    }
    __device__ __forceinline__ void operator()(f32x4 (&acc)[2][2][4][2], const Unit& u, int wr, int wc, int fr, int fq, const Carry& cy) const {
        bf16_t* out = (bf16_t*)(ws + WS_K);
        const int row0 = u.pm * BM + wr * 64 + fr, col0 = u.pn * BM + wc * 32 + 8 * fq;
#pragma unroll
        for (int ai = 0; ai < 2; ++ai)
#pragma unroll
            for (int m = 0; m < 4; ++m)
#pragma unroll
                for (int bj = 0; bj < 2; ++bj) { const u32x4 b = cy.wb[ai][m]; const f32x4 v0 = acc[ai][bj][m][0] * (ub4(bj ? b.z : b.x) * (1.0f / 255.0f)), v1 = acc[ai][bj][m][1] * (ub4(bj ? b.w : b.y) * (1.0f / 255.0f));
                    u32x4 w; w.x = cvt_pk_bf16(v0[0], v0[1]); w.y = cvt_pk_bf16(v0[2], v0[3]); w.z = cvt_pk_bf16(v1[0], v1[1]); w.w = cvt_pk_bf16(v1[2], v1[3]);
                    *(u32x4*)(out + (size_t)(row0 + ai * HALF + m * 16) * 1024 + col0 + bj * HALF) = w; }
    }
};
struct EpiX1 {
    static constexpr bool PERM = true, AFTER_DRAIN = false, DUAL = false;
    unsigned char* ws; PG8_LAS float* px;
    __device__ __forceinline__ void operator()(f32x4 (&acc)[2][2][4][2], const Unit& u, int wr, int wc, int fr, int fq) const {
        { const int ln = lane_id_fresh(); fr = ln & 15; fq = ln >> 4; }
        const bf16_t* xn = (const bf16_t*)(ws + WS_XN); bf16_t* xb = (bf16_t*)(ws + WS_XN); const float* rs0 = (const float*)(ws + WS_RS0); float* rsp = (float*)(ws + WS_RSP);
        const unsigned e0 = (unsigned)(u.pm * BM + wr * 64 + fr) * 1024u + (unsigned)(u.pn * BM + wc * 32 + 8 * fq);
        u32x4 b[2][4][2]; float ivl[2];
#pragma unroll
        for (int ai = 0; ai < 2; ++ai) { ivl[ai] = rs0[u.pm * BM + wr * 64 + ai * HALF + fq * 16 + fr];
#pragma unroll
            for (int m = 0; m < 4; ++m)
#pragma unroll
                for (int bj = 0; bj < 2; ++bj) b[ai][m][bj] = __builtin_nontemporal_load((const u32x4*)at_byte(xn, (e0 + (unsigned)((ai * HALF + m * 16) * 1024 + bj * HALF)) * 2u)); }
        asm volatile("" ::: "memory");
#pragma unroll
        for (int ai = 0; ai < 2; ++ai) {
            {   float iv[4];
#pragma unroll
                for (int m = 0; m < 4; ++m) iv[m] = __shfl(ivl[ai], 16 * m + fr);
#pragma unroll
                for (int m = 0; m < 4; ++m)
#pragma unroll
                    for (int bj = 0; bj < 2; ++bj) { const u32x4 w = b[ai][m][bj];
                        acc[ai][bj][m][0] += (f32x4){bflo(w.x), bfhi(w.x), bflo(w.y), bfhi(w.y)} * iv[m]; acc[ai][bj][m][1] += (f32x4){bflo(w.z), bfhi(w.z), bflo(w.w), bfhi(w.w)} * iv[m]; }
                asm volatile("" ::: "memory");
            }
#pragma unroll
            for (int m = 0; m < 4; ++m) { f32x4 s4 = {0.f, 0.f, 0.f, 0.f};
#pragma unroll
                for (int bj = 0; bj < 2; ++bj)
#pragma unroll
                    for (int n = 0; n < 2; ++n) { const f32x4 v = acc[ai][bj][m][n]; s4 += v * v; }
                float ss = (s4[0] + s4[1]) + (s4[2] + s4[3]);
                ss += __shfl_xor(ss, 16); ss += __shfl_xor(ss, 32);
                if (fq == 0) px[(ai * HALF + wr * 64 + m * 16 + fr) * 4 + wc] = ss; }
#pragma unroll
            for (int m = 0; m < 4; ++m)
#pragma unroll
                for (int bj = 0; bj < 2; ++bj) { const unsigned eo = e0 + (unsigned)((ai * HALF + m * 16) * 1024 + bj * HALF); const f32x4 v0 = acc[ai][bj][m][0], v1 = acc[ai][bj][m][1];
                    u32x4 w; w.x = cvt_pk_bf16(v0[0], v0[1]); w.y = cvt_pk_bf16(v0[2], v0[3]); w.z = cvt_pk_bf16(v1[0], v1[1]); w.w = cvt_pk_bf16(v1[2], v1[3]); *(u32x4*)at_byte(xb, eo * 2u) = w; }
            asm volatile("" ::: "memory");
        }
        asm volatile("s_waitcnt lgkmcnt(0)" ::: "memory"); __builtin_amdgcn_s_barrier(); asm volatile("" ::: "memory");
        const int t = (wr * 4 + wc) * 64 + fq * 16 + fr;
        if (t < 256) { const f32x4 p = *(const PG8_LAS f32x4*)(px + t * 4); rsp[((size_t)u.pm * BM + t) * 4 + u.pn] = (p[0] + p[1]) + (p[2] + p[3]); }
    }
};
struct EpiOut {
    static constexpr bool PERM = true, AFTER_DRAIN = false, DUAL = false;
    unsigned char* ws; float* out;
    __device__ __forceinline__ void operator()(f32x4 (&acc)[2][2][4][2], const Unit& u, int wr, int wc, int fr, int fq) const {
        const bf16_t* xb = (const bf16_t*)(ws + WS_XN);
        const unsigned e0 = (unsigned)(u.pm * BM + wr * 64 + fr) * 1024u + (unsigned)(u.pn * BM + wc * 32 + 8 * fq);
        u32x4 r[2][4][2];
#pragma unroll
        for (int ai = 0; ai < 2; ++ai)
#pragma unroll
            for (int m = 0; m < 4; ++m)
#pragma unroll
                for (int bj = 0; bj < 2; ++bj) r[ai][m][bj] = *(const u32x4*)at_byte(xb, (e0 + (unsigned)((ai * HALF + m * 16) * 1024 + bj * HALF)) * 2u);
        asm volatile("" ::: "memory");
#pragma unroll
        for (int ai = 0; ai < 2; ++ai)
#pragma unroll
            for (int m = 0; m < 4; ++m)
#pragma unroll
                for (int bj = 0; bj < 2; ++bj) { const u32x4 w = r[ai][m][bj]; const unsigned eo = e0 + (unsigned)((ai * HALF + m * 16) * 1024 + bj * HALF);
                    const f32x4 v0 = acc[ai][bj][m][0] + (f32x4){bflo(w.x), bfhi(w.x), bflo(w.y), bfhi(w.y)}, v1 = acc[ai][bj][m][1] + (f32x4){bflo(w.z), bfhi(w.z), bflo(w.w), bfhi(w.w)};
                    float* po = at_byte(out, eo * 4u); __builtin_nontemporal_store(v0, (f32x4*)po); __builtin_nontemporal_store(v1, (f32x4*)(po + 4)); }
    }
};
template <int CTRL> __device__ __forceinline__ float dpp_mov(float old, float src) { return __builtin_bit_cast(float, __builtin_amdgcn_update_dpp(__builtin_bit_cast(int, old), __builtin_bit_cast(int, src), CTRL, 0xf, 0xf, false)); }
struct EpiUGF {
    static constexpr bool PERM = true, AFTER_DRAIN = false, DUAL = false;
    struct Pre { f32x4 rq[2]; float tap; };
    __device__ __forceinline__ void prefetch(const Unit& u, Pre& pr, int wr, int wc, int fr, int fq) const {
        const float* rsp = (const float*)(ws + WS_RSP);
#pragma unroll
        for (int ai = 0; ai < 2; ++ai) pr.rq[ai] = *(const f32x4*)at_byte(rsp, (unsigned)(u.pm * BM + ai * HALF + wr * 64 + fq * 16 + fr) * 16u);
        const int t = (wr * 4 + wc) * 64 + fq * 16 + fr, r4 = t >> 7, c = t & 127;
        pr.tap = (r4 < 3) ? cw[r4 * 2816 + u.pn * HALF + c] : cb[u.pn * HALF + c];
    }
    unsigned char* ws; const float* cw; const float* cb; PG8_LAS float* halo; int variant;
    __device__ __forceinline__ void operator()(f32x4 (&acc)[2][2][4][2], const Unit& u, int wr, int wc, int fr, int fq, const Pre& pr) const {
        bf16_t* act = (bf16_t*)(ws + WS_ACT); float* sb_last = (float*)(ws + WS_SB); float* su0 = (float*)(ws + WS_SU0); float* sg0 = (float*)(ws + WS_SG0); const float* rsp = (const float*)(ws + WS_RSP);
        const int colh = wc * 32 + 8 * fq, gcol = u.pn * HALF + colh;
        if (variant == 1) {
#pragma unroll
            for (int ai = 0; ai < 2; ++ai)
#pragma unroll
                for (int bj = 0; bj < 2; ++bj)
#pragma unroll
                    for (int m = 0; m < 4; ++m)
#pragma unroll
                        for (int n = 0; n < 2; ++n) asm volatile("" :: "v"(acc[ai][bj][m][n]));
            return; }
        {
            { const int t = (wr * 4 + wc) * 64 + fq * 16 + fr, r4 = t >> 7, c = t & 127;
              halo[1024 + t] = pr.tap; }
#pragma unroll
            for (int ai = 0; ai < 2; ++ai) { const f32x4 p = pr.rq[ai]; const float rl = __builtin_amdgcn_rsqf(((p[0] + p[1]) + (p[2] + p[3])) * (1.0f / 1024.0f) + 1e-6f);
#pragma unroll
                for (int m = 0; m < 4; ++m) { const float rstd = __shfl(rl, 16 * m + fr);
#pragma unroll
                    for (int bj = 0; bj < 2; ++bj) { acc[ai][bj][m][0] *= rstd; acc[ai][bj][m][1] *= rstd; } } }
        }
        asm volatile("" ::: "memory");
        if (fr >= 14) {
#pragma unroll
            for (int ai = 0; ai < 2; ++ai)
#pragma unroll
                for (int n = 0; n < 2; ++n) *(PG8_LAS f32x4*)(halo + ((2 * ai + wr) * 2 + (fr - 14)) * 128 + colh + 4 * n) = acc[ai][0][3][n];
            if (wr == 1) {
#pragma unroll
                for (int n = 0; n < 2; ++n) *(f32x4*)(sb_last + ((size_t)u.pm * 2 + (fr - 14)) * 2816 + gcol + 4 * n) = acc[1][0][3][n];
            }
        }
        asm volatile("s_waitcnt lgkmcnt(0)" ::: "memory"); __builtin_amdgcn_s_barrier(); asm volatile("" ::: "memory");
        f32x4 tw0[2], tw1[2], tw2[2], tbb[2];
#pragma unroll
        for (int n = 0; n < 2; ++n) { tw0[n] = *(const PG8_LAS f32x4*)(halo + 1024 + colh + 4 * n); tw1[n] = *(const PG8_LAS f32x4*)(halo + 1024 + 128 + colh + 4 * n); tw2[n] = *(const PG8_LAS f32x4*)(halo + 1024 + 256 + colh + 4 * n); tbb[n] = *(const PG8_LAS f32x4*)(halo + 1024 + 384 + colh + 4 * n); }
#pragma unroll
        for (int ai = 0; ai < 2; ++ai) {
            const int seg = 2 * ai + wr;
            f32x4 prev[2];
#pragma unroll
            for (int n = 0; n < 2; ++n) prev[n] = *(const PG8_LAS f32x4*)(halo + (((seg > 0 ? seg - 1 : 0)) * 2 + (fr & 1)) * 128 + colh + 4 * n);
#pragma unroll
            for (int m = 0; m < 4; ++m) {
                float r[8];
#pragma unroll
                for (int n = 0; n < 2; ++n) { const f32x4 cur = acc[ai][0][m][n], gt = acc[ai][1][m][n];
                    const f32x4 w0 = tw0[n], w1 = tw1[n], w2 = tw2[n], bb = tbb[n];
                    f32x4 v1, v2;
#pragma unroll
                    for (int j = 0; j < 4; ++j) {
                        const float t1 = dpp_mov<0x121>(prev[n][j], prev[n][j]); v1[j] = dpp_mov<0x111>(t1, cur[j]);
                        const float t2 = dpp_mov<0x122>(prev[n][j], prev[n][j]); v2[j] = dpp_mov<0x112>(t2, cur[j]); }
                    const f32x4 c = bb + w2 * cur + w1 * v1 + w0 * v2;
                    f32x4 ez = (c * c * 0.044715f + 1.0f) * c * (-2.0f * 1.4426950408889634f * 0.7978845608028654f);
#pragma unroll
                    for (int j = 0; j < 4; ++j) ez[j] = __builtin_amdgcn_exp2f(ez[j]);
                    ez = ez + 1.0f;
#pragma unroll
                    for (int j = 0; j < 4; ++j) ez[j] = __builtin_amdgcn_rcpf(ez[j]);
                    const f32x4 o = c * gt * ez;
                    r[4 * n] = o[0]; r[4 * n + 1] = o[1]; r[4 * n + 2] = o[2]; r[4 * n + 3] = o[3];
                    prev[n] = cur; }
                const unsigned row = (unsigned)(u.pm * BM + ai * HALF + wr * 64 + m * 16 + fr);
                const bool head = (seg == 0) && (m == 0) && (fr < 2);
                if (!head) { u32x4 w; w.x = cvt_pk_bf16(r[0], r[1]); w.y = cvt_pk_bf16(r[2], r[3]); w.z = cvt_pk_bf16(r[4], r[5]); w.w = cvt_pk_bf16(r[6], r[7]);
                    if (variant == 2) asm volatile("" :: "v"(w)); else *(u32x4*)at_byte(act, (row * 2816u + (unsigned)gcol) * 2u) = w; }
                else {
#pragma unroll
                    for (int n = 0; n < 2; ++n) { *(f32x4*)(su0 + ((size_t)u.pm * 2 + fr) * 2816 + gcol + 4 * n) = acc[0][0][0][n]; *(f32x4*)(sg0 + ((size_t)u.pm * 2 + fr) * 2816 + gcol + 4 * n) = acc[0][1][0][n]; }
                }
            }
        }
    }
};
template <class E, bool D> struct CarryOf { struct type {}; };
template <class E, class = void> struct PreOf { struct type {}; static constexpr bool HAS = false; };
template <class E> struct PreOf<E, decltype((void)sizeof(typename E::Pre))> { using type = typename E::Pre; static constexpr bool HAS = true; };
template <class E> struct CarryOf<E, true> { using type = typename E::Carry; };
template <class Epi, class Sched, bool ALIGN_EPI = false, bool SP2 = false>
__device__ __forceinline__ void gemm_phase(PG8_LAS unsigned char* lds, const Gemm g, const Sched& S, const Epi& E, const int wid) {
    const int lane = lane_id_now(), tid = wid * 64 + lane, wr = wid >> 2, wc = wid & 3, fr = lane & 15, fq = lane >> 4;
    const int K = g.K, nt = K / BK;
    unsigned voffA[2], voffB[2];
#pragma unroll
    for (int i = 0; i < 2; ++i) { int R, C; stage_rc(tid * 16 + i * 8192, R, C); const int Rb = Epi::PERM ? ((R & ~31) + perm32(R & 31)) : R;
        voffA[i] = (unsigned)(R * K + C) * 2u; voffB[i] = (unsigned)(Rb * K + C) * 2u; }
    const size_t kstep = (size_t)(BK * 2);
    const size_t hstep = (size_t)HALF * K * 2;
    const size_t tstep = 2 * hstep;
    const unsigned ldsw = (unsigned)wid * 1024u;
    const int aoff = lds_byte(wr * 64 + fr, fq * 8), boff = lds_byte(wc * 32 + fr, fq * 8);
#define PG8_SA(b, h) (((b) * 2 + (h)) * HTB)
#define PG8_SB(b, h) ((4 + (b) * 2 + (h)) * HTB)
#ifndef PG8_AUX_B
#define PG8_AUX_B 0
#endif
#define PG8_STAGE(bufoff, gbase, voff) do { _Pragma("unroll") for (int _i = 0; _i < 2; ++_i) \
        __builtin_amdgcn_global_load_lds((const unsigned*)((const char*)(gbase) + (voff)[_i]), (PG8_LAS unsigned*)(lds + (bufoff) + ldsw + _i * 8192), 16, 0, (((bufoff) >= 4 * HTB) ? PG8_AUX_B : 0)); } while (0)
#define PG8_LDA(dst, b, h) do { _Pragma("unroll") for (int m = 0; m < 4; ++m) _Pragma("unroll") for (int k = 0; k < 2; ++k) dst[m][k] = *(const PG8_LAS bf16x8*)(lds + PG8_SA(b, h) + aoff + m * 2048 + k * 1024); } while (0)
#define PG8_LDB(dst, b, h) do { _Pragma("unroll") for (int n = 0; n < 2; ++n) _Pragma("unroll") for (int k = 0; k < 2; ++k) dst[n][k] = *(const PG8_LAS bf16x8*)(lds + PG8_SB(b, h) + boff + n * 2048 + k * 1024); } while (0)
#define PG8_MMA(ai, bj, At, Bt) do { __builtin_amdgcn_s_setprio(1); _Pragma("unroll") for (int m = 0; m < 4; ++m) _Pragma("unroll") for (int n = 0; n < 2; ++n) _Pragma("unroll") for (int k = 0; k < 2; ++k) \
        acc[ai][bj][m][n] = __builtin_amdgcn_mfma_f32_16x16x32_bf16(Bt[n][k], At[m][k], acc[ai][bj][m][n], 0, 0, 0); __builtin_amdgcn_s_setprio(0); } while (0)
#define PG8_WAIT_V(n) asm volatile("s_waitcnt vmcnt(" #n ")" ::: "memory")
#define PG8_WAIT_L(n) asm volatile("s_waitcnt lgkmcnt(" #n ")" ::: "memory")
#define PG8_BAR __builtin_amdgcn_s_barrier()
#define PG8_SCHED __builtin_amdgcn_sched_barrier(0)
    Unit cur, nxt; int ui = 0;
    if (!S.next(0, cur)) return;
    f32x4 acc[2][2][4][2];
#pragma unroll
    for (int a = 0; a < 2; ++a)
#pragma unroll
        for (int b = 0; b < 2; ++b)
#pragma unroll
            for (int m = 0; m < 4; ++m)
#pragma unroll
                for (int n = 0; n < 2; ++n) acc[a][b][m][n] = (f32x4){0.f, 0.f, 0.f, 0.f};
    bf16x8 At[4][2], B0[2][2], B1[2][2];
    typename CarryOf<Epi, Epi::DUAL>::type carry;
    typename PreOf<Epi>::type pre;
    const char* cA = (const char*)(cur.half ? g.A2 : g.A) + (size_t)cur.pm * tstep; const char* cB = (const char*)(cur.half ? g.Bt2 : g.Bt) + (size_t)cur.pn * tstep;
    S.a_ready(cur);
    if constexpr (SP2) {
        PG8_STAGE(PG8_SB(0, 0), cB, voffB); PG8_STAGE(PG8_SB(0, 1), cB + hstep, voffB); PG8_STAGE(PG8_SA(0, 0), cA, voffA); PG8_STAGE(PG8_SA(0, 1), cA + hstep, voffA);
        if (wr == 1) PG8_BAR;
        PG8_WAIT_V(2); PG8_BAR;
        PG8_STAGE(PG8_SB(1, 0), cB + kstep, voffB); PG8_STAGE(PG8_SA(1, 0), cA + kstep, voffA); PG8_STAGE(PG8_SB(1, 1), cB + hstep + kstep, voffB);
        PG8_WAIT_V(6); PG8_BAR;
    } else {
        PG8_STAGE(PG8_SB(0, 0), cB, voffB); PG8_STAGE(PG8_SA(0, 0), cA, voffA); PG8_STAGE(PG8_SB(0, 1), cB + hstep, voffB); PG8_STAGE(PG8_SA(0, 1), cA + hstep, voffA);
        if (wr == 1) PG8_BAR;
        PG8_WAIT_V(4); PG8_BAR;
        PG8_STAGE(PG8_SB(1, 0), cB + kstep, voffB); PG8_STAGE(PG8_SA(1, 0), cA + kstep, voffA); PG8_STAGE(PG8_SB(1, 1), cB + hstep + kstep, voffB);
        PG8_WAIT_V(6); PG8_BAR;
    }
    for (;;) {
        const bool has_next = S.next(ui + 1, nxt);
        if constexpr (PreOf<Epi>::HAS) { const int ln1 = lane_id_fresh(); E.prefetch(cur, pre, wr, wc, ln1 & 15, ln1 >> 4); }
        const char* nA = has_next ? (const char*)(nxt.half ? g.A2 : g.A) + (size_t)nxt.pm * tstep : cA; const char* nB = has_next ? (const char*)(nxt.half ? g.Bt2 : g.Bt) + (size_t)nxt.pn * tstep : cB;
        static_assert(SP2, "only the two-super-phase K-loop is kept in this file");
        for (int t = 0; t < nt; t += 2) {
            const bool last = (t == nt - 2);
            const char* a1 = cA + (size_t)(t + 1) * kstep;
            const char* a2 = last ? nA : cA + (size_t)(t + 2) * kstep; const char* b2 = last ? nB : cB + (size_t)(t + 2) * kstep;
            const char* a3 = a2 + kstep; const char* b3 = b2 + kstep;
            if (last && has_next) S.a_ready(nxt);
            PG8_LDB(B0, 0, 0); PG8_LDB(B1, 0, 1); PG8_SCHED; PG8_LDA(At, 0, 0); PG8_STAGE(PG8_SA(1, 1), a1 + hstep, voffA);
            PG8_WAIT_V(8); PG8_WAIT_L(0); PG8_BAR; PG8_MMA(0, 0, At, B0); PG8_MMA(0, 1, At, B1); PG8_BAR; PG8_SCHED;
            PG8_LDA(At, 0, 1); PG8_STAGE(PG8_SB(0, 0), b2, voffB); PG8_STAGE(PG8_SB(0, 1), b2 + hstep, voffB); PG8_STAGE(PG8_SA(0, 0), a2, voffA);
            PG8_WAIT_V(8); PG8_WAIT_L(0); PG8_BAR; PG8_MMA(1, 0, At, B0); PG8_MMA(1, 1, At, B1); PG8_BAR; PG8_SCHED;
            PG8_LDB(B0, 1, 0); PG8_LDB(B1, 1, 1); PG8_SCHED; PG8_LDA(At, 1, 0); PG8_STAGE(PG8_SA(0, 1), a2 + hstep, voffA);
            PG8_WAIT_V(8); PG8_WAIT_L(0); PG8_BAR; PG8_MMA(0, 0, At, B0); PG8_MMA(0, 1, At, B1); PG8_BAR; PG8_SCHED;
            PG8_LDA(At, 1, 1); PG8_STAGE(PG8_SB(1, 0), b3, voffB); PG8_STAGE(PG8_SB(1, 1), b3 + hstep, voffB); PG8_STAGE(PG8_SA(1, 0), a3, voffA);
            PG8_WAIT_V(8); PG8_WAIT_L(0); PG8_BAR; PG8_MMA(1, 0, At, B0); PG8_MMA(1, 1, At, B1); PG8_BAR; PG8_SCHED;
        }
        if constexpr (ALIGN_EPI) { if (wr == 0) PG8_BAR; }
        bool keep_acc = false;
        const int ln2 = lane_id_fresh(); const int fr2 = ln2 & 15, fq2 = ln2 >> 4;
        if constexpr (Epi::DUAL) { if (cur.half == 0) { E.mid(acc, cur, wr, wc, fr2, fq2, carry); keep_acc = true; } }
        if constexpr (!Epi::AFTER_DRAIN) { if (!keep_acc) { if constexpr (Epi::DUAL) E(acc, cur, wr, wc, fr2, fq2, carry); else if constexpr (PreOf<Epi>::HAS) E(acc, cur, wr, wc, fr2, fq2, pre); else E(acc, cur, wr, wc, fr2, fq2); S.done(cur); } }
        if (!has_next) break;
        if (!keep_acc) {
#pragma unroll
        for (int a = 0; a < 2; ++a)
#pragma unroll
            for (int b = 0; b < 2; ++b)
#pragma unroll
                for (int m = 0; m < 4; ++m)
#pragma unroll
                    for (int n = 0; n < 2; ++n) acc[a][b][m][n] = (f32x4){0.f, 0.f, 0.f, 0.f};
        }
        cur = nxt; cA = nA; cB = nB; ++ui;
        if constexpr (ALIGN_EPI) { if (wr == 1) PG8_BAR; }
    }
    PG8_WAIT_V(0);
    if constexpr (!ALIGN_EPI) { if (wr == 0) PG8_BAR; }
    PG8_BAR;
    if constexpr (Epi::AFTER_DRAIN) { E.fused(acc, cur, wr, wc, fr, fq, lds, wid, lane); S.done(cur); }
#undef PG8_SA
#undef PG8_SB
#undef PG8_STAGE
#undef PG8_LDA
#undef PG8_LDB
#undef PG8_MMA
#undef PG8_WAIT_V
#undef PG8_WAIT_L
#undef PG8_BAR
#undef PG8_SCHED
}
}
#define GAS __attribute__((address_space(1)))
#define LAS __attribute__((address_space(3)))
typedef unsigned short bf16;
typedef unsigned v4u __attribute__((ext_vector_type(4)));
typedef float f32x4 __attribute__((ext_vector_type(4)));
typedef short bf16x8 __attribute__((ext_vector_type(8)));
typedef GAS unsigned gu32;
typedef GAS unsigned long long gu64;
#define RLX_AGENT __ATOMIC_RELAXED, __HIP_MEMORY_SCOPE_AGENT
#define LDS_WAIT() asm volatile("s_waitcnt lgkmcnt(0)" ::: "memory")
#define VM_WAIT() asm volatile("s_waitcnt vmcnt(0)" ::: "memory")
__device__ __forceinline__ unsigned long long rt() { return __builtin_amdgcn_s_memrealtime(); }
__device__ __forceinline__ unsigned f2bf(float f) { unsigned u = __builtin_bit_cast(unsigned, f); return (u + 0x7fffu + ((u >> 16) & 1u)) >> 16; }
__device__ __forceinline__ unsigned pk2(float lo, float hi) { return f2bf(lo) | (f2bf(hi) << 16); }

#define XB_TMO      128
#define XB_XCNT(j)  (256  + 64 * (j))
#define XB_XSUB(j)  (1280 + 64 * (j))
#define XB_XGEN(j)  (2304 + 64 * (j))
#define XB_TOP      3328
#define XB_TOPGEN   3392
#define XCD_BAR_WORDS 3456
#define XB_SPIN_CAP (1u << 18)

__device__ __forceinline__ unsigned xb_ld(unsigned* p)              { return __hip_atomic_load(p, __ATOMIC_RELAXED, __HIP_MEMORY_SCOPE_AGENT); }
__device__ __forceinline__ unsigned xb_add(unsigned* p, unsigned v) { return __hip_atomic_fetch_add(p, v, __ATOMIC_RELAXED, __HIP_MEMORY_SCOPE_AGENT); }
__device__ __forceinline__ unsigned xb_xcc_id() { return (unsigned)__builtin_amdgcn_s_getreg((3 << 11) | 20) & 0xFu; }
#define XB_SPIN(cond, bar) do { unsigned _sp = 0; while (cond) { __builtin_amdgcn_s_sleep(1); \
    if ((++_sp & 255u) == 0u) { if (xb_ld(&(bar)[XB_TMO])) break; if (_sp > XB_SPIN_CAP) { atomicAdd(&(bar)[XB_TMO], 1u); break; } } } } while (0)

struct XcdBarrier {
    unsigned* bar; unsigned x;
    volatile LAS unsigned* st;
};

__device__ __forceinline__ XcdBarrier xcd_barrier_post(unsigned* bar, volatile LAS unsigned* st) {
    XcdBarrier b; b.bar = bar; b.x = xb_xcc_id(); b.st = st;
    if (threadIdx.x == 0) (void)xb_add(&bar[XB_XCNT(b.x)], 1u);
    return b;
}
__device__ __forceinline__ void xcd_barrier_complete(unsigned* bar, unsigned x, unsigned& nloc, unsigned& nx) {
    const unsigned G = gridDim.x * gridDim.y * gridDim.z;
    unsigned sum, cnt, mine, sp = 0u;
    for (;;) {
        sum = 0u; cnt = 0u; mine = 0u;
#pragma unroll
        for (unsigned j = 0; j < 16; ++j) { const unsigned c = xb_ld(&bar[XB_XCNT(j)]); sum += c; cnt += (c > 0u) ? 1u : 0u; mine = (j == x) ? c : mine; }
        if (sum == G) break;
        __builtin_amdgcn_s_sleep(1);
        if ((++sp & 255u) == 0u) { if (xb_ld(&bar[XB_TMO])) break; if (sp > XB_SPIN_CAP) { atomicAdd(&bar[XB_TMO], 1u); break; } }
    }
    nloc = mine > 0u ? mine : 1u; nx = cnt > 0u ? cnt : 1u;
}

__device__ __forceinline__ void xcd_barrier(const XcdBarrier& b, const bool lead) {
    asm volatile("s_waitcnt vmcnt(0)" ::: "memory");
    __syncthreads();
    if (lead) {
        unsigned* bar = b.bar;
        __builtin_amdgcn_s_waitcnt(0);
        unsigned nloc = b.st[0], nx = b.st[1];
        if (nloc == 0u) { xcd_barrier_complete(bar, b.x, nloc, nx); b.st[0] = nloc; b.st[1] = nx; }
        const unsigned old = xb_add(&bar[XB_XSUB(b.x)], 1u);
        const unsigned gen = old / nloc;
        if (old + 1u == (gen + 1u) * nloc) {
            __builtin_amdgcn_fence(__ATOMIC_RELEASE, "agent");
            asm volatile("s_waitcnt vmcnt(0)" ::: "memory");
            const unsigned og = xb_add(&bar[XB_TOP], 1u);
            const unsigned tg = og / nx;
            if (og + 1u == (tg + 1u) * nx) xb_add(&bar[XB_TOPGEN], 1u);
            else XB_SPIN(xb_ld(&bar[XB_TOPGEN]) == tg, bar);
            __builtin_amdgcn_fence(__ATOMIC_ACQUIRE, "agent");
            xb_add(&bar[XB_XGEN(b.x)], 1u);
            asm volatile("s_waitcnt vmcnt(0)" ::: "memory");
        } else {
            XB_SPIN(xb_ld(&bar[XB_XGEN(b.x)]) == gen, bar);
            __builtin_amdgcn_fence(__ATOMIC_ACQUIRE, "agent");
            asm volatile("s_waitcnt vmcnt(0)" ::: "memory");
        }
    }
    __syncthreads();
}
template <class F> __device__ __forceinline__ void xcd_barrier_with(const XcdBarrier& b, const bool lead, const int wave, F&& f) {
    asm volatile("s_waitcnt vmcnt(0)" ::: "memory");
    __syncthreads();
    if (wave != 0) f();
    if (lead) {
        unsigned* bar = b.bar;
        __builtin_amdgcn_s_waitcnt(0);
        unsigned nloc = b.st[0], nx = b.st[1];
        if (nloc == 0u) { xcd_barrier_complete(bar, b.x, nloc, nx); b.st[0] = nloc; b.st[1] = nx; }
        const unsigned old = xb_add(&bar[XB_XSUB(b.x)], 1u);
        const unsigned gen = old / nloc;
        if (old + 1u == (gen + 1u) * nloc) {
            __builtin_amdgcn_fence(__ATOMIC_RELEASE, "agent");
            asm volatile("s_waitcnt vmcnt(0)" ::: "memory");
            const unsigned og = xb_add(&bar[XB_TOP], 1u);
            const unsigned tg = og / nx;
            if (og + 1u == (tg + 1u) * nx) xb_add(&bar[XB_TOPGEN], 1u);
            else XB_SPIN(xb_ld(&bar[XB_TOPGEN]) == tg, bar);
            __builtin_amdgcn_fence(__ATOMIC_ACQUIRE, "agent");
            xb_add(&bar[XB_XGEN(b.x)], 1u);
            asm volatile("s_waitcnt vmcnt(0)" ::: "memory");
        } else {
            XB_SPIN(xb_ld(&bar[XB_XGEN(b.x)]) == gen, bar);
            __builtin_amdgcn_fence(__ATOMIC_ACQUIRE, "agent");
            asm volatile("s_waitcnt vmcnt(0)" ::: "memory");
        }
    }
    __syncthreads();
}
__device__ __forceinline__ float wave_sum(float v) {
#pragma unroll
    for (int o = 1; o < 64; o <<= 1) v += __shfl_xor(v, o);
    return v;
}
__device__ __forceinline__ unsigned cvtpk_bf16(float lo, float hi) { unsigned r; asm volatile("v_cvt_pk_bf16_f32 %0, %1, %2" : "=v"(r) : "v"(lo), "v"(hi)); return r; }
__device__ __forceinline__ void p0_transpose_item(const float* W, int N, bf16* WT, int ldwt, int drow0, const float* gain, LAS float* scr, int kb, int nb, int lane) {
    const int k0 = 64 * kb, n0 = 64 * nb, lr = lane >> 4, lc = (lane & 15) * 4;
    f32x4 v[16]; float gv[16];
#pragma unroll
    for (int i = 0; i < 16; ++i) gv[i] = gain ? gain[k0 + 4 * i + lr] : 1.0f;
#pragma unroll
    for (int i = 0; i < 16; ++i) v[i] = __builtin_nontemporal_load((const GAS f32x4*)(W + (size_t)(k0 + 4 * i + lr) * N + n0 + lc));
    asm volatile("" ::: "memory");
#pragma unroll
    for (int i = 0; i < 16; ++i) { const int kk = 4 * i + lr; const float g = gv[i]; LAS float* d = scr + kk * 65 + lc; d[0] = v[i][0] * g; d[1] = v[i][1] * g; d[2] = v[i][2] * g; d[3] = v[i][3] * g; }
    LDS_WAIT(); asm volatile("" ::: "memory");
    const int c = lane & 7;
#pragma unroll
    for (int j = 0; j < 8; ++j) { const int n = (lane >> 3) + 8 * j; const LAS float* s = scr + (8 * c) * 65 + n;
        v4u o; o.x = cvtpk_bf16(s[0 * 65], s[1 * 65]); o.y = cvtpk_bf16(s[2 * 65], s[3 * 65]); o.z = cvtpk_bf16(s[4 * 65], s[5 * 65]); o.w = cvtpk_bf16(s[6 * 65], s[7 * 65]);
        *(GAS v4u*)(WT + (size_t)(drow0 + n) * ldwt + k0 + 8 * c) = o; }
    LDS_WAIT(); asm volatile("" ::: "memory");
}
__device__ __forceinline__ void rms_rows_to_bf16(const float* x, bf16* o, float* rs0, int m0, int mstep, int lane) {
    f32x4 v[4], w[4], z[4];
    if (m0 < M) {
#pragma unroll
        for (int j = 0; j < 4; ++j) v[j] = __builtin_nontemporal_load(((const GAS f32x4*)(x + (size_t)m0 * DM) + lane) + 64 * j); }
    if (m0 + mstep < M) {
#pragma unroll
        for (int j = 0; j < 4; ++j) w[j] = __builtin_nontemporal_load(((const GAS f32x4*)(x + (size_t)(m0 + mstep) * DM) + lane) + 64 * j); }
#pragma unroll 1
    for (int m = m0; m < M; m += mstep) {
        const int mn = m + 2 * mstep;
        if (mn < M) {
#pragma unroll
            for (int j = 0; j < 4; ++j) z[j] = __builtin_nontemporal_load(((const GAS f32x4*)(x + (size_t)mn * DM) + lane) + 64 * j); }
        float s = 0.f;
#pragma unroll
        for (int j = 0; j < 4; ++j) s += (v[j].x * v[j].x + v[j].y * v[j].y) + (v[j].z * v[j].z + v[j].w * v[j].w);
        const float sd = sqrtf(wave_sum(s) * (1.f / DM) + EPS), rstd = 1.0f / sd;
        if (lane == 0) rs0[m] = sd;
        const bool odd = lane & 1;
#pragma unroll
        for (int h = 0; h < 2; ++h) {
            const unsigned a0 = cvtpk_bf16(v[2 * h].x * rstd, v[2 * h].y * rstd), a1 = cvtpk_bf16(v[2 * h].z * rstd, v[2 * h].w * rstd);
            const unsigned b0 = cvtpk_bf16(v[2 * h + 1].x * rstd, v[2 * h + 1].y * rstd), b1 = cvtpk_bf16(v[2 * h + 1].z * rstd, v[2 * h + 1].w * rstd);
            const unsigned r0 = (unsigned)__shfl_xor((int)(odd ? a0 : b0), 1), r1 = (unsigned)__shfl_xor((int)(odd ? a1 : b1), 1);
            v4u o4; o4.x = odd ? r0 : a0; o4.y = odd ? r1 : a1; o4.z = odd ? b0 : r0; o4.w = odd ? b1 : r1;
            *(GAS v4u*)(o + (size_t)m * DM + 256 * (2 * h + (odd ? 1 : 0)) + 8 * (lane >> 1)) = o4;
        }
#pragma unroll
        for (int j = 0; j < 4; ++j) { v[j] = w[j]; w[j] = z[j]; }
    }
}

struct Args { const float* in[21]; float* out; unsigned char* ws; int ph_lo, ph_hi, li, pad; };
enum { I_X = 0, I_N1G, I_WIN, I_CONVW, I_CONVB, I_WR, I_BR, I_WI, I_BI, I_LAM, I_QNG, I_KNG, I_PA, I_PB, I_WOUT, I_N2G, I_WUP, I_WGATE, I_FCW, I_FCB, I_WDN };

namespace p0i { constexpr int I_IN = 16 * 112, I_SQ = 16 * 16, I_UP = 16 * 44, I_DN = 44 * 16, I_RG = 32, NLATE = 3 * I_SQ + 2 * I_UP + I_DN, NITEMS = I_IN + NLATE + 2 * I_RG; }
__device__ __forceinline__ void p0_item(const Args& a, int r, LAS float* scr, int lane) {
    using namespace p0i;
    unsigned char* ws = a.ws;
    const float* W; const float* gain = nullptr; bf16* WT; int N, ldwt, drow0, kb, nb;
    if (r < I_IN) { W = a.in[I_WIN]; N = DIN; WT = (bf16*)(ws + WS_WIN); ldwt = DM; kb = r / 112; nb = r % 112; drow0 = 64 * nb; gain = a.in[I_N1G]; }
    else if ((r -= I_IN) < 3 * I_SQ) { const int w = r / I_SQ; r -= w * I_SQ; W = a.in[w == 0 ? I_PA : w == 1 ? I_PB : I_WOUT]; N = DM; WT = (bf16*)(ws + (w == 0 ? WS_PA : w == 1 ? WS_PB : WS_WOUT)); ldwt = DM; kb = r / 16; nb = r % 16; drow0 = 64 * nb; }
    else if ((r -= 3 * I_SQ) < 2 * I_UP) { const int w = r / I_UP; r -= w * I_UP; nb = r % 44; kb = r / 44; const int n0 = 64 * nb; W = a.in[w == 0 ? I_WUP : I_WGATE]; N = DFF; WT = (bf16*)(ws + WS_WUG); ldwt = DM; drow0 = 256 * (n0 / 128) + 128 * w + (n0 % 128); gain = a.in[I_N2G]; }
    else if ((r -= 2 * I_UP) < I_DN) { W = a.in[I_WDN]; N = DM; WT = (bf16*)(ws + WS_WDN); ldwt = DFF; kb = r / 16; nb = r % 16; drow0 = 64 * nb; }
    else { r -= I_DN; const int w = r / I_RG; r -= w * I_RG; const int blk = r >> 2, q = r & 3; W = a.in[w == 0 ? I_WR : I_WI] + blk * 16384; N = 128; WT = (bf16*)(ws + (w == 0 ? WS_WR : WS_WI)) + blk * 16384; ldwt = 128; kb = q >> 1; nb = q & 1; drow0 = 64 * nb; }
    p0_transpose_item(W, N, WT, ldwt, drow0, gain, scr, kb, nb, lane);
}
__device__ __forceinline__ void p0_prologue(const Args& a, LAS unsigned char* lds, int gw, int NGW, int wave, int lane, bool defer) {
    using namespace p0i;
    LAS float* scr = (LAS float*)(lds + wave * 16896);
    const int nit = defer ? I_IN + 2 * I_RG : NITEMS;
    for (int it = gw; it < nit; it += NGW) p0_item(a, (defer && it >= I_IN) ? it + NLATE : it, scr, lane);
    rms_rows_to_bf16(a.in[I_X], (bf16*)(a.ws + WS_XN), (float*)(a.ws + WS_RS0), gw, NGW, lane);
}
__device__ __forceinline__ void p0_late_item(const Args& a, LAS unsigned char* lds, int vcu, int wave, int which) {
    using namespace p0i;
    const int idx = which * (4 * 256) + vcu * 4 + (wave - 1);
    if (wave <= 4 && idx < NLATE) p0_item(a, I_IN + idx, (LAS float*)(lds + (wave - 1) * 16896), pg8::lane_id_fresh());
}

__device__ __forceinline__ float xch16(float v, int kq) { const auto r = __builtin_amdgcn_permlane16_swap(__float_as_uint(v), __float_as_uint(v), false, false); return __uint_as_float((kq & 1) ? r[0] : r[1]); }
__device__ __forceinline__ float xch32(float v, int kq) { const auto r = __builtin_amdgcn_permlane32_swap(__float_as_uint(v), __float_as_uint(v), false, false); return __uint_as_float((kq & 2) ? r[0] : r[1]); }
__device__ __forceinline__ void scan4(float A, float H, int kq, float& At, float& Ht, float& Ae, float& He) {
    const float Ap = xch16(A, kq), Hp = xch16(H, kq);
    const bool odd = (kq & 1) != 0, hi = (kq & 2) != 0;
    const float PA = A * Ap, PH = odd ? (A * Hp + H) : (Ap * H + Hp);
    const float QA = xch32(PA, kq), QH = xch32(PH, kq);
    At = PA * QA; Ht = hi ? (PA * QH + PH) : (QA * PH + QH);
    const float e1A = odd ? Ap : 1.f, e1H = odd ? Hp : 0.f;
    Ae = hi ? (QA * e1A) : e1A; He = hi ? (e1A * QH + e1H) : e1H;
}
constexpr int CW_RFLAG = 20480;
template <class Hook> __device__ __forceinline__ void rnn_phase(const Args& a, LAS unsigned char* lds, int G, int wave, int lane, int tid, int variant, Hook&& hook) {
    LAS bf16* XRs = (LAS bf16*)lds;
    LAS bf16* XAb = (LAS bf16*)(lds + 18432);
    LAS bf16* HB = (LAS bf16*)(lds + 18432 + 17408);
    LAS float* CWl = (LAS float*)(lds + 18432 + 2 * 17408);
    const bf16* XR = (const bf16*)(a.ws + WS_XR); const bf16* GR = (const bf16*)(a.ws + WS_GR); bf16* YA = (bf16*)((unsigned char*)a.out + 64 * MiB);
    gu64* AG = (gu64*)(a.ws + WS_AG); gu32* RFLAG = (gu32*)(a.ws + WS_CTL) + CW_RFLAG;
    const int kq = lane >> 4, fr = lane & 15;
    if (G != 256) return;
    const int w = blockIdx.x, seqi = w & 31, sub = w >> 5, bb = seqi >> 3, n = seqi & 7;
    const int dcol = 16 * wave + fr, ch = n * 128 + dcol;
    bf16x8 wfr[8];
#pragma unroll
    for (int ks = 0; ks < 4; ++ks) { wfr[2 * ks] = *(const GAS bf16x8*)((const bf16*)(a.ws + WS_WR) + (size_t)ch * 128 + 32 * ks + 8 * kq);
                                     wfr[2 * ks + 1] = *(const GAS bf16x8*)((const bf16*)(a.ws + WS_WI) + (size_t)ch * 128 + 32 * ks + 8 * kq); }
    const float nbr = -1.4426950408889634f * a.in[I_BR][ch], nbi = -1.4426950408889634f * a.in[I_BI][ch];
    const float sp = log1pf(expf(-a.in[I_LAM][ch]));
    const float c1 = -16.0f * sp, c2 = -8.0f * sp * 1.4426950408889634f;
    for (int e = tid; e < 640; e += 512) CWl[e] = (e < 512) ? a.in[I_CONVW][(e >> 7) * 1024 + n * 128 + (e & 127)] : a.in[I_CONVB][n * 128 + (e & 127)];
    float hc = 0.f;
    int cfold = 0;
    v4u pre[3];
    {
        const int rb0 = bb * 32 + sub; const bool seqstart = (sub == 0);
#pragma unroll
        for (int pp = 0; pp < 3; ++pp) { const int p = tid + 512 * pp;
            if (p < 67 * 16) { const int row = p >> 4, c = p & 15; const bool z = seqstart && row < 3; const int srow = z ? rb0 * 256 : rb0 * 256 - 3 + row;
                v4u v = __builtin_nontemporal_load((const GAS v4u*)(XR + (size_t)srow * DM + n * 128 + 8 * c)); if (z) v = (v4u){0u, 0u, 0u, 0u}; pre[pp] = v; } }
    }
#pragma unroll 1
    for (int it = 0; it < 4; ++it) {
        const int chunk = 8 * it + sub, rb = bb * 32 + chunk;
        unsigned aup[4][4][2], bxp[4][4][2];
        float hl = 0.f, Pa = 1.f;
#pragma unroll
        for (int s = 0; s < 4; ++s) {
            const int r0 = rb * 256 + 64 * s;
            int tl = tid; asm volatile("" : "+v"(tl));
            const int cg = tl & 15, cc = n * 128 + 8 * cg;
#pragma unroll
            for (int pp = 0; pp < 3; ++pp) { const int p = tl + 512 * pp; if (p < 67 * 16) *(LAS v4u*)(XRs + (p >> 4) * 136 + 8 * (p & 15)) = pre[pp]; }
            __syncthreads();
            if (s < 3 || it < 3) {
                const int nr = (s < 3) ? r0 + 64 : r0 - 192 + 2048;
#pragma unroll
                for (int pp = 0; pp < 3; ++pp) { const int p = tl + 512 * pp; if (p < 67 * 16) pre[pp] = __builtin_nontemporal_load((const GAS v4u*)(XR + (size_t)(nr - 3 + (p >> 4)) * DM + n * 128 + 8 * (p & 15))); }
            }
            f32x4 tb0 = *(const LAS f32x4*)(CWl + 512 + 8 * cg), tb1 = *(const LAS f32x4*)(CWl + 512 + 8 * cg + 4), tc0[4], tc1[4];
#pragma unroll
            for (int k = 0; k < 4; ++k) { tc0[k] = *(const LAS f32x4*)(CWl + k * 128 + 8 * cg); tc1[k] = *(const LAS f32x4*)(CWl + k * 128 + 8 * cg + 4); }
#pragma unroll
            for (int pp = 0; pp < 2; ++pp) {
                const int tok = (tl >> 4) + 32 * pp;
                f32x4 a0 = tb0, a1 = tb1;
#pragma unroll
                for (int k = 0; k < 4; ++k) { const v4u wv = *(const LAS v4u*)(XRs + (tok + k) * 136 + 8 * cg);
                    const f32x4 c0 = tc0[k], c1v = tc1[k];
                    a0 += c0 * (f32x4){pg8::bflo(wv.x), pg8::bfhi(wv.x), pg8::bflo(wv.y), pg8::bfhi(wv.y)}; a1 += c1v * (f32x4){pg8::bflo(wv.z), pg8::bfhi(wv.z), pg8::bflo(wv.w), pg8::bfhi(wv.w)}; }
                v4u o; o.x = cvtpk_bf16(a0[0], a0[1]); o.y = cvtpk_bf16(a0[2], a0[3]); o.z = cvtpk_bf16(a1[0], a1[1]); o.w = cvtpk_bf16(a1[2], a1[3]);
                *(LAS v4u*)(XAb + tok * 136 + 8 * cg) = o;
            }
            __syncthreads();
            if (variant == 2) { _Pragma("unroll") for (int r_ = 0; r_ < 4; ++r_) { aup[s][r_][0] = aup[s][r_][1] = 0u; bxp[s][r_][0] = bxp[s][r_][1] = 0u; } continue; }
#pragma unroll
            for (int rt = 0; rt < 4; ++rt) {
                f32x4 aR = {0.f, 0.f, 0.f, 0.f}, aI = {0.f, 0.f, 0.f, 0.f};
#pragma unroll
                for (int ks = 0; ks < 4; ++ks) { const bf16x8 af = *(const LAS bf16x8*)(XAb + (16 * rt + fr) * 136 + 32 * ks + 8 * kq);
                    aR = __builtin_amdgcn_mfma_f32_16x16x32_bf16(af, wfr[2 * ks], aR, 0, 0, 0); aI = __builtin_amdgcn_mfma_f32_16x16x32_bf16(af, wfr[2 * ks + 1], aI, 0, 0, 0); }
                float A = 1.f, H = 0.f; float bxt[4];
                {
                    f32x4 er = aR * (-1.4426950408889634f) + nbr, ei = aI * (-1.4426950408889634f) + nbi;
#pragma unroll
                    for (int rg = 0; rg < 4; ++rg) { er[rg] = __builtin_amdgcn_exp2f(er[rg]); ei[rg] = __builtin_amdgcn_exp2f(ei[rg]); }
                    er = er + 1.0f; ei = ei + 1.0f;
                    f32x4 r, ig;
#pragma unroll
                    for (int rg = 0; rg < 4; ++rg) { r[rg] = __builtin_amdgcn_rcpf(er[rg]); ig[rg] = __builtin_amdgcn_rcpf(ei[rg]); }
                    f32x4 aa = r * c2;
#pragma unroll
                    for (int rg = 0; rg < 4; ++rg) aa[rg] = __builtin_amdgcn_exp2f(aa[rg]);
                    const f32x4 um = 1.0f - aa;
                    f32x4 em1 = um * (aa + 1.0f), xa;
#pragma unroll
                    for (int rg = 0; rg < 4; ++rg) xa[rg] = pg8::bf2f(XAb[(16 * rt + 4 * kq + rg) * 136 + dcol]);
#pragma unroll
                    for (int rg = 0; rg < 4; ++rg) em1[rg] = __builtin_amdgcn_sqrtf(em1[rg]);
                    const f32x4 bv = em1 * ig * xa;
                    aup[s][rt][0] = cvtpk_bf16(um[0], um[1]); aup[s][rt][1] = cvtpk_bf16(um[2], um[3]);
                    const float ar[4] = { 1.0f - pg8::bflo(aup[s][rt][0]), 1.0f - pg8::bfhi(aup[s][rt][0]), 1.0f - pg8::bflo(aup[s][rt][1]), 1.0f - pg8::bfhi(aup[s][rt][1]) };
#pragma unroll
                    for (int rg = 0; rg < 4; ++rg) { bxt[rg] = bv[rg]; H = ar[rg] * H + bv[rg]; A *= ar[rg]; }
                }
                bxp[s][rt][0] = cvtpk_bf16(bxt[0], bxt[1]); bxp[s][rt][1] = cvtpk_bf16(bxt[2], bxt[3]);
                float At, Ht, Aeu, Heu;
                scan4(A, H, kq, At, Ht, Aeu, Heu);
                hl = At * hl + Ht; Pa *= At;
                __builtin_amdgcn_sched_barrier(0);
            }
        }
        if (kq == 0) __hip_atomic_store(AG + (size_t)rb * 1024 + ch, ((unsigned long long)__float_as_uint(hl) << 32) | __float_as_uint(Pa), RLX_AGENT);
        asm volatile("s_waitcnt vmcnt(0)" ::: "memory");
        __syncthreads();
        if (tid == 0) __hip_atomic_store(RFLAG + rb * 8 + n, 1u, RLX_AGENT);
        hook(it);
        if (wave == 0) {
            unsigned spins = 0;
            const int ln = pg8::lane_id_fresh();
            for (;;) {
                const unsigned f = (ln >= cfold && ln < chunk) ? __hip_atomic_load(RFLAG + (bb * 32 + ln) * 8 + n, RLX_AGENT) : 1u;
                if (__all(f != 0u)) break;
                __builtin_amdgcn_s_sleep(2);
                if (++spins > (1u << 22)) break;
            }
        }
        __syncthreads();
        {
            unsigned long long ah[8];
#pragma unroll
            for (int j = 0; j < 8; ++j) { const int ci = (cfold + j < chunk) ? cfold + j : (chunk > 0 ? chunk - 1 : 0); ah[j] = __hip_atomic_load(AG + (size_t)(bb * 32 + ci) * 1024 + ch, RLX_AGENT); }
#pragma unroll
            for (int j = 0; j < 8; ++j) if (cfold + j < chunk) hc = __uint_as_float((unsigned)ah[j]) * hc + __uint_as_float((unsigned)(ah[j] >> 32));
            cfold = chunk;
        }
        if (variant >= 1) { asm volatile("" :: "v"(hc)); _Pragma("unroll") for (int s_ = 0; s_ < 4; ++s_) _Pragma("unroll") for (int r_ = 0; r_ < 4; ++r_) { asm volatile("" :: "v"(aup[s_][r_][0]), "v"(aup[s_][r_][1]), "v"(bxp[s_][r_][0]), "v"(bxp[s_][r_][1])); } __syncthreads(); continue; }
        float hs = hc;
#pragma unroll
        for (int s = 0; s < 4; ++s) {
            const int r0 = rb * 256 + 64 * s;
            int tl = tid; asm volatile("" : "+v"(tl));
            const int cg = tl & 15, cc = n * 128 + 8 * cg;
            v4u gpre[2];
#pragma unroll
            for (int pp = 0; pp < 2; ++pp) gpre[pp] = __builtin_nontemporal_load((const GAS v4u*)(GR + (size_t)(r0 + (tl >> 4) + 32 * pp) * DM + cc));
#pragma unroll
            for (int rt = 0; rt < 4; ++rt) {
                float A = 1.f, H = 0.f;
                const float bxv[4] = { pg8::bflo(bxp[s][rt][0]), pg8::bfhi(bxp[s][rt][0]), pg8::bflo(bxp[s][rt][1]), pg8::bfhi(bxp[s][rt][1]) };
                const float ar[4] = { 1.0f - pg8::bflo(aup[s][rt][0]), 1.0f - pg8::bfhi(aup[s][rt][0]), 1.0f - pg8::bflo(aup[s][rt][1]), 1.0f - pg8::bfhi(aup[s][rt][1]) };
#pragma unroll
                for (int rg = 0; rg < 4; ++rg) { H = ar[rg] * H + bxv[rg]; A *= ar[rg]; }
                float At, Ht, Ae, He;
                scan4(A, H, kq, At, Ht, Ae, He);
                float h = Ae * hs + He;
#pragma unroll
                for (int rg = 0; rg < 4; ++rg) { h = ar[rg] * h + bxv[rg]; HB[(16 * rt + 4 * kq + rg) * 136 + dcol] = (bf16)cvtpk_bf16(h, h); }
                hs = At * hs + Ht;
            }
            __syncthreads();
#pragma unroll
            for (int pp = 0; pp < 2; ++pp) {
                const int tok = (tl >> 4) + 32 * pp;
                const v4u hw = *(const LAS v4u*)(HB + tok * 136 + 8 * cg);
                const v4u gw = gpre[pp];
                v4u o; o.x = cvtpk_bf16(pg8::bflo(hw.x) * pg8::bflo(gw.x), pg8::bfhi(hw.x) * pg8::bfhi(gw.x)); o.y = cvtpk_bf16(pg8::bflo(hw.y) * pg8::bflo(gw.y), pg8::bfhi(hw.y) * pg8::bfhi(gw.y));
                o.z = cvtpk_bf16(pg8::bflo(hw.z) * pg8::bflo(gw.z), pg8::bfhi(hw.z) * pg8::bfhi(gw.z)); o.w = cvtpk_bf16(pg8::bflo(hw.w) * pg8::bflo(gw.w), pg8::bfhi(hw.w) * pg8::bfhi(gw.w));
                __builtin_nontemporal_store(o, (GAS v4u*)(YA + (size_t)(r0 + tok) * DM + cc));
            }
            __syncthreads();
        }
        hc = Pa * hc + hl; cfold = chunk + 1;
    }
}
typedef short s16x4 __attribute__((ext_vector_type(4)));
typedef float f32x16 __attribute__((ext_vector_type(16)));
typedef short v4i16_t __attribute__((ext_vector_type(4)));
constexpr size_t WS_PART = 304 * MiB, WS_LIST = 496 * MiB, WS_LP = 42 * MiB;
constexpr int CW_CNT = 16384;
constexpr int LIST_PER_BH = 256 * 496;
__device__ __forceinline__ int list_off(int n) { return 256 * (31 * n - (n * (n - 1)) / 2); }
__device__ __forceinline__ unsigned cvtpk(float lo, float hi) { unsigned r; asm volatile("v_cvt_pk_bf16_f32 %0, %1, %2" : "=v"(r) : "v"(lo), "v"(hi)); return r; }
__device__ __forceinline__ s16x4 vtr(const LAS unsigned char* p) { return __builtin_bit_cast(s16x4, __builtin_amdgcn_ds_read_tr16_b64_v4i16((LAS v4i16_t*)p)); }

template <int AUX = 0> __device__ __forceinline__ void load_kv_block(LAS unsigned char* lds, const bf16* Kg, const bf16* Vg, size_t row0, int hh, int wave, int lane) {
#pragma unroll
    for (int i = 0; i < 8; ++i) {
        const int I = wave * 8 + i;
        { const int r = 4 * I + (lane >> 4), cp = lane & 15, c = cp ^ (r & 15);
          __builtin_amdgcn_global_load_lds((const unsigned*)(Kg + (row0 + r) * DM + hh * HD + 8 * c), (LAS unsigned*)(lds + I * 1024), 16, 0, AUX); }
        { const int dt = lane >> 4, q = (lane >> 2) & 3, c8 = lane & 3;
          __builtin_amdgcn_global_load_lds((const unsigned*)(Vg + (row0 + 4 * I + q) * DM + hh * HD + 32 * dt + 8 * c8), (LAS unsigned*)(lds + 65536 + I * 1024), 16, 0, AUX); }
    }
}

__device__ __forceinline__ void attn_wave(const LAS unsigned char* lds, const bf16x8 (&qf)[8], f32x16 (&O)[4], float& lsum, int kt_hi, int diag, int lane) {
    const int h2 = lane >> 5, kr = lane & 31;
    unsigned kaddr[8];
#pragma unroll
    for (int s = 0; s < 8; ++s) kaddr[s] = (unsigned)(kr * 256 + (((2 * s + h2) ^ (lane & 15)) * 16));
    const LAS unsigned char* vb = lds + 65536 + h2 * 1024 + ((lane >> 2) & 3) * 64 + ((lane >> 4) & 1) * 32 + (lane & 3) * 8;
#pragma unroll 1
    for (int kt = 0; kt < kt_hi; ++kt) {
        f32x16 S;
#pragma unroll
        for (int r = 0; r < 16; ++r) S[r] = 0.f;
#pragma unroll
        for (int s = 0; s < 8; ++s) { const bf16x8 kf = *(const LAS bf16x8*)(lds + kt * 8192 + kaddr[s]); S = __builtin_amdgcn_mfma_f32_32x32x16_bf16(kf, qf[s], S, 0, 0, 0); }
        float P[16];
#pragma unroll
        for (int r = 0; r < 16; ++r) P[r] = __builtin_amdgcn_exp2f(S[r]);
        if (kt == diag) {
#pragma unroll
            for (int r = 0; r < 16; ++r) { const int kl = (r & 3) + 8 * (r >> 2) + 4 * h2; P[r] = (kl <= kr) ? P[r] : 0.f; }
        }
        float ls = 0.f;
#pragma unroll
        for (int r = 0; r < 16; ++r) ls += P[r];
        lsum += ls;
        v4u pw0, pw1;
        pw0.x = cvtpk(P[0], P[1]); pw0.y = cvtpk(P[2], P[3]); pw0.z = cvtpk(P[4], P[5]); pw0.w = cvtpk(P[6], P[7]);
        pw1.x = cvtpk(P[8], P[9]); pw1.y = cvtpk(P[10], P[11]); pw1.z = cvtpk(P[12], P[13]); pw1.w = cvtpk(P[14], P[15]);
        const bf16x8 pb0 = __builtin_bit_cast(bf16x8, pw0), pb1 = __builtin_bit_cast(bf16x8, pw1);
        const LAS unsigned char* vk = vb + kt * 8192;
#pragma unroll
        for (int dt = 0; dt < 4; ++dt) {
            { const s16x4 lo = vtr(vk + dt * 256), hi = vtr(vk + dt * 256 + 2048);
              const bf16x8 vf = (bf16x8){lo[0], lo[1], lo[2], lo[3], hi[0], hi[1], hi[2], hi[3]};
              O[dt] = __builtin_amdgcn_mfma_f32_32x32x16_bf16(vf, pb0, O[dt], 0, 0, 0); }
            { const s16x4 lo = vtr(vk + 4096 + dt * 256), hi = vtr(vk + 4096 + dt * 256 + 2048);
              const bf16x8 vf = (bf16x8){lo[0], lo[1], lo[2], lo[3], hi[0], hi[1], hi[2], hi[3]};
              O[dt] = __builtin_amdgcn_mfma_f32_32x32x16_bf16(vf, pb1, O[dt], 0, 0, 0); }
        }
    }
}

__device__ __forceinline__ void q_unstage(LAS unsigned char* stg, const v4u (&qs)[8], bf16x8 (&qf)[8], int lane) {
    const int ra = lane >> 2, rb2 = ra + 16, part = lane & 3, h2 = lane >> 5, kr = lane & 31;
#pragma unroll
    for (int p = 0; p < 4; ++p) {
        *(LAS v4u*)(stg + ra * 80 + part * 16) = qs[2 * p]; *(LAS v4u*)(stg + rb2 * 80 + part * 16) = qs[2 * p + 1];
        asm volatile("s_waitcnt lgkmcnt(0)" ::: "memory");
        qf[2 * p] = *(const LAS bf16x8*)(stg + kr * 80 + h2 * 16); qf[2 * p + 1] = *(const LAS bf16x8*)(stg + kr * 80 + 32 + h2 * 16);
        asm volatile("s_waitcnt lgkmcnt(0)" ::: "memory");
    }
}
constexpr int GATE_LDS = 122880;
__device__ __forceinline__ void gate_prologue(const Args& a, LAS unsigned char* lds0, int vcu, int wave) {
    LAS unsigned char* lds = lds0 + GATE_LDS;
    const int lane = pg8::lane_id_fresh(); const int tid = wave * 64 + lane;
    LAS unsigned* lcnt = (LAS unsigned*)lds; const float* KM = (const float*)(a.ws + WS_KM);
    if (tid < 128) lcnt[tid] = 0u;
    LAS unsigned char* KMf = lds + 1024;
    const int bh0 = (vcu * 4) >> 5, bb0 = bh0 >> 3, hh0 = bh0 & 7;
    const int fl = tid & 63, s = tid >> 6;
    const float* kmp = KM + ((size_t)(bb0 * 32 + (fl & 31)) * 8 + hh0) * 128 + 16 * s + 8 * (fl >> 5);
    const f32x4 k0 = *(const GAS f32x4*)kmp, k1 = *(const GAS f32x4*)(kmp + 4);
    const float kv[8] = {k0[0], k0[1], k0[2], k0[3], k1[0], k1[1], k1[2], k1[3]};
    unsigned hi[4], lo[4];
#pragma unroll
    for (int j = 0; j < 4; ++j) { const unsigned hw = cvtpk(kv[2 * j], kv[2 * j + 1]); hi[j] = hw;
        lo[j] = cvtpk(kv[2 * j] - __builtin_bit_cast(float, hw << 16), kv[2 * j + 1] - __builtin_bit_cast(float, hw & 0xffff0000u)); }
    *(LAS v4u*)(KMf + (2 * s) * 1024 + fl * 16) = (v4u){hi[0], hi[1], hi[2], hi[3]};
    *(LAS v4u*)(KMf + (2 * s + 1) * 1024 + fl * 16) = (v4u){lo[0], lo[1], lo[2], lo[3]};
}
__device__ __forceinline__ void gate_unit(const Args& a, LAS unsigned char* lds0, int vcu, int wave, int ui) {
    LAS unsigned char* lds = lds0 + GATE_LDS;
    const int lane = pg8::lane_id_fresh(); const int tid = wave * 64 + lane;
    LAS unsigned* lcnt = (LAS unsigned*)lds; LAS unsigned char* KMf = lds + 1024; LAS unsigned* RES = (LAS unsigned*)(lds + 1024 + 16384);
    const bf16* Qg = (const bf16*)(a.ws + WS_Q);
    const int h2 = lane >> 5, kr = lane & 31;
    const int unit = vcu * 4 + ui, bh = unit >> 5, qb = unit & 31, bb = bh >> 3, hh = bh & 7;
    const size_t rowbase = (size_t)bb * SEQ; const int tq = qb * 256 + 32 * wave + kr;
    const bf16* qp = Qg + (rowbase + tq) * DM + hh * HD + 8 * h2;
    bf16x8 bq[8];
#pragma unroll
    for (int s = 0; s < 8; ++s) bq[s] = *(const GAS bf16x8*)(qp + 16 * s);
    f32x16 acc;
#pragma unroll
    for (int r = 0; r < 16; ++r) acc[r] = 0.f;
#pragma unroll
    for (int s = 0; s < 8; ++s) {
        const bf16x8 ahi = *(const LAS bf16x8*)(KMf + (2 * s) * 1024 + lane * 16), alo = *(const LAS bf16x8*)(KMf + (2 * s + 1) * 1024 + lane * 16);
        acc = __builtin_amdgcn_mfma_f32_32x32x16_bf16(ahi, bq[s], acc, 0, 0, 0); acc = __builtin_amdgcn_mfma_f32_32x32x16_bf16(alo, bq[s], acc, 0, 0, 0);
    }
    unsigned mask = 0u, wsel = 0u, wpos = 0u;
#pragma unroll
    for (int r3 = 0; r3 < 3; ++r3) {
        if (r3 < qb) { float best = -3.0e38f; int bi = 64;
#pragma unroll
            for (int r = 0; r < 16; ++r) { const int blk = (r & 3) + 8 * (r >> 2) + 4 * h2; const bool ok = (blk < qb) && !((mask >> blk) & 1u) && (acc[r] > best); best = ok ? acc[r] : best; bi = ok ? blk : bi; }
            const float ob = __shfl_xor(best, 32); const int oi = __shfl_xor(bi, 32);
            const bool take = (ob > best) || (ob == best && oi < bi);
            bi = take ? oi : bi; bi &= 31;
            mask |= 1u << bi; wsel |= (unsigned)bi << (8 * r3);
            if (h2 == 0) wpos |= __hip_atomic_fetch_add(lcnt + ui * 32 + bi, 1u, __ATOMIC_RELAXED, __HIP_MEMORY_SCOPE_WORKGROUP) << (10 * r3); }
    }
    RES[(ui * 2) * 512 + tid] = wsel; RES[(ui * 2 + 1) * 512 + tid] = wpos;
}
__device__ __forceinline__ void gate_count(const Args& a, LAS unsigned char* lds0, int vcu, int wave, int variant) {
    LAS unsigned char* lds = lds0 + GATE_LDS;
    const int lane = pg8::lane_id_fresh(); const int tid = wave * 64 + lane;
    LAS unsigned* lcnt = (LAS unsigned*)lds; LAS unsigned* gbase = lcnt + 128;
    unsigned* CNT = (unsigned*)(a.ws + WS_CTL) + CW_CNT;
    __syncthreads();
    if (tid < 128) { const unsigned c = lcnt[tid]; const int bh = (vcu * 4 + (tid >> 5)) >> 5; gbase[tid] = (c && !variant) ? atomicAdd(CNT + bh * 32 + (tid & 31), c) : 0u; }
}
__device__ __forceinline__ void gate_finish(const Args& a, LAS unsigned char* lds0, int vcu, int wave, int variant) {
    LAS unsigned char* lds = lds0 + GATE_LDS;
    const int lane = pg8::lane_id_fresh(); const int tid = wave * 64 + lane;
    LAS unsigned* lcnt = (LAS unsigned*)lds; LAS unsigned* gbase = lcnt + 128; LAS unsigned* RES = (LAS unsigned*)(lds + 1024 + 16384);
    unsigned* LIST = (unsigned*)(a.ws + WS_LIST);
    const int h2 = lane >> 5, kr = lane & 31;
    __syncthreads();
    if (h2 == 0 && !variant) {
#pragma unroll
        for (int ui = 0; ui < 4; ++ui) { const int unit = vcu * 4 + ui, bh = unit >> 5, qb = unit & 31; const int tq = qb * 256 + 32 * wave + kr;
            const unsigned wsel = RES[(ui * 2) * 512 + tid], wpos = RES[(ui * 2 + 1) * 512 + tid];
#pragma unroll
            for (int r3 = 0; r3 < 3; ++r3) if (r3 < qb) { const int sel = (int)((wsel >> (8 * r3)) & 31u); LIST[(size_t)bh * LIST_PER_BH + list_off(sel) + gbase[ui * 32 + sel] + ((wpos >> (10 * r3)) & 1023u)] = ((unsigned)tq << 2) | (unsigned)r3; } }
    }
    __syncthreads();
}

__device__ __forceinline__ void sparse_phase(const Args& a, LAS unsigned char* lds, int G, int wave, int lane, int tid, int variant = 0) {
    const unsigned wgv = (G % 8 == 0) ? (blockIdx.x % 8) * (unsigned)(G / 8) + blockIdx.x / 8 : blockIdx.x;
    LAS unsigned* cntl = (LAS unsigned*)(lds + 131072 + 1024);
    LAS unsigned* pre = cntl + 1024;
    const bf16* Qg = (const bf16*)(a.ws + WS_Q); const bf16* Kg = (const bf16*)(a.ws + WS_K); const bf16* Vg = (const bf16*)(a.ws + WS_V);
    const unsigned* CNT = (const unsigned*)(a.ws + WS_CTL) + CW_CNT; const unsigned* LIST = (const unsigned*)(a.ws + WS_LIST);
    bf16* PART = (bf16*)(a.ws + WS_PART); float* LP = (float*)(a.ws + WS_LP);
    const int h2 = lane >> 5, kr = lane & 31;
    for (int i = tid; i < 1024; i += 512) cntl[i] = __hip_atomic_load(CNT + i, __ATOMIC_RELAXED, __HIP_MEMORY_SCOPE_AGENT);
    __syncthreads();
#ifndef SP_WT
#define SP_WT 2u
#define SP_WL 1u
#endif
    LAS unsigned* pre2 = (LAS unsigned*)(lds + 131072 + 10240);
    if (wave == 0) {
        unsigned loc[16], loc2[16]; unsigned s = 0u, s2 = 0u;
#pragma unroll
        for (int j = 0; j < 16; ++j) { const unsigned t = (cntl[16 * lane + j] + 255u) >> 8; loc[j] = s; loc2[j] = s2; s += t; s2 += t ? SP_WT * t + SP_WL : 0u; }
        unsigned inc = s, inc2 = s2;
#pragma unroll
        for (int o = 1; o < 64; o <<= 1) { const unsigned t = __shfl_up(inc, o), t2 = __shfl_up(inc2, o); if (lane >= o) { inc += t; inc2 += t2; } }
        const unsigned exc = inc - s, exc2 = inc2 - s2;
#pragma unroll
        for (int j = 0; j < 16; ++j) { pre[16 * lane + j] = exc + loc[j]; pre2[16 * lane + j] = exc2 + loc2[j]; }
        if (lane == 63) { pre[1024] = inc; pre2[1024] = inc2; }
    }
    __syncthreads();
    const unsigned T = pre[1024], C = pre2[1024];
    unsigned lo, hi;
    {
        unsigned bnd[2];
#pragma unroll
        for (int e = 0; e < 2; ++e) {
            const unsigned cb = (unsigned)(((unsigned long long)(wgv + e) * C) / (unsigned)G);
            if (wgv + e >= (unsigned)G) { bnd[e] = T; continue; }
            int a0 = 0, b0 = 1024; while (b0 - a0 > 1) { const int m = (a0 + b0) >> 1; if (pre2[m] <= cb) a0 = m; else b0 = m; }
            const unsigned tl = pre[a0 + 1] - pre[a0], base = pre2[a0] + SP_WL;
            const unsigned k = (cb > base) ? (cb - base + SP_WT - 1u) / SP_WT : 0u;
            bnd[e] = (k >= tl) ? pre[a0 + 1] : pre[a0] + k;
        }
        lo = bnd[0]; hi = bnd[1];
    }
    __syncthreads();
    if (lo >= hi) return;
    int li = 0;
    { int a0 = 0, b0 = 1024; while (b0 - a0 > 1) { const int m = (a0 + b0) >> 1; if (pre[m] <= lo) a0 = m; else b0 = m; } li = a0; }
#define SP_ENTRY(LI, K2) ({ const int bh_ = (LI) >> 5, nn_ = (LI) & 31; const int idx_ = 256 * (K2) + 32 * wave + kr; (idx_ < (int)cntl[LI]) ? LIST[(size_t)bh_ * LIST_PER_BH + list_off(nn_) + idx_] : 0xffffffffu; })
#define SP_QROW(LI, E) (Qg + ((size_t)((LI) >> 8) * SEQ + (((E) == 0xffffffffu) ? 0u : ((E) >> 2))) * DM + (((LI) >> 5) & 7) * HD + 8 * (lane & 3))
#define SP_QLOAD(DST, LI, E) do { const unsigned ea_ = __shfl((E), lane >> 2), eb_ = __shfl((E), (lane >> 2) + 16); const bf16* qa_ = SP_QROW(LI, ea_); const bf16* qb_ = SP_QROW(LI, eb_); \
        _Pragma("unroll") for (int p_ = 0; p_ < 4; ++p_) { DST[2 * p_] = *(const GAS v4u*)(qa_ + 32 * p_); DST[2 * p_ + 1] = *(const GAS v4u*)(qb_ + 32 * p_); } } while (0)
    int l1 = li, l2, l3;
    unsigned t1 = lo;
    while (t1 >= pre[l1 + 1]) ++l1;
    l2 = l1; if (lo + 1 < hi) { while (lo + 1 >= pre[l2 + 1]) ++l2; }
    int cur = l1; bool first = true;
    { const int bh0 = l1 >> 5; load_kv_block(lds, Kg, Vg, (size_t)(bh0 >> 3) * SEQ + (size_t)(l1 & 31) * 256, bh0 & 7, wave, lane); }
    unsigned e1 = SP_ENTRY(l1, (int)(lo - pre[l1]));
    unsigned e2 = (lo + 1 < hi) ? SP_ENTRY(l2, (int)(lo + 1 - pre[l2])) : 0xffffffffu;
    LAS unsigned char* stg = lds + 131072 + 10240 + wave * 2560;
    v4u qs[8];
    SP_QLOAD(qs, l1, e1);
#pragma unroll 1
    for (unsigned tile = lo; tile < hi; ++tile) {
        const int k = (int)(tile - pre[l1]); const int cnt = (int)cntl[l1];
        const int bh = l1 >> 5, nn = l1 & 31, bb = bh >> 3, hh = bh & 7; const size_t rowbase = (size_t)bb * SEQ;
        if (l1 != cur) {
            __syncthreads();
            if (variant != 4 || cur < 0) load_kv_block(lds, Kg, Vg, rowbase + (size_t)nn * 256, hh, wave, lane);
            asm volatile("s_waitcnt vmcnt(0)" ::: "memory");
            __syncthreads();
            cur = l1;
        } else if (first) {
            asm volatile("s_waitcnt vmcnt(0)" ::: "memory");
            __syncthreads();
        }
        first = false;
        bf16x8 qf[8];
        q_unstage(stg, qs, qf, lane);
        unsigned e3 = 0xffffffffu; l3 = l2;
        if (tile + 1 < hi && variant != 5) SP_QLOAD(qs, l2, e2);
        if (tile + 2 < hi) { while (tile + 2 >= pre[l3 + 1]) ++l3; e3 = SP_ENTRY(l3, (int)(tile + 2 - pre[l3])); }
        const int idx0 = 256 * k + 32 * wave;
        if (idx0 < cnt) {
            const bool valid = (e1 != 0xffffffffu);
            const int t = (int)(e1 >> 2), j = (int)(e1 & 3u);
            f32x16 O[4];
#pragma unroll
            for (int dt = 0; dt < 4; ++dt)
#pragma unroll
                for (int r = 0; r < 16; ++r) O[dt][r] = 0.f;
            float lsum = 0.f;
            if (variant != 1) attn_wave(lds, qf, O, lsum, variant == 2 ? 4 : 8, -1, lane);
            lsum += __shfl_xor(lsum, 32);
            if (variant) {
#pragma unroll
                for (int dt = 0; dt < 4; ++dt)
#pragma unroll
                    for (int r = 0; r < 16; ++r) asm volatile("" :: "v"(O[dt][r]));
                asm volatile("" :: "v"(lsum));
            }
            if (variant == 0 || variant == 3) {
                const int psl = valid ? (int)(((unsigned)bh * SEQ + (unsigned)t) * 3u + (unsigned)j) : -1;
                if (valid && h2 == 0) LP[psl] = lsum;
                const int ra = lane >> 2, rb2 = ra + 16, part = lane & 3;
                const int psa = __shfl(psl, ra), psb = __shfl(psl, rb2);
#pragma unroll
                for (int dt = 0; dt < 4; ++dt) {
#pragma unroll
                    for (int rq = 0; rq < 4; ++rq) { const unsigned long long w = (unsigned long long)cvtpk(O[dt][4 * rq], O[dt][4 * rq + 1]) | ((unsigned long long)cvtpk(O[dt][4 * rq + 2], O[dt][4 * rq + 3]) << 32);
                        *(LAS unsigned long long*)(stg + kr * 80 + rq * 16 + h2 * 8) = w; }
                    asm volatile("s_waitcnt lgkmcnt(0)" ::: "memory");
                    const v4u ca = *(const LAS v4u*)(stg + ra * 80 + part * 16), cb2 = *(const LAS v4u*)(stg + rb2 * 80 + part * 16);
                    if (psa >= 0) *(GAS v4u*)(PART + (size_t)psa * 128 + dt * 32 + part * 8) = ca;
                    if (psb >= 0) *(GAS v4u*)(PART + (size_t)psb * 128 + dt * 32 + part * 8) = cb2;
                    asm volatile("s_waitcnt lgkmcnt(0)" ::: "memory");
                }
            }
        }
        e1 = e2; e2 = e3; l1 = l2; l2 = l3;
    }
#undef SP_ENTRY
#undef SP_QROW
#undef SP_QLOAD
}

__device__ __forceinline__ void own_phase(const Args& a, LAS unsigned char* lds, int vcu, int wave, int lane, int tid, int variant, const XcdBarrier* barp) {
    bf16* Qg = (bf16*)(a.ws + WS_Q); const bf16* Kg = (const bf16*)(a.ws + WS_K); const bf16* Vg = (const bf16*)(a.ws + WS_V);
    const bf16* PART = (const bf16*)(a.ws + WS_PART); const float* LP = (const float*)(a.ws + WS_LP);
    const int h2 = lane >> 5, kr = lane & 31;
    LAS unsigned char* stg = lds + 131072 + 10240 + wave * 2560;
    const int ra = lane >> 2, rb2 = ra + 16, part = lane & 3;
    v4u qs[8];
#define OWN_QLOAD(UI) do { const int unit_ = vcu * 4 + (UI), bh_ = unit_ >> 5; const int ln_ = pg8::lane_id_fresh(); \
        const bf16* qa_ = Qg + ((size_t)(bh_ >> 3) * SEQ + (unit_ & 31) * 256 + 32 * wave + (ln_ >> 2)) * DM + (bh_ & 7) * HD + 8 * (ln_ & 3); \
        _Pragma("unroll") for (int p_ = 0; p_ < 4; ++p_) { qs[2 * p_] = *(const GAS v4u*)(qa_ + 32 * p_); qs[2 * p_ + 1] = *(const GAS v4u*)(qa_ + 16 * DM + 32 * p_); } } while (0)
#define OWN_KV(UI) do { const int unit_ = vcu * 4 + (UI), bh_ = unit_ >> 5; load_kv_block<2>(lds, Kg, Vg, (size_t)(bh_ >> 3) * SEQ + (size_t)(unit_ & 31) * 256, bh_ & 7, wave, pg8::lane_id_fresh()); } while (0)
    if (barp) { xcd_barrier_with(*barp, tid == 0, wave, [&]() { OWN_KV(0); OWN_QLOAD(0); }); if (wave == 0) { OWN_KV(0); OWN_QLOAD(0); } }
    else { __syncthreads(); OWN_KV(0); OWN_QLOAD(0); }
#pragma unroll 1
    for (int ui = 0; ui < 4; ++ui) {
        const int unit = vcu * 4 + ui, bh = unit >> 5, qb = unit & 31, bb = bh >> 3, hh = bh & 7;
        const size_t rowbase = (size_t)bb * SEQ; const int t0 = qb * 256 + 32 * wave, t = t0 + kr;
        if (ui > 0) { __syncthreads(); OWN_KV(ui); }
        const int nsel = qb < 3 ? qb : 3;
        const unsigned psa = (unsigned)(bh * SEQ + t0 + ra) * 3u, psb = psa + 48u;
        float lp[3];
        { typedef float f32x3 __attribute__((ext_vector_type(3))); const f32x3 l3 = *(const GAS f32x3*)(LP + ((size_t)bh * SEQ + t) * 3);
          lp[0] = (0 < nsel) ? l3[0] : 0.f; lp[1] = (1 < nsel) ? l3[1] : 0.f; lp[2] = (2 < nsel) ? l3[2] : 0.f; }
        asm volatile("s_waitcnt vmcnt(0)" ::: "memory");
        __syncthreads();
        bf16x8 qf[8];
        q_unstage(stg, qs, qf, lane);
        f32x16 O[4];
#pragma unroll
        for (int dt = 0; dt < 4; ++dt)
#pragma unroll
            for (int r = 0; r < 16; ++r) O[dt][r] = 0.f;
        float lsum = 0.f;
        attn_wave(lds, qf, O, lsum, wave + 1, wave, lane);
        lsum += __shfl_xor(lsum, 32);
        lsum += (lp[0] + lp[1]) + lp[2];
        {
            v4u pa[3][8];
#pragma unroll
            for (int j = 0; j < 3; ++j) {
#pragma unroll
                for (int dt = 0; dt < 4; ++dt) { pa[j][2 * dt] = __builtin_nontemporal_load((const GAS v4u*)(PART + (size_t)(psa + j) * 128 + dt * 32 + part * 8)); pa[j][2 * dt + 1] = __builtin_nontemporal_load((const GAS v4u*)(PART + (size_t)(psb + j) * 128 + dt * 32 + part * 8)); } }
#pragma unroll
            for (int j = 0; j < 3; ++j) if (j < nsel) {
#pragma unroll
                for (int dt = 0; dt < 4; ++dt) {
                    *(LAS v4u*)(stg + ra * 80 + part * 16) = pa[j][2 * dt]; *(LAS v4u*)(stg + rb2 * 80 + part * 16) = pa[j][2 * dt + 1];
                    asm volatile("s_waitcnt lgkmcnt(0)" ::: "memory");
#pragma unroll
                    for (int rq = 0; rq < 4; ++rq) { const unsigned long long w = *(const LAS unsigned long long*)(stg + kr * 80 + rq * 16 + h2 * 8); const unsigned w0 = (unsigned)w, w1 = (unsigned)(w >> 32);
                        O[dt][4 * rq] += pg8::bflo(w0); O[dt][4 * rq + 1] += pg8::bfhi(w0); O[dt][4 * rq + 2] += pg8::bflo(w1); O[dt][4 * rq + 3] += pg8::bfhi(w1); }
                    asm volatile("s_waitcnt lgkmcnt(0)" ::: "memory");
                }
            }
        }
        const float inv = 1.0f / lsum;
        bf16* ya = Qg + (rowbase + t0 + ra) * DM + hh * HD; bf16* yb = Qg + (rowbase + t0 + rb2) * DM + hh * HD;
#pragma unroll
        for (int dt = 0; dt < 4; ++dt) {
#pragma unroll
            for (int rq = 0; rq < 4; ++rq) { const unsigned long long w = (unsigned long long)cvtpk(O[dt][4 * rq] * inv, O[dt][4 * rq + 1] * inv) | ((unsigned long long)cvtpk(O[dt][4 * rq + 2] * inv, O[dt][4 * rq + 3] * inv) << 32);
                *(LAS unsigned long long*)(stg + kr * 80 + rq * 16 + h2 * 8) = w; }
            asm volatile("s_waitcnt lgkmcnt(0)" ::: "memory");
            const v4u ca = *(const LAS v4u*)(stg + ra * 80 + part * 16), cb2 = *(const LAS v4u*)(stg + rb2 * 80 + part * 16);
            if (variant) { asm volatile("" :: "v"(ca), "v"(cb2)); } else { *(GAS v4u*)(ya + dt * 32 + part * 8) = ca; *(GAS v4u*)(yb + dt * 32 + part * 8) = cb2; }
            asm volatile("s_waitcnt lgkmcnt(0)" ::: "memory");
        }
        OWN_QLOAD(ui < 3 ? ui + 1 : 3);
    }
#undef OWN_QLOAD
#undef OWN_KV
}
__device__ __forceinline__ void fix_rows2(const Args& a, int pmA, int pmB, int tid) {
    const float* SB = (const float*)(a.ws + WS_SB); const float* SU0 = (const float*)(a.ws + WS_SU0); const float* SG0 = (const float*)(a.ws + WS_SG0);
    bf16* ACT = (bf16*)(a.ws + WS_ACT); const float* cw = a.in[I_FCW]; const float* cb = a.in[I_FCB];
    const bool firstA = (pmA & 31) == 0, firstB = (pmB & 31) == 0;
    const int ppA = firstA ? pmA : pmA - 1, ppB = firstB ? pmB : pmB - 1;
    constexpr int NI = 2 * DFF / (NWAVES * 64);
    static_assert(NI * NWAVES * 64 == 2 * DFF && NI == 11, "");
#pragma unroll 1
    for (int hb = 0; hb < 2; ++hb) {
        const int i0 = hb * 6;
        float up0[2][6], gt[2][6], pl1[2][6], pl0[2][6], su[2][6], b0[6], w2[6], w1[6], w0[6];
#pragma unroll
        for (int i = 0; i < 6; ++i) { const int ii = (i0 + i < NI) ? i0 + i : NI - 1; const int e = tid + ii * (NWAVES * 64), r = e >= DFF ? 1 : 0, col = e - r * DFF;
            b0[i] = cb[col]; w2[i] = cw[2 * DFF + col]; w1[i] = cw[DFF + col]; w0[i] = cw[col];
#pragma unroll
            for (int q = 0; q < 2; ++q) { const int pm = q ? pmB : pmA, pp = q ? ppB : ppA;
                up0[q][i] = SU0[((size_t)pm * 2 + r) * DFF + col]; gt[q][i] = SG0[((size_t)pm * 2 + r) * DFF + col];
                pl1[q][i] = SB[((size_t)pp * 2 + 1) * DFF + col]; pl0[q][i] = SB[((size_t)pp * 2 + 0) * DFF + col]; su[q][i] = SU0[((size_t)pm * 2 + 0) * DFF + col]; } }
#pragma unroll
        for (int i = 0; i < 6; ++i) { const int ii = (i0 + i < NI) ? i0 + i : NI - 1; const int e = tid + ii * (NWAVES * 64), r = e >= DFF ? 1 : 0, col = e - r * DFF;
#pragma unroll
            for (int q = 0; q < 2; ++q) { const int pm = q ? pmB : pmA; const bool first = q ? firstB : firstA;
                const float p1 = first ? 0.f : pl1[q][i], p0 = first ? 0.f : pl0[q][i];
                const float x1 = (r == 0) ? p1 : su[q][i], x2 = (r == 0) ? p0 : p1;
                const float c = b0[i] + w2[i] * up0[q][i] + w1[i] * x1 + w0[i] * x2;
                ACT[((size_t)pm * 256 + r) * DFF + col] = (bf16)f2bf(pg8::gelu_tanh(c) * gt[q][i]); } }
    }
}

template <int PV> __global__ void __launch_bounds__(NWAVES * 64, 2) mk_fwd(Args args) {
    extern __shared__ __attribute__((aligned(16))) unsigned char lds_raw[];
    LAS unsigned char* lds = (LAS unsigned char*)lds_raw;
    volatile LAS unsigned* MISC = (volatile LAS unsigned*)(lds + MISC_OFF);
    const int tid = threadIdx.x, lane = tid & 63, wave = __builtin_amdgcn_readfirstlane(tid >> 6);
    const int G = gridDim.x; const int bx = blockIdx.x; const int vcu = (G % 8 == 0) ? (bx % 8) * (G / 8) + bx / 8 : bx;
    unsigned char* ws = args.ws;
    gu32* ctl = (gu32*)(ws + WS_CTL);
    for (int u = tid; u < (LDS_BYTES - 131072) / 4; u += NWAVES * 64) ((LAS unsigned*)(lds + 131072))[u] = 0u;
    __syncthreads();
    XcdBarrier bar; bar.bar = (unsigned*)(ctl + CW_BAR); bar.x = 0; bar.st = nullptr;
    if (MK_ONE_LAUNCH) bar = xcd_barrier_post((unsigned*)(ctl + CW_BAR), MISC + 8);
    const int lo = args.ph_lo, hi = args.ph_hi;
#ifndef WGM_G1
#define WGM_G1 4
#endif
#ifndef WGM_G5
#define WGM_G5 4
#endif
#ifndef PROBE_DUP
#define PROBE_DUP 0
#endif
#ifndef PROBE_VARIANT
#define PROBE_VARIANT 0
#endif
#define LAUNDER() int tid = wave * 64 + (int)__builtin_amdgcn_mbcnt_hi(~0u, __builtin_amdgcn_mbcnt_lo(~0u, 0u)); asm volatile("" : "+v"(tid)); const int lane = tid & 63; (void)lane
#ifndef PH_MASK
#define PH_MASK 0xffff
#endif
#define IN(k) (((PH_MASK >> (k)) & 1) && lo <= (k) && (k) < hi)
#define SEAM(k) do { if (IN(k) && IN((k) + 1)) xcd_barrier(bar, wave * 64 + pg8::lane_id_fresh() == 0); } while (0)
#define TABP ((LAS int*)(lds + 131072 + 512))
#define SEAMF(k, SDECL) do { if (IN(k) && IN((k) + 1)) xcd_barrier_with(bar, wave * 64 + pg8::lane_id_fresh() == 0, wave, [&]() { if (wave == 1) { SDECL; pg8::TableOrder::fill_wave(S, TABP); } }); } while (0)
#define TSGET(kprev) pg8::TableOrder TS; if (IN(kprev) && IN((kprev) + 1)) TS.attach(TABP); else TS.fill(S, TABP, tid)
    const int gw = vcu * NWAVES + wave, NGW = G * NWAVES;
    bf16* XN = (bf16*)(ws + WS_XN); bf16* XR = (bf16*)(ws + WS_XR); bf16* GR = (bf16*)(ws + WS_GR);
    bf16* Qb = (bf16*)(ws + WS_Q); bf16* Kb = (bf16*)(ws + WS_K); bf16* Vb = (bf16*)(ws + WS_V);
    bf16* GA = (bf16*)args.out; bf16* GB = (bf16*)((unsigned char*)args.out + 32 * MiB); bf16* YA = (bf16*)((unsigned char*)args.out + 64 * MiB);

    const bool defer = IN(0) && IN(1) && IN(2) && IN(3) && IN(4) && (G == 256);
    if (IN(0)) { LAUNDER(); p0_prologue(args, lds, gw, NGW, wave, lane, defer); }
    if (IN(0) && IN(1)) xcd_barrier_with(bar, wave * 64 + pg8::lane_id_fresh() == 0, wave, [&]() { if (wave == 1) { pg8::StaticOrder S; S.init(M, DIN, G, bx, WGM_G1); pg8::TableOrder::fill_wave(S, TABP); } if (defer) p0_late_item(args, lds, vcu, wave, 0); });
    if (IN(1)) { LAUNDER();
        pg8::Gemm g{XN, (const bf16*)(ws + WS_WIN), M, DIN, DM, nullptr, nullptr}; pg8::StaticOrder S; S.init(M, DIN, G, bx, WGM_G1);
        pg8::EpiG1 E{ws, (unsigned char*)args.out, args.in[I_QNG], args.in[I_KNG], (LAS float*)(lds + 131072 + 1024), QSCALE, PV};
        TSGET(0); pg8::gemm_phase<pg8::EpiG1, pg8::TableOrder, true, true>(lds, g, TS, E, wave); }
    if (IN(1) && IN(2)) { if (defer) xcd_barrier_with(bar, wave * 64 + pg8::lane_id_fresh() == 0, wave, [&]() { p0_late_item(args, lds, vcu, wave, 1); }); else xcd_barrier(bar, wave * 64 + pg8::lane_id_fresh() == 0); }
    if (IN(3)) { LAUNDER(); gate_prologue(args, lds, vcu, wave); rnn_phase(args, lds, G, wave, lane, tid, PV, [&](int it) { gate_unit(args, lds, vcu, wave, it); if (it == 3) gate_count(args, lds, vcu, wave, PV); }); gate_finish(args, lds, vcu, wave, PV); }
    if (IN(3) && IN(4)) { if (defer) xcd_barrier_with(bar, wave * 64 + pg8::lane_id_fresh() == 0, wave, [&]() { p0_late_item(args, lds, vcu, wave, 2); }); else xcd_barrier(bar, wave * 64 + pg8::lane_id_fresh() == 0); }
    if (IN(6)) { LAUNDER(); sparse_phase(args, lds, G, wave, lane, tid, PV); }
    if (IN(7)) { LAUNDER(); own_phase(args, lds, vcu, wave, lane, tid, PV, (IN(6) && IN(7)) ? &bar : nullptr); } SEAMF(7, pg8::DualOrder S; S.init(M, DM, G, bx));
    if (IN(8)) { LAUNDER(); pg8::Gemm g{YA, (const bf16*)(ws + WS_PA), M, DM, DM, Qb  , (const bf16*)(ws + WS_PB)}; pg8::DualOrder S; S.init(M, DM, G, bx);
        pg8::EpiG3 E{ws, (const unsigned char*)args.out};
        TSGET(7); pg8::gemm_phase<pg8::EpiG3, pg8::TableOrder, false, true>(lds, g, TS, E, wave); } SEAMF(8, pg8::StaticOrder S; S.init(M, DM, G, bx));
    if (IN(10)) { LAUNDER();
        pg8::Gemm g{Kb  , (const bf16*)(ws + WS_WOUT), M, DM, DM, nullptr, nullptr}; pg8::StaticOrder S; S.init(M, DM, G, bx);
        pg8::EpiX1 E{ws, (LAS float*)(lds + 131072 + 1024)};
        TSGET(8); pg8::gemm_phase<pg8::EpiX1, pg8::TableOrder, true, true>(lds, g, TS, E, wave); } SEAMF(10, pg8::StaticOrder S; S.init(M, 2 * DFF, G, bx, WGM_G5));
    if (IN(12)) { LAUNDER(); pg8::Gemm g{XN  , (const bf16*)(ws + WS_WUG), M, 2 * DFF, DM, nullptr, nullptr}; pg8::StaticOrder S; S.init(M, 2 * DFF, G, bx, WGM_G5);
        pg8::EpiUGF E{ws, args.in[I_FCW], args.in[I_FCB], (LAS float*)(lds + 131072 + 1024), PV};
        TSGET(10); pg8::gemm_phase<pg8::EpiUGF, pg8::TableOrder, true, true>(lds, g, TS, E, wave); } SEAMF(12, pg8::StaticOrder S; S.init(M, DM, G, bx));
    if (IN(14)) { LAUNDER(); pg8::Gemm g{(const bf16*)(ws + WS_ACT), (const bf16*)(ws + WS_WDN), M, DM, DFF, nullptr, nullptr}; pg8::StaticOrder S; S.init(M, DM, G, bx);
        { pg8::Unit fu; int i = 0; while (S.next(i, fu)) { const int pa = fu.pm; int pb = pa; if (S.next(i + 1, fu)) pb = fu.pm; fix_rows2(args, pa, pb, tid); i += 2; } asm volatile("s_waitcnt vmcnt(0)" ::: "memory"); __syncthreads(); }
        pg8::EpiOut E{ws, args.out};
        TSGET(12); pg8::gemm_phase<pg8::EpiOut, pg8::TableOrder, false, true>(lds, g, TS, E, wave); }
#undef IN
#undef SEAM
#undef SEAMF
#undef TSGET
#undef TABP
}

extern "C" void kernel_launch(void* const* d_in, const int* in_sizes, int n_in, void* d_out, int out_size, void* d_ws, size_t ws_size, hipStream_t stream) {
    static int grid = 0;
    if (grid == 0) {
        if (n_in != 21 || out_size != M * DM || ws_size < WS_END) { fprintf(stderr, "kernel_launch: unexpected shapes: n_in %d out %d ws %zu\n", n_in, out_size, ws_size); grid = -1; return; }
        int dev = 0, cus = 0;
        if (hipGetDevice(&dev) != hipSuccess || hipDeviceGetAttribute(&cus, hipDeviceAttributeMultiprocessorCount, dev) != hipSuccess) { grid = -1; return; }
        if (hipFuncSetAttribute((const void*)mk_fwd<0>, hipFuncAttributeMaxDynamicSharedMemorySize, LDS_BYTES) != hipSuccess || (PROBE_VARIANT && hipFuncSetAttribute((const void*)mk_fwd<PROBE_VARIANT>, hipFuncAttributeMaxDynamicSharedMemorySize, LDS_BYTES) != hipSuccess)) { fprintf(stderr, "kernel_launch: hipFuncSetAttribute failed\n"); grid = -1; return; }
        int per_cu = 0;
        if (hipOccupancyMaxActiveBlocksPerMultiprocessor(&per_cu, (const void*)mk_fwd<0>, NWAVES * 64, LDS_BYTES) != hipSuccess || per_cu < 1) fprintf(stderr, "kernel_launch: occupancy query says %d\n", per_cu);
        (void)hipGetLastError();
        grid = cus;
    }
    if (grid < 0) return;
    (void)hipMemsetAsync((char*)d_ws + WS_CTL, 0, CTL_ZERO_BYTES, stream);
    Args a{};
    for (int i = 0; i < 21; ++i) a.in[i] = (const float*)d_in[i];
    a.out = (float*)d_out; a.ws = (unsigned char*)d_ws;
#if MK_ONE_LAUNCH
    a.ph_lo = 0; a.ph_hi = NPHASE; a.li = 0;
    hipLaunchKernelGGL(mk_fwd<0>, dim3(grid), dim3(NWAVES * 64), LDS_BYTES, stream, a);
#else
    for (int p = 0; p < NPHASE; ++p) { a.ph_lo = p; a.ph_hi = p + 1; a.li = p; const int reps = ((PROBE_DUP >> p) & 1) ? 2 : 1;
        for (int r = 0; r < reps; ++r) { if (r && PROBE_VARIANT) hipLaunchKernelGGL(mk_fwd<PROBE_VARIANT>, dim3(grid), dim3(NWAVES * 64), LDS_BYTES, stream, a); else hipLaunchKernelGGL(mk_fwd<0>, dim3(grid), dim3(NWAVES * 64), LDS_BYTES, stream, a); } }
#endif
}
```
